# Optimizing an MI355X kernel written in HIP

```python
import math
import jax, jax.numpy as jnp
from jax import lax
import numpy as np

D_MODEL = 1024
BATCH = 8
SEQ = 4096
DEPTH = 4

CTX_LEN = 256
GRID_W = 64
HEAD_DIM = 64
ROPE_BASE = 10000.0
EPS = 1e-6
BLOCK = 128
DIFF_HEADS = D_MODEL // (2 * HEAD_DIM)
DIFF_V_DIM = 2 * HEAD_DIM
HY_WIDTH = D_MODEL
HY_BANDS = 16
HY_EMB_DIM = 1 + 2 * HY_BANDS
HY_FF = 64
HY_FAST_DECAY = 0.3
HY_SLOW_DECAY = 1.5
HY_TARGET = 1e-2
SHORT_CONV = 3
SWA_Q_HEADS = D_MODEL // HEAD_DIM
SWA_KV_HEADS = 4
SWA_GROUP = SWA_Q_HEADS // SWA_KV_HEADS
WINDOW = 128
N_BRANCH = 3
N_EXPERTS = 16
D_EXPERT = 1024
CAPACITY_FACTOR = 2
IN_WIDTHS = (DIFF_HEADS * 2 * HEAD_DIM, DIFF_HEADS * 2 * HEAD_DIM, DIFF_HEADS * DIFF_V_DIM,
             3 * HY_WIDTH, SWA_Q_HEADS * HEAD_DIM, SWA_KV_HEADS * HEAD_DIM, SWA_KV_HEADS * HEAD_DIM,
             N_BRANCH * D_MODEL)
D_IN = sum(IN_WIDTHS)

kernel_name = "hybrid_diffattn_hyena_swa_ecmoe_dit"


def rmsnorm(x, g):
    x32 = x.astype(jnp.float32)
    y = x32 * lax.rsqrt(jnp.mean(x32 * x32, axis=-1, keepdims=True) + EPS)
    return y.astype(x.dtype) * g


def modulate(h, shift, scale):
    return h * (1 + scale) + shift


def split_in(proj):
    offs, acc = [], 0
    for w in IN_WIDTHS[:-1]:
        acc += w
        offs.append(acc)
    return jnp.split(proj, offs, axis=-1)


def axial_rope(n_tok, dtype):
    rows = n_tok // GRID_W
    row = jnp.broadcast_to(jnp.arange(rows, dtype=jnp.float32)[:, None], (rows, GRID_W)).reshape(-1)
    col = jnp.broadcast_to(jnp.arange(GRID_W, dtype=jnp.float32)[None, :], (rows, GRID_W)).reshape(-1)
    n_freq = HEAD_DIM // 4
    inv = ROPE_BASE ** (-jnp.arange(n_freq, dtype=jnp.float32) / n_freq)
    ang = jnp.stack([row[:, None] * inv, col[:, None] * inv], axis=1)
    return jnp.cos(ang).astype(dtype), jnp.sin(ang).astype(dtype)


def apply_rope(x, cos, sin):
    shape = x.shape
    xr = x.reshape(shape[:-1] + (2, 2, HEAD_DIM // 4))
    bshape = (shape[1],) + (1,) * (x.ndim - 3) + (2, HEAD_DIM // 4)
    c, s = cos.reshape(bshape), sin.reshape(bshape)
    x1, x2 = xr[..., 0, :], xr[..., 1, :]
    return jnp.stack([x1 * c - x2 * s, x2 * c + x1 * s], axis=-2).reshape(shape)


def diff_attend(q, k, v, lam):
    s = jnp.einsum('bqhmd,bkhmd->bhmqk', q, k).astype(jnp.float32) * HEAD_DIM ** -0.5
    a = jax.nn.softmax(s, axis=-1)
    w = a[:, :, 0] - lam * a[:, :, 1]
    return jnp.einsum('bhqk,bkhe->bqhe', w.astype(v.dtype), v)


def diff_latent(q, k_all, v_all, lam):
    B, L = q.shape[:2]
    nb = L // BLOCK
    qb = jnp.moveaxis(q.reshape((B, nb, BLOCK) + q.shape[2:]), 1, 0)
    o = lax.map(lambda qi: diff_attend(qi, k_all, v_all, lam), qb)
    return jnp.moveaxis(o, 0, 1).reshape(B, L, DIFF_HEADS, DIFF_V_DIM)


def diff_post(o, g, lambda_init):
    return (rmsnorm(o, g) * (1.0 - lambda_init)).reshape(o.shape[0], o.shape[1], -1)


def short_conv(u, w, b):
    L = u.shape[1]
    up = jnp.pad(u, ((0, 0), (SHORT_CONV // 2, SHORT_CONV // 2), (0, 0)))
    return sum(up[:, j:j + L] * w[j] for j in range(SHORT_CONV)) + b


def hyena_filter(L, p):
    f32 = jnp.float32
    t = jnp.linspace(0.0, 1.0, L, dtype=f32)[:, None]
    w = 2.0 * math.pi * jnp.arange(L, dtype=f32)[:, None] / L
    f = jnp.linspace(1e-4, HY_BANDS - 1, HY_BANDS, dtype=f32)[None, :]
    emb = jnp.concatenate([t, jnp.cos(f * w), -jnp.sin(f * w)], axis=-1)
    freq = p['hy_sin_freq'].astype(f32)
    z = jnp.sin(freq * (emb @ p['hy_ff_w1'].astype(f32) + p['hy_ff_b1'].astype(f32)))
    z = jnp.sin(freq * (z @ p['hy_ff_w2'].astype(f32) + p['hy_ff_b2'].astype(f32)))
    h = (z @ p['hy_ff_w3'].astype(f32)).reshape(L, 2, HY_WIDTH)
    deltas = jnp.abs(jnp.linspace(math.log(HY_TARGET) / HY_FAST_DECAY,
                                  math.log(HY_TARGET) / HY_SLOW_DECAY, HY_WIDTH, dtype=f32))
    h = h * jnp.exp(-t * deltas)[:, None, :]
    return h / (jnp.sum(jnp.abs(h), axis=(0, 1), keepdims=True) + EPS)


def fft_long_conv(u, h, bias):
    L = u.shape[1]
    k = jnp.concatenate([h[:, 0], jnp.zeros((1, HY_WIDTH), jnp.float32), h[:0:-1, 1]], axis=0)
    u32 = u.astype(jnp.float32)
    uf = jnp.fft.rfft(u32, n=2 * L, axis=1)
    kf = jnp.fft.rfft(k, n=2 * L, axis=0)
    y = jnp.fft.irfft(uf * kf[None], n=2 * L, axis=1)[:, :L]
    return (y + u32 * bias.astype(jnp.float32)).astype(u.dtype)


def hyena(u_in, p):
    L = u_in.shape[1]
    u = short_conv(u_in, p['hy_conv_w'], p['hy_conv_b'])
    x0, x1, v = jnp.split(u, 3, axis=-1)
    return x0 * fft_long_conv(x1 * v, hyena_filter(L, p), p['hy_bias'])


def attend_sink(q, ks, vs, masks, sink):
    B, Lq = q.shape[:2]
    parts = []
    for k, m in zip(ks, masks):
        s = jnp.einsum('bqhgd,bkhd->bhgqk', q, k).astype(jnp.float32) * HEAD_DIM ** -0.5
        parts.append(s if m is None else jnp.where(m, s, -jnp.inf))
    sink_col = jnp.broadcast_to(sink.astype(jnp.float32)[None, :, :, None, None],
                                (B, SWA_KV_HEADS, SWA_GROUP, Lq, 1))
    pr = jax.nn.softmax(jnp.concatenate(parts + [sink_col], axis=-1), axis=-1)
    out, off = 0, 0
    for v in vs:
        n = v.shape[1]
        out = out + jnp.einsum('bhgqk,bkhd->bqhgd', pr[..., off:off + n].astype(v.dtype), v)
        off += n
    return out


def swa_latent(q, k, v, kc, vc, sink):
    B, L = q.shape[:2]
    nb = L // BLOCK
    pad = ((0, 0), (BLOCK, BLOCK), (0, 0), (0, 0))
    kp, vp = jnp.pad(k, pad), jnp.pad(v, pad)

    def block(i):
        start = i * BLOCK
        qb = lax.dynamic_slice_in_dim(q, start, BLOCK, axis=1)
        kb = lax.dynamic_slice_in_dim(kp, start, 3 * BLOCK, axis=1)
        vb = lax.dynamic_slice_in_dim(vp, start, 3 * BLOCK, axis=1)
        q_pos = start + jnp.arange(BLOCK)
        k_pos = start - BLOCK + jnp.arange(3 * BLOCK)
        valid = ((jnp.abs(k_pos[None, :] - q_pos[:, None]) <= WINDOW)
                 & (k_pos >= 0)[None, :] & (k_pos < L)[None, :])
        return attend_sink(qb, [kb, kc], [vb, vc], [valid, None], sink)

    o = lax.map(block, jnp.arange(nb))
    return jnp.moveaxis(o, 0, 1).reshape(B, L, SWA_Q_HEADS * HEAD_DIM)


def merge(ys, gate_pre, p):
    gates = jax.nn.sigmoid(gate_pre.astype(jnp.float32)).astype(gate_pre.dtype)
    gs = jnp.split(gates, N_BRANCH, axis=-1)
    merged = sum(gs[b] * (ys[b] @ p['w_branch'][b]) for b in range(N_BRANCH))
    return merged @ p['w_out']


def token_mixer(h, hc, p, lambda_init, ctx_out):
    B, L, _ = h.shape
    Lc = hc.shape[1]
    dq, dk, dv, hy, sq, sk, sv, gt = split_in(h @ p['w_in'])
    dqc, dkc, dvc, hyc, sqc, skc, svc, gtc = split_in(hc @ p['w_in'])
    cos, sin = axial_rope(L, h.dtype)
    lp = p['diff_lambda'].astype(jnp.float32)
    lam = jnp.exp(jnp.sum(lp[0] * lp[1])) - jnp.exp(jnp.sum(lp[2] * lp[3])) + lambda_init
    qk_shape = (DIFF_HEADS, 2, HEAD_DIM)
    q = apply_rope(dq.reshape((B, L) + qk_shape), cos, sin)
    k = apply_rope(dk.reshape((B, L) + qk_shape), cos, sin)
    v = dv.reshape(B, L, DIFF_HEADS, DIFF_V_DIM)
    kc = dkc.reshape((B, Lc) + qk_shape)
    vc = dvc.reshape(B, Lc, DIFF_HEADS, DIFF_V_DIM)
    y_diff = diff_post(diff_latent(q, jnp.concatenate([k, kc], axis=1), jnp.concatenate([v, vc], axis=1), lam),
                       p['diff_subln_g'], lambda_init)
    y_hy = hyena(hy, p)
    sink = p['swa_sink'].reshape(SWA_KV_HEADS, SWA_GROUP)
    s_q = apply_rope(sq.reshape(B, L, SWA_KV_HEADS, SWA_GROUP, HEAD_DIM), cos, sin)
    s_k = apply_rope(sk.reshape(B, L, SWA_KV_HEADS, HEAD_DIM), cos, sin)
    s_v = sv.reshape(B, L, SWA_KV_HEADS, HEAD_DIM)
    s_kc = skc.reshape(B, Lc, SWA_KV_HEADS, HEAD_DIM)
    s_vc = svc.reshape(B, Lc, SWA_KV_HEADS, HEAD_DIM)
    y_swa = swa_latent(s_q, s_k, s_v, s_kc, s_vc, sink)
    y = merge([y_diff, y_hy, y_swa], gt, p)
    if not ctx_out:
        return y, None
    qc = dqc.reshape((B, Lc) + qk_shape)
    yc_diff = diff_post(diff_attend(qc, kc, vc, lam), p['diff_subln_g'], lambda_init)
    yc_hy = hyena(hyc, p)
    yc_swa = attend_sink(sqc.reshape(B, Lc, SWA_KV_HEADS, SWA_GROUP, HEAD_DIM), [s_kc], [s_vc], [None],
                         sink).reshape(B, Lc, SWA_Q_HEADS * HEAD_DIM)
    yc = merge([yc_diff, yc_hy, yc_swa], gtc, p)
    return y, yc


def ec_moe(h, p):
    B, N, D = h.shape
    cap = CAPACITY_FACTOR * N // N_EXPERTS
    logits = jnp.einsum('bnd,de->bne', h, p['router_w']).astype(jnp.float32)
    aff = jax.nn.softmax(logits, axis=-1)
    g, idx = lax.top_k(jnp.swapaxes(aff, 1, 2), cap)
    flat = idx.reshape(B, N_EXPERTS * cap)
    xg = jnp.take_along_axis(h, flat[:, :, None], axis=1).reshape(B, N_EXPERTS, cap, D)
    a = jnp.einsum('becd,edf->becf', xg, p['moe_w1'])
    b = jnp.einsum('becd,edf->becf', xg, p['moe_w3'])
    y = jnp.einsum('becf,efd->becd', jax.nn.silu(a) * b, p['moe_w2']) * g[..., None].astype(h.dtype)
    return jnp.zeros_like(h).at[jnp.arange(B)[:, None], flat].add(y.reshape(B, N_EXPERTS * cap, D))


def _layer(x, xc, sc, sc_ctx, p, lambda_init, ctx_out):
    mod = jnp.split((sc @ p['w_mod'] + p['b_mod'])[:, None, :], 6, axis=-1)
    modc = jnp.split(sc_ctx @ p['w_mod'] + p['b_mod'], 6, axis=-1)
    h = modulate(rmsnorm(x, p['norm1_g']), mod[0], mod[1])
    hc = modulate(rmsnorm(xc, p['norm1_g']), modc[0], modc[1])
    y, yc = token_mixer(h, hc, p, lambda_init, ctx_out)
    x = x + mod[2] * y
    h2 = modulate(rmsnorm(x, p['norm2_g']), mod[3], mod[4])
    x = x + mod[5] * ec_moe(h2, p)
    if ctx_out:
        xc = xc + modc[2] * yc
        h2c = modulate(rmsnorm(xc, p['norm2_g']), modc[3], modc[4])
        xc = xc + modc[5] * ec_moe(h2c, p)
    return x, xc


def setup_inputs(seed: int = 0) -> dict:
    key = jax.random.key(seed)
    ks = jax.random.split(key, 28)
    D, L = D_MODEL, DEPTH

    def nrm(k, shape, s):
        return jax.random.normal(k, shape, jnp.float32) * s

    return {
        'x': nrm(ks[0], (BATCH, SEQ, D), 1.0),
        'c': nrm(ks[1], (BATCH, D), 1.0),
        'ctx': nrm(ks[2], (BATCH, CTX_LEN, D), 1.0),
        'c_ctx': nrm(ks[3], (D,), 1.0),
        'w_mod': nrm(ks[4], (L, D, 6 * D), 0.5 * D ** -0.5),
        'b_mod': nrm(ks[5], (L, 6 * D), 0.02),
        'norm1_g': 1.0 + nrm(ks[6], (L, D), 0.02),
        'norm2_g': 1.0 + nrm(ks[7], (L, D), 0.02),
        'w_in': nrm(ks[8], (L, D, D_IN), D ** -0.5),
        'diff_lambda': nrm(ks[9], (L, 4, HEAD_DIM), 0.1),
        'diff_subln_g': 1.0 + nrm(ks[10], (L, DIFF_V_DIM), 0.02),
        'hy_conv_w': nrm(ks[11], (L, SHORT_CONV, 3 * HY_WIDTH), SHORT_CONV ** -0.5),
        'hy_conv_b': nrm(ks[12], (L, 3 * HY_WIDTH), 0.02),
        'hy_ff_w1': nrm(ks[13], (L, HY_EMB_DIM, HY_FF), HY_EMB_DIM ** -0.5),
        'hy_ff_b1': nrm(ks[14], (L, HY_FF), 0.02),
        'hy_ff_w2': nrm(ks[15], (L, HY_FF, HY_FF), HY_FF ** -0.5),
        'hy_ff_b2': nrm(ks[16], (L, HY_FF), 0.02),
        'hy_ff_w3': nrm(ks[17], (L, HY_FF, 2 * HY_WIDTH), HY_FF ** -0.5),
        'hy_sin_freq': 1.0 + nrm(ks[18], (L, HY_FF), 0.02),
        'hy_bias': nrm(ks[19], (L, HY_WIDTH), 1.0),
        'swa_sink': nrm(ks[20], (L, SWA_Q_HEADS), 0.5),
        'w_branch': nrm(ks[21], (L, N_BRANCH, D, D), D ** -0.5),
        'w_out': nrm(ks[22], (L, D, D), D ** -0.5),
        'router_w': nrm(ks[23], (L, D, N_EXPERTS), D ** -0.5),
        'moe_w1': nrm(ks[24], (L, N_EXPERTS, D, D_EXPERT), D ** -0.5),
        'moe_w3': nrm(ks[25], (L, N_EXPERTS, D, D_EXPERT), D ** -0.5),
        'moe_w2': nrm(ks[26], (L, N_EXPERTS, D_EXPERT, D), D_EXPERT ** -0.5),
        'final_g': 1.0 + nrm(ks[27], (D,), 0.02),
    }


def reference(x, c, ctx, c_ctx, w_mod, b_mod, norm1_g, norm2_g, w_in, diff_lambda, diff_subln_g,
              hy_conv_w, hy_conv_b, hy_ff_w1, hy_ff_b1, hy_ff_w2, hy_ff_b2, hy_ff_w3, hy_sin_freq,
              hy_bias, swa_sink, w_branch, w_out, router_w, moe_w1, moe_w3, moe_w2, final_g):
    sc = jax.nn.silu(c)
    sc_ctx = jax.nn.silu(c_ctx)
    xc = ctx
    for l in range(DEPTH):
        p = {'w_mod': w_mod[l], 'b_mod': b_mod[l], 'norm1_g': norm1_g[l], 'norm2_g': norm2_g[l],
             'w_in': w_in[l], 'diff_lambda': diff_lambda[l], 'diff_subln_g': diff_subln_g[l],
             'hy_conv_w': hy_conv_w[l], 'hy_conv_b': hy_conv_b[l], 'hy_ff_w1': hy_ff_w1[l],
             'hy_ff_b1': hy_ff_b1[l], 'hy_ff_w2': hy_ff_w2[l], 'hy_ff_b2': hy_ff_b2[l],
             'hy_ff_w3': hy_ff_w3[l], 'hy_sin_freq': hy_sin_freq[l], 'hy_bias': hy_bias[l],
             'swa_sink': swa_sink[l], 'w_branch': w_branch[l], 'w_out': w_out[l],
             'router_w': router_w[l], 'moe_w1': moe_w1[l], 'moe_w3': moe_w3[l], 'moe_w2': moe_w2[l]}
        lambda_init = 0.8 - 0.6 * math.exp(-0.3 * l)
        x, xc = _layer(x, xc, sc, sc_ctx, p, lambda_init, l < DEPTH - 1)
    return rmsnorm(x, final_g)
```

```cpp
#define MK_N_LAUNCHES 1
#include <hip/hip_runtime.h>
#include <cstdio>
#include <cstdint>

#ifndef MK_N_LAUNCHES
#define MK_N_LAUNCHES 1
#endif
#ifndef MK_CHECK
#define MK_CHECK 0
#endif

#define LAS __attribute__((address_space(3)))
#define GAS __attribute__((address_space(1)))
typedef unsigned short bf16_t;
typedef short bf16x8 __attribute__((ext_vector_type(8)));
typedef short s16x4 __attribute__((ext_vector_type(4)));
typedef float f32x2 __attribute__((ext_vector_type(2)));
typedef float f32x4 __attribute__((ext_vector_type(4)));
typedef float f32x16 __attribute__((ext_vector_type(16)));
typedef unsigned u32x2 __attribute__((ext_vector_type(2)));
typedef unsigned u32x4 __attribute__((ext_vector_type(4)));
typedef GAS unsigned gu32;
#define RLX_AGENT __ATOMIC_RELAXED, __HIP_MEMORY_SCOPE_AGENT
#define LDS_WAIT() asm volatile("s_waitcnt lgkmcnt(0)" ::: "memory")
#define VM_WAIT() asm volatile("s_waitcnt vmcnt(0)" ::: "memory")

constexpr int NB = 8, LS = 4096, LC = 256, LT = LS + LC;
constexpr int TROWS = NB * LT;
constexpr int D = 1024, DIN = 10752, DEPTH = 4, NEXP = 16;
constexpr int CAP_L = 512, CAP_C = 32;
constexpr int SLOT_L = NEXP * NB * CAP_L, SLOT_C = NEXP * NB * CAP_C, SLOTS = SLOT_L + SLOT_C;
constexpr float EPS = 1e-6f;
constexpr float LOG2E = 1.4426950408889634f;
constexpr float QSCALE = 0.125f * LOG2E;

__device__ __forceinline__ unsigned f2bf(float f) { unsigned u = __builtin_bit_cast(unsigned, f); return (u + 0x7fffu + ((u >> 16) & 1u)) >> 16; }
__device__ __forceinline__ unsigned pk2(float lo, float hi) { return f2bf(lo) | (f2bf(hi) << 16); }
__device__ __forceinline__ float bf2f(unsigned v) { return __builtin_bit_cast(float, v << 16); }
__device__ __forceinline__ float bflo(unsigned w) { return __builtin_bit_cast(float, w << 16); }
__device__ __forceinline__ float bfhi(unsigned w) { return __builtin_bit_cast(float, w & 0xffff0000u); }
typedef __bf16 bf16x2_t __attribute__((ext_vector_type(2)));
__device__ __forceinline__ unsigned cvtpk(float lo, float hi) { f32x2 v = {lo, hi}; bf16x2_t b = __builtin_convertvector(v, bf16x2_t); return __builtin_bit_cast(unsigned, b); }
__device__ __forceinline__ float wave_sum(float v) {
#pragma unroll
    for (int o = 1; o < 64; o <<= 1) v += __shfl_xor(v, o);
    return v;
}
__device__ __forceinline__ float sin_rev(float rev) { return __builtin_amdgcn_sinf(__builtin_amdgcn_fractf(rev)); }
__device__ __forceinline__ float cos_rev(float rev) { return __builtin_amdgcn_cosf(__builtin_amdgcn_fractf(rev)); }
__device__ __forceinline__ float sin_rad(float x) { return sin_rev(x * 0.15915494309189535f); }
__device__ __forceinline__ float fast_exp(float x) { return __builtin_amdgcn_exp2f(x * LOG2E); }
__device__ __forceinline__ float sigmoidf_(float x) { return __builtin_amdgcn_rcpf(1.0f + fast_exp(-x)); }

constexpr size_t SZ1K = (size_t)TROWS * 1024 * 2;
constexpr size_t OFF_PROJ = (size_t)353 << 20;
constexpr size_t OFF_DQ = OFF_PROJ, OFF_DK = OFF_DQ + SZ1K, OFF_DV = OFF_DK + SZ1K, OFF_HY = OFF_DV + SZ1K, OFF_SQ = OFF_HY + 3 * SZ1K, OFF_SK = OFF_SQ + SZ1K, OFF_SV = OFF_SK + SZ1K / 4, OFF_GT = OFF_SV + SZ1K / 4;
constexpr size_t OFF_YHY = OFF_HY + ((size_t)64 << 20);

namespace pg8 {
constexpr int BM = 256, BK = 64, HALF = 128, HTB = HALF * BK * 2, STAGE_BYTES = 8 * HTB, NXCD = 8, WGM = 8;
__host__ __device__ __forceinline__ int lds_byte(int r, int c) { const int st = (r >> 4) * 2 + (c >> 5), rr = r & 15, cc = c & 31, ob = rr * 64 + cc * 2; return st * 1024 + (ob ^ (((ob >> 9) & 1) << 5)); }
__host__ __device__ __forceinline__ void stage_rc(int b, int& R, int& C) { const int st = b / 1024, sb = b % 1024, swz = sb ^ (((sb >> 9) & 1) << 5); R = (st >> 1) * 16 + swz / 64; C = (st & 1) * 32 + (swz % 64) / 2; }
__host__ __device__ __forceinline__ int perm32(int rho) { const int n = rho >> 4, i = rho & 15; return 8 * (i >> 2) + 4 * n + (i & 3); }

struct Unit { int pm, pn, aux; const char* A; const char* B; };

struct TileOrder {
    int nM, nN, nwg;
    __device__ __forceinline__ void init(int nM_, int nN_) { nM = nM_; nN = nN_; nwg = nM * nN; }
    __device__ __forceinline__ void map(int L, int& pm, int& pn) const {
        int wgid = L; { const int q = nwg / NXCD, r = nwg % NXCD, xcd = wgid % NXCD, off = wgid / NXCD; wgid = (xcd < r ? xcd * (q + 1) : r * (q + 1) + (xcd - r) * q) + off; }
        const int nig = WGM * nN, gid = wgid / nig, fm = gid * WGM, gsz = (nM - fm) < WGM ? (nM - fm) : WGM;
        pm = fm + ((wgid % nig) % gsz); pn = (wgid % nig) / gsz;
    }
};

template <class Epi, class Sched>
__device__ __forceinline__ void gemm_phase(LAS unsigned char* lds, const int K, const Sched& S, const Epi& E) {
    int tid_ = threadIdx.x; asm volatile("" : "+v"(tid_));
    const int tid = tid_, wid = __builtin_amdgcn_readfirstlane(tid >> 6), lane = tid & 63, wr = wid >> 2, wc = wid & 3, fr = lane & 15, fq = lane >> 4;
    const int nt = K / BK;
    unsigned voffA[2], voffB[2];
#pragma unroll
    for (int i = 0; i < 2; ++i) { int R, C; stage_rc(tid * 16 + i * 8192, R, C); const int Rb = Epi::PERM ? ((R & ~31) + perm32(R & 31)) : R;
        voffA[i] = (unsigned)(R * K + C) * 2u; voffB[i] = (unsigned)(Rb * K + C) * 2u; }
    const size_t kstep = (size_t)(BK * 2);
    const size_t hstep = (size_t)HALF * K * 2;
    const unsigned ldsw = (unsigned)wid * 1024u;
    const int aoff = lds_byte(wr * 64 + fr, fq * 8), boff = lds_byte(wc * 32 + fr, fq * 8);
#define PG8_SA(b, h) (((b) * 2 + (h)) * HTB)
#define PG8_SB(b, h) ((4 + (b) * 2 + (h)) * HTB)
#define PG8_STAGE(bufoff, gbase, voff) do { _Pragma("unroll") for (int _i = 0; _i < 2; ++_i) \
        __builtin_amdgcn_global_load_lds((const unsigned*)((const char*)(gbase) + (voff)[_i]), (LAS unsigned*)(lds + (bufoff) + ldsw + _i * 8192), 16, 0, 0); } while (0)
#define PG8_LDA(dst, b, h) do { _Pragma("unroll") for (int m = 0; m < 4; ++m) _Pragma("unroll") for (int k = 0; k < 2; ++k) dst[m][k] = *(const LAS bf16x8*)(lds + PG8_SA(b, h) + aoff + m * 2048 + k * 1024); } while (0)
#define PG8_LDB(dst, b, h) do { _Pragma("unroll") for (int n = 0; n < 2; ++n) _Pragma("unroll") for (int k = 0; k < 2; ++k) dst[n][k] = *(const LAS bf16x8*)(lds + PG8_SB(b, h) + boff + n * 2048 + k * 1024); } while (0)
#define PG8_MMA(ai, bj, At, Bt) do { __builtin_amdgcn_s_setprio(1); _Pragma("unroll") for (int m = 0; m < 4; ++m) _Pragma("unroll") for (int n = 0; n < 2; ++n) _Pragma("unroll") for (int k = 0; k < 2; ++k) \
        acc[ai][bj][m][n] = __builtin_amdgcn_mfma_f32_16x16x32_bf16(Bt[n][k], At[m][k], acc[ai][bj][m][n], 0, 0, 0); __builtin_amdgcn_s_setprio(0); } while (0)
#define PG8_WAIT_V(n) asm volatile("s_waitcnt vmcnt(" #n ")" ::: "memory")
#define PG8_WAIT_L(n) asm volatile("s_waitcnt lgkmcnt(" #n ")" ::: "memory")
#define PG8_BAR __builtin_amdgcn_s_barrier()
#define PG8_SCHED __builtin_amdgcn_sched_barrier(0)
    Unit cur, nxt; int ui = 0;
    if (!S.next(0, cur)) return;
    f32x4 acc[2][2][4][2];
#pragma unroll
    for (int a = 0; a < 2; ++a)
#pragma unroll
        for (int b = 0; b < 2; ++b)
#pragma unroll
            for (int m = 0; m < 4; ++m)
#pragma unroll
                for (int n = 0; n < 2; ++n) acc[a][b][m][n] = (f32x4){0.f, 0.f, 0.f, 0.f};
    bf16x8 At[4][2], B0[2][2], B1[2][2];
    const char* cA = cur.A; const char* cB = cur.B;
    PG8_STAGE(PG8_SB(0, 0), cB, voffB); PG8_STAGE(PG8_SB(0, 1), cB + hstep, voffB); PG8_STAGE(PG8_SA(0, 0), cA, voffA); PG8_STAGE(PG8_SA(0, 1), cA + hstep, voffA);
    if (wr == 1) PG8_BAR;
    PG8_WAIT_V(2); PG8_BAR;
    PG8_STAGE(PG8_SB(1, 0), cB + kstep, voffB); PG8_STAGE(PG8_SA(1, 0), cA + kstep, voffA); PG8_STAGE(PG8_SB(1, 1), cB + hstep + kstep, voffB);
    PG8_WAIT_V(6); PG8_BAR;
    for (;;) {
        const bool has_next = S.next(ui + 1, nxt);
        const char* nA = has_next ? nxt.A : cA; const char* nB = has_next ? nxt.B : cB;
        for (int t = 0; t < nt; t += 2) {
            const bool last = (t == nt - 2);
            const char* a1 = cA + (size_t)(t + 1) * kstep;
            const char* a2 = last ? nA : cA + (size_t)(t + 2) * kstep; const char* b2 = last ? nB : cB + (size_t)(t + 2) * kstep;
            const char* a3 = a2 + kstep; const char* b3 = b2 + kstep;
            PG8_LDB(B0, 0, 0); PG8_LDB(B1, 0, 1); PG8_SCHED; PG8_LDA(At, 0, 0); PG8_STAGE(PG8_SA(1, 1), a1 + hstep, voffA);
            PG8_WAIT_V(8); PG8_WAIT_L(0); PG8_BAR; PG8_MMA(0, 0, At, B0); PG8_MMA(0, 1, At, B1); PG8_BAR; PG8_SCHED;
            PG8_LDA(At, 0, 1); PG8_STAGE(PG8_SB(0, 0), b2, voffB); PG8_STAGE(PG8_SB(0, 1), b2 + hstep, voffB); PG8_STAGE(PG8_SA(0, 0), a2, voffA);
            PG8_WAIT_V(8); PG8_WAIT_L(0); PG8_BAR; PG8_MMA(1, 0, At, B0); PG8_MMA(1, 1, At, B1); PG8_BAR; PG8_SCHED;
            PG8_LDB(B0, 1, 0); PG8_LDB(B1, 1, 1); PG8_SCHED; PG8_LDA(At, 1, 0); PG8_STAGE(PG8_SA(0, 1), a2 + hstep, voffA);
            PG8_WAIT_V(8); PG8_WAIT_L(0); PG8_BAR; PG8_MMA(0, 0, At, B0); PG8_MMA(0, 1, At, B1); PG8_BAR; PG8_SCHED;
            PG8_LDA(At, 1, 1); PG8_STAGE(PG8_SB(1, 0), b3, voffB); PG8_STAGE(PG8_SB(1, 1), b3 + hstep, voffB); PG8_STAGE(PG8_SA(1, 0), a3, voffA);
            PG8_WAIT_V(8); PG8_WAIT_L(0); PG8_BAR; PG8_MMA(1, 0, At, B0); PG8_MMA(1, 1, At, B1); PG8_BAR; PG8_SCHED;
        }
        if (wr == 0) PG8_BAR;
        E(acc, cur, wr, wc, fr, fq);
        if (!has_next) break;
        if (!E.keep(cur)) {
#pragma unroll
            for (int a = 0; a < 2; ++a)
#pragma unroll
                for (int b = 0; b < 2; ++b)
#pragma unroll
                    for (int m = 0; m < 4; ++m)
#pragma unroll
                        for (int n = 0; n < 2; ++n) acc[a][b][m][n] = (f32x4){0.f, 0.f, 0.f, 0.f};
        }
        cur = nxt; cA = nA; cB = nB; ++ui;
        if (wr == 1) PG8_BAR;
    }
    PG8_WAIT_V(0);
    PG8_BAR;
#undef PG8_SA
#undef PG8_SB
#undef PG8_STAGE
#undef PG8_LDA
#undef PG8_LDB
#undef PG8_MMA
#undef PG8_WAIT_V
#undef PG8_WAIT_L
#undef PG8_BAR
#undef PG8_SCHED
}
}
namespace pg8 {

struct SchedPlain {
    TileOrder T; int G, c; const char* A; const char* B; size_t tstep;
    __device__ __forceinline__ void init(const bf16_t* A_, const bf16_t* B_, int M, int N, int K, int G_, int c_) { T.init(M / BM, N / BM); G = G_; c = c_; A = (const char*)A_; B = (const char*)B_; tstep = (size_t)BM * K * 2; }
    __device__ __forceinline__ bool next(int i, Unit& u) const {
        const long L = (long)i * G + c; if (L >= T.nwg) return false;
        T.map((int)L, u.pm, u.pn); u.aux = 0; u.A = A + (size_t)u.pm * tstep; u.B = B + (size_t)u.pn * tstep; return true;
    }
};

struct EpiProj {
    static constexpr bool PERM = true;
    unsigned char* ws;
    __device__ __forceinline__ bool keep(const Unit&) const { return false; }
    __device__ __forceinline__ void operator()(f32x4 (&acc)[2][2][4][2], const Unit& u, int wr, int wc, int fr, int fq) const {
        const int pn = u.pn; int t0, ldc; size_t boff;
        if (pn < 4) { boff = OFF_DQ; t0 = 0; ldc = 1024; } else if (pn < 8) { boff = OFF_DK; t0 = 4; ldc = 1024; } else if (pn < 12) { boff = OFF_DV; t0 = 8; ldc = 1024; }
        else if (pn < 24) { boff = OFF_HY; t0 = 12; ldc = 3072; } else if (pn < 28) { boff = OFF_SQ; t0 = 24; ldc = 1024; } else if (pn < 29) { boff = OFF_SK; t0 = 28; ldc = 256; }
        else if (pn < 30) { boff = OFF_SV; t0 = 29; ldc = 256; } else { boff = OFF_GT; t0 = 30; ldc = 3072; }
        bf16_t* base = (bf16_t*)(ws + boff);
        const int row0 = u.pm * BM + wr * 64 + fr, col0 = (pn - t0) * BM + wc * 32 + 8 * fq;
#pragma unroll
        for (int ai = 0; ai < 2; ++ai)
#pragma unroll
            for (int m = 0; m < 4; ++m) { bf16_t* rowp = base + (size_t)(row0 + ai * HALF + m * 16) * ldc + col0;
#pragma unroll
                for (int bj = 0; bj < 2; ++bj) { const f32x4 v0 = acc[ai][bj][m][0], v1 = acc[ai][bj][m][1];
                    u32x4 w; w.x = cvtpk(v0[0], v0[1]); w.y = cvtpk(v0[2], v0[3]); w.z = cvtpk(v1[0], v1[1]); w.w = cvtpk(v1[2], v1[3]);
                    *(u32x4*)(rowp + bj * HALF) = w; } }
    }
};

struct SchedBranch {
    TileOrder T; int G, c; const char* ws; const char* B; size_t tstep, bstep;
    __device__ __forceinline__ bool next(int i, Unit& u) const {
        const int ti = i / 3, br = i - ti * 3; const long L = (long)ti * G + c; if (L >= T.nwg) return false;
        T.map((int)L, u.pm, u.pn); u.aux = br; size_t ao = br == 0 ? OFF_DQ : (br == 1 ? OFF_YHY : OFF_SQ); asm volatile("" : "+s"(ao));     u.A = ws + ao + (size_t)u.pm * tstep; u.B = B + (size_t)br * bstep + (size_t)u.pn * tstep; return true;
    }
};
struct EpiBranch {
    static constexpr bool PERM = true;
    unsigned char* ws;
    __device__ __forceinline__ bool keep(const Unit& u) const { return u.aux < 2; }
    __device__ __forceinline__ void operator()(f32x4 (&acc)[2][2][4][2], const Unit& u, int wr, int wc, int fr, int fq) const {
        const int br = u.aux;
        const bf16_t* gt = (const bf16_t*)(ws + OFF_GT); bf16_t* out = (bf16_t*)(ws + OFF_DK);
        const int row0 = u.pm * BM + wr * 64 + fr, col0 = u.pn * BM + wc * 32 + 8 * fq;
#pragma unroll
        for (int ai = 0; ai < 2; ++ai)
#pragma unroll
            for (int m = 0; m < 4; ++m) { const size_t row = (size_t)(row0 + ai * HALF + m * 16);
#pragma unroll
                for (int bj = 0; bj < 2; ++bj) {
                    const bf16_t* gp = gt + row * 3072 + br * 1024 + col0 + bj * HALF;
                    const u32x4 ga = *(const u32x4*)gp;
                    float s[8];
                    if (br < 2) {
                        const u32x4 gb = *(const u32x4*)(gp + 1024);
#pragma unroll
                        for (int j = 0; j < 4; ++j) {
                            const float a0 = bflo(ga[j]), a1 = bfhi(ga[j]), b0 = bflo(gb[j]), b1 = bfhi(gb[j]);
                            s[2 * j]     = (1.0f + fast_exp(fminf(-b0, 80.f))) * __builtin_amdgcn_rcpf(1.0f + fast_exp(fminf(-a0, 80.f)));
                            s[2 * j + 1] = (1.0f + fast_exp(fminf(-b1, 80.f))) * __builtin_amdgcn_rcpf(1.0f + fast_exp(fminf(-a1, 80.f)));
                        }
                    } else {
#pragma unroll
                        for (int j = 0; j < 4; ++j) { s[2 * j] = __builtin_amdgcn_rcpf(1.0f + fast_exp(fminf(-bflo(ga[j]), 80.f))); s[2 * j + 1] = __builtin_amdgcn_rcpf(1.0f + fast_exp(fminf(-bfhi(ga[j]), 80.f))); }
                    }
                    f32x4 v0 = acc[ai][bj][m][0], v1 = acc[ai][bj][m][1];
                    v0[0] *= s[0]; v0[1] *= s[1]; v0[2] *= s[2]; v0[3] *= s[3]; v1[0] *= s[4]; v1[1] *= s[5]; v1[2] *= s[6]; v1[3] *= s[7];
                    if (br < 2) { acc[ai][bj][m][0] = v0; acc[ai][bj][m][1] = v1; }
                    else { u32x4 w; w.x = cvtpk(v0[0], v0[1]); w.y = cvtpk(v0[2], v0[3]); w.z = cvtpk(v1[0], v1[1]); w.w = cvtpk(v1[2], v1[3]);
                        *(u32x4*)(out + row * 1024 + col0 + bj * HALF) = w; }
                }
                asm volatile("" ::: "memory"); }
    }
};

struct EpiResid {
    static constexpr bool PERM = false;
    float* xres; const float* mod;
    __device__ __forceinline__ bool keep(const Unit&) const { return false; }
    __device__ __forceinline__ void operator()(f32x4 (&acc)[2][2][4][2], const Unit& u, int wr, int wc, int fr, int fq) const {
        const int b = u.pm / 17, isctx = (u.pm - b * 17) == 16; const float* mrow = mod + (size_t)(isctx ? 8 : b) * 6144 + 2 * 1024;
        const int row0 = u.pm * BM + wr * 64 + fr, col0 = u.pn * BM + wc * 32 + 4 * fq;
        f32x4 mv[2][2];
#pragma unroll
        for (int bj = 0; bj < 2; ++bj)
#pragma unroll
            for (int n = 0; n < 2; ++n) mv[bj][n] = *(const f32x4*)(mrow + col0 + bj * HALF + n * 16);
#pragma unroll
        for (int ai = 0; ai < 2; ++ai)
#pragma unroll
            for (int m = 0; m < 4; ++m) { float* rowp = xres + (size_t)(row0 + ai * HALF + m * 16) * 1024 + col0;
#pragma unroll
                for (int bj = 0; bj < 2; ++bj)
#pragma unroll
                    for (int n = 0; n < 2; ++n) { f32x4* p = (f32x4*)(rowp + bj * HALF + n * 16); const f32x4 x = *p; *p = x + mv[bj][n] * acc[ai][bj][m][n]; }
                if (m & 1) asm volatile("" ::: "memory"); }
    }
};

struct SchedMoe {
    TileOrder T; int G, c; const char* A; const char* B; size_t tstep, estep;
    __device__ __forceinline__ bool next(int i, Unit& u) const {
        const long L = (long)i * G + c; if (L >= T.nwg) return false;
        T.map((int)L, u.pm, u.pn); const int e = u.pm < 256 ? (u.pm >> 4) : (u.pm - 256); u.aux = e;
        u.A = A + (size_t)u.pm * tstep; u.B = B + (size_t)e * estep + (size_t)u.pn * tstep; return true;
    }
};
struct EpiSwiglu {
    static constexpr bool PERM = true;
    bf16_t* hid;
    __device__ __forceinline__ bool keep(const Unit&) const { return false; }
    __device__ __forceinline__ void operator()(f32x4 (&acc)[2][2][4][2], const Unit& u, int wr, int wc, int fr, int fq) const {
        const int row0 = u.pm * BM + wr * 64 + fr, col0 = u.pn * HALF + wc * 32 + 8 * fq;
#pragma unroll
        for (int ai = 0; ai < 2; ++ai)
#pragma unroll
            for (int m = 0; m < 4; ++m) { bf16_t* rowp = hid + (size_t)(row0 + ai * HALF + m * 16) * 1024 + col0;
                float h[8];
#pragma unroll
                for (int n = 0; n < 2; ++n)
#pragma unroll
                    for (int j = 0; j < 4; ++j) { const float a = acc[ai][0][m][n][j], b = acc[ai][1][m][n][j]; h[4 * n + j] = a * __builtin_amdgcn_rcpf(1.0f + fast_exp(-a)) * b; }
                u32x4 w; w.x = cvtpk(h[0], h[1]); w.y = cvtpk(h[2], h[3]); w.z = cvtpk(h[4], h[5]); w.w = cvtpk(h[6], h[7]);
                *(u32x4*)rowp = w; }
    }
};
struct EpiRowScale {
    static constexpr bool PERM = true;
    bf16_t* out; const float* gate;
    __device__ __forceinline__ bool keep(const Unit&) const { return false; }
    __device__ __forceinline__ void operator()(f32x4 (&acc)[2][2][4][2], const Unit& u, int wr, int wc, int fr, int fq) const {
        const int row0 = u.pm * BM + wr * 64 + fr, col0 = u.pn * BM + wc * 32 + 8 * fq;
#pragma unroll
        for (int ai = 0; ai < 2; ++ai)
#pragma unroll
            for (int m = 0; m < 4; ++m) { const int row = row0 + ai * HALF + m * 16; const float g = gate[row]; bf16_t* rowp = out + (size_t)row * 1024 + col0;
#pragma unroll
                for (int bj = 0; bj < 2; ++bj) { const f32x4 v0 = acc[ai][bj][m][0] * g, v1 = acc[ai][bj][m][1] * g;
                    u32x4 w; w.x = cvtpk(v0[0], v0[1]); w.y = cvtpk(v0[2], v0[3]); w.z = cvtpk(v1[0], v1[1]); w.w = cvtpk(v1[2], v1[3]);
                    *(u32x4*)(rowp + bj * HALF) = w; } }
    }
};
}
namespace att {
__device__ __forceinline__ int crow(int r, int hi) { return (r & 3) + 8 * (r >> 2) + 4 * hi; }
__device__ __forceinline__ void glds16(const void* gsrc, unsigned lds_dst) { unsigned keep;
    asm volatile("s_mov_b32 %0, m0\n\ts_mov_b32 m0, %2\n\ts_nop 0\n\tglobal_load_lds_dwordx4 %1, off\n\ts_mov_b32 m0, %0" : "=&s"(keep) : "v"(gsrc), "s"(lds_dst) : "memory"); }
#define ATT_WAIT_BAR() asm volatile("s_waitcnt vmcnt(0) lgkmcnt(0)\n\ts_barrier" ::: "memory")

constexpr int KSLOT = 8192;
template <int DV> struct Lay { static constexpr int VSLOT = DV * 128, K0 = 0, V0 = 2 * KSLOT, WS = V0 + 2 * VSLOT, BYTES = WS + 8 * 256; };

struct Pass {
    const bf16_t* Qw; int ldq;
    const bf16_t* Kb; int ldk;
    const bf16_t* Vb; int ldv;
    int nA, ks, nC;
    int band;
    int qpos;
    float m0, l0;
};

template <int DV>
__device__ __forceinline__ void flash_pass(char* shm, const Pass& P, f32x16 (&o)[DV / 32], float& l_fin) {
    typedef Lay<DV> L;
    int tid_ = threadIdx.x; asm volatile("" : "+v"(tid_));
    const int tid = tid_, lane = tid & 63, r32 = lane & 31, hi = lane >> 5; const int wid = __builtin_amdgcn_readfirstlane(tid >> 6);
    const unsigned lds0 = (unsigned)(uintptr_t)shm;
    float* wsf = (float*)(shm + L::WS) + wid * 64;
    const int NT = P.nA + P.nC;
    bf16x8 qr[4];
#pragma unroll
    for (int d0 = 0; d0 < 4; ++d0) qr[d0] = *reinterpret_cast<const bf16x8*>(P.Qw + (size_t)r32 * P.ldq + d0 * 16 + hi * 8);
#pragma unroll
    for (int d = 0; d < DV / 32; ++d) o[d] = f32x16{};
    float m = P.m0, lsum = (hi == 0) ? P.l0 : 0.f;
    const bf16_t* ksrc = P.Kb + (size_t)lane * P.ldk + wid * 8;
    const bf16_t* vsrc = P.Vb + (size_t)(16 * (wid & 3) + (lane >> 2)) * P.ldv + (wid >> 2) * 32 + (lane & 3) * 8;
#define ATT_KEYROW(t) ((t) < P.nA ? P.ks + 64 * (t) : LS + 64 * ((t) - P.nA))
#define ATT_DMA(t, slot) do { const int kr_ = ATT_KEYROW(t); \
        glds16(ksrc + (size_t)kr_ * P.ldk, (unsigned)__builtin_amdgcn_readfirstlane(lds0 + L::K0 + (slot) * KSLOT + wid * 1024)); \
        _Pragma("unroll") for (int s2_ = 0; s2_ < DV / 64; ++s2_) \
            glds16(vsrc + (size_t)kr_ * P.ldv + s2_ * 64, (unsigned)__builtin_amdgcn_readfirstlane(lds0 + L::V0 + (slot) * L::VSLOT + s2_ * 8192 + wid * 1024)); } while (0)
    ATT_DMA(0, 0);
    for (int t = 0; t < NT; ++t) {
        ATT_WAIT_BAR();
        if (t + 1 < NT) ATT_DMA(t + 1, (t + 1) & 1);
        const int slot = t & 1;
        f32x16 p0 = f32x16{}, p1 = f32x16{};
        { const char* kb = shm + L::K0 + slot * KSLOT + hi * 1024 + r32 * 16;
#pragma unroll
          for (int d0 = 0; d0 < 4; ++d0) {
              const bf16x8 b0 = *reinterpret_cast<const bf16x8*>(kb + d0 * 2048);
              const bf16x8 b1 = *reinterpret_cast<const bf16x8*>(kb + d0 * 2048 + 512);
              p0 = __builtin_amdgcn_mfma_f32_32x32x16_bf16(b0, qr[d0], p0, 0, 0, 0);
              p1 = __builtin_amdgcn_mfma_f32_32x32x16_bf16(b1, qr[d0], p1, 0, 0, 0); } }
        if (P.band && t < P.nA) {
            const int q = P.qpos + r32, kb0 = P.ks + 64 * t + 4 * hi;
#pragma unroll
            for (int r = 0; r < 16; ++r) { const int kv = kb0 + (r & 3) + 8 * (r >> 2); int dd = kv - q; dd = dd < 0 ? -dd : dd; int d1 = kv + 32 - q; d1 = d1 < 0 ? -d1 : d1;
                if (dd > 128) p0[r] = -INFINITY; if (d1 > 128) p1[r] = -INFINITY; }
        }
        float rm = fmaxf(p0[0], p1[0]);
#pragma unroll
        for (int r = 1; r < 16; ++r) rm = fmaxf(rm, fmaxf(p0[r], p1[r]));
        { auto rr = __builtin_amdgcn_permlane32_swap(__float_as_uint(rm), __float_as_uint(rm), false, false); rm = fmaxf(__uint_as_float(rr[0]), __uint_as_float(rr[1])); }
        const float mn = fmaxf(m, rm);
        if (__any(mn > m)) {
            const float f = __builtin_amdgcn_exp2f(m - mn);
            lsum *= f; if (hi == 0) wsf[r32] = f; m = mn;
            LDS_WAIT();
#pragma unroll
            for (int r = 0; r < 16; ++r) { const float fr_ = wsf[crow(r, hi)];
#pragma unroll
                for (int d = 0; d < DV / 32; ++d) o[d][r] *= fr_; }
        }
        float sacc = 0.f;
#pragma unroll
        for (int r = 0; r < 16; ++r) { p0[r] = __builtin_amdgcn_exp2f(p0[r] - m); p1[r] = __builtin_amdgcn_exp2f(p1[r] - m); sacc += p0[r] + p1[r]; }
        lsum += sacc;
        u32x4 pw0, pw1, pw2, pw3;
        pw0 = (u32x4){cvtpk(p0[0], p0[1]), cvtpk(p0[2], p0[3]), cvtpk(p0[4], p0[5]), cvtpk(p0[6], p0[7])};
        pw1 = (u32x4){cvtpk(p0[8], p0[9]), cvtpk(p0[10], p0[11]), cvtpk(p0[12], p0[13]), cvtpk(p0[14], p0[15])};
        pw2 = (u32x4){cvtpk(p1[0], p1[1]), cvtpk(p1[2], p1[3]), cvtpk(p1[4], p1[5]), cvtpk(p1[6], p1[7])};
        pw3 = (u32x4){cvtpk(p1[8], p1[9]), cvtpk(p1[10], p1[11]), cvtpk(p1[12], p1[13]), cvtpk(p1[14], p1[15])};
        const int vb = (int)(lds0 + L::V0 + slot * L::VSLOT) + ((lane >> 4) & 1) * 32 + (lane & 3) * 8 + (4 * hi + ((lane & 15) >> 2)) * 64;
#pragma unroll
        for (int d0 = 0; d0 < DV / 32; ++d0) { s16x4 lo[4], hh[4];
#pragma unroll
            for (int ks = 0; ks < 4; ++ks) {
                asm volatile("ds_read_b64_tr_b16 %0,%1 offset:%c2" : "=&v"(lo[ks]) : "v"(vb), "i"((d0 >> 1) * 8192 + (d0 & 1) * 4096 + ks * 1024) : "memory");
                asm volatile("ds_read_b64_tr_b16 %0,%1 offset:%c2" : "=&v"(hh[ks]) : "v"(vb), "i"((d0 >> 1) * 8192 + (d0 & 1) * 4096 + ks * 1024 + 512) : "memory"); }
            asm volatile("s_waitcnt lgkmcnt(0)" ::: "memory"); __builtin_amdgcn_sched_barrier(0);
#define ATT_PK(k) (bf16x8){lo[k][0], lo[k][1], lo[k][2], lo[k][3], hh[k][0], hh[k][1], hh[k][2], hh[k][3]}
            o[d0] = __builtin_amdgcn_mfma_f32_32x32x16_bf16(__builtin_bit_cast(bf16x8, pw0), ATT_PK(0), o[d0], 0, 0, 0);
            o[d0] = __builtin_amdgcn_mfma_f32_32x32x16_bf16(__builtin_bit_cast(bf16x8, pw1), ATT_PK(1), o[d0], 0, 0, 0);
            o[d0] = __builtin_amdgcn_mfma_f32_32x32x16_bf16(__builtin_bit_cast(bf16x8, pw2), ATT_PK(2), o[d0], 0, 0, 0);
            o[d0] = __builtin_amdgcn_mfma_f32_32x32x16_bf16(__builtin_bit_cast(bf16x8, pw3), ATT_PK(3), o[d0], 0, 0, 0);
#undef ATT_PK
        }
    }
    asm volatile("s_waitcnt lgkmcnt(0)\n\ts_barrier" ::: "memory");
    { auto rr = __builtin_amdgcn_permlane32_swap(__float_as_uint(lsum), __float_as_uint(lsum), false, false); l_fin = __uint_as_float(rr[0]) + __uint_as_float(rr[1]); }
#undef ATT_KEYROW
#undef ATT_DMA
}

template <int DV>
__device__ __forceinline__ void normalize(char* shm, f32x16 (&o)[DV / 32], float l) {
    typedef Lay<DV> L;
    int tid_ = threadIdx.x; asm volatile("" : "+v"(tid_));
    const int lane = tid_ & 63, r32 = lane & 31, hi = lane >> 5; const int wid = __builtin_amdgcn_readfirstlane(tid_ >> 6);
    float* wsf = (float*)(shm + L::WS) + wid * 64;
    if (hi == 0) wsf[r32] = 1.0f / l;
    LDS_WAIT();
#pragma unroll
    for (int r = 0; r < 16; ++r) { const float rl = wsf[crow(r, hi)];
#pragma unroll
        for (int d = 0; d < DV / 32; ++d) o[d][r] *= rl; }
    LDS_WAIT();
}
}
namespace hy {
constexpr int UROW = 4096 * 2 + 16;
constexpr int LDS_U = 0, LDS_R = 8 * UROW, LDS_BYTES = LDS_R + 8192 * 2;

__device__ __forceinline__ void conv_channel(char* shm, const bf16_t* zc, const bf16_t* Rc, bf16_t* outc) {
    int tid_ = threadIdx.x; asm volatile("" : "+v"(tid_));
    const int tid = tid_, lane = tid & 63, n = lane & 31, kg = lane >> 5; const int w = __builtin_amdgcn_readfirstlane(tid >> 6);
    asm volatile("s_waitcnt lgkmcnt(0)\n\ts_barrier" ::: "memory");
#pragma unroll
    for (int j = 0; j < 8; ++j) { const int id = tid + 512 * j, b = id >> 9, off = (id & 511) * 16; *(u32x4*)(shm + LDS_U + b * UROW + off) = *(const u32x4*)((const char*)zc + (size_t)b * 8192 + off); }
#pragma unroll
    for (int j = 0; j < 2; ++j) { const int off = (tid + 512 * j) * 16; *(u32x4*)(shm + LDS_R + off) = *(const u32x4*)((const char*)Rc + off); }
    asm volatile("s_waitcnt vmcnt(0) lgkmcnt(0)\n\ts_barrier" ::: "memory");
    f32x16 acc[4];
#pragma unroll
    for (int k = 0; k < 4; ++k) acc[k] = f32x16{};
    const int bcol = n >> 2, il = n & 3;
    const unsigned short* Rl = (const unsigned short*)(shm + LDS_R);
    const char* Ub = shm + LDS_U + bcol * UROW + kg * 16;
    const int dlo = 16 * w - 127, dhi = 16 * w + 15;
    for (int d = dlo; d <= dhi; ++d) {
#pragma unroll
        for (int sc = 0; sc < 2; ++sc) {
            const int x0 = 4096 - 32 * d - n + 16 * sc + 8 * kg;
            u32x4 aw;
            aw.x = (unsigned)Rl[x0 + 0] | ((unsigned)Rl[x0 + 1] << 16); aw.y = (unsigned)Rl[x0 + 2] | ((unsigned)Rl[x0 + 3] << 16);
            aw.z = (unsigned)Rl[x0 + 4] | ((unsigned)Rl[x0 + 5] << 16); aw.w = (unsigned)Rl[x0 + 6] | ((unsigned)Rl[x0 + 7] << 16);
            const bf16x8 af = __builtin_bit_cast(bf16x8, aw);
#pragma unroll
            for (int k = 0; k < 4; ++k) {
                const int j = 16 * w + 4 * k + il - d;
                u32x4 bw = (u32x4){0u, 0u, 0u, 0u};
                if (j >= 0 && j < 128) bw = *(const u32x4*)(Ub + (32 * j + 16 * sc) * 2);
                acc[k] = __builtin_amdgcn_mfma_f32_32x32x16_bf16(af, __builtin_bit_cast(bf16x8, bw), acc[k], 0, 0, 0);
            }
        }
    }
#pragma unroll
    for (int k = 0; k < 4; ++k) { const int i = 16 * w + 4 * k + il; bf16_t* op = outc + (size_t)bcol * 4096 + 32 * i + 4 * kg;
#pragma unroll
        for (int g = 0; g < 4; ++g) { u32x2 v; v.x = cvtpk(acc[k][4 * g], acc[k][4 * g + 1]); v.y = cvtpk(acc[k][4 * g + 2], acc[k][4 * g + 3]); *(u32x2*)(op + 8 * g) = v; } }
}
}
constexpr int NWAVES = 8;
constexpr size_t MiB = 1u << 20;
constexpr size_t WS_CTL = 0, CTL_ZERO_BYTES = 1 * MiB;
constexpr size_t WS_MODS = 1 * MiB;
constexpr size_t WS_FCTX = 2 * MiB;
constexpr size_t WS_ZFEAT = 4 * MiB;
constexpr size_t WS_AFF = 9 * MiB;
constexpr size_t WS_SLOTOF = 12 * MiB;
constexpr size_t WS_ROWSEL = 15 * MiB;
constexpr size_t WS_GATE = 16 * MiB;
constexpr size_t WS_ZCTX = 17 * MiB;
constexpr size_t WS_XRES = 24 * MiB;
constexpr size_t WS_H = WS_XRES + 136 * MiB;
constexpr size_t WS_W = WS_H + 68 * MiB;
constexpr size_t WS_WIN = WS_W, WS_WBR = WS_WIN + 21 * MiB, WS_WOUT = WS_WBR + 6 * MiB, WS_W13 = WS_WOUT + 2 * MiB, WS_W2 = WS_W13 + 64 * MiB;
constexpr size_t WS_PROJ = WS_W2 + 32 * MiB;
static_assert(WS_PROJ == OFF_PROJ, "projection base");
constexpr size_t WS_DQ = OFF_DQ, WS_DK = OFF_DK, WS_DV = OFF_DV, WS_HY = OFF_HY, WS_SQ = OFF_SQ, WS_SK = OFF_SK, WS_SV = OFF_SV, WS_GT = OFF_GT;
constexpr size_t WS_END = WS_GT + 3 * SZ1K;
constexpr size_t WS_CONVT = WS_HY;
constexpr size_t WS_YHY = OFF_YHY;
constexpr size_t WS_MERGED = WS_DK;
constexpr size_t WS_XG = WS_HY;
constexpr size_t WS_HID = WS_GT;
static_assert(WS_YHY + SZ1K <= WS_SQ && WS_XG + (size_t)SLOTS * 2048 <= WS_SQ && WS_HID + (size_t)SLOTS * 2048 <= WS_END, "overlays");
constexpr size_t OUT_ZT = 0;
constexpr size_t OUT_FILT = 64 * MiB;
constexpr size_t OUT_STASH = 80 * MiB;
static_assert(OUT_STASH + 32 * MiB <= (size_t)NB * LS * D * 4, "d_out scratch");

constexpr int CW_TMO = 0, CW_CODE = 1, CW_CHK = 64, CW_BAR = 4096;

constexpr int RING_BYTES = 131072, LDSCTL_OFF = RING_BYTES, MISC_OFF = LDSCTL_OFF + 320, LDS_BYTES = 147456;

#define XB_TMO      128
#define XB_XCNT(j)  (256  + 64 * (j))
#define XB_XSUB(j)  (1280 + 64 * (j))
#define XB_XGEN(j)  (2304 + 64 * (j))
#define XB_TOP      3328
#define XB_TOPGEN   3392
#define XCD_BAR_WORDS 3456
#define XB_SPIN_CAP (1u << 22)
__device__ __forceinline__ unsigned xb_ld(unsigned* p)              { return __hip_atomic_load(p, __ATOMIC_RELAXED, __HIP_MEMORY_SCOPE_AGENT); }
__device__ __forceinline__ unsigned xb_add(unsigned* p, unsigned v) { return __hip_atomic_fetch_add(p, v, __ATOMIC_RELAXED, __HIP_MEMORY_SCOPE_AGENT); }
__device__ __forceinline__ unsigned xb_xcc_id() { return (unsigned)__builtin_amdgcn_s_getreg((3 << 11) | 20) & 0xFu; }
#define XB_SPIN(cond, bar) do { unsigned _sp = 0; while (cond) { __builtin_amdgcn_s_sleep(1); \
    if ((++_sp & 255u) == 0u) { if (xb_ld(&(bar)[XB_TMO])) break; if (_sp > XB_SPIN_CAP) { atomicAdd(&(bar)[XB_TMO], 1u); break; } } } } while (0)
struct XcdBarrier { unsigned* bar; unsigned x; volatile LAS unsigned* st; };
__device__ __forceinline__ XcdBarrier xcd_barrier_post(unsigned* bar, volatile LAS unsigned* st) {
    XcdBarrier b; b.bar = bar; b.x = xb_xcc_id(); b.st = st;
    if (threadIdx.x == 0) (void)xb_add(&bar[XB_XCNT(b.x)], 1u);
    return b;
}
__device__ __forceinline__ void xcd_barrier_complete(unsigned* bar, unsigned x, unsigned& nloc, unsigned& nx) {
    const unsigned G = gridDim.x * gridDim.y * gridDim.z;
    unsigned sum, cnt, mine, sp = 0u;
    for (;;) {
        sum = 0u; cnt = 0u; mine = 0u;
#pragma unroll
        for (unsigned j = 0; j < 16; ++j) { const unsigned c = xb_ld(&bar[XB_XCNT(j)]); sum += c; cnt += (c > 0u) ? 1u : 0u; mine = (j == x) ? c : mine; }
        if (sum == G) break;
        __builtin_amdgcn_s_sleep(1);
        if ((++sp & 255u) == 0u) { if (xb_ld(&bar[XB_TMO])) break; if (sp > XB_SPIN_CAP) { atomicAdd(&bar[XB_TMO], 1u); break; } }
    }
    nloc = mine > 0u ? mine : 1u; nx = cnt > 0u ? cnt : 1u;
}
__device__ __forceinline__ void xcd_barrier(const XcdBarrier& b) {
    asm volatile("s_waitcnt vmcnt(0)" ::: "memory");
    __syncthreads();
    if (threadIdx.x == 0) {
        unsigned* bar = b.bar;
        __builtin_amdgcn_s_waitcnt(0);
        unsigned nloc = b.st[0], nx = b.st[1];
        if (nloc == 0u) { xcd_barrier_complete(bar, b.x, nloc, nx); b.st[0] = nloc; b.st[1] = nx; }
        const unsigned old = xb_add(&bar[XB_XSUB(b.x)], 1u);
        const unsigned gen = old / nloc;
        if (old + 1u == (gen + 1u) * nloc) {
            __builtin_amdgcn_fence(__ATOMIC_RELEASE, "agent");
            asm volatile("s_waitcnt vmcnt(0)" ::: "memory");
            const unsigned og = xb_add(&bar[XB_TOP], 1u);
            const unsigned tg = og / nx;
            if (og + 1u == (tg + 1u) * nx) xb_add(&bar[XB_TOPGEN], 1u);
            else XB_SPIN(xb_ld(&bar[XB_TOPGEN]) == tg, bar);
            __builtin_amdgcn_fence(__ATOMIC_ACQUIRE, "agent");
            xb_add(&bar[XB_XGEN(b.x)], 1u);
            asm volatile("s_waitcnt vmcnt(0)" ::: "memory");
        } else {
            XB_SPIN(xb_ld(&bar[XB_XGEN(b.x)]) == gen, bar);
            __builtin_amdgcn_fence(__ATOMIC_ACQUIRE, "agent");
            asm volatile("s_waitcnt vmcnt(0)" ::: "memory");
        }
    }
    __syncthreads();
}

struct Args {
    const float* in[28]; float* out; unsigned char* ws; int ph_lo, ph_hi;
};
struct Frame {
    LAS unsigned char* lds; char* shm;
    int tid, lane, wave, G, bid;
    unsigned char* ws; unsigned char* outb;
};
enum { I_X = 0, I_C, I_CTX, I_CCTX, I_WMOD, I_BMOD, I_N1G, I_N2G, I_WIN, I_DLAM, I_SUBLN, I_HCW, I_HCB, I_FW1, I_FB1, I_FW2, I_FB2, I_FW3, I_FREQ, I_HBIAS, I_SINK, I_WBR, I_WOUT, I_ROUTER, I_W1, I_W3, I_W2, I_FINALG };
__device__ __forceinline__ void p0_mods_zfeat(Frame& F, const Args& a) {
    float* sc = (float*)F.shm;
    float* part = (float*)(F.shm + 9 * 1024 * 4);
    for (int i = F.tid; i < 9 * 1024; i += 512) { const int r = i >> 10, k = i & 1023; const float v = r < 8 ? a.in[I_C][r * 1024 + k] : a.in[I_CCTX][k]; sc[i] = v * sigmoidf_(v); }
    __syncthreads();
    float* mods = (float*)(F.ws + WS_MODS);
    for (int ch = F.bid; ch < 192; ch += F.G) {
        const int l = ch / 48, c0 = (ch % 48) * 128, col = F.tid & 127, kq = F.tid >> 7;
        const float* w = a.in[I_WMOD] + ((size_t)l * 1024 + kq * 256) * 6144 + c0 + col;
        float acc[9];
#pragma unroll
        for (int r = 0; r < 9; ++r) acc[r] = 0.f;
        for (int k = 0; k < 256; ++k) { const float wv = w[(size_t)k * 6144];
#pragma unroll
            for (int r = 0; r < 9; ++r) acc[r] += sc[r * 1024 + kq * 256 + k] * wv; }
#pragma unroll
        for (int r = 0; r < 9; ++r) part[(kq * 9 + r) * 128 + col] = acc[r];
        __syncthreads();
        for (int i = F.tid; i < 9 * 128; i += 512) { const int r = i >> 7, cc = i & 127;
            const float s = part[(0 * 9 + r) * 128 + cc] + part[(1 * 9 + r) * 128 + cc] + part[(2 * 9 + r) * 128 + cc] + part[(3 * 9 + r) * 128 + cc];
            mods[((size_t)l * 9 + r) * 6144 + c0 + cc] = s + a.in[I_BMOD][l * 6144 + c0 + cc]; }
        __syncthreads();
    }
    float* zf = (float*)(F.ws + WS_ZFEAT);
    const int gw = F.bid * NWAVES + F.wave, NGW = F.G * NWAVES;
    for (int it = gw; it < DEPTH * LT; it += NGW) {
        const int l = it / LT, row = it - l * LT; const int Lf = row < LS ? LS : LC, ii = row < LS ? row : row - LS;
        const float tt = (float)ii / (float)(Lf - 1);
        const float wrev = (float)ii / (float)Lf;
        const int j = F.lane & 15; const float fj = 1e-4f + (float)j * ((15.0f - 1e-4f) / 15.0f);
        const float cs = cos_rev(fj * wrev), sn = -sin_rev(fj * wrev);
        const float* w1 = a.in[I_FW1] + (size_t)l * 33 * 64; const float* w2 = a.in[I_FW2] + (size_t)l * 64 * 64;
        const float fq = a.in[I_FREQ][l * 64 + F.lane];
        float s = tt * w1[F.lane] + a.in[I_FB1][l * 64 + F.lane];
#pragma unroll
        for (int k = 0; k < 16; ++k) { s += __shfl(cs, k) * w1[(1 + k) * 64 + F.lane]; s += __shfl(sn, k) * w1[(17 + k) * 64 + F.lane]; }
        const float z1 = sin_rad(fq * s);
        float s2 = a.in[I_FB2][l * 64 + F.lane];
#pragma unroll 8
        for (int k = 0; k < 64; ++k) s2 += __shfl(z1, k) * w2[k * 64 + F.lane];
        zf[(size_t)it * 64 + F.lane] = sin_rad(fq * s2);
    }
}

__device__ __forceinline__ void transpose_item(const float* W, int K, int N, bf16_t* WT, int k0, int n0, int drow, LAS float* scr, int lane) {
#pragma unroll 8
    for (int i = 0; i < 32; ++i) { const int kk = 2 * i + (lane >> 5); scr[kk * 33 + (lane & 31)] = W[(size_t)(k0 + kk) * N + n0 + (lane & 31)]; }
    LDS_WAIT(); asm volatile("" ::: "memory");
    const int c = lane & 7;
#pragma unroll
    for (int j = 0; j < 4; ++j) { const int n = (lane >> 3) + 8 * j; const LAS float* s = scr + (8 * c) * 33 + n;
        u32x4 o; o.x = pk2(s[0 * 33], s[1 * 33]); o.y = pk2(s[2 * 33], s[3 * 33]); o.z = pk2(s[4 * 33], s[5 * 33]); o.w = pk2(s[6 * 33], s[7 * 33]);
        *(GAS u32x4*)(WT + (size_t)(drow + n) * K + k0 + 8 * c) = o; }
    LDS_WAIT(); asm volatile("" ::: "memory");
}
__device__ __forceinline__ void p1_weights(Frame& F, const Args& a, int l) {
    LAS float* scr = (LAS float*)(F.lds + F.wave * 8448);
    const int gw = F.bid * NWAVES + F.wave, NGW = F.G * NWAVES;
    constexpr int I_IN = 16 * 336, I_SQ = 16 * 32;
    constexpr int NITEMS = I_IN + 4 * I_SQ + 48 * I_SQ;
    bf16_t* WinT = (bf16_t*)(F.ws + WS_WIN); bf16_t* WbrT = (bf16_t*)(F.ws + WS_WBR); bf16_t* WoutT = (bf16_t*)(F.ws + WS_WOUT);
    bf16_t* W13T = (bf16_t*)(F.ws + WS_W13); bf16_t* W2T = (bf16_t*)(F.ws + WS_W2);
    for (int it = gw; it < NITEMS; it += NGW) {
        int r = it;
        if (r < I_IN) { const int kb = r / 336, nb = r % 336; transpose_item(a.in[I_WIN] + (size_t)l * 1024 * DIN, 1024, DIN, WinT, 64 * kb, 32 * nb, 32 * nb, scr, F.lane); continue; }
        r -= I_IN;
        const int mi = r / I_SQ, q = r % I_SQ, kb = q / 32, nb = q % 32, n0 = 32 * nb;
        if (mi < 3) { transpose_item(a.in[I_WBR] + ((size_t)l * 3 + mi) * 1048576, 1024, 1024, WbrT + (size_t)mi * 1048576, 64 * kb, n0, n0, scr, F.lane); continue; }
        if (mi == 3) { transpose_item(a.in[I_WOUT] + (size_t)l * 1048576, 1024, 1024, WoutT, 64 * kb, n0, n0, scr, F.lane); continue; }
        const int e = (mi - 4) / 3, which = (mi - 4) % 3; const size_t eo = ((size_t)l * 16 + e) * 1048576;
        if (which == 0) transpose_item(a.in[I_W1] + eo, 1024, 1024, W13T + (size_t)e * 2097152, 64 * kb, n0, (n0 >> 7) * 256 + (n0 & 127), scr, F.lane);
        else if (which == 1) transpose_item(a.in[I_W3] + eo, 1024, 1024, W13T + (size_t)e * 2097152, 64 * kb, n0, (n0 >> 7) * 256 + 128 + (n0 & 127), scr, F.lane);
        else transpose_item(a.in[I_W2] + eo, 1024, 1024, W2T + (size_t)e * 1048576, 64 * kb, n0, n0, scr, F.lane);
    }
}

__device__ __forceinline__ void p1_filters(Frame& F, const Args& a, int l) {
    float* w3s = (float*)(F.shm + 72 * 1024);
    float* red = w3s + 512;
    float* nrm = red + 32;
    const float* zf = (const float*)(F.ws + WS_ZFEAT) + (size_t)l * LT * 64;
    bf16_t* filtR = (bf16_t*)(F.outb + OUT_FILT); float* fctx = (float*)(F.ws + WS_FCTX);
    const float da = -15.350567286626973f, db = -3.0701134573253946f;
    for (int cg = F.bid; cg < 256; cg += F.G) {
        const int c0 = 4 * cg;
        __syncthreads();
        { const int k = F.tid >> 3, q = F.tid & 7; w3s[F.tid] = a.in[I_FW3][((size_t)l * 64 + k) * 2048 + (q >> 2) * 1024 + c0 + (q & 3)]; }
        __syncthreads();
        float delta[4];
#pragma unroll
        for (int cc = 0; cc < 4; ++cc) delta[cc] = fabsf(da + (float)(c0 + cc) * ((db - da) / 1023.0f));
        float asum[4] = {0.f, 0.f, 0.f, 0.f};
#pragma unroll 1
        for (int pass = 0; pass < 2; ++pass) {
            if (pass == 1) {
#pragma unroll
                for (int cc = 0; cc < 4; ++cc) { const float s = wave_sum(asum[cc]); if (F.lane == 0) red[F.wave * 4 + cc] = s; }
                __syncthreads();
                if (F.tid < 4) { float s = 0.f; for (int w = 0; w < 8; ++w) s += red[w * 4 + F.tid]; nrm[F.tid] = 1.0f / (s + EPS); }
                __syncthreads();
                if (F.tid == 0) { for (int cc = 0; cc < 4; ++cc) filtR[(size_t)(c0 + cc) * 8192] = 0; }
            }
#pragma unroll 1
            for (int j = 0; j < 8; ++j) {
                const int i = 8 * F.tid + j; const float* zr = zf + (size_t)i * 64;
                float h8[8] = {0.f, 0.f, 0.f, 0.f, 0.f, 0.f, 0.f, 0.f};
#pragma unroll 4
                for (int k4 = 0; k4 < 16; ++k4) { const f32x4 z = *(const f32x4*)(zr + 4 * k4);
#pragma unroll
                    for (int kk = 0; kk < 4; ++kk) { const f32x4 wa = *(const f32x4*)(w3s + (4 * k4 + kk) * 8), wb = *(const f32x4*)(w3s + (4 * k4 + kk) * 8 + 4);
                        h8[0] += z[kk] * wa[0]; h8[1] += z[kk] * wa[1]; h8[2] += z[kk] * wa[2]; h8[3] += z[kk] * wa[3];
                        h8[4] += z[kk] * wb[0]; h8[5] += z[kk] * wb[1]; h8[6] += z[kk] * wb[2]; h8[7] += z[kk] * wb[3]; } }
                const float tt = (float)i / 4095.0f;
#pragma unroll
                for (int cc = 0; cc < 4; ++cc) { const float dec = fast_exp(-tt * delta[cc]); const float hf = h8[cc] * dec, hbk = h8[4 + cc] * dec;
                    if (pass == 0) asum[cc] += fabsf(hf) + fabsf(hbk);
                    else { const float inv = nrm[cc]; bf16_t* Rc = filtR + (size_t)(c0 + cc) * 8192;
                        Rc[4096 - i] = (bf16_t)f2bf(hf * inv);
                        if (i > 0) Rc[4096 + i] = (bf16_t)f2bf(hbk * inv); } }
            }
        }
        __syncthreads();
        float hc[8]; float cs4[4] = {0.f, 0.f, 0.f, 0.f};
        if (F.tid < 256) {
            const float* zr = zf + (size_t)(LS + F.tid) * 64;
#pragma unroll
            for (int q = 0; q < 8; ++q) hc[q] = 0.f;
            for (int k = 0; k < 64; ++k) { const float z = zr[k];
#pragma unroll
                for (int q = 0; q < 8; ++q) hc[q] += z * w3s[k * 8 + q]; }
            const float tt = (float)F.tid / 255.0f;
#pragma unroll
            for (int cc = 0; cc < 4; ++cc) { const float dec = fast_exp(-tt * delta[cc]); hc[cc] *= dec; hc[4 + cc] *= dec; cs4[cc] = fabsf(hc[cc]) + fabsf(hc[4 + cc]); }
        }
#pragma unroll
        for (int cc = 0; cc < 4; ++cc) { const float s = wave_sum(cs4[cc]); if (F.lane == 0) red[F.wave * 4 + cc] = s; }
        __syncthreads();
        if (F.tid < 4) { float s = 0.f; for (int w = 0; w < 8; ++w) s += red[w * 4 + F.tid]; nrm[F.tid] = 1.0f / (s + EPS); }
        __syncthreads();
        if (F.tid < 256) {
#pragma unroll
            for (int q = 0; q < 8; ++q) fctx[((size_t)(q >> 2) * 256 + F.tid) * 1024 + c0 + (q & 3)] = hc[q] * nrm[q & 3];
        }
    }
}

__device__ __forceinline__ void combine_row(Frame& F, f32x4 (&v)[4], int row, const float* mod5) {
    const int* so = (const int*)(F.ws + WS_SLOTOF) + (size_t)row * 16;
    const bf16_t* ys = (const bf16_t*)(F.ws + WS_XG);
    f32x4 s[4];
#pragma unroll
    for (int j = 0; j < 4; ++j) s[j] = (f32x4){0.f, 0.f, 0.f, 0.f};
    for (int e = 0; e < 16; ++e) { const int sl = so[e];
        if (sl >= 0) { const bf16_t* yr = ys + (size_t)sl * 1024 + 4 * F.lane;
#pragma unroll
            for (int j = 0; j < 4; ++j) { const u32x2 w = *(const u32x2*)(yr + 256 * j); s[j][0] += bflo(w.x); s[j][1] += bfhi(w.x); s[j][2] += bflo(w.y); s[j][3] += bfhi(w.y); } } }
#pragma unroll
    for (int j = 0; j < 4; ++j) { const f32x4 m = *(const f32x4*)(mod5 + 4 * F.lane + 256 * j); v[j] += m * s[j]; }
}
__device__ __forceinline__ void p1_norm1(Frame& F, const Args& a, int l) {
    const int gw = F.bid * NWAVES + F.wave, NGW = F.G * NWAVES;
    float* xres = (float*)(F.ws + WS_XRES); bf16_t* hb = (bf16_t*)(F.ws + WS_H);
    const float* mods = (const float*)(F.ws + WS_MODS);
    const float* g1 = a.in[I_N1G] + (size_t)l * 1024;
    for (int row = gw; row < TROWS; row += NGW) {
        const int b = row / LT, t = row - b * LT; const int mr = t < LS ? b : 8;
        f32x4 v[4];
        if (l == 0) { const float* src = t < LS ? a.in[I_X] + ((size_t)b * LS + t) * 1024 : a.in[I_CTX] + ((size_t)b * LC + (t - LS)) * 1024;
#pragma unroll
            for (int j = 0; j < 4; ++j) v[j] = *(const f32x4*)(src + 4 * F.lane + 256 * j);
        } else {
#pragma unroll
            for (int j = 0; j < 4; ++j) v[j] = *(const f32x4*)(xres + (size_t)row * 1024 + 4 * F.lane + 256 * j);
            combine_row(F, v, row, mods + ((size_t)(l - 1) * 9 + mr) * 6144 + 5 * 1024);
        }
        float ss = 0.f;
#pragma unroll
        for (int j = 0; j < 4; ++j) { *(f32x4*)(xres + (size_t)row * 1024 + 4 * F.lane + 256 * j) = v[j]; ss += (v[j][0] * v[j][0] + v[j][1] * v[j][1]) + (v[j][2] * v[j][2] + v[j][3] * v[j][3]); }
        const float rstd = 1.0f / sqrtf(wave_sum(ss) * (1.0f / 1024.0f) + EPS);
        const float* mrow = mods + ((size_t)l * 9 + mr) * 6144;
#pragma unroll
        for (int j = 0; j < 4; ++j) { const int c = 4 * F.lane + 256 * j; const f32x4 g = *(const f32x4*)(g1 + c), sh = *(const f32x4*)(mrow + c), scl = *(const f32x4*)(mrow + 1024 + c);
            const f32x4 y = (v[j] * rstd * g) * (scl + 1.0f) + sh;
            u32x2 w; w.x = cvtpk(y[0], y[1]); w.y = cvtpk(y[2], y[3]); *(u32x2*)(hb + (size_t)row * 1024 + c) = w; }
    }
}
__device__ __forceinline__ void pf_final(Frame& F, const Args& a) {
    const int gw = F.bid * NWAVES + F.wave, NGW = F.G * NWAVES;
    const float* xres = (const float*)(F.ws + WS_XRES); const float* mods = (const float*)(F.ws + WS_MODS);
    const float* g = a.in[I_FINALG];
    for (int r = gw; r < NB * LS; r += NGW) {
        const int b = r / LS, t = r - b * LS, row = b * LT + t;
        f32x4 v[4];
#pragma unroll
        for (int j = 0; j < 4; ++j) v[j] = *(const f32x4*)(xres + (size_t)row * 1024 + 4 * F.lane + 256 * j);
        combine_row(F, v, row, mods + ((size_t)(DEPTH - 1) * 9 + b) * 6144 + 5 * 1024);
        float ss = 0.f;
#pragma unroll
        for (int j = 0; j < 4; ++j) ss += (v[j][0] * v[j][0] + v[j][1] * v[j][1]) + (v[j][2] * v[j][2] + v[j][3] * v[j][3]);
        const float rstd = 1.0f / sqrtf(wave_sum(ss) * (1.0f / 1024.0f) + EPS);
#pragma unroll
        for (int j = 0; j < 4; ++j) { const int c = 4 * F.lane + 256 * j; const f32x4 gg = *(const f32x4*)(g + c); *(f32x4*)(a.out + (size_t)r * 1024 + c) = v[j] * rstd * gg; }
    }
}
__device__ __forceinline__ void p3_rope(Frame& F) {
    float* cst = (float*)F.shm;
    float* snt = cst + 1024;
    for (int i = F.tid; i < 1024; i += 512) { const int pos = i >> 4, f = i & 15; const float inv = __builtin_amdgcn_exp2f(-(float)f * (13.287712379549449f / 16.0f));
        const float ang = (float)pos * inv, rev = ang * 0.15915494309189535f; cst[i] = cos_rev(rev); snt[i] = sin_rev(rev); }
    __syncthreads();
    bf16_t* dq = (bf16_t*)(F.ws + WS_DQ); bf16_t* dk = (bf16_t*)(F.ws + WS_DK); bf16_t* sq = (bf16_t*)(F.ws + WS_SQ); bf16_t* sk = (bf16_t*)(F.ws + WS_SK);
    const int gw = F.bid * NWAVES + F.wave, NGW = F.G * NWAVES;
    for (int row = gw; row < TROWS; row += NGW) {
        const int b = row / LT, t = row - b * LT; const bool lat = t < LS;
        for (int it = F.lane; it < 208; it += 64) {
            const int hs = it >> 2, ax = (it >> 1) & 1, fc = it & 1;
            bf16_t* base; float scl;
            if (hs < 16) { base = dq + (size_t)row * 1024 + hs * 64; scl = QSCALE; }
            else if (hs < 32) { base = dk + (size_t)row * 1024 + (hs - 16) * 64; scl = 1.f; }
            else if (hs < 48) { base = sq + (size_t)row * 1024 + (hs - 32) * 64; scl = QSCALE; }
            else { base = sk + (size_t)row * 256 + (hs - 48) * 64; scl = 1.f; }
            if (!lat && scl == 1.f) continue;
            bf16_t* p1 = base + ax * 32 + fc * 8; bf16_t* p2 = p1 + 16;
            const u32x4 a = *(const u32x4*)p1, c = *(const u32x4*)p2;
            float x1[8], x2[8];
#pragma unroll
            for (int j = 0; j < 4; ++j) { x1[2 * j] = bflo(a[j]); x1[2 * j + 1] = bfhi(a[j]); x2[2 * j] = bflo(c[j]); x2[2 * j + 1] = bfhi(c[j]); }
            float o1[8], o2[8];
            if (lat) { const int pos = ax == 0 ? (t >> 6) : (t & 63);
#pragma unroll
                for (int j = 0; j < 8; ++j) { const float cs = cst[pos * 16 + fc * 8 + j], sn = snt[pos * 16 + fc * 8 + j]; o1[j] = (x1[j] * cs - x2[j] * sn) * scl; o2[j] = (x2[j] * cs + x1[j] * sn) * scl; }
            } else {
#pragma unroll
                for (int j = 0; j < 8; ++j) { o1[j] = x1[j] * scl; o2[j] = x2[j] * scl; }
            }
            u32x4 w1, w2;
#pragma unroll
            for (int j = 0; j < 4; ++j) { w1[j] = cvtpk(o1[2 * j], o1[2 * j + 1]); w2[j] = cvtpk(o2[2 * j], o2[2 * j + 1]); }
            *(u32x4*)p1 = w1; *(u32x4*)p2 = w2;
        }
    }
}
__device__ __forceinline__ void p3_hyena_pre(Frame& F, const Args& a, int l) {
    const bf16_t* hyb = (const bf16_t*)(F.ws + WS_HY); bf16_t* x0c = (bf16_t*)(F.ws + WS_H); bf16_t* zT = (bf16_t*)(F.outb + OUT_ZT); bf16_t* zctx = (bf16_t*)(F.ws + WS_ZCTX);
    const float* cw = a.in[I_HCW] + (size_t)l * 3 * 3072; const float* cb = a.in[I_HCB] + (size_t)l * 3072;
    bf16_t* zt = (bf16_t*)(F.shm + 40960);
    constexpr int NT_L = NB * 64 * 16, NT_C = NB * 4 * 16;
    for (int tile = F.bid; tile < NT_L + NT_C; tile += F.G) {
        int b, t0, c0, Lseq, tbase; bool lat = tile < NT_L;
        if (lat) { b = tile / 1024; const int r = tile % 1024; t0 = (r >> 4) * 64; c0 = (r & 15) * 64; Lseq = LS; tbase = 0; }
        else { const int q = tile - NT_L; b = q / 64; const int r = q % 64; t0 = (r >> 4) * 64; c0 = (r & 15) * 64; Lseq = LC; tbase = LS; }
        const int tl = F.tid >> 3, cc = (F.tid & 7) * 8, t = t0 + tl, c = c0 + cc;
        const size_t row = (size_t)b * LT + tbase + t;
        float u[3][8];
#pragma unroll
        for (int g = 0; g < 3; ++g) {
            const int ch = g * 1024 + c;
            f32x4 bb0 = *(const f32x4*)(cb + ch), bb1 = *(const f32x4*)(cb + ch + 4);
#pragma unroll
            for (int j = 0; j < 4; ++j) { u[g][j] = bb0[j]; u[g][4 + j] = bb1[j]; }
#pragma unroll
            for (int k = 0; k < 3; ++k) { const int ts = t + k - 1;
                if (ts >= 0 && ts < Lseq) { const u32x4 x = *(const u32x4*)(hyb + (row + k - 1) * 3072 + ch);
                    const f32x4 w0 = *(const f32x4*)(cw + k * 3072 + ch), w1 = *(const f32x4*)(cw + k * 3072 + ch + 4);
#pragma unroll
                    for (int j = 0; j < 4; ++j) { u[g][2 * j] += bflo(x[j]) * (j < 2 ? w0[2 * j] : w1[2 * j - 4]); u[g][2 * j + 1] += bfhi(x[j]) * (j < 2 ? w0[2 * j + 1] : w1[2 * j - 3]); } } }
        }
        u32x4 w;
#pragma unroll
        for (int j = 0; j < 4; ++j) w[j] = cvtpk(u[0][2 * j], u[0][2 * j + 1]);
        *(u32x4*)(x0c + row * 1024 + c) = w;
        float z[8];
#pragma unroll
        for (int j = 0; j < 8; ++j) z[j] = u[1][j] * u[2][j];
        if (!lat) {
#pragma unroll
            for (int j = 0; j < 4; ++j) w[j] = cvtpk(z[2 * j], z[2 * j + 1]);
            *(u32x4*)(zctx + ((size_t)b * LC + t) * 1024 + c) = w;
        } else {
            __syncthreads();
#pragma unroll
            for (int j = 0; j < 8; ++j) zt[(cc + j) * 72 + tl] = (bf16_t)f2bf(z[j]);
            __syncthreads();
            const int cr = F.tid >> 3, ch8 = (F.tid & 7) * 8;
            const u32x4 v = *(const u32x4*)(zt + cr * 72 + ch8);
            *(u32x4*)(zT + ((size_t)(c0 + cr) * NB + b) * LS + t0 + ch8) = v;
        }
    }
}
__device__ __forceinline__ void p5_hyena_post(Frame& F, const Args& a, int l) {
    const bf16_t* convT = (const bf16_t*)(F.ws + WS_CONVT); const bf16_t* zT = (const bf16_t*)(F.outb + OUT_ZT); const bf16_t* x0c = (const bf16_t*)(F.ws + WS_H); bf16_t* yhy = (bf16_t*)(F.ws + WS_YHY);
    const float* hb = a.in[I_HBIAS] + (size_t)l * 1024;
    float* tl_ = (float*)(F.shm + 49152);
    for (int tile = F.bid; tile < NB * 64 * 16; tile += F.G) {
        const int b = tile / 1024, r = tile % 1024, t0 = (r >> 4) * 64, c0 = (r & 15) * 64;
        __syncthreads();
        { const int cr = F.tid >> 3, ch8 = (F.tid & 7) * 8; const size_t off = ((size_t)(c0 + cr) * NB + b) * LS + t0 + ch8;
          const u32x4 cv = *(const u32x4*)(convT + off), zv = *(const u32x4*)(zT + off); const float bias = hb[c0 + cr];
#pragma unroll
          for (int j = 0; j < 4; ++j) { tl_[cr * 65 + ch8 + 2 * j] = bflo(cv[j]) + bflo(zv[j]) * bias; tl_[cr * 65 + ch8 + 2 * j + 1] = bfhi(cv[j]) + bfhi(zv[j]) * bias; } }
        __syncthreads();
        const int tl = F.tid >> 3, cc = (F.tid & 7) * 8; const size_t row = (size_t)b * LT + t0 + tl;
        const u32x4 xv = *(const u32x4*)(x0c + row * 1024 + c0 + cc);
        u32x4 w;
#pragma unroll
        for (int j = 0; j < 4; ++j) w[j] = cvtpk(bflo(xv[j]) * tl_[(cc + 2 * j) * 65 + tl], bfhi(xv[j]) * tl_[(cc + 2 * j + 1) * 65 + tl]);
        *(u32x4*)(yhy + row * 1024 + c0 + cc) = w;
    }
}
__device__ __forceinline__ void p4_hyena_ctx(Frame& F, const Args& a, int l) {
    const bf16_t* zctx = (const bf16_t*)(F.ws + WS_ZCTX); const float* fctx = (const float*)(F.ws + WS_FCTX); const bf16_t* x0c = (const bf16_t*)(F.ws + WS_H); bf16_t* yhy = (bf16_t*)(F.ws + WS_YHY);
    const float* hb = a.in[I_HBIAS] + (size_t)l * 1024;
    for (int it = F.bid; it < 256; it += F.G) {
        const int b = it >> 5, tg = (it >> 1) & 15, c = (it & 1) * 512 + F.tid, t0 = tg * 16;
        float acc[16];
#pragma unroll
        for (int j = 0; j < 16; ++j) acc[j] = 0.f;
        for (int s = 0; s < LC; ++s) {
            const float zv = bf2f(zctx[((size_t)b * LC + s) * 1024 + c]);
#pragma unroll
            for (int j = 0; j < 16; ++j) { const int lag = t0 + j - s; const float f = lag >= 0 ? fctx[(size_t)lag * 1024 + c] : fctx[(size_t)(256 - lag) * 1024 + c]; acc[j] += f * zv; }
        }
        const float bias = hb[c];
#pragma unroll
        for (int j = 0; j < 16; ++j) { const size_t row = (size_t)b * LT + LS + t0 + j; const float zv = bf2f(zctx[((size_t)b * LC + t0 + j) * 1024 + c]);
            yhy[row * 1024 + c] = (bf16_t)f2bf(bf2f(x0c[row * 1024 + c]) * (acc[j] + zv * bias)); }
    }
}
__device__ __forceinline__ void p4_hyena_lat(Frame& F) {
    const bf16_t* zT = (const bf16_t*)(F.outb + OUT_ZT); const bf16_t* filtR = (const bf16_t*)(F.outb + OUT_FILT); bf16_t* convT = (bf16_t*)(F.ws + WS_CONVT);
    for (int c = F.bid; c < 1024; c += F.G) hy::conv_channel(F.shm, zT + (size_t)c * NB * LS, filtR + (size_t)c * 8192, convT + (size_t)c * NB * LS);
    asm volatile("s_waitcnt lgkmcnt(0)\n\ts_barrier" ::: "memory");
}

__device__ __forceinline__ void diff_unit(Frame& F, const Args& a, int l, int b, int h, int qrow, bool isctx, float lam, float lam_init) {
    bf16_t* dq = (bf16_t*)(F.ws + WS_DQ); const bf16_t* dk = (const bf16_t*)(F.ws + WS_DK); const bf16_t* dv = (const bf16_t*)(F.ws + WS_DV);
    f32x4* stash = (f32x4*)(F.outb + OUT_STASH) + (size_t)F.bid * 16 * 512 + F.tid;
    const int lane = F.lane, r32 = lane & 31, hi = lane >> 5;
    const size_t brow = (size_t)b * LT;
    f32x16 o[4]; float lf;
#pragma unroll 1
    for (int m = 0; m < 2; ++m) {
        att::Pass P;
        P.Qw = dq + (brow + qrow + F.wave * 32) * 1024 + h * 128 + m * 64; P.ldq = 1024;
        P.Kb = dk + brow * 1024 + h * 128 + m * 64; P.ldk = 1024;
        P.Vb = dv + brow * 1024 + h * 128; P.ldv = 1024;
        if (isctx) { P.nA = 0; P.ks = 0; P.nC = 4; } else { P.nA = LT / 64; P.ks = 0; P.nC = 0; }
        P.band = 0; P.qpos = 0; P.m0 = -INFINITY; P.l0 = 0.f;
        att::flash_pass<128>(F.shm, P, o, lf);
        att::normalize<128>(F.shm, o, lf);
        if (m == 0) {
            unsigned long long spa = (unsigned long long)stash; asm volatile("" : "+v"(spa)); GAS f32x4* sp = (GAS f32x4*)spa;
#pragma unroll
            for (int d = 0; d < 4; ++d)
#pragma unroll
                for (int g = 0; g < 4; ++g) sp[(d * 4 + g) * 512] = (f32x4){o[d][4 * g], o[d][4 * g + 1], o[d][4 * g + 2], o[d][4 * g + 3]};
        }
    }
    float ss[16];
#pragma unroll
    for (int r = 0; r < 16; ++r) ss[r] = 0.f;
    { unsigned long long spa = (unsigned long long)stash; asm volatile("" : "+v"(spa)); const GAS f32x4* sp = (const GAS f32x4*)spa;
#pragma unroll
      for (int d = 0; d < 4; ++d)
#pragma unroll
        for (int g = 0; g < 4; ++g) { const f32x4 o0 = sp[(d * 4 + g) * 512];
#pragma unroll
            for (int j = 0; j < 4; ++j) { const float y = o0[j] - lam * o[d][4 * g + j]; o[d][4 * g + j] = y; ss[4 * g + j] += y * y; } } }
#pragma unroll
    for (int r = 0; r < 16; ++r) { float s = ss[r];
#pragma unroll
        for (int off = 1; off < 32; off <<= 1) s += __shfl_xor(s, off);
        ss[r] = 1.0f / sqrtf(s * (1.0f / 128.0f) + EPS) * (1.0f - lam_init); }
    const float* sg = a.in[I_SUBLN] + (size_t)l * 128;
    unsigned long long yba = (unsigned long long)(dq + (brow + qrow + F.wave * 32 + 4 * hi) * 1024 + h * 128 + r32); asm volatile("" : "+v"(yba)); GAS bf16_t* yb = (GAS bf16_t*)yba;
#pragma unroll
    for (int d = 0; d < 4; ++d) { const float g = sg[32 * d + r32];
#pragma unroll
        for (int r = 0; r < 16; ++r) yb[((r & 3) + 8 * (r >> 2)) * 1024 + 32 * d] = (bf16_t)f2bf(o[d][r] * ss[r] * g); }
}
__device__ __forceinline__ void p4_diff(Frame& F, const Args& a, int l, bool ctx_out) {
    const float* lp = a.in[I_DLAM] + (size_t)l * 256;
    const float d01 = wave_sum(lp[F.lane] * lp[64 + F.lane]), d23 = wave_sum(lp[128 + F.lane] * lp[192 + F.lane]);
    const float lam_init = 0.8f - 0.6f * expf(-0.3f * (float)l);
    const float lam = expf(d01) - expf(d23) + lam_init;
    const int nun = NB * 8 * 16 + (ctx_out ? NB * 8 : 0);
    for (int u = F.bid; u < nun; u += F.G) {
        if (u < NB * 8 * 16) { const int b = u >> 7, h = (u >> 4) & 7, qb = u & 15; diff_unit(F, a, l, b, h, qb * 256, false, lam, lam_init); }
        else { const int v = u - NB * 8 * 16; diff_unit(F, a, l, v >> 3, v & 7, LS, true, lam, lam_init); }
    }
}
__device__ __forceinline__ void swa_unit(Frame& F, const Args& a, int l, int b, int qh, int qrow, bool isctx) {
    bf16_t* sq = (bf16_t*)(F.ws + WS_SQ); const bf16_t* sk = (const bf16_t*)(F.ws + WS_SK); const bf16_t* sv = (const bf16_t*)(F.ws + WS_SV);
    const int lane = F.lane, r32 = lane & 31, hi = lane >> 5; const size_t brow = (size_t)b * LT; const int kvh = qh >> 2;
    att::Pass P;
    P.Qw = sq + (brow + qrow + F.wave * 32) * 1024 + qh * 64; P.ldq = 1024;
    P.Kb = sk + brow * 256 + kvh * 64; P.ldk = 256; P.Vb = sv + brow * 256 + kvh * 64; P.ldv = 256;
    if (isctx) { P.nA = 0; P.ks = 0; P.nC = 4; P.band = 0; }
    else { const int ks = qrow >= 128 ? qrow - 128 : 0, ke = qrow + 384 <= LS ? qrow + 384 : LS; P.ks = ks; P.nA = (ke - ks) >> 6; P.nC = 4; P.band = 1; }
    P.qpos = qrow + F.wave * 32; P.m0 = a.in[I_SINK][l * 16 + qh] * LOG2E; P.l0 = 1.0f;
    f32x16 o[2]; float lf;
    att::flash_pass<64>(F.shm, P, o, lf);
    att::normalize<64>(F.shm, o, lf);
    unsigned long long yba = (unsigned long long)(sq + (brow + qrow + F.wave * 32 + 4 * hi) * 1024 + qh * 64 + r32); asm volatile("" : "+v"(yba)); GAS bf16_t* yb = (GAS bf16_t*)yba;
#pragma unroll
    for (int d = 0; d < 2; ++d)
#pragma unroll
        for (int r = 0; r < 16; ++r) yb[((r & 3) + 8 * (r >> 2)) * 1024 + 32 * d] = (bf16_t)f2bf(o[d][r]);
}
__device__ __forceinline__ void p4_swa(Frame& F, const Args& a, int l, bool ctx_out) {
    const int nun = NB * 16 * 16 + (ctx_out ? NB * 16 : 0);
    for (int u = F.bid; u < nun; u += F.G) {
        if (u < NB * 16 * 16) { const int b = u >> 8, qh = (u >> 4) & 15, qb = u & 15; swa_unit(F, a, l, b, qh, qb * 256, false); }
        else { const int v = u - NB * 16 * 16; swa_unit(F, a, l, v >> 4, v & 15, LS, true); }
    }
}
__device__ __forceinline__ void p8_norm2_router(Frame& F, const Args& a, int l) {
    float* rwT = (float*)F.shm;
    const float* rw = a.in[I_ROUTER] + (size_t)l * 1024 * 16;
    for (int i = F.tid; i < 16384; i += 512) { const int k = i >> 4, e = i & 15; rwT[e * 1024 + k] = rw[i]; }
    __syncthreads();
    const int gw = F.bid * NWAVES + F.wave, NGW = F.G * NWAVES;
    const float* xres = (const float*)(F.ws + WS_XRES); bf16_t* hb = (bf16_t*)(F.ws + WS_H); float* aff = (float*)(F.ws + WS_AFF);
    const float* mods = (const float*)(F.ws + WS_MODS); const float* g2 = a.in[I_N2G] + (size_t)l * 1024;
    for (int row = gw; row < TROWS; row += NGW) {
        asm volatile("" ::: "memory");
        const int b = row / LT, t = row - b * LT; const int mr = t < LS ? b : 8;
        const float* mrow = mods + ((size_t)l * 9 + mr) * 6144;
        f32x4 v[4]; float ss = 0.f;
#pragma unroll
        for (int j = 0; j < 4; ++j) { v[j] = *(const f32x4*)(xres + (size_t)row * 1024 + 4 * F.lane + 256 * j); ss += (v[j][0] * v[j][0] + v[j][1] * v[j][1]) + (v[j][2] * v[j][2] + v[j][3] * v[j][3]); }
        const float rstd = 1.0f / sqrtf(wave_sum(ss) * (1.0f / 1024.0f) + EPS);
#pragma unroll
        for (int j = 0; j < 4; ++j) { const int c = 4 * F.lane + 256 * j; const f32x4 g = *(const f32x4*)(g2 + c), sh = *(const f32x4*)(mrow + 3 * 1024 + c), scl = *(const f32x4*)(mrow + 4 * 1024 + c);
            v[j] = (v[j] * rstd * g) * (scl + 1.0f) + sh;
            u32x2 w; w.x = cvtpk(v[j][0], v[j][1]); w.y = cvtpk(v[j][2], v[j][3]); *(u32x2*)(hb + (size_t)row * 1024 + c) = w; }
        float lg[16];
#pragma unroll
        for (int e = 0; e < 16; ++e) { float s = 0.f;
#pragma unroll
            for (int j = 0; j < 4; ++j) { const f32x4 w = *(const f32x4*)(rwT + e * 1024 + 4 * F.lane + 256 * j); s += (v[j][0] * w[0] + v[j][1] * w[1]) + (v[j][2] * w[2] + v[j][3] * w[3]); }
            lg[e] = wave_sum(s); }
        float mx = lg[0];
#pragma unroll
        for (int e = 1; e < 16; ++e) mx = fmaxf(mx, lg[e]);
        float den = 0.f;
#pragma unroll
        for (int e = 0; e < 16; ++e) { lg[e] = __expf(lg[e] - mx); den += lg[e]; }
        const float inv = 1.0f / den;
        float mine = 0.f;
#pragma unroll
        for (int e = 0; e < 16; ++e) mine = (F.lane == e) ? lg[e] * inv : mine;
        if (F.lane < 16) aff[(size_t)row * 16 + F.lane] = mine;
    }
}
__device__ __forceinline__ void p9_topk(Frame& F) {
    unsigned* hist = (unsigned*)F.shm;
    unsigned* sh = hist + 256;
    const float* aff = (const float*)(F.ws + WS_AFF); int* slotof = (int*)(F.ws + WS_SLOTOF); int* rowsel = (int*)(F.ws + WS_ROWSEL); float* gate = (float*)(F.ws + WS_GATE);
    for (int task = F.bid; task < 256; task += F.G) {
        const bool isctx = task >= 128; const int q = task & 127, b = q >> 4, e = q & 15;
        const int N = isctx ? LC : LS, cap = N / 8, per = isctx ? 1 : 8;
        const int rbase = b * LT + (isctx ? LS : 0);
        const bool act = isctx ? (F.tid < 256) : true;
        unsigned key[8];
#pragma unroll
        for (int j = 0; j < 8; ++j) { key[j] = 0u; if (act && j < per) key[j] = __float_as_uint(aff[(size_t)(rbase + F.tid * per + j) * 16 + e]); }
        unsigned prefix = 0u, krem = (unsigned)cap;
#pragma unroll 1
        for (int pass = 3; pass >= 0; --pass) {
            const int shft = pass * 8; const unsigned himask = pass == 3 ? 0u : (0xffffffffu << (shft + 8));
            __syncthreads();
            if (F.tid < 256) hist[F.tid] = 0u;
            __syncthreads();
#pragma unroll
            for (int j = 0; j < 8; ++j) if (act && j < per && (key[j] & himask) == prefix) atomicAdd(&hist[(key[j] >> shft) & 255u], 1u);
            __syncthreads();
            if (F.tid == 0) { unsigned cum = 0u; int bin = 255; for (; bin > 0; --bin) { if (cum + hist[bin] >= krem) break; cum += hist[bin]; }
                sh[0] = prefix | ((unsigned)bin << shft); sh[1] = krem - cum; }
            __syncthreads();
            prefix = sh[0]; krem = sh[1];
        }
        unsigned cg = 0u, ce = 0u;
#pragma unroll
        for (int j = 0; j < 8; ++j) if (act && j < per) { cg += key[j] > prefix ? 1u : 0u; ce += key[j] == prefix ? 1u : 0u; }
        unsigned pk = cg | (ce << 16), inc = pk;
#pragma unroll
        for (int off = 1; off < 64; off <<= 1) { const unsigned o = __shfl_up(inc, off); if (F.lane >= off) inc += o; }
        __syncthreads();
        if (F.lane == 63) sh[16 + F.wave] = inc;
        __syncthreads();
        unsigned base = 0u;
        for (int w = 0; w < F.wave; ++w) base += sh[16 + w];
        unsigned ex = base + inc - pk; unsigned gb = ex & 0xffffu, eb = ex >> 16;
        const int sbase = isctx ? SLOT_L + (e * NB + b) * CAP_C : (e * NB + b) * CAP_L;
#pragma unroll
        for (int j = 0; j < 8; ++j) if (act && j < per) {
            const int row = rbase + F.tid * per + j; int slot = -1;
            if (key[j] > prefix) { slot = (int)(gb + (eb < krem ? eb : krem)); gb++; }
            else if (key[j] == prefix) { if (eb < krem) slot = (int)(gb + eb); eb++; }
            if (slot >= 0) { rowsel[sbase + slot] = row; gate[sbase + slot] = __uint_as_float(key[j]); slot += sbase; }
            slotof[(size_t)row * 16 + e] = slot;
        }
    }
}
__device__ __forceinline__ void p10_gather(Frame& F) {
    const int gw = F.bid * NWAVES + F.wave, NGW = F.G * NWAVES;
    const bf16_t* hb = (const bf16_t*)(F.ws + WS_H); bf16_t* xg = (bf16_t*)(F.ws + WS_XG); const int* rowsel = (const int*)(F.ws + WS_ROWSEL);
    for (int s = gw; s < SLOTS; s += NGW) { const int row = rowsel[s];
        const u32x4* src = (const u32x4*)(hb + (size_t)row * 1024) + F.lane; u32x4* dst = (u32x4*)(xg + (size_t)s * 1024) + F.lane;
        dst[0] = src[0]; dst[64] = src[64]; }
}
constexpr int PPL = 12;
constexpr int NPHASE = 1 + DEPTH * PPL + 1;

__global__ void __launch_bounds__(NWAVES * 64, 2) mk_fwd(Args args) {
    extern __shared__ __attribute__((aligned(16))) unsigned char lds[];
    Frame F;
    F.lds = (LAS unsigned char*)lds; F.shm = (char*)lds;
    F.tid = threadIdx.x; F.lane = F.tid & 63; F.wave = __builtin_amdgcn_readfirstlane(F.tid >> 6);
    F.G = gridDim.x; F.bid = blockIdx.x; F.ws = args.ws; F.outb = (unsigned char*)args.out;
    volatile LAS unsigned* MISC = (volatile LAS unsigned*)(F.lds + MISC_OFF);
    for (int u = F.tid; u < (LDS_BYTES - LDSCTL_OFF) / 4; u += NWAVES * 64) ((LAS unsigned*)(F.lds + LDSCTL_OFF))[u] = 0u;
    __syncthreads();
    unsigned* ctl = (unsigned*)(F.ws + WS_CTL);
    const int lo = args.ph_lo, hi = args.ph_hi;
    XcdBarrier bar; bar.bar = ctl + CW_BAR; bar.x = 0; bar.st = nullptr;
    if (hi - lo > 1) bar = xcd_barrier_post(ctl + CW_BAR, MISC + 8);
#ifdef MK_ONLY
#define PHON(j) ((j) == MK_ONLY)
#else
#define PHON(j) true
#endif
#define IN(k) (lo <= (k) && (k) < hi)
#define LOCALF Frame Fp = F; asm volatile("" : "+v"(Fp.tid), "+v"(Fp.lane))
#define SEAM(k) do { if (IN((k) + 1)) xcd_barrier(bar); } while (0)

    if (PHON(100) && IN(0)) { LOCALF; p0_mods_zfeat(Fp, args); SEAM(0); }

    for (int l = 0; l < DEPTH; ++l) {
        const int pb = 1 + l * PPL;
        const float* mods_l = (const float*)(F.ws + WS_MODS) + (size_t)l * 9 * 6144;
        if (PHON(0) && IN(pb + 0)) {
#ifndef MK_SUB0
#define MK_SUB0 7
#endif
            LOCALF;
            if (MK_SUB0 & 1) { p1_weights(Fp, args, l); __syncthreads(); }
            if (MK_SUB0 & 2) { p1_filters(Fp, args, l); __syncthreads(); }
            if (MK_SUB0 & 4) { p1_norm1(Fp, args, l); }
            SEAM(pb + 0); }
        if (PHON(1) && IN(pb + 1)) {
            pg8::SchedPlain S; S.init((const bf16_t*)(F.ws + WS_H), (const bf16_t*)(F.ws + WS_WIN), TROWS, DIN, 1024, F.G, F.bid);
            pg8::EpiProj E; E.ws = F.ws;
            pg8::gemm_phase<pg8::EpiProj, pg8::SchedPlain>(F.lds, 1024, S, E);
            SEAM(pb + 1);
        }
        if (PHON(2) && IN(pb + 2)) { LOCALF; p3_rope(Fp); __syncthreads(); p3_hyena_pre(Fp, args, l); SEAM(pb + 2); }
        if (PHON(3) && IN(pb + 3)) {
#ifndef MK_SUB
#define MK_SUB 15
#endif
            LOCALF;
            if (MK_SUB & 1) { p4_diff(Fp, args, l, true); __syncthreads(); }
            if (MK_SUB & 2) { p4_swa(Fp, args, l, true); __syncthreads(); }
            if (MK_SUB & 4) { p4_hyena_lat(Fp); __syncthreads(); }
            if (MK_SUB & 8) { p4_hyena_ctx(Fp, args, l); }
            SEAM(pb + 3); }
        if (PHON(4) && IN(pb + 4)) { LOCALF; p5_hyena_post(Fp, args, l); SEAM(pb + 4); }
        if (PHON(5) && IN(pb + 5)) {
            pg8::SchedBranch S; S.T.init(TROWS / 256, 4); S.G = F.G; S.c = F.bid; S.ws = (const char*)F.ws;
            S.B = (const char*)(F.ws + WS_WBR); S.tstep = (size_t)256 * 1024 * 2; S.bstep = (size_t)1024 * 1024 * 2;
            pg8::EpiBranch E; E.ws = F.ws; static_assert(WS_MERGED == OFF_DK && WS_GT == OFF_GT, "branch epilogue offsets");
            pg8::gemm_phase<pg8::EpiBranch, pg8::SchedBranch>(F.lds, 1024, S, E);
            SEAM(pb + 5);
        }
        if (PHON(6) && IN(pb + 6)) {
            pg8::SchedPlain S; S.init((const bf16_t*)(F.ws + WS_MERGED), (const bf16_t*)(F.ws + WS_WOUT), TROWS, 1024, 1024, F.G, F.bid);
            pg8::EpiResid E; E.xres = (float*)(F.ws + WS_XRES); E.mod = mods_l;
            pg8::gemm_phase<pg8::EpiResid, pg8::SchedPlain>(F.lds, 1024, S, E);
            SEAM(pb + 6);
        }
        if (PHON(7) && IN(pb + 7)) { LOCALF; p8_norm2_router(Fp, args, l); SEAM(pb + 7); }
        if (PHON(8) && IN(pb + 8)) { LOCALF; p9_topk(Fp); SEAM(pb + 8); }
        if (PHON(9) && IN(pb + 9)) { LOCALF; p10_gather(Fp); SEAM(pb + 9); }
        if (PHON(10) && IN(pb + 10)) {
            pg8::SchedMoe S; S.T.init(SLOTS / 256, 8); S.G = F.G; S.c = F.bid; S.A = (const char*)(F.ws + WS_XG); S.B = (const char*)(F.ws + WS_W13); S.tstep = (size_t)256 * 1024 * 2; S.estep = (size_t)2048 * 1024 * 2;
            pg8::EpiSwiglu E; E.hid = (bf16_t*)(F.ws + WS_HID);
            pg8::gemm_phase<pg8::EpiSwiglu, pg8::SchedMoe>(F.lds, 1024, S, E);
            SEAM(pb + 10);
        }
        if (PHON(11) && IN(pb + 11)) {
            pg8::SchedMoe S; S.T.init(SLOTS / 256, 4); S.G = F.G; S.c = F.bid; S.A = (const char*)(F.ws + WS_HID); S.B = (const char*)(F.ws + WS_W2); S.tstep = (size_t)256 * 1024 * 2; S.estep = (size_t)1024 * 1024 * 2;
            pg8::EpiRowScale E; E.out = (bf16_t*)(F.ws + WS_XG); E.gate = (const float*)(F.ws + WS_GATE);
            pg8::gemm_phase<pg8::EpiRowScale, pg8::SchedMoe>(F.lds, 1024, S, E);
            SEAM(pb + 11);
        }
    }
    if (PHON(101) && IN(NPHASE - 1)) { LOCALF; pf_final(Fp, args); }
#undef IN
#undef SEAM
}

extern "C" void kernel_launch(void* const* d_in, const int* in_sizes, int n_in, void* d_out, int out_size, void* d_ws, size_t ws_size, hipStream_t stream) {
    static int grid = 0;
    if (grid == 0) {
        if (n_in != 28 || out_size != NB * LS * D || ws_size < WS_END) { fprintf(stderr, "kernel_launch: unexpected shapes (n_in %d out %d ws %zu need %zu)\n", n_in, out_size, ws_size, (size_t)WS_END); grid = -1; return; }
        int dev = 0, cus = 0, per_cu = 0;
        if (hipGetDevice(&dev) != hipSuccess || hipDeviceGetAttribute(&cus, hipDeviceAttributeMultiprocessorCount, dev) != hipSuccess) { grid = -1; return; }
        if (hipFuncSetAttribute((const void*)mk_fwd, hipFuncAttributeMaxDynamicSharedMemorySize, LDS_BYTES) != hipSuccess) { fprintf(stderr, "kernel_launch: hipFuncSetAttribute failed\n"); grid = -1; return; }
        if (hipOccupancyMaxActiveBlocksPerMultiprocessor(&per_cu, (const void*)mk_fwd, NWAVES * 64, LDS_BYTES) != hipSuccess || per_cu < 1) { fprintf(stderr, "kernel_launch: occupancy query says %d\n", per_cu); }
        (void)hipGetLastError();
        grid = cus;
    }
    if (grid < 0) return;
    if (hipMemsetAsync((char*)d_ws + WS_CTL, 0, CTL_ZERO_BYTES, stream) != hipSuccess) return;
    Args a{};
    for (int i = 0; i < 28; ++i) a.in[i] = (const float*)d_in[i];
    a.out = (float*)d_out; a.ws = (unsigned char*)d_ws;
#if MK_N_LAUNCHES == 1
    a.ph_lo = 0; a.ph_hi = NPHASE;
    hipLaunchKernelGGL(mk_fwd, dim3(grid), dim3(NWAVES * 64), LDS_BYTES, stream, a);
#else
    for (int p = 0; p < NPHASE; ++p) { a.ph_lo = p; a.ph_hi = p + 1; hipLaunchKernelGGL(mk_fwd, dim3(grid), dim3(NWAVES * 64), LDS_BYTES, stream, a); }
#endif
}
```

```cpp
#include <hip/hip_runtime.h>
#include <cstdio>
#include <cstdint>
#include <type_traits>

#ifndef MK_N_LAUNCHES
#define MK_N_LAUNCHES 1
#endif

#define LAS __attribute__((address_space(3)))
#define GAS __attribute__((address_space(1)))
typedef unsigned short bf16_t;
typedef short bf16x8 __attribute__((ext_vector_type(8)));
typedef short s16x4 __attribute__((ext_vector_type(4)));
typedef float f32x2 __attribute__((ext_vector_type(2)));
typedef float f32x4 __attribute__((ext_vector_type(4)));
typedef float f32x16 __attribute__((ext_vector_type(16)));
typedef unsigned u32x2 __attribute__((ext_vector_type(2)));
typedef unsigned u32x4 __attribute__((ext_vector_type(4)));
typedef GAS unsigned gu32;
#define RLX_AGENT __ATOMIC_RELAXED, __HIP_MEMORY_SCOPE_AGENT
#define LDS_WAIT() asm volatile("s_waitcnt lgkmcnt(0)" ::: "memory")
#define VM_WAIT() asm volatile("s_waitcnt vmcnt(0)" ::: "memory")

constexpr int NB = 8, LS = 4096, LC = 256, LT = LS + LC;
constexpr int TROWS = NB * LT;
constexpr int D = 1024, DIN = 10752, DEPTH = 4, NEXP = 16;
constexpr int CAP_L = 512, CAP_C = 32;
constexpr int SLOT_L = NEXP * NB * CAP_L, SLOT_C = NEXP * NB * CAP_C, SLOTS = SLOT_L + SLOT_C;
constexpr float EPS = 1e-6f;
constexpr float LOG2E = 1.4426950408889634f;
constexpr float QSCALE = 0.125f * LOG2E;

__device__ __forceinline__ unsigned f2bf(float f) { unsigned u = __builtin_bit_cast(unsigned, f); return (u + 0x7fffu + ((u >> 16) & 1u)) >> 16; }
__device__ __forceinline__ unsigned pk2(float lo, float hi) { return f2bf(lo) | (f2bf(hi) << 16); }
__device__ __forceinline__ float bf2f(unsigned v) { return __builtin_bit_cast(float, v << 16); }
__device__ __forceinline__ float bflo(unsigned w) { return __builtin_bit_cast(float, w << 16); }
__device__ __forceinline__ float bfhi(unsigned w) { return __builtin_bit_cast(float, w & 0xffff0000u); }
typedef __bf16 bf16x2_t __attribute__((ext_vector_type(2)));
__device__ __forceinline__ unsigned cvtpk(float lo, float hi) { f32x2 v = {lo, hi}; bf16x2_t b = __builtin_convertvector(v, bf16x2_t); return __builtin_bit_cast(unsigned, b); }
__device__ __forceinline__ float wave_sum(float v) {
#pragma unroll
    for (int o = 1; o < 64; o <<= 1) v += __shfl_xor(v, o);
    return v;
}
__device__ __forceinline__ float sin_rev(float rev) { return __builtin_amdgcn_sinf(__builtin_amdgcn_fractf(rev)); }
__device__ __forceinline__ float cos_rev(float rev) { return __builtin_amdgcn_cosf(__builtin_amdgcn_fractf(rev)); }
__device__ __forceinline__ float sin_rad(float x) { return sin_rev(x * 0.15915494309189535f); }
__device__ __forceinline__ float fast_exp(float x) { return __builtin_amdgcn_exp2f(x * LOG2E); }
__device__ __forceinline__ float sigmoidf_(float x) { return __builtin_amdgcn_rcpf(1.0f + fast_exp(-x)); }

constexpr size_t SZ1K = (size_t)TROWS * 1024 * 2;
constexpr size_t OFF_PROJ = (size_t)353 << 20;
constexpr size_t OFF_DQ = OFF_PROJ, OFF_DK = OFF_DQ + SZ1K, OFF_DV = OFF_DK + SZ1K, OFF_HY = OFF_DV + SZ1K, OFF_SQ = OFF_HY + 3 * SZ1K, OFF_SK = OFF_SQ + SZ1K, OFF_SV = OFF_SK + SZ1K / 4, OFF_GT = OFF_SV + SZ1K / 4;
constexpr size_t OFF_YHY = OFF_HY + ((size_t)64 << 20);

namespace pg8 {
constexpr int BM = 256, BK = 64, HALF = 128, HTB = HALF * BK * 2, STAGE_BYTES = 8 * HTB, NXCD = 8, WGM = 8;
__host__ __device__ __forceinline__ int lds_byte(int r, int c) { const int st = (r >> 4) * 2 + (c >> 5), rr = r & 15, cc = c & 31, ob = rr * 64 + cc * 2; return st * 1024 + (ob ^ (((ob >> 9) & 1) << 5)); }
__host__ __device__ __forceinline__ void stage_rc(int b, int& R, int& C) { const int st = b / 1024, sb = b % 1024, swz = sb ^ (((sb >> 9) & 1) << 5); R = (st >> 1) * 16 + swz / 64; C = (st & 1) * 32 + (swz % 64) / 2; }
__host__ __device__ __forceinline__ int perm32(int rho) { const int n = rho >> 4, i = rho & 15; return 8 * (i >> 2) + 4 * n + (i & 3); }

struct Unit { int pm, pn, aux; const char* A; const char* B; };

struct TileOrder {
    int nM, nN, nwg;
    __device__ __forceinline__ void init(int nM_, int nN_) { nM = nM_; nN = nN_; nwg = nM * nN; }
    __device__ __forceinline__ void map(int L, int& pm, int& pn) const {
        int wgid = L; { const int q = nwg / NXCD, r = nwg % NXCD, xcd = wgid % NXCD, off = wgid / NXCD; wgid = (xcd < r ? xcd * (q + 1) : r * (q + 1) + (xcd - r) * q) + off; }
        const int nig = WGM * nN, gid = wgid / nig, fm = gid * WGM, gsz = (nM - fm) < WGM ? (nM - fm) : WGM;
        pm = fm + ((wgid % nig) % gsz); pn = (wgid % nig) / gsz;
    }
};

template <class Epi, class Sched>
__device__ __forceinline__ void gemm_phase(LAS unsigned char* lds, const int K, const Sched& S, const Epi& E) {
    int tid_ = threadIdx.x; asm volatile("" : "+v"(tid_));
    const int tid = tid_, wid = __builtin_amdgcn_readfirstlane(tid >> 6), lane = tid & 63, wr = wid >> 2, wc = wid & 3, fr = lane & 15, fq = lane >> 4;
    const int nt = K / BK;
    unsigned voffA[2], voffB[2];
#pragma unroll
    for (int i = 0; i < 2; ++i) { int R, C; stage_rc(tid * 16 + i * 8192, R, C); const int Rb = Epi::PERM ? ((R & ~31) + perm32(R & 31)) : R;
        voffA[i] = (unsigned)(R * K + C) * 2u; voffB[i] = (unsigned)(Rb * K + C) * 2u; }
    const size_t kstep = (size_t)(BK * 2);
    const size_t hstep = (size_t)HALF * K * 2;
    const unsigned ldsw = (unsigned)wid * 1024u;
    const int aoff = lds_byte(wr * 64 + fr, fq * 8), boff = lds_byte(wc * 32 + fr, fq * 8);
#define PG8_SA(b, h) (((b) * 2 + (h)) * HTB)
#define PG8_SB(b, h) ((4 + (b) * 2 + (h)) * HTB)
#define PG8_STAGE(bufoff, gbase, voff) do { _Pragma("unroll") for (int _i = 0; _i < 2; ++_i) \
        __builtin_amdgcn_global_load_lds((const unsigned*)((const char*)(gbase) + (voff)[_i]), (LAS unsigned*)(lds + (bufoff) + ldsw + _i * 8192), 16, 0, 0); } while (0)
#define PG8_LDA(dst, b, h) do { _Pragma("unroll") for (int m = 0; m < 4; ++m) _Pragma("unroll") for (int k = 0; k < 2; ++k) dst[m][k] = *(const LAS bf16x8*)(lds + PG8_SA(b, h) + aoff + m * 2048 + k * 1024); } while (0)
#define PG8_LDB(dst, b, h) do { _Pragma("unroll") for (int n = 0; n < 2; ++n) _Pragma("unroll") for (int k = 0; k < 2; ++k) dst[n][k] = *(const LAS bf16x8*)(lds + PG8_SB(b, h) + boff + n * 2048 + k * 1024); } while (0)
#define PG8_MMA(ai, bj, At, Bt) do { __builtin_amdgcn_s_setprio(1); _Pragma("unroll") for (int m = 0; m < 4; ++m) _Pragma("unroll") for (int n = 0; n < 2; ++n) _Pragma("unroll") for (int k = 0; k < 2; ++k) \
        acc[ai][bj][m][n] = __builtin_amdgcn_mfma_f32_16x16x32_bf16(Bt[n][k], At[m][k], acc[ai][bj][m][n], 0, 0, 0); __builtin_amdgcn_s_setprio(0); } while (0)
#define PG8_WAIT_V(n) asm volatile("s_waitcnt vmcnt(" #n ")" ::: "memory")
#define PG8_WAIT_L(n) asm volatile("s_waitcnt lgkmcnt(" #n ")" ::: "memory")
#define PG8_BAR __builtin_amdgcn_s_barrier()
#define PG8_SCHED __builtin_amdgcn_sched_barrier(0)
    Unit cur, nxt; int ui = 0;
    if (!S.next(0, cur)) return;
    f32x4 acc[2][2][4][2];
#pragma unroll
    for (int a = 0; a < 2; ++a)
#pragma unroll
        for (int b = 0; b < 2; ++b)
#pragma unroll
            for (int m = 0; m < 4; ++m)
#pragma unroll
                for (int n = 0; n < 2; ++n) acc[a][b][m][n] = (f32x4){0.f, 0.f, 0.f, 0.f};
    bf16x8 At[4][2], B0[2][2], B1[2][2];
    const char* cA = cur.A; const char* cB = cur.B;
    PG8_STAGE(PG8_SB(0, 0), cB, voffB); PG8_STAGE(PG8_SB(0, 1), cB + hstep, voffB); PG8_STAGE(PG8_SA(0, 0), cA, voffA); PG8_STAGE(PG8_SA(0, 1), cA + hstep, voffA);
    if (wr == 1) PG8_BAR;
    PG8_WAIT_V(2); PG8_BAR;
    PG8_STAGE(PG8_SB(1, 0), cB + kstep, voffB); PG8_STAGE(PG8_SA(1, 0), cA + kstep, voffA); PG8_STAGE(PG8_SB(1, 1), cB + hstep + kstep, voffB);
    PG8_WAIT_V(6); PG8_BAR;
    for (;;) {
        const bool has_next = S.next(ui + 1, nxt);
        const char* nA = has_next ? nxt.A : cA; const char* nB = has_next ? nxt.B : cB;
        for (int t = 0; t < nt; t += 2) {
            const bool last = (t == nt - 2);
            const char* a1 = cA + (size_t)(t + 1) * kstep;
            const char* a2 = last ? nA : cA + (size_t)(t + 2) * kstep; const char* b2 = last ? nB : cB + (size_t)(t + 2) * kstep;
            const char* a3 = a2 + kstep; const char* b3 = b2 + kstep;
            PG8_LDB(B0, 0, 0); PG8_LDB(B1, 0, 1); PG8_SCHED; PG8_LDA(At, 0, 0); PG8_STAGE(PG8_SA(1, 1), a1 + hstep, voffA);
            PG8_WAIT_V(8); PG8_WAIT_L(0); PG8_BAR; PG8_MMA(0, 0, At, B0); PG8_MMA(0, 1, At, B1); PG8_BAR; PG8_SCHED;
            PG8_LDA(At, 0, 1); PG8_STAGE(PG8_SB(0, 0), b2, voffB); PG8_STAGE(PG8_SB(0, 1), b2 + hstep, voffB); PG8_STAGE(PG8_SA(0, 0), a2, voffA);
            PG8_WAIT_V(8); PG8_WAIT_L(0); PG8_BAR; PG8_MMA(1, 0, At, B0); PG8_MMA(1, 1, At, B1); PG8_BAR; PG8_SCHED;
            PG8_LDB(B0, 1, 0); PG8_LDB(B1, 1, 1); PG8_SCHED; PG8_LDA(At, 1, 0); PG8_STAGE(PG8_SA(0, 1), a2 + hstep, voffA);
            PG8_WAIT_V(8); PG8_WAIT_L(0); PG8_BAR; PG8_MMA(0, 0, At, B0); PG8_MMA(0, 1, At, B1); PG8_BAR; PG8_SCHED;
            PG8_LDA(At, 1, 1); PG8_STAGE(PG8_SB(1, 0), b3, voffB); PG8_STAGE(PG8_SB(1, 1), b3 + hstep, voffB); PG8_STAGE(PG8_SA(1, 0), a3, voffA);
            PG8_WAIT_V(8); PG8_WAIT_L(0); PG8_BAR; PG8_MMA(1, 0, At, B0); PG8_MMA(1, 1, At, B1); PG8_BAR; PG8_SCHED;
        }
        if (wr == 0) PG8_BAR;
        E(acc, cur, wr, wc, fr, fq);
        if (!has_next) break;
        if (!E.keep(cur)) {
#pragma unroll
            for (int a = 0; a < 2; ++a)
#pragma unroll
                for (int b = 0; b < 2; ++b)
#pragma unroll
                    for (int m = 0; m < 4; ++m)
#pragma unroll
                        for (int n = 0; n < 2; ++n) acc[a][b][m][n] = (f32x4){0.f, 0.f, 0.f, 0.f};
        }
        cur = nxt; cA = nA; cB = nB; ++ui;
        if (wr == 1) PG8_BAR;
    }
    PG8_WAIT_V(0);
    PG8_BAR;
#undef PG8_SA
#undef PG8_SB
#undef PG8_STAGE
#undef PG8_LDA
#undef PG8_LDB
#undef PG8_MMA
#undef PG8_WAIT_V
#undef PG8_WAIT_L
#undef PG8_BAR
#undef PG8_SCHED
}
}
namespace pg8 {

struct SchedPlain {
    TileOrder T; int G, c; const char* A; const char* B; size_t tstep; int latonly;
    __device__ __forceinline__ void init(const bf16_t* A_, const bf16_t* B_, int M, int N, int K, int G_, int c_, int latonly_ = 0) { latonly = latonly_; T.init(latonly_ ? NB * 16 : M / BM, N / BM); G = G_; c = c_; A = (const char*)A_; B = (const char*)B_; tstep = (size_t)BM * K * 2; }
    __device__ __forceinline__ bool next(int i, Unit& u) const {
        const long L = (long)i * G + c; if (L >= T.nwg) return false;
        T.map((int)L, u.pm, u.pn); if (latonly) u.pm = (u.pm >> 4) * 17 + (u.pm & 15); u.aux = 0; u.A = A + (size_t)u.pm * tstep; u.B = B + (size_t)u.pn * tstep; return true;
    }
};

struct EpiProj {
    static constexpr bool PERM = true;
    unsigned char* ws;
    const LAS float* rope;
    __device__ __forceinline__ bool keep(const Unit&) const { return false; }
    __device__ __forceinline__ void operator()(f32x4 (&acc)[2][2][4][2], const Unit& u, int wr, int wc, int fr, int fq) const {
        const int pn = u.pn; int t0, ldc; size_t boff; bool roped = false; float scl = 1.0f;
        if (pn < 4) { boff = OFF_DQ; t0 = 0; ldc = 1024; }                           else if (pn < 8) { boff = OFF_DK; t0 = 4; ldc = 1024; roped = true; } else if (pn < 12) { boff = OFF_DV; t0 = 8; ldc = 1024; }
        else if (pn < 24) { boff = OFF_HY; t0 = 12; ldc = 3072; } else if (pn < 28) { boff = OFF_SQ; t0 = 24; ldc = 1024; } else if (pn < 29) { boff = OFF_SK; t0 = 28; ldc = 256; roped = true; }
        else if (pn < 30) { boff = OFF_SV; t0 = 29; ldc = 256; } else { boff = OFF_GT; t0 = 30; ldc = 3072; }
        bf16_t* base = (bf16_t*)(ws + boff);
        const int row0 = u.pm * BM + wr * 64 + fr, col0 = (pn - t0) * BM + wc * 32 + 8 * fq;
        const int tb = (u.pm % 17) * BM;
        const bool lat = tb < LS;
        if (roped) {
            const int ax = wc & 1, half = fq >> 1, f0 = 8 * (fq & 1);
#pragma unroll
            for (int ai = 0; ai < 2; ++ai)
#pragma unroll
                for (int m = 0; m < 4; ++m) {
                    const int t = tb + wr * 64 + fr + ai * HALF + m * 16; const int pos = ax == 0 ? (t >> 6) : (t & 63);
                    f32x4 c0 = (f32x4){1.f, 1.f, 1.f, 1.f}, c1 = c0, s0 = (f32x4){0.f, 0.f, 0.f, 0.f}, s1 = s0;
                    if (lat) { const LAS float* cp = rope + pos * 16 + f0; c0 = *(const LAS f32x4*)cp; c1 = *(const LAS f32x4*)(cp + 4); s0 = *(const LAS f32x4*)(cp + 1024); s1 = *(const LAS f32x4*)(cp + 1028); }
                    if (half == 0) { s0 = -s0; s1 = -s1; }
                    bf16_t* rowp = base + (size_t)(row0 + ai * HALF + m * 16) * ldc + col0;
#pragma unroll
                    for (int bj = 0; bj < 2; ++bj) { const f32x4 v0 = acc[ai][bj][m][0], v1 = acc[ai][bj][m][1];
                        f32x4 q0, q1;
#pragma unroll
                        for (int j = 0; j < 4; ++j) {
                            const auto r0 = __builtin_amdgcn_permlane32_swap(__float_as_uint(v0[j]), __float_as_uint(v0[j]), false, false);
                            const auto r1 = __builtin_amdgcn_permlane32_swap(__float_as_uint(v1[j]), __float_as_uint(v1[j]), false, false);
                            q0[j] = __uint_as_float(half == 0 ? r0[1] : r0[0]); q1[j] = __uint_as_float(half == 0 ? r1[1] : r1[0]); }
                        const f32x4 o0 = (v0 * c0 + q0 * s0) * scl, o1 = (v1 * c1 + q1 * s1) * scl;
                        u32x4 w; w.x = cvtpk(o0[0], o0[1]); w.y = cvtpk(o0[2], o0[3]); w.z = cvtpk(o1[0], o1[1]); w.w = cvtpk(o1[2], o1[3]);
                        *(u32x4*)(rowp + bj * HALF) = w; }
                }
            return;
        }
#pragma unroll
        for (int ai = 0; ai < 2; ++ai)
#pragma unroll
            for (int m = 0; m < 4; ++m) { bf16_t* rowp = base + (size_t)(row0 + ai * HALF + m * 16) * ldc + col0;
#pragma unroll
                for (int bj = 0; bj < 2; ++bj) { const f32x4 v0 = acc[ai][bj][m][0], v1 = acc[ai][bj][m][1];
                    u32x4 w; w.x = cvtpk(v0[0], v0[1]); w.y = cvtpk(v0[2], v0[3]); w.z = cvtpk(v1[0], v1[1]); w.w = cvtpk(v1[2], v1[3]);
                    *(u32x4*)(rowp + bj * HALF) = w; } }
    }
};

struct SchedBranch {
    TileOrder T; int G, c; const char* ws; const char* B; size_t tstep, bstep; int latonly;
    __device__ __forceinline__ bool next(int i, Unit& u) const {
        const int ti = i / 3, br = i - ti * 3; const long L = (long)ti * G + c; if (L >= T.nwg) return false;
        T.map((int)L, u.pm, u.pn); if (latonly) u.pm = (u.pm >> 4) * 17 + (u.pm & 15); u.aux = br; size_t ao = br == 0 ? OFF_DQ : (br == 1 ? OFF_YHY : OFF_SQ); asm volatile("" : "+s"(ao));     u.A = ws + ao + (size_t)u.pm * tstep; u.B = B + (size_t)br * bstep + (size_t)u.pn * tstep; return true;
    }
};
struct EpiBranch {
    static constexpr bool PERM = true;
    unsigned char* ws;
    __device__ __forceinline__ bool keep(const Unit& u) const { return u.aux < 2; }
    __device__ __forceinline__ void operator()(f32x4 (&acc)[2][2][4][2], const Unit& u, int wr, int wc, int fr, int fq) const {
        const int br = u.aux;
        const bf16_t* gt = (const bf16_t*)(ws + OFF_GT); bf16_t* out = (bf16_t*)(ws + OFF_DK);
        const int row0 = u.pm * BM + wr * 64 + fr, col0 = u.pn * BM + wc * 32 + 8 * fq;
#pragma unroll
        for (int ai = 0; ai < 2; ++ai) {
            u32x4 GA[4][2], GB[4][2];
#pragma unroll
            for (int m = 0; m < 4; ++m)
#pragma unroll
                for (int bj = 0; bj < 2; ++bj) { const bf16_t* gp = gt + (size_t)(row0 + ai * HALF + m * 16) * 3072 + br * 1024 + col0 + bj * HALF;
                    GA[m][bj] = *(const u32x4*)gp; GB[m][bj] = br < 2 ? *(const u32x4*)(gp + 1024) : (u32x4){0u, 0u, 0u, 0u}; }
#pragma unroll
            for (int m = 0; m < 4; ++m) { const size_t row = (size_t)(row0 + ai * HALF + m * 16);
#pragma unroll
                for (int bj = 0; bj < 2; ++bj) {
                    const u32x4 ga = GA[m][bj], gb = GB[m][bj];
                    float s[8];
                    if (br < 2) {
#pragma unroll
                        for (int j = 0; j < 4; ++j) {
                            const float a0 = bflo(ga[j]), a1 = bfhi(ga[j]), b0 = bflo(gb[j]), b1 = bfhi(gb[j]);
                            s[2 * j]     = (1.0f + fast_exp(fminf(-b0, 80.f))) * __builtin_amdgcn_rcpf(1.0f + fast_exp(fminf(-a0, 80.f)));
                            s[2 * j + 1] = (1.0f + fast_exp(fminf(-b1, 80.f))) * __builtin_amdgcn_rcpf(1.0f + fast_exp(fminf(-a1, 80.f)));
                        }
                    } else {
#pragma unroll
                        for (int j = 0; j < 4; ++j) { s[2 * j] = __builtin_amdgcn_rcpf(1.0f + fast_exp(fminf(-bflo(ga[j]), 80.f))); s[2 * j + 1] = __builtin_amdgcn_rcpf(1.0f + fast_exp(fminf(-bfhi(ga[j]), 80.f))); }
                    }
                    f32x4 v0 = acc[ai][bj][m][0], v1 = acc[ai][bj][m][1];
                    v0[0] *= s[0]; v0[1] *= s[1]; v0[2] *= s[2]; v0[3] *= s[3]; v1[0] *= s[4]; v1[1] *= s[5]; v1[2] *= s[6]; v1[3] *= s[7];
                    if (br < 2) { acc[ai][bj][m][0] = v0; acc[ai][bj][m][1] = v1; }
                    else { u32x4 w; w.x = cvtpk(v0[0], v0[1]); w.y = cvtpk(v0[2], v0[3]); w.z = cvtpk(v1[0], v1[1]); w.w = cvtpk(v1[2], v1[3]);
                        *(u32x4*)(out + row * 1024 + col0 + bj * HALF) = w; }
                } }
            asm volatile("" ::: "memory"); }
    }
};

struct EpiResid {
    static constexpr bool PERM = false;
    float* xres; const float* mod; int dry;
    __device__ __forceinline__ bool keep(const Unit&) const { return false; }
    __device__ __forceinline__ void operator()(f32x4 (&acc)[2][2][4][2], const Unit& u, int wr, int wc, int fr, int fq) const {
        const int b = u.pm / 17, isctx = (u.pm - b * 17) == 16; const float* mrow = mod + (size_t)(isctx ? 8 : b) * 6144 + 2 * 1024;
        const int row0 = u.pm * BM + wr * 64 + fr, col0 = u.pn * BM + wc * 32 + 4 * fq;
        f32x4 mv[2][2];
#pragma unroll
        for (int bj = 0; bj < 2; ++bj)
#pragma unroll
            for (int n = 0; n < 2; ++n) mv[bj][n] = *(const f32x4*)(mrow + col0 + bj * HALF + n * 16);
#pragma unroll
        for (int ai = 0; ai < 2; ++ai)
#pragma unroll
            for (int m = 0; m < 4; ++m) { float* rowp = xres + (size_t)(row0 + ai * HALF + m * 16) * 1024 + col0;
#pragma unroll
                for (int bj = 0; bj < 2; ++bj)
#pragma unroll
                    for (int n = 0; n < 2; ++n) { f32x4* p = (f32x4*)(rowp + bj * HALF + n * 16); const f32x4 x = *p; if (!dry) *p = x + mv[bj][n] * acc[ai][bj][m][n]; }
                if (m == 3) asm volatile("" ::: "memory"); }
    }
};

struct SchedMoe {
    TileOrder T; int G, c; const char* A; const char* B; size_t tstep, estep;
    __device__ __forceinline__ bool next(int i, Unit& u) const {
        const long L = (long)i * G + c; if (L >= T.nwg) return false;
        T.map((int)L, u.pm, u.pn); const int e = u.pm < 256 ? (u.pm >> 4) : (u.pm - 256); u.aux = e;
        u.A = A + (size_t)u.pm * tstep; u.B = B + (size_t)e * estep + (size_t)u.pn * tstep; return true;
    }
};
struct EpiSwiglu {
    static constexpr bool PERM = true;
    bf16_t* hid;
    __device__ __forceinline__ bool keep(const Unit&) const { return false; }
    __device__ __forceinline__ void operator()(f32x4 (&acc)[2][2][4][2], const Unit& u, int wr, int wc, int fr, int fq) const {
        const int row0 = u.pm * BM + wr * 64 + fr, col0 = u.pn * HALF + wc * 32 + 8 * fq;
#pragma unroll
        for (int ai = 0; ai < 2; ++ai)
#pragma unroll
            for (int m = 0; m < 4; ++m) { bf16_t* rowp = hid + (size_t)(row0 + ai * HALF + m * 16) * 1024 + col0;
                float h[8];
#pragma unroll
                for (int n = 0; n < 2; ++n)
#pragma unroll
                    for (int j = 0; j < 4; ++j) { const float a = acc[ai][0][m][n][j], b = acc[ai][1][m][n][j]; h[4 * n + j] = a * __builtin_amdgcn_rcpf(1.0f + fast_exp(-a)) * b; }
                u32x4 w; w.x = cvtpk(h[0], h[1]); w.y = cvtpk(h[2], h[3]); w.z = cvtpk(h[4], h[5]); w.w = cvtpk(h[6], h[7]);
                *(u32x4*)rowp = w; }
    }
};
struct EpiRowScale {
    static constexpr bool PERM = true;
    bf16_t* out; const float* gate;
    __device__ __forceinline__ bool keep(const Unit&) const { return false; }
    __device__ __forceinline__ void operator()(f32x4 (&acc)[2][2][4][2], const Unit& u, int wr, int wc, int fr, int fq) const {
        const int row0 = u.pm * BM + wr * 64 + fr, col0 = u.pn * BM + wc * 32 + 8 * fq;
#pragma unroll
        for (int ai = 0; ai < 2; ++ai)
#pragma unroll
            for (int m = 0; m < 4; ++m) { const int row = row0 + ai * HALF + m * 16; const float g = gate[row]; bf16_t* rowp = out + (size_t)row * 1024 + col0;
#pragma unroll
                for (int bj = 0; bj < 2; ++bj) { const f32x4 v0 = acc[ai][bj][m][0] * g, v1 = acc[ai][bj][m][1] * g;
                    u32x4 w; w.x = cvtpk(v0[0], v0[1]); w.y = cvtpk(v0[2], v0[3]); w.z = cvtpk(v1[0], v1[1]); w.w = cvtpk(v1[2], v1[3]);
                    *(u32x4*)(rowp + bj * HALF) = w; } }
    }
};
}
namespace att {
__device__ __forceinline__ int crow(int r, int hi) { return (r & 3) + 8 * (r >> 2) + 4 * hi; }
__device__ __forceinline__ void glds16(const void* gsrc, unsigned lds_dst) { unsigned keep;
    asm volatile("s_mov_b32 %0, m0\n\ts_mov_b32 m0, %2\n\ts_nop 0\n\tglobal_load_lds_dwordx4 %1, off\n\ts_mov_b32 m0, %0" : "=&s"(keep) : "v"(gsrc), "s"(lds_dst) : "memory"); }
#define ATT_WAIT_BAR() asm volatile("s_waitcnt vmcnt(0) lgkmcnt(0)\n\ts_barrier" ::: "memory")

constexpr int KSLOT = 8192;
constexpr int NSLOT = 4;
template <int DV> struct Lay { static constexpr int VSLOT = DV * 128, K0 = 0, V0 = NSLOT * KSLOT, WS = V0 + NSLOT * VSLOT, BYTES = WS + 8 * 256; };

struct Pass {
    const bf16_t* Qw; int ldq;
    const bf16_t* Kb; int ldk;
    const bf16_t* Vb; int ldv;
    int nA, ks, nC;
    int band;
    int qpos;
    float m0, l0;
    int rope; const LAS float* rtab;
};

__device__ __forceinline__ float max3f(float a, float b, float c) { float r; asm("v_max3_f32 %0, %1, %2, %3" : "=v"(r) : "v"(a), "v"(b), "v"(c)); return r; }
constexpr float ATT_THR = 8.0f;

template <int DV>
__device__ __forceinline__ void flash_pass(char* shm, const Pass& P, f32x16 (&o)[DV / 32], f32x16& osum) {
    typedef Lay<DV> L;
    int tid_ = threadIdx.x; asm volatile("" : "+v"(tid_));
    const int tid = tid_, lane = tid & 63, r32 = lane & 31, hi = lane >> 5; const int wid = __builtin_amdgcn_readfirstlane(tid >> 6);
    const unsigned lds0 = (unsigned)(uintptr_t)shm;
    float* wsf = (float*)(shm + L::WS) + wid * 64;
    const int NT = P.nA + P.nC;
    bf16x8 qr[4];
#pragma unroll
    for (int d0 = 0; d0 < 4; ++d0) qr[d0] = *reinterpret_cast<const bf16x8*>(P.Qw + (size_t)r32 * P.ldq + d0 * 16 + hi * 8);
    { const int tq = P.qpos + r32;
#pragma unroll
      for (int ax = 0; ax < 2; ++ax) {
          f32x4 c0 = (f32x4){1.f, 1.f, 1.f, 1.f}, c1 = c0, s0 = (f32x4){0.f, 0.f, 0.f, 0.f}, s1 = s0;
          if (P.rope) { const LAS float* cp = P.rtab + (ax == 0 ? (tq >> 6) : (tq & 63)) * 16 + 8 * hi; c0 = *(const LAS f32x4*)cp; c1 = *(const LAS f32x4*)(cp + 4); s0 = *(const LAS f32x4*)(cp + 1024); s1 = *(const LAS f32x4*)(cp + 1028); }
          const u32x4 a = __builtin_bit_cast(u32x4, qr[2 * ax]), b = __builtin_bit_cast(u32x4, qr[2 * ax + 1]); u32x4 oa, ob;
#pragma unroll
          for (int j = 0; j < 4; ++j) { const float cl = j < 2 ? c0[2 * j] : c1[2 * j - 4], ch = j < 2 ? c0[2 * j + 1] : c1[2 * j - 3], sl_ = j < 2 ? s0[2 * j] : s1[2 * j - 4], sh_ = j < 2 ? s0[2 * j + 1] : s1[2 * j - 3];
              const float x1l = bflo(a[j]), x1h = bfhi(a[j]), x2l = bflo(b[j]), x2h = bfhi(b[j]);
              oa[j] = cvtpk((x1l * cl - x2l * sl_) * QSCALE, (x1h * ch - x2h * sh_) * QSCALE); ob[j] = cvtpk((x2l * cl + x1l * sl_) * QSCALE, (x2h * ch + x1h * sh_) * QSCALE); }
          qr[2 * ax] = __builtin_bit_cast(bf16x8, oa); qr[2 * ax + 1] = __builtin_bit_cast(bf16x8, ob); } }
#pragma unroll
    for (int d = 0; d < DV / 32; ++d) o[d] = f32x16{};
    float lsum = (hi == 0) ? P.l0 : 0.f;
    const bf16_t* ksrc = P.Kb + (size_t)lane * P.ldk + wid * 8;
    const bf16_t* vsrc = P.Vb + (size_t)(16 * (wid & 3) + (lane >> 2)) * P.ldv + (wid >> 2) * 32 + (lane & 3) * 8;
#define ATT_KEYROW(t) ((t) < P.nA ? P.ks + 64 * (t) : LS + 64 * ((t) - P.nA))
#define ATT_DMA_K(t, slot) do { const int kr_ = ATT_KEYROW(t); \
        glds16(ksrc + (size_t)kr_ * P.ldk, (unsigned)__builtin_amdgcn_readfirstlane(lds0 + L::K0 + (slot) * KSLOT + wid * 1024)); } while (0)
#define ATT_DMA_V(t, slot, s2_) do { const int kr_ = ATT_KEYROW(t); \
        glds16(vsrc + (size_t)kr_ * P.ldv + (s2_) * 64, (unsigned)__builtin_amdgcn_readfirstlane(lds0 + L::V0 + (slot) * L::VSLOT + (s2_) * 8192 + wid * 1024)); } while (0)
#define ATT_DMA(t, slot) do { ATT_DMA_K(t, slot); _Pragma("unroll") for (int s2__ = 0; s2__ < DV / 64; ++s2__) ATT_DMA_V(t, slot, s2__); } while (0)
#define ATT_QK(p0_, p1_, slot, cinit) do { const char* kb_ = shm + L::K0 + (slot) * KSLOT + hi * 1024 + r32 * 16; bf16x8 kf_[4]; \
        _Pragma("unroll") for (int d0 = 0; d0 < 2; ++d0) { kf_[2 * d0] = *reinterpret_cast<const bf16x8*>(kb_ + d0 * 2048); kf_[2 * d0 + 1] = *reinterpret_cast<const bf16x8*>(kb_ + d0 * 2048 + 512); } \
        __builtin_amdgcn_sched_barrier(0);        \
        p0_ = __builtin_amdgcn_mfma_f32_32x32x16_bf16(kf_[0], qr[0], cinit, 0, 0, 0); p1_ = __builtin_amdgcn_mfma_f32_32x32x16_bf16(kf_[1], qr[0], cinit, 0, 0, 0); \
        p0_ = __builtin_amdgcn_mfma_f32_32x32x16_bf16(kf_[2], qr[1], p0_, 0, 0, 0); p1_ = __builtin_amdgcn_mfma_f32_32x32x16_bf16(kf_[3], qr[1], p1_, 0, 0, 0); \
        __builtin_amdgcn_sched_barrier(0); \
        _Pragma("unroll") for (int d0 = 2; d0 < 4; ++d0) { kf_[2 * d0 - 4] = *reinterpret_cast<const bf16x8*>(kb_ + d0 * 2048); kf_[2 * d0 - 3] = *reinterpret_cast<const bf16x8*>(kb_ + d0 * 2048 + 512); } \
        __builtin_amdgcn_sched_barrier(0); \
        p0_ = __builtin_amdgcn_mfma_f32_32x32x16_bf16(kf_[0], qr[2], p0_, 0, 0, 0); p1_ = __builtin_amdgcn_mfma_f32_32x32x16_bf16(kf_[1], qr[2], p1_, 0, 0, 0); \
        p0_ = __builtin_amdgcn_mfma_f32_32x32x16_bf16(kf_[2], qr[3], p0_, 0, 0, 0); p1_ = __builtin_amdgcn_mfma_f32_32x32x16_bf16(kf_[3], qr[3], p1_, 0, 0, 0); } while (0)
#define ATT_ROWMAX(rm_, p0_, p1_) do { float a_ = max3f(p0_[0], p0_[1], p1_[0]), b_ = max3f(p0_[2], p0_[3], p1_[1]); a_ = max3f(a_, p1_[2], p1_[3]); \
        _Pragma("unroll") for (int r = 4; r < 16; r += 4) { a_ = max3f(a_, p0_[r], p0_[r + 1]); b_ = max3f(b_, p0_[r + 2], p0_[r + 3]); a_ = max3f(a_, p1_[r], p1_[r + 1]); b_ = max3f(b_, p1_[r + 2], p1_[r + 3]); } \
        rm_ = fmaxf(a_, b_); auto rr_ = __builtin_amdgcn_permlane32_swap(__float_as_uint(rm_), __float_as_uint(rm_), false, false); rm_ = fmaxf(__uint_as_float(rr_[0]), __uint_as_float(rr_[1])); } while (0)
    ATT_DMA(0, 0);
#define ATT_WAITV(ktiles) do { if ((ktiles) == 0) asm volatile("s_waitcnt vmcnt(0)" ::: "memory"); \
        else if ((ktiles) == 1) { if (DV == 128) asm volatile("s_waitcnt vmcnt(3)" ::: "memory"); else asm volatile("s_waitcnt vmcnt(2)" ::: "memory"); } \
        else { if (DV == 128) asm volatile("s_waitcnt vmcnt(6)" ::: "memory"); else asm volatile("s_waitcnt vmcnt(4)" ::: "memory"); } } while (0)
    if (NT > 1) ATT_DMA(1, 1);
    if (NT > 2) ATT_DMA(2, 2);
    { const int younger = NT > 2 ? 2 : (NT > 1 ? 1 : 0); ATT_WAITV(younger); }
    asm volatile("s_waitcnt lgkmcnt(0)\n\ts_barrier" ::: "memory");
    f32x16 p0, p1, n0, n1, negm;
    { const f32x16 zero = f32x16{}; ATT_QK(p0, p1, 0, zero); }
    asm volatile("s_nop 15\n\ts_nop 7" : "+v"(p0), "+v"(p1));
    float m = P.m0;
    if (!(P.m0 > -INFINITY)) { float rm0; ATT_ROWMAX(rm0, p0, p1); m = rm0; }
#pragma unroll
    for (int r = 0; r < 16; ++r) { p0[r] -= m; p1[r] -= m; negm[r] = -m; }
    int sl = 0;
    for (int t = 0; t < NT; ++t) {
        { const int younger = t + 2 < NT ? 1 : 0; ATT_WAITV(younger); }
        asm volatile("s_waitcnt lgkmcnt(0)\n\ts_barrier" ::: "memory");
        const int sl1 = (sl + 1) & (NSLOT - 1), sl2 = (sl + 3) & (NSLOT - 1);
        if (t + 1 < NT) { ATT_QK(n0, n1, sl1, negm); }
        __builtin_amdgcn_sched_barrier(0);
        const bool pre = t + 3 < NT;
        if (pre) ATT_DMA_K(t + 3, sl2);
        if (P.band && t < P.nA) {
            const int q = P.qpos + r32, kb0 = P.ks + 64 * t + 4 * hi;
#pragma unroll
            for (int r = 0; r < 16; ++r) { const int kv = kb0 + (r & 3) + 8 * (r >> 2); int dd = kv - q; dd = dd < 0 ? -dd : dd; int d1 = kv + 32 - q; d1 = d1 < 0 ? -d1 : d1;
                if (dd > 128) p0[r] = -INFINITY; if (d1 > 128) p1[r] = -INFINITY; }
        }
        float rm; ATT_ROWMAX(rm, p0, p1);
        if (__any(rm > ATT_THR)) {
            const float dl = fmaxf(rm, 0.f), f = __builtin_amdgcn_exp2f(-dl);
            m += dl; lsum *= f; if (hi == 0) wsf[r32] = f;
#pragma unroll
            for (int r = 0; r < 16; ++r) { p0[r] -= dl; p1[r] -= dl; negm[r] = -m; }
            if (t + 1 < NT) {
#pragma unroll
                for (int r = 0; r < 16; ++r) { n0[r] -= dl; n1[r] -= dl; }
            }
            LDS_WAIT();
#pragma unroll
            for (int r = 0; r < 16; ++r) { const float fr_ = wsf[crow(r, hi)];
#pragma unroll
                for (int d = 0; d < DV / 32; ++d) o[d][r] *= fr_; }
        }
        { float sacc = 0.f;
#pragma unroll
          for (int r = 0; r < 16; ++r) { p0[r] = __builtin_amdgcn_exp2f(p0[r]); p1[r] = __builtin_amdgcn_exp2f(p1[r]); sacc += p0[r] + p1[r]; }
          lsum += sacc; }
        u32x4 pw0, pw1, pw2, pw3;
        pw0 = (u32x4){cvtpk(p0[0], p0[1]), cvtpk(p0[2], p0[3]), cvtpk(p0[4], p0[5]), cvtpk(p0[6], p0[7])};
        pw1 = (u32x4){cvtpk(p0[8], p0[9]), cvtpk(p0[10], p0[11]), cvtpk(p0[12], p0[13]), cvtpk(p0[14], p0[15])};
        pw2 = (u32x4){cvtpk(p1[0], p1[1]), cvtpk(p1[2], p1[3]), cvtpk(p1[4], p1[5]), cvtpk(p1[6], p1[7])};
        pw3 = (u32x4){cvtpk(p1[8], p1[9]), cvtpk(p1[10], p1[11]), cvtpk(p1[12], p1[13]), cvtpk(p1[14], p1[15])};
        const int vb = (int)(lds0 + L::V0 + sl * L::VSLOT) + ((lane >> 4) & 1) * 32 + (lane & 3) * 8 + (4 * hi + ((lane & 15) >> 2)) * 64;
        s16x4 loA[4], hhA[4], loB[4], hhB[4];
        asm volatile("s_waitcnt lgkmcnt(0)" ::: "memory");
#define ATT_VRD(lo_, hh_, d0) do { _Pragma("unroll") for (int ks = 0; ks < 4; ++ks) { \
            asm volatile("ds_read_b64_tr_b16 %0,%1 offset:%c2" : "=&v"(lo_[ks]) : "v"(vb), "i"(((d0) >> 1) * 8192 + ((d0) & 1) * 4096 + ks * 1024) : "memory"); \
            asm volatile("ds_read_b64_tr_b16 %0,%1 offset:%c2" : "=&v"(hh_[ks]) : "v"(vb), "i"(((d0) >> 1) * 8192 + ((d0) & 1) * 4096 + ks * 1024 + 512) : "memory"); } } while (0)
#define ATT_PK(lo_, hh_, k) (bf16x8){lo_[k][0], lo_[k][1], lo_[k][2], lo_[k][3], hh_[k][0], hh_[k][1], hh_[k][2], hh_[k][3]}
#define ATT_PV(lo_, hh_, d0) do { \
            o[d0] = __builtin_amdgcn_mfma_f32_32x32x16_bf16(__builtin_bit_cast(bf16x8, pw0), ATT_PK(lo_, hh_, 0), o[d0], 0, 0, 0); \
            o[d0] = __builtin_amdgcn_mfma_f32_32x32x16_bf16(__builtin_bit_cast(bf16x8, pw1), ATT_PK(lo_, hh_, 1), o[d0], 0, 0, 0); \
            o[d0] = __builtin_amdgcn_mfma_f32_32x32x16_bf16(__builtin_bit_cast(bf16x8, pw2), ATT_PK(lo_, hh_, 2), o[d0], 0, 0, 0); \
            o[d0] = __builtin_amdgcn_mfma_f32_32x32x16_bf16(__builtin_bit_cast(bf16x8, pw3), ATT_PK(lo_, hh_, 3), o[d0], 0, 0, 0); } while (0)
        ATT_VRD(loA, hhA, 0);
#pragma unroll
        for (int d0 = 0; d0 < DV / 32; d0 += 2) {
            ATT_VRD(loB, hhB, d0 + 1);
            asm volatile("s_waitcnt lgkmcnt(8)" ::: "memory"); __builtin_amdgcn_sched_barrier(0);
            ATT_PV(loA, hhA, d0);
            __builtin_amdgcn_sched_barrier(0);
            if (pre) ATT_DMA_V(t + 3, sl2, d0 >> 1);
            if (d0 + 2 < DV / 32) { ATT_VRD(loA, hhA, d0 + 2); asm volatile("s_waitcnt lgkmcnt(8)" ::: "memory"); }
            else asm volatile("s_waitcnt lgkmcnt(0)" ::: "memory");
            __builtin_amdgcn_sched_barrier(0);
            ATT_PV(loB, hhB, d0 + 1);
            __builtin_amdgcn_sched_barrier(0);
        }
#undef ATT_VRD
#undef ATT_PK
#undef ATT_PV
        p0 = n0; p1 = n1; sl = sl1;
    }
    asm volatile("s_waitcnt lgkmcnt(0)\n\ts_barrier" ::: "memory");
    { auto rr = __builtin_amdgcn_permlane32_swap(__float_as_uint(lsum), __float_as_uint(lsum), false, false); const float l = __uint_as_float(rr[0]) + __uint_as_float(rr[1]);
      if (hi == 0) wsf[r32] = l; LDS_WAIT();
#pragma unroll
      for (int r = 0; r < 16; ++r) osum[r] = wsf[crow(r, hi)];
      LDS_WAIT(); }
#undef ATT_KEYROW
#undef ATT_WAITV
#undef ATT_DMA
#undef ATT_QK
#undef ATT_ROWMAX
}

template <int DV>
__device__ __forceinline__ void normalize(f32x16 (&o)[DV / 32], const f32x16& osum) {
#pragma unroll
    for (int r = 0; r < 16; ++r) { const float rl = 1.0f / osum[r];
#pragma unroll
        for (int d = 0; d < DV / 32; ++d) o[d][r] *= rl; }
}
}
namespace hy {
constexpr int UPAD = 20 * 64;
constexpr int UROW = UPAD + 4096 * 2 + UPAD + 16;
constexpr int LDS_U = 0, LDS_R = 8 * UROW, LDS_R1 = LDS_R + 16384 + 64, LDS_BYTES = LDS_R1 + 16384;
static_assert(LDS_BYTES <= 131072 && UROW % 16 == 0, "hyena LDS");

__device__ __forceinline__ void conv_init(char* shm) {
    constexpr int Q = UPAD / 16;
    unsigned z_ = 0u; asm volatile("" : "+v"(z_));
    for (int i = threadIdx.x; i < 8 * 2 * Q; i += 512) { const int b = i / (2 * Q), r = i % (2 * Q), side = r / Q, q = r % Q;
        *(u32x4*)(shm + LDS_U + b * UROW + (side ? UPAD + 8192 : 0) + q * 16) = (u32x4){z_, z_, z_, z_}; }
}
__device__ __forceinline__ void conv_channel(char* shm, const bf16_t* zc, const bf16_t* Rc, bf16_t* outc) {
    int tid_ = threadIdx.x; asm volatile("" : "+v"(tid_));
    const int tid = tid_, lane = tid & 63, n = lane & 31, kg = lane >> 5; const int w = __builtin_amdgcn_readfirstlane(tid >> 6);
    asm volatile("s_waitcnt lgkmcnt(0)\n\ts_barrier" ::: "memory");
#pragma unroll
    for (int j = 0; j < 8; ++j) { const int id = tid + 512 * j, b = id >> 9, off = (id & 511) * 16; *(u32x4*)(shm + LDS_U + b * UROW + UPAD + off) = *(const u32x4*)((const char*)zc + (size_t)b * 8192 + off); }
#pragma unroll
    for (int j = 0; j < 2; ++j) { const int ci = tid + 512 * j, off = ci * 16; const u32x4 a = *(const u32x4*)((const char*)Rc + off);
        const unsigned e8 = ci < 1023 ? (unsigned)Rc[8 * ci + 8] : 0u;
        *(u32x4*)(shm + LDS_R + off) = a;
        u32x4 sft; sft.x = (a.x >> 16) | (a.y << 16); sft.y = (a.y >> 16) | (a.z << 16); sft.z = (a.z >> 16) | (a.w << 16); sft.w = (a.w >> 16) | (e8 << 16);
        *(u32x4*)(shm + LDS_R1 + off) = sft; }
    asm volatile("s_waitcnt vmcnt(0) lgkmcnt(0)\n\ts_barrier" ::: "memory");
    f32x16 acc[4];
#pragma unroll
    for (int k = 0; k < 4; ++k) acc[k] = f32x16{};
    const int bcol = n >> 2, il = n & 3;
    const LAS char* Abase = (const LAS char*)shm + ((n & 1) ? (LDS_R1 - 2) : LDS_R) + (4096 - n + 8 * kg) * 2;
    const LAS char* Ubase = (const LAS char*)shm + LDS_U + bcol * UROW + UPAD + kg * 16 + 64 * (16 * w + il);
    const int dlo = 16 * w - 127, dhi = 16 * w + 15;
#define HY_LDA(dst, d, sc) do { const volatile LAS unsigned* ap_ = (const volatile LAS unsigned*)(Abase + (16 * (sc) - 32 * (d)) * 2); u32x4 aw_; aw_.x = ap_[0]; aw_.y = ap_[1]; aw_.z = ap_[2]; aw_.w = ap_[3]; dst = __builtin_bit_cast(bf16x8, aw_); } while (0)
#define HY_LDB(dst, m, sc) dst = *(const LAS bf16x8*)(Ubase + 64 * (m) + 32 * (sc))
#pragma unroll 1
    for (int rho = 0; rho < 4; ++rho) {
        int d = dlo + rho;
        bf16x8 A0, A1, X0[5], X1[5];
        HY_LDA(A0, d, 0); HY_LDA(A1, d, 1);
#pragma unroll
        for (int k = 0; k < 4; ++k) { HY_LDB(X0[k], 4 * k - d, 0); HY_LDB(X1[k], 4 * k - d, 1); }
#define HY_STEP(s) { if (d > dhi) break; \
            bf16x8 nA0, nA1;                   \
            HY_LDA(nA0, d + 4, 0); HY_LDA(nA1, d + 4, 1); HY_LDB(X0[(4 - (s) + 5) % 5], -(d + 4), 0); HY_LDB(X1[(4 - (s) + 5) % 5], -(d + 4), 1); \
            _Pragma("unroll") for (int k = 0; k < 4; ++k) { acc[k] = __builtin_amdgcn_mfma_f32_32x32x16_bf16(A0, X0[(k - (s) + 5) % 5], acc[k], 0, 0, 0); acc[k] = __builtin_amdgcn_mfma_f32_32x32x16_bf16(A1, X1[(k - (s) + 5) % 5], acc[k], 0, 0, 0); } \
            A0 = nA0; A1 = nA1; d += 4; }
        for (;;) { HY_STEP(0) HY_STEP(1) HY_STEP(2) HY_STEP(3) HY_STEP(4) }
#undef HY_STEP
    }
#undef HY_LDA
#undef HY_LDB
#pragma unroll
    for (int k = 0; k < 4; ++k) { const int i = 16 * w + 4 * k + il; bf16_t* op = outc + (size_t)bcol * 4096 + 32 * i + 4 * kg;
#pragma unroll
        for (int g = 0; g < 4; ++g) { u32x2 v; v.x = cvtpk(acc[k][4 * g], acc[k][4 * g + 1]); v.y = cvtpk(acc[k][4 * g + 2], acc[k][4 * g + 3]); *(u32x2*)(op + 8 * g) = v; } }
}
}
constexpr int NWAVES = 8;
constexpr size_t MiB = 1u << 20;
constexpr size_t WS_CTL = 0, CTL_ZERO_BYTES = 1 * MiB;
constexpr size_t WS_MODS = 1 * MiB;
constexpr size_t WS_FCTX = 2 * MiB;
constexpr size_t WS_ZFEAT = 4 * MiB;
constexpr size_t WS_AFF = 9 * MiB;
constexpr size_t WS_SLOTOF = 12 * MiB;
constexpr size_t WS_GATE = 16 * MiB;
constexpr size_t WS_ZCTX = 17 * MiB;
constexpr size_t WS_XRES = 24 * MiB;
constexpr size_t WS_H = WS_XRES + 136 * MiB;
constexpr size_t WS_W = WS_H + 68 * MiB;
constexpr size_t WS_WIN = WS_W, WS_WBR = WS_WIN + 21 * MiB, WS_WOUT = WS_WBR + 6 * MiB, WS_W13 = WS_WOUT + 2 * MiB, WS_W2 = WS_W13 + 64 * MiB;
constexpr size_t WS_PROJ = WS_W2 + 32 * MiB;
static_assert(WS_PROJ == OFF_PROJ, "projection base");
constexpr size_t WS_DQ = OFF_DQ, WS_DK = OFF_DK, WS_DV = OFF_DV, WS_HY = OFF_HY, WS_SQ = OFF_SQ, WS_SK = OFF_SK, WS_SV = OFF_SV, WS_GT = OFF_GT;
constexpr size_t WS_END = WS_GT + 3 * SZ1K;
constexpr size_t WS_HRAW = WS_END;
constexpr size_t WS_TOTAL = WS_HRAW + 32 * MiB;
constexpr size_t WS_CONVT = WS_HY;
constexpr size_t WS_YHY = OFF_YHY;
constexpr size_t WS_MERGED = WS_DK;
constexpr size_t WS_XG = WS_HY;
constexpr size_t WS_HID = WS_GT;
static_assert(WS_YHY + SZ1K <= WS_SQ && WS_XG + (size_t)SLOTS * 2048 <= WS_SQ && WS_HID + (size_t)SLOTS * 2048 <= WS_END, "overlays");
constexpr size_t OUT_ZT = 0;
constexpr size_t OUT_FILT = 64 * MiB;
constexpr size_t OUT_STASH = 80 * MiB;
static_assert(OUT_STASH + 32 * MiB <= (size_t)NB * LS * D * 4, "d_out scratch");

constexpr int CW_TMO = 0, CW_CODE = 1, CW_CHK = 64, CW_BAR = 4096;

constexpr int RING_BYTES = 131072, LDSCTL_OFF = RING_BYTES, MISC_OFF = LDSCTL_OFF + 320, ROPE_OFF = LDSCTL_OFF + 1024  , LDS_BYTES = 147456;
static_assert(ROPE_OFF + 8192 <= LDS_BYTES, "LDS map");

#define XB_TMO      128
#define XB_XCNT(j)  (256  + 64 * (j))
#define XB_XSUB(j)  (1280 + 64 * (j))
#define XB_XGEN(j)  (2304 + 64 * (j))
#define XB_TOP      3328
#define XB_TOPGEN   3392
#define XCD_BAR_WORDS 3456
#define XB_SPIN_CAP (1u << 22)
__device__ __forceinline__ unsigned xb_ld(unsigned* p)              { return __hip_atomic_load(p, __ATOMIC_RELAXED, __HIP_MEMORY_SCOPE_AGENT); }
__device__ __forceinline__ unsigned xb_add(unsigned* p, unsigned v) { return __hip_atomic_fetch_add(p, v, __ATOMIC_RELAXED, __HIP_MEMORY_SCOPE_AGENT); }
__device__ __forceinline__ unsigned xb_xcc_id() { return (unsigned)__builtin_amdgcn_s_getreg((3 << 11) | 20) & 0xFu; }
#define XB_SPIN(cond, bar) do { unsigned _sp = 0; while (cond) { __builtin_amdgcn_s_sleep(1); \
    if ((++_sp & 255u) == 0u) { if (xb_ld(&(bar)[XB_TMO])) break; if (_sp > XB_SPIN_CAP) { atomicAdd(&(bar)[XB_TMO], 1u); break; } } } } while (0)
struct XcdBarrier { unsigned* bar; unsigned x; volatile LAS unsigned* st; };
__device__ __forceinline__ XcdBarrier xcd_barrier_post(unsigned* bar, volatile LAS unsigned* st) {
    XcdBarrier b; b.bar = bar; b.x = xb_xcc_id(); b.st = st;
    if (threadIdx.x == 0) (void)xb_add(&bar[XB_XCNT(b.x)], 1u);
    return b;
}
__device__ __forceinline__ void xcd_barrier_complete(unsigned* bar, unsigned x, unsigned& nloc, unsigned& nx) {
    const unsigned G = gridDim.x * gridDim.y * gridDim.z;
    unsigned sum, cnt, mine, sp = 0u;
    for (;;) {
        sum = 0u; cnt = 0u; mine = 0u;
#pragma unroll
        for (unsigned j = 0; j < 16; ++j) { const unsigned c = xb_ld(&bar[XB_XCNT(j)]); sum += c; cnt += (c > 0u) ? 1u : 0u; mine = (j == x) ? c : mine; }
        if (sum == G) break;
        __builtin_amdgcn_s_sleep(1);
        if ((++sp & 255u) == 0u) { if (xb_ld(&bar[XB_TMO])) break; if (sp > XB_SPIN_CAP) { atomicAdd(&bar[XB_TMO], 1u); break; } }
    }
    nloc = mine > 0u ? mine : 1u; nx = cnt > 0u ? cnt : 1u;
}
__device__ __forceinline__ void xcd_barrier(const XcdBarrier& b) {
    asm volatile("s_waitcnt vmcnt(0)" ::: "memory");
    __syncthreads();
    if (threadIdx.x == 0) {
        unsigned* bar = b.bar;
        __builtin_amdgcn_s_waitcnt(0);
        unsigned nloc = b.st[0], nx = b.st[1];
        if (nloc == 0u) { xcd_barrier_complete(bar, b.x, nloc, nx); b.st[0] = nloc; b.st[1] = nx; }
        const unsigned old = xb_add(&bar[XB_XSUB(b.x)], 1u);
        const unsigned gen = old / nloc;
        if (old + 1u == (gen + 1u) * nloc) {
            __builtin_amdgcn_fence(__ATOMIC_RELEASE, "agent");
            asm volatile("s_waitcnt vmcnt(0)" ::: "memory");
            const unsigned og = xb_add(&bar[XB_TOP], 1u);
            const unsigned tg = og / nx;
            if (og + 1u == (tg + 1u) * nx) xb_add(&bar[XB_TOPGEN], 1u);
            else XB_SPIN(xb_ld(&bar[XB_TOPGEN]) == tg, bar);
            __builtin_amdgcn_fence(__ATOMIC_ACQUIRE, "agent");
            xb_add(&bar[XB_XGEN(b.x)], 1u);
            asm volatile("s_waitcnt vmcnt(0)" ::: "memory");
        } else {
            XB_SPIN(xb_ld(&bar[XB_XGEN(b.x)]) == gen, bar);
            __builtin_amdgcn_fence(__ATOMIC_ACQUIRE, "agent");
            asm volatile("s_waitcnt vmcnt(0)" ::: "memory");
        }
    }
    __syncthreads();
}

struct Args {
    const float* in[28]; float* out; unsigned char* ws; int ph_lo, ph_hi;
};
struct Frame {
    LAS unsigned char* lds; char* shm;
    int tid, lane, wave, G, bid;
    int dry;
    unsigned char* ws; unsigned char* outb;
};
enum { I_X = 0, I_C, I_CTX, I_CCTX, I_WMOD, I_BMOD, I_N1G, I_N2G, I_WIN, I_DLAM, I_SUBLN, I_HCW, I_HCB, I_FW1, I_FB1, I_FW2, I_FB2, I_FW3, I_FREQ, I_HBIAS, I_SINK, I_WBR, I_WOUT, I_ROUTER, I_W1, I_W3, I_W2, I_FINALG };
__device__ __forceinline__ void p0_mods_zfeat(Frame& F, const Args& a) {
    float* sc = (float*)F.shm;
    float* part = (float*)(F.shm + 9 * 1024 * 4);
    for (int i = F.tid; i < 9 * 1024; i += 512) { const int r = i >> 10, k = i & 1023; const float v = r < 8 ? a.in[I_C][r * 1024 + k] : a.in[I_CCTX][k]; sc[i] = v * sigmoidf_(v); }
    __syncthreads();
    float* mods = (float*)(F.ws + WS_MODS);
    for (int ch = F.bid; ch < 192; ch += F.G) {
        const int l = ch / 48, c0 = (ch % 48) * 128, col = F.tid & 127, kq = F.tid >> 7;
        const float* w = a.in[I_WMOD] + ((size_t)l * 1024 + kq * 256) * 6144 + c0 + col;
        float acc[9];
#pragma unroll
        for (int r = 0; r < 9; ++r) acc[r] = 0.f;
        for (int k = 0; k < 256; ++k) { const float wv = w[(size_t)k * 6144];
#pragma unroll
            for (int r = 0; r < 9; ++r) acc[r] += sc[r * 1024 + kq * 256 + k] * wv; }
#pragma unroll
        for (int r = 0; r < 9; ++r) part[(kq * 9 + r) * 128 + col] = acc[r];
        __syncthreads();
        for (int i = F.tid; i < 9 * 128; i += 512) { const int r = i >> 7, cc = i & 127;
            const float s = part[(0 * 9 + r) * 128 + cc] + part[(1 * 9 + r) * 128 + cc] + part[(2 * 9 + r) * 128 + cc] + part[(3 * 9 + r) * 128 + cc];
            mods[((size_t)l * 9 + r) * 6144 + c0 + cc] = s + a.in[I_BMOD][l * 6144 + c0 + cc]; }
        __syncthreads();
    }
    float* zf = (float*)(F.ws + WS_ZFEAT);
    const int gw = F.bid * NWAVES + F.wave, NGW = F.G * NWAVES;
    for (int it = gw; it < DEPTH * LT; it += NGW) {
        const int l = it / LT, row = it - l * LT; const int Lf = row < LS ? LS : LC, ii = row < LS ? row : row - LS;
        const float tt = (float)ii / (float)(Lf - 1);
        const float wrev = (float)ii / (float)Lf;
        const int j = F.lane & 15; const float fj = 1e-4f + (float)j * ((15.0f - 1e-4f) / 15.0f);
        const float cs = cos_rev(fj * wrev), sn = -sin_rev(fj * wrev);
        const float* w1 = a.in[I_FW1] + (size_t)l * 33 * 64; const float* w2 = a.in[I_FW2] + (size_t)l * 64 * 64;
        const float fq = a.in[I_FREQ][l * 64 + F.lane];
        float s = tt * w1[F.lane] + a.in[I_FB1][l * 64 + F.lane];
#pragma unroll
        for (int k = 0; k < 16; ++k) { s += __shfl(cs, k) * w1[(1 + k) * 64 + F.lane]; s += __shfl(sn, k) * w1[(17 + k) * 64 + F.lane]; }
        const float z1 = sin_rad(fq * s);
        float s2 = a.in[I_FB2][l * 64 + F.lane];
#pragma unroll 8
        for (int k = 0; k < 64; ++k) s2 += __shfl(z1, k) * w2[k * 64 + F.lane];
        zf[((size_t)l * 64 + F.lane) * LT + row] = sin_rad(fq * s2);
    }
}

__device__ __forceinline__ void transpose_item(const float* W, int K, int N, bf16_t* WT, int k0, int n0, int drow, LAS float* scr, int lane) {
#pragma unroll 8
    for (int i = 0; i < 32; ++i) { const int kk = 2 * i + (lane >> 5); scr[kk * 33 + (lane & 31)] = W[(size_t)(k0 + kk) * N + n0 + (lane & 31)]; }
    LDS_WAIT(); asm volatile("" ::: "memory");
    const int c = lane & 7;
#pragma unroll
    for (int j = 0; j < 4; ++j) { const int n = (lane >> 3) + 8 * j; const LAS float* s = scr + (8 * c) * 33 + n;
        u32x4 o; o.x = pk2(s[0 * 33], s[1 * 33]); o.y = pk2(s[2 * 33], s[3 * 33]); o.z = pk2(s[4 * 33], s[5 * 33]); o.w = pk2(s[6 * 33], s[7 * 33]);
        *(GAS u32x4*)(WT + (size_t)(drow + n) * K + k0 + 8 * c) = o; }
    LDS_WAIT(); asm volatile("" ::: "memory");
}
__device__ __forceinline__ void p1_weights(Frame& F, const Args& a, int l) {
    LAS float* scr = (LAS float*)(F.lds + F.wave * 8448);
    const int gw = F.bid * NWAVES + F.wave, NGW = F.G * NWAVES;
    constexpr int I_IN = 16 * 336, I_SQ = 16 * 32;
    constexpr int NITEMS = I_IN + 4 * I_SQ + 48 * I_SQ;
    bf16_t* WinT = (bf16_t*)(F.ws + WS_WIN); bf16_t* WbrT = (bf16_t*)(F.ws + WS_WBR); bf16_t* WoutT = (bf16_t*)(F.ws + WS_WOUT);
    bf16_t* W13T = (bf16_t*)(F.ws + WS_W13); bf16_t* W2T = (bf16_t*)(F.ws + WS_W2);
    for (int it = gw; it < NITEMS; it += NGW) {
        int r = it;
        if (r < I_IN) { const int kb = r / 336, nb = r % 336; transpose_item(a.in[I_WIN] + (size_t)l * 1024 * DIN, 1024, DIN, WinT, 64 * kb, 32 * nb, 32 * nb, scr, F.lane); continue; }
        r -= I_IN;
        const int mi = r / I_SQ, q = r % I_SQ, kb = q / 32, nb = q % 32, n0 = 32 * nb;
        if (mi < 3) { transpose_item(a.in[I_WBR] + ((size_t)l * 3 + mi) * 1048576, 1024, 1024, WbrT + (size_t)mi * 1048576, 64 * kb, n0, n0, scr, F.lane); continue; }
        if (mi == 3) { transpose_item(a.in[I_WOUT] + (size_t)l * 1048576, 1024, 1024, WoutT, 64 * kb, n0, n0, scr, F.lane); continue; }
        const int e = (mi - 4) / 3, which = (mi - 4) % 3; const size_t eo = ((size_t)l * 16 + e) * 1048576;
        if (which == 0) transpose_item(a.in[I_W1] + eo, 1024, 1024, W13T + (size_t)e * 2097152, 64 * kb, n0, (n0 >> 7) * 256 + (n0 & 127), scr, F.lane);
        else if (which == 1) transpose_item(a.in[I_W3] + eo, 1024, 1024, W13T + (size_t)e * 2097152, 64 * kb, n0, (n0 >> 7) * 256 + 128 + (n0 & 127), scr, F.lane);
        else transpose_item(a.in[I_W2] + eo, 1024, 1024, W2T + (size_t)e * 1048576, 64 * kb, n0, n0, scr, F.lane);
    }
}

__device__ __forceinline__ void p1_filters(Frame& F, const Args& a, int l) {
    float* w3s = (float*)(F.shm + 72 * 1024);
    float* red = w3s + 512;
    float* nrm = red + 32;
    const float* zf = (const float*)(F.ws + WS_ZFEAT) + (size_t)l * LT * 64;
    bf16_t* filtR = (bf16_t*)(F.outb + OUT_FILT); float* fctx = (float*)(F.ws + WS_FCTX);
    const float da = -15.350567286626973f, db = -3.0701134573253946f;
    for (int cg = F.bid; cg < 256; cg += F.G) {
        const int c0 = 4 * cg;
        __syncthreads();
        { const int k = F.tid >> 3, q = F.tid & 7; w3s[F.tid] = a.in[I_FW3][((size_t)l * 64 + k) * 2048 + (q >> 2) * 1024 + c0 + (q & 3)]; }
        __syncthreads();
        float delta[4];
#pragma unroll
        for (int cc = 0; cc < 4; ++cc) delta[cc] = fabsf(da + (float)(c0 + cc) * ((db - da) / 1023.0f));
        float asum[4] = {0.f, 0.f, 0.f, 0.f};
        f32x4* slab = (f32x4*)(F.ws + WS_HRAW) + ((size_t)F.bid * 4096 + 8 * F.tid) * 2;
        { float h[8][8];
#pragma unroll
          for (int j = 0; j < 8; ++j)
#pragma unroll
            for (int q = 0; q < 8; ++q) h[j][q] = 0.f;
          const float* zc = zf + 8 * F.tid;
#pragma unroll 2
          for (int k = 0; k < 64; ++k) { const f32x4 za = *(const f32x4*)(zc + (size_t)k * LT), zb = *(const f32x4*)(zc + (size_t)k * LT + 4);
              const f32x4 wa = *(const f32x4*)(w3s + k * 8), wb = *(const f32x4*)(w3s + k * 8 + 4);
#pragma unroll
              for (int j = 0; j < 8; ++j) { const float z = j < 4 ? za[j] : zb[j - 4];
#pragma unroll
                  for (int q = 0; q < 4; ++q) { h[j][q] += z * wa[q]; h[j][4 + q] += z * wb[q]; } } }
#pragma unroll
          for (int j = 0; j < 8; ++j) { const int i = 8 * F.tid + j; const float tt = (float)i / 4095.0f; f32x4 hf, hbk;
#pragma unroll
              for (int cc = 0; cc < 4; ++cc) { const float dec = fast_exp(-tt * delta[cc]); hf[cc] = h[j][cc] * dec; hbk[cc] = h[j][4 + cc] * dec; asum[cc] += fabsf(hf[cc]) + fabsf(hbk[cc]); }
              slab[2 * j] = hf; slab[2 * j + 1] = hbk; } }
#pragma unroll
        for (int cc = 0; cc < 4; ++cc) { const float s = wave_sum(asum[cc]); if (F.lane == 0) red[F.wave * 4 + cc] = s; }
        __syncthreads();
        if (F.tid < 4) { float s = 0.f; for (int w = 0; w < 8; ++w) s += red[w * 4 + F.tid]; nrm[F.tid] = 1.0f / (s + EPS); }
        __syncthreads();
        { bf16_t* img = (bf16_t*)F.shm;
          if (F.tid < 4) img[F.tid * 8192] = 0;
#pragma unroll 1
          for (int j = 0; j < 8; ++j) { const int i = 8 * F.tid + j; const f32x4 hf = slab[2 * j], hbk = slab[2 * j + 1];
#pragma unroll
              for (int cc = 0; cc < 4; ++cc) { const float inv = nrm[cc];
                  img[cc * 8192 + 4096 - i] = (bf16_t)f2bf(hf[cc] * inv);
                  if (i > 0) img[cc * 8192 + 4096 + i] = (bf16_t)f2bf(hbk[cc] * inv); } }
          __syncthreads();
          for (int q = F.tid; q < 4096; q += 512) *(u32x4*)(filtR + (size_t)c0 * 8192 + q * 8) = *(const u32x4*)(img + q * 8);
        }
        __syncthreads();
        float hc[8]; float cs4[4] = {0.f, 0.f, 0.f, 0.f};
        if (F.tid < 256) {
            const float* zr = zf + LS + F.tid;
#pragma unroll
            for (int q = 0; q < 8; ++q) hc[q] = 0.f;
            for (int k = 0; k < 64; ++k) { const float z = zr[(size_t)k * LT];
#pragma unroll
                for (int q = 0; q < 8; ++q) hc[q] += z * w3s[k * 8 + q]; }
            const float tt = (float)F.tid / 255.0f;
#pragma unroll
            for (int cc = 0; cc < 4; ++cc) { const float dec = fast_exp(-tt * delta[cc]); hc[cc] *= dec; hc[4 + cc] *= dec; cs4[cc] = fabsf(hc[cc]) + fabsf(hc[4 + cc]); }
        }
#pragma unroll
        for (int cc = 0; cc < 4; ++cc) { const float s = wave_sum(cs4[cc]); if (F.lane == 0) red[F.wave * 4 + cc] = s; }
        __syncthreads();
        if (F.tid < 4) { float s = 0.f; for (int w = 0; w < 8; ++w) s += red[w * 4 + F.tid]; nrm[F.tid] = 1.0f / (s + EPS); }
        __syncthreads();
        if (F.tid < 256) {
#pragma unroll
            for (int q = 0; q < 8; ++q) fctx[((size_t)(q >> 2) * 256 + F.tid) * 1024 + c0 + (q & 3)] = hc[q] * nrm[q & 3];
        }
    }
}

__device__ __forceinline__ int load_sov(Frame& F, int row) { return F.lane < 16 ? ((const int*)(F.ws + WS_SLOTOF))[(size_t)row * 16 + F.lane] : -1; }
__device__ __forceinline__ void combine_row(Frame& F, f32x4 (&v)[4], const int sov, const f32x4 (&m5q)[4]) {
    const bf16_t* ys = (const bf16_t*)(F.ws + WS_XG) + 4 * F.lane;
    unsigned mask = (unsigned)(__ballot(sov >= 0) & 0xffffull);
    f32x4 s[4];
#pragma unroll
    for (int j = 0; j < 4; ++j) s[j] = (f32x4){0.f, 0.f, 0.f, 0.f};
    while (mask) {
        const int e0 = __builtin_ctz(mask); mask &= mask - 1; const bool two = mask != 0u; int e1 = e0; if (two) { e1 = __builtin_ctz(mask); mask &= mask - 1; }
        const int s0 = __builtin_amdgcn_readlane(sov, e0), s1 = __builtin_amdgcn_readlane(sov, e1); const float w1 = two ? 1.f : 0.f;
        const bf16_t* y0 = ys + (size_t)s0 * 1024; const bf16_t* y1 = ys + (size_t)s1 * 1024;
        u32x2 a[4], b[4];
#pragma unroll
        for (int j = 0; j < 4; ++j) { a[j] = *(const u32x2*)(y0 + 256 * j); b[j] = *(const u32x2*)(y1 + 256 * j); }
#pragma unroll
        for (int j = 0; j < 4; ++j) { s[j][0] += bflo(a[j].x) + w1 * bflo(b[j].x); s[j][1] += bfhi(a[j].x) + w1 * bfhi(b[j].x); s[j][2] += bflo(a[j].y) + w1 * bflo(b[j].y); s[j][3] += bfhi(a[j].y) + w1 * bfhi(b[j].y); }
    }
#pragma unroll
    for (int j = 0; j < 4; ++j) v[j] += m5q[j] * s[j];
}
__device__ __forceinline__ void p1_norm1(Frame& F, const Args& a, int l) {
    const int gw = F.bid * NWAVES + F.wave, NGW = F.G * NWAVES;
    float* xres = (float*)(F.ws + WS_XRES); bf16_t* hb = (bf16_t*)(F.ws + WS_H);
    const float* mods = (const float*)(F.ws + WS_MODS);
    const float* g1 = a.in[I_N1G] + (size_t)l * 1024;
#define N1_SRC(row_) ((l == 0) ? (((row_) % LT) < LS ? a.in[I_X] + ((size_t)((row_) / LT) * LS + ((row_) % LT)) * 1024 : a.in[I_CTX] + ((size_t)((row_) / LT) * LC + (((row_) % LT) - LS)) * 1024) : xres + (size_t)(row_) * 1024)
    const int rpw = (TROWS + NGW - 1) / NGW, r0 = gw * rpw, r1 = r0 + rpw < TROWS ? r0 + rpw : TROWS;
    f32x4 gq[4], shq[4], sclq[4], m5q[4]; int mr_cur = -1;
#pragma unroll
    for (int j = 0; j < 4; ++j) { gq[j] = *(const f32x4*)(g1 + 4 * F.lane + 256 * j); m5q[j] = (f32x4){0.f, 0.f, 0.f, 0.f}; }
    f32x4 vn[4]; int sovn = -1;
    if (r0 < r1) { const float* src = N1_SRC(r0);
#pragma unroll
        for (int j = 0; j < 4; ++j) vn[j] = *(const f32x4*)(src + 4 * F.lane + 256 * j);
        if (l > 0) sovn = load_sov(F, r0); }
    for (int row = r0; row < r1; ++row) {
        const int b = row / LT, t = row - b * LT; const int mr = t < LS ? b : 8;
        if (mr != mr_cur) { mr_cur = mr; const float* mrow = mods + ((size_t)l * 9 + mr) * 6144;
#pragma unroll
            for (int j = 0; j < 4; ++j) { shq[j] = *(const f32x4*)(mrow + 4 * F.lane + 256 * j); sclq[j] = *(const f32x4*)(mrow + 1024 + 4 * F.lane + 256 * j) + 1.0f;
                if (l > 0) m5q[j] = *(const f32x4*)(mods + ((size_t)(l - 1) * 9 + mr) * 6144 + 5 * 1024 + 4 * F.lane + 256 * j); } }
        f32x4 v[4]; const int sov = sovn;
#pragma unroll
        for (int j = 0; j < 4; ++j) v[j] = vn[j];
        if (row + 1 < r1) { const float* src = N1_SRC(row + 1);
#pragma unroll
            for (int j = 0; j < 4; ++j) vn[j] = *(const f32x4*)(src + 4 * F.lane + 256 * j);
            if (l > 0) sovn = load_sov(F, row + 1); }
        if (l > 0) combine_row(F, v, sov, m5q);
        float ss = 0.f;
#pragma unroll
        for (int j = 0; j < 4; ++j) { if (!F.dry) *(f32x4*)(xres + (size_t)row * 1024 + 4 * F.lane + 256 * j) = v[j]; ss += (v[j][0] * v[j][0] + v[j][1] * v[j][1]) + (v[j][2] * v[j][2] + v[j][3] * v[j][3]); }
        const float rstd = 1.0f / sqrtf(wave_sum(ss) * (1.0f / 1024.0f) + EPS);
#pragma unroll
        for (int j = 0; j < 4; ++j) { const int c = 4 * F.lane + 256 * j;
            const f32x4 y = (v[j] * rstd * gq[j]) * sclq[j] + shq[j];
            u32x2 w; w.x = cvtpk(y[0], y[1]); w.y = cvtpk(y[2], y[3]); *(u32x2*)(hb + (size_t)row * 1024 + c) = w; }
    }
#undef N1_SRC
}
__device__ __forceinline__ void pf_final(Frame& F, const Args& a) {
    const int gw = F.bid * NWAVES + F.wave, NGW = F.G * NWAVES;
    const float* xres = (const float*)(F.ws + WS_XRES); const float* mods = (const float*)(F.ws + WS_MODS);
    const float* g = a.in[I_FINALG];
#define FN_ROW(r_) (((r_) / LS) * LT + ((r_) % LS))
    const int rpw = (NB * LS + NGW - 1) / NGW, r0 = gw * rpw, r1 = r0 + rpw < NB * LS ? r0 + rpw : NB * LS;
    f32x4 gq[4], m5q[4]; int b_cur = -1;
#pragma unroll
    for (int j = 0; j < 4; ++j) gq[j] = *(const f32x4*)(g + 4 * F.lane + 256 * j);
    f32x4 vn[4]; int sovn = -1;
    if (r0 < r1) { const int row = FN_ROW(r0);
#pragma unroll
        for (int j = 0; j < 4; ++j) vn[j] = *(const f32x4*)(xres + (size_t)row * 1024 + 4 * F.lane + 256 * j);
        sovn = load_sov(F, row); }
    for (int r = r0; r < r1; ++r) {
        const int b = r / LS;
        if (b != b_cur) { b_cur = b;
#pragma unroll
            for (int j = 0; j < 4; ++j) m5q[j] = *(const f32x4*)(mods + ((size_t)(DEPTH - 1) * 9 + b) * 6144 + 5 * 1024 + 4 * F.lane + 256 * j); }
        f32x4 v[4]; const int sov = sovn;
#pragma unroll
        for (int j = 0; j < 4; ++j) v[j] = vn[j];
        if (r + 1 < r1) { const int row = FN_ROW(r + 1);
#pragma unroll
            for (int j = 0; j < 4; ++j) vn[j] = *(const f32x4*)(xres + (size_t)row * 1024 + 4 * F.lane + 256 * j);
            sovn = load_sov(F, row); }
        combine_row(F, v, sov, m5q);
        float ss = 0.f;
#pragma unroll
        for (int j = 0; j < 4; ++j) ss += (v[j][0] * v[j][0] + v[j][1] * v[j][1]) + (v[j][2] * v[j][2] + v[j][3] * v[j][3]);
        const float rstd = 1.0f / sqrtf(wave_sum(ss) * (1.0f / 1024.0f) + EPS);
#pragma unroll
        for (int j = 0; j < 4; ++j) { const int c = 4 * F.lane + 256 * j; *(f32x4*)(a.out + (size_t)r * 1024 + c) = v[j] * rstd * gq[j]; }
    }
#undef FN_ROW
}
__device__ __forceinline__ void p3_rope(Frame& F) {
    float* cst = (float*)F.shm;
    float* snt = cst + 1024;
    for (int i = F.tid; i < 1024; i += 512) { const int pos = i >> 4, f = i & 15; const float inv = __builtin_amdgcn_exp2f(-(float)f * (13.287712379549449f / 16.0f));
        const float ang = (float)pos * inv, rev = ang * 0.15915494309189535f; cst[i] = cos_rev(rev); snt[i] = sin_rev(rev); }
    __syncthreads();
    bf16_t* dq = (bf16_t*)(F.ws + WS_DQ); bf16_t* dk = (bf16_t*)(F.ws + WS_DK); bf16_t* sq = (bf16_t*)(F.ws + WS_SQ); bf16_t* sk = (bf16_t*)(F.ws + WS_SK);
    const int gw = F.bid * NWAVES + F.wave, NGW = F.G * NWAVES;
    for (int row = gw; row < TROWS; row += NGW) {
        const int b = row / LT, t = row - b * LT; const bool lat = t < LS;
        for (int it = F.lane; it < 208; it += 64) {
            const int hs = it >> 2, ax = (it >> 1) & 1, fc = it & 1;
            bf16_t* base; float scl;
            if (hs < 16) { base = dq + (size_t)row * 1024 + hs * 64; scl = QSCALE; }
            else if (hs < 32) { base = dk + (size_t)row * 1024 + (hs - 16) * 64; scl = 1.f; }
            else if (hs < 48) { base = sq + (size_t)row * 1024 + (hs - 32) * 64; scl = QSCALE; }
            else { base = sk + (size_t)row * 256 + (hs - 48) * 64; scl = 1.f; }
            if (!lat && scl == 1.f) continue;
            bf16_t* p1 = base + ax * 32 + fc * 8; bf16_t* p2 = p1 + 16;
            const u32x4 a = *(const u32x4*)p1, c = *(const u32x4*)p2;
            float x1[8], x2[8];
#pragma unroll
            for (int j = 0; j < 4; ++j) { x1[2 * j] = bflo(a[j]); x1[2 * j + 1] = bfhi(a[j]); x2[2 * j] = bflo(c[j]); x2[2 * j + 1] = bfhi(c[j]); }
            float o1[8], o2[8];
            if (lat) { const int pos = ax == 0 ? (t >> 6) : (t & 63);
#pragma unroll
                for (int j = 0; j < 8; ++j) { const float cs = cst[pos * 16 + fc * 8 + j], sn = snt[pos * 16 + fc * 8 + j]; o1[j] = (x1[j] * cs - x2[j] * sn) * scl; o2[j] = (x2[j] * cs + x1[j] * sn) * scl; }
            } else {
#pragma unroll
                for (int j = 0; j < 8; ++j) { o1[j] = x1[j] * scl; o2[j] = x2[j] * scl; }
            }
            u32x4 w1, w2;
#pragma unroll
            for (int j = 0; j < 4; ++j) { w1[j] = cvtpk(o1[2 * j], o1[2 * j + 1]); w2[j] = cvtpk(o2[2 * j], o2[2 * j + 1]); }
            if (!F.dry) { *(u32x4*)p1 = w1; *(u32x4*)p2 = w2; }
        }
    }
}
struct PreTile { int b, t0, c0, Lseq, tbase; bool lat; };
__device__ __forceinline__ PreTile pre_tile(int tile) {
    constexpr int NT_L = NB * 64 * 16;
    PreTile T; T.lat = tile < NT_L;
    if (T.lat) { T.b = tile / 1024; const int r = tile % 1024; T.t0 = (r >> 4) * 64; T.c0 = (r & 15) * 64; T.Lseq = LS; T.tbase = 0; }
    else { const int q = tile - NT_L; T.b = q / 64; const int r = q % 64; T.t0 = (r >> 4) * 64; T.c0 = (r & 15) * 64; T.Lseq = LC; T.tbase = LS; }
    return T;
}
__device__ __forceinline__ void pre_load(const bf16_t* hyb, const PreTile& T, int tl, int cc, u32x4 (&x)[3][3]) {
    const int t = T.t0 + tl, c = T.c0 + cc; const size_t row = (size_t)T.b * LT + T.tbase + t;
#pragma unroll
    for (int g = 0; g < 3; ++g)
#pragma unroll
        for (int k = 0; k < 3; ++k) { const int ts = t + k - 1; x[g][k] = (u32x4){0u, 0u, 0u, 0u};
            if (ts >= 0 && ts < T.Lseq) x[g][k] = *(const u32x4*)(hyb + (row + k - 1) * 3072 + g * 1024 + c); }
}
__device__ __forceinline__ void p3_hyena_pre(Frame& F, const Args& a, int l) {
    const bf16_t* hyb = (const bf16_t*)(F.ws + WS_HY); bf16_t* x0c = (bf16_t*)(F.ws + WS_H); bf16_t* zT = (bf16_t*)(F.outb + OUT_ZT); bf16_t* zctx = (bf16_t*)(F.ws + WS_ZCTX);
    const float* cw = a.in[I_HCW] + (size_t)l * 3 * 3072; const float* cb = a.in[I_HCB] + (size_t)l * 3072;
    bf16_t* zt = (bf16_t*)(F.shm + 40960);
    constexpr int NTILES = NB * 64 * 16 + NB * 4 * 16;
    const int tl = F.tid >> 3, cc = (F.tid & 7) * 8;
    u32x4 xn[3][3];
    float wq[3][3][8], bq[3][8]; int cw_c = -1;
    if (F.bid < NTILES) { const PreTile T = pre_tile(F.bid); pre_load(hyb, T, tl, cc, xn); }
    for (int tile = F.bid; tile < NTILES; tile += F.G) {
        const PreTile T = pre_tile(tile);
        u32x4 x[3][3];
#pragma unroll
        for (int g = 0; g < 3; ++g)
#pragma unroll
            for (int k = 0; k < 3; ++k) x[g][k] = xn[g][k];
        if (tile + F.G < NTILES) { const PreTile Tn = pre_tile(tile + F.G); pre_load(hyb, Tn, tl, cc, xn); }
        const int t = T.t0 + tl, c = T.c0 + cc;
        const size_t row = (size_t)T.b * LT + T.tbase + t;
        if (c != cw_c) { cw_c = c;
#pragma unroll
            for (int g = 0; g < 3; ++g) { const int ch = g * 1024 + c;
                const f32x4 bb0 = *(const f32x4*)(cb + ch), bb1 = *(const f32x4*)(cb + ch + 4);
#pragma unroll
                for (int j = 0; j < 4; ++j) { bq[g][j] = bb0[j]; bq[g][4 + j] = bb1[j]; }
#pragma unroll
                for (int k = 0; k < 3; ++k) { const f32x4 w0 = *(const f32x4*)(cw + k * 3072 + ch), w1 = *(const f32x4*)(cw + k * 3072 + ch + 4);
#pragma unroll
                    for (int j = 0; j < 4; ++j) { wq[g][k][j] = w0[j]; wq[g][k][4 + j] = w1[j]; } } } }
        float u[3][8];
#pragma unroll
        for (int g = 0; g < 3; ++g) {
#pragma unroll
            for (int j = 0; j < 8; ++j) u[g][j] = bq[g][j];
#pragma unroll
            for (int k = 0; k < 3; ++k) { const u32x4 xv = x[g][k];
#pragma unroll
                for (int j = 0; j < 4; ++j) { u[g][2 * j] += bflo(xv[j]) * wq[g][k][2 * j]; u[g][2 * j + 1] += bfhi(xv[j]) * wq[g][k][2 * j + 1]; } }
        }
        u32x4 w;
#pragma unroll
        for (int j = 0; j < 4; ++j) w[j] = cvtpk(u[0][2 * j], u[0][2 * j + 1]);
        *(u32x4*)(x0c + row * 1024 + c) = w;
        float z[8];
#pragma unroll
        for (int j = 0; j < 8; ++j) z[j] = u[1][j] * u[2][j];
        if (!T.lat) {
#pragma unroll
            for (int j = 0; j < 4; ++j) w[j] = cvtpk(z[2 * j], z[2 * j + 1]);
            *(u32x4*)(zctx + ((size_t)T.b * LC + t) * 1024 + c) = w;
        } else {
            __syncthreads();
#pragma unroll
            for (int j = 0; j < 8; ++j) zt[(cc + j) * 72 + tl] = (bf16_t)f2bf(z[j]);
            __syncthreads();
            const int cr = F.tid >> 3, ch8 = (F.tid & 7) * 8;
            const u32x4 v = *(const u32x4*)(zt + cr * 72 + ch8);
            *(u32x4*)(zT + ((size_t)(T.c0 + cr) * NB + T.b) * LS + T.t0 + ch8) = v;
        }
    }
}
__device__ __forceinline__ void p5_hyena_post(Frame& F, const Args& a, int l) {
    const bf16_t* convT = (const bf16_t*)(F.ws + WS_CONVT); const bf16_t* zT = (const bf16_t*)(F.outb + OUT_ZT); const bf16_t* x0c = (const bf16_t*)(F.ws + WS_H); bf16_t* yhy = (bf16_t*)(F.ws + WS_YHY);
    const float* hb = a.in[I_HBIAS] + (size_t)l * 1024;
    float* tl_ = (float*)(F.shm + 49152);
    constexpr int NTILES = NB * 64 * 16;
    const int cr = F.tid >> 3, ch8 = (F.tid & 7) * 8, tl = F.tid >> 3, cc = (F.tid & 7) * 8;
#define P5_LOAD(tile_, cv_, zv_, xv_) do { const int b_ = (tile_) / 1024, r_ = (tile_) % 1024, t0_ = (r_ >> 4) * 64, c0_ = (r_ & 15) * 64; \
        const size_t off_ = ((size_t)(c0_ + cr) * NB + b_) * LS + t0_ + ch8; cv_ = *(const u32x4*)(convT + off_); zv_ = *(const u32x4*)(zT + off_); \
        xv_ = *(const u32x4*)(x0c + ((size_t)b_ * LT + t0_ + tl) * 1024 + c0_ + cc); } while (0)
    u32x4 cvn, zvn, xvn;
    if (F.bid < NTILES) P5_LOAD(F.bid, cvn, zvn, xvn);
    for (int tile = F.bid; tile < NTILES; tile += F.G) {
        const int b = tile / 1024, r = tile % 1024, t0 = (r >> 4) * 64, c0 = (r & 15) * 64;
        const u32x4 cv = cvn, zv = zvn, xv = xvn;
        if (tile + F.G < NTILES) P5_LOAD(tile + F.G, cvn, zvn, xvn);
        __syncthreads();
        { const float bias = hb[c0 + cr];
#pragma unroll
          for (int j = 0; j < 4; ++j) { tl_[cr * 65 + ch8 + 2 * j] = bflo(cv[j]) + bflo(zv[j]) * bias; tl_[cr * 65 + ch8 + 2 * j + 1] = bfhi(cv[j]) + bfhi(zv[j]) * bias; } }
        __syncthreads();
        const size_t row = (size_t)b * LT + t0 + tl;
        u32x4 w;
#pragma unroll
        for (int j = 0; j < 4; ++j) w[j] = cvtpk(bflo(xv[j]) * tl_[(cc + 2 * j) * 65 + tl], bfhi(xv[j]) * tl_[(cc + 2 * j + 1) * 65 + tl]);
        *(u32x4*)(yhy + row * 1024 + c0 + cc) = w;
    }
#undef P5_LOAD
}
__device__ __forceinline__ void p4_hyena_ctx(Frame& F, const Args& a, int l) {
    const bf16_t* zctx = (const bf16_t*)(F.ws + WS_ZCTX); const float* fctx = (const float*)(F.ws + WS_FCTX); const bf16_t* x0c = (const bf16_t*)(F.ws + WS_H); bf16_t* yhy = (bf16_t*)(F.ws + WS_YHY);
    const float* hb = a.in[I_HBIAS] + (size_t)l * 1024;
    float* g = (float*)F.shm;
    float* zs = g + 512 * 32;
    for (int it = F.bid; it < 256; it += F.G) {
        const int b = it >> 5, c0 = (it & 31) * 32, c = F.tid & 31, tg = F.tid >> 5, t0 = tg * 16;
        __syncthreads();
        for (int i = F.tid; i < 512 * 32; i += 512) { const int x = i >> 5, cc = i & 31, lag = x - 256;
            g[i] = x == 0 ? 0.f : (lag >= 0 ? fctx[(size_t)lag * 1024 + c0 + cc] : fctx[(size_t)(256 - lag) * 1024 + c0 + cc]); }
        for (int i = F.tid; i < 256 * 32; i += 512) { const int s = i >> 5, cc = i & 31; zs[i] = bf2f(zctx[((size_t)b * LC + s) * 1024 + c0 + cc]); }
        __syncthreads();
        float acc[16];
#pragma unroll
        for (int j = 0; j < 16; ++j) acc[j] = 0.f;
#pragma unroll 1
        for (int sb = 0; sb < 8; ++sb) { const int s0 = 32 * sb;
            float fw[47], zv[32];
#pragma unroll
            for (int k = 0; k < 47; ++k) fw[k] = g[(t0 - s0 + 225 + k) * 32 + c];
#pragma unroll
            for (int si = 0; si < 32; ++si) zv[si] = zs[(s0 + si) * 32 + c];
#pragma unroll
            for (int si = 0; si < 32; ++si)
#pragma unroll
                for (int j = 0; j < 16; ++j) acc[j] += fw[j - si + 31] * zv[si];
        }
        const float bias = hb[c0 + c];
#pragma unroll
        for (int j = 0; j < 16; ++j) { const size_t row = (size_t)b * LT + LS + t0 + j;
            yhy[row * 1024 + c0 + c] = (bf16_t)f2bf(bf2f(x0c[row * 1024 + c0 + c]) * (acc[j] + zs[(t0 + j) * 32 + c] * bias)); }
    }
}
__device__ __forceinline__ void p4_hyena_lat(Frame& F) {
    const bf16_t* zT = (const bf16_t*)(F.outb + OUT_ZT); const bf16_t* filtR = (const bf16_t*)(F.outb + OUT_FILT); bf16_t* convT = (bf16_t*)(F.ws + WS_CONVT);
    hy::conv_init(F.shm);
    for (int c = F.bid; c < 1024; c += F.G) hy::conv_channel(F.shm, zT + (size_t)c * NB * LS, filtR + (size_t)c * 8192, convT + (size_t)c * NB * LS);
    asm volatile("s_waitcnt lgkmcnt(0)\n\ts_barrier" ::: "memory");
}

__device__ __forceinline__ void diff_unit(Frame& F, const Args& a, int l, int b, int h, int qrow, bool isctx, float lam, float lam_init) {
    bf16_t* dq = (bf16_t*)(F.ws + WS_DQ); const bf16_t* dk = (const bf16_t*)(F.ws + WS_DK); const bf16_t* dv = (const bf16_t*)(F.ws + WS_DV);
    f32x4* stash = (f32x4*)(F.outb + OUT_STASH) + (size_t)F.bid * 16 * 512 + F.tid;
    const int lane = F.lane, r32 = lane & 31, hi = lane >> 5;
    const size_t brow = (size_t)b * LT;
    f32x16 o[4], lf;
#pragma unroll 1
    for (int m = 0; m < 2; ++m) {
        att::Pass P;
        P.Qw = dq + (brow + qrow + F.wave * 32) * 1024 + h * 128 + m * 64; P.ldq = 1024;
        P.Kb = dk + brow * 1024 + h * 128 + m * 64; P.ldk = 1024;
        P.Vb = dv + brow * 1024 + h * 128; P.ldv = 1024;
        if (isctx) { P.nA = 0; P.ks = 0; P.nC = 4; } else { P.nA = LT / 64; P.ks = 0; P.nC = 0; }
        P.band = 0; P.qpos = qrow + F.wave * 32; P.m0 = -INFINITY; P.l0 = 0.f; P.rope = isctx ? 0 : 1; P.rtab = (const LAS float*)(F.lds + ROPE_OFF);
        att::flash_pass<128>(F.shm, P, o, lf);
        att::normalize<128>(o, lf);
        if (m == 0) {
            unsigned long long spa = (unsigned long long)stash; asm volatile("" : "+v"(spa)); GAS f32x4* sp = (GAS f32x4*)spa;
#pragma unroll
            for (int d = 0; d < 4; ++d)
#pragma unroll
                for (int g = 0; g < 4; ++g) sp[(d * 4 + g) * 512] = (f32x4){o[d][4 * g], o[d][4 * g + 1], o[d][4 * g + 2], o[d][4 * g + 3]};
        }
    }
    float ss[16];
#pragma unroll
    for (int r = 0; r < 16; ++r) ss[r] = 0.f;
    { unsigned long long spa = (unsigned long long)stash; asm volatile("" : "+v"(spa)); const GAS f32x4* sp = (const GAS f32x4*)spa;
#pragma unroll
      for (int d = 0; d < 4; ++d)
#pragma unroll
        for (int g = 0; g < 4; ++g) { const f32x4 o0 = sp[(d * 4 + g) * 512];
#pragma unroll
            for (int j = 0; j < 4; ++j) { const float y = o0[j] - lam * o[d][4 * g + j]; o[d][4 * g + j] = y; ss[4 * g + j] += y * y; } } }
#pragma unroll
    for (int r = 0; r < 16; ++r) { float s = ss[r];
#pragma unroll
        for (int off = 1; off < 32; off <<= 1) s += __shfl_xor(s, off);
        ss[r] = 1.0f / sqrtf(s * (1.0f / 128.0f) + EPS) * (1.0f - lam_init); }
    const float* sg = a.in[I_SUBLN] + (size_t)l * 128;
    { int ln_ = threadIdx.x & 63; asm volatile("" : "+v"(ln_)); const int r32 = ln_ & 31, hi = ln_ >> 5, lane = ln_;
      LAS bf16_t* stg = (LAS bf16_t*)F.lds + F.wave * 4096;
#pragma unroll
      for (int d = 0; d < 4; ++d) { const float g = sg[32 * d + r32];
#pragma unroll
        for (int r = 0; r < 16; ++r) stg[att::crow(r, hi) * 128 + 32 * d + r32] = (bf16_t)f2bf(o[d][r] * ss[r] * g); }
      LDS_WAIT();
      unsigned long long yba = (unsigned long long)(dq + (brow + qrow + F.wave * 32) * 1024 + h * 128); asm volatile("" : "+v"(yba)); GAS bf16_t* yb = (GAS bf16_t*)yba;
#pragma unroll
      for (int i = 0; i < 8; ++i) { const int row = i * 4 + (lane >> 4), ch = lane & 15; const u32x4 v = *(const LAS u32x4*)(stg + row * 128 + ch * 8); if (!F.dry) *(GAS u32x4*)(yb + row * 1024 + ch * 8) = v; }
      asm volatile("s_waitcnt lgkmcnt(0)\n\ts_barrier" ::: "memory"); }
}
__device__ __forceinline__ void p4_diff(Frame& F, const Args& a, int l, bool ctx_out) {
    const float* lp = a.in[I_DLAM] + (size_t)l * 256;
    const float d01 = wave_sum(lp[F.lane] * lp[64 + F.lane]), d23 = wave_sum(lp[128 + F.lane] * lp[192 + F.lane]);
    const float lam_init = 0.8f - 0.6f * expf(-0.3f * (float)l);
    const float lam = __uint_as_float(__builtin_amdgcn_readfirstlane(__float_as_uint(expf(d01) - expf(d23) + lam_init)));
    const int nun = NB * 8 * 16 + (ctx_out ? NB * 8 : 0);
    const int vcu = (F.G % 8 == 0) ? (F.bid % 8) * (F.G / 8) + F.bid / 8 : F.bid;
    for (int u = vcu; u < nun; u += F.G) {
        if (u < NB * 8 * 16) { const int b = u >> 7, h = (u >> 4) & 7, qb = u & 15; diff_unit(F, a, l, b, h, qb * 256, false, lam, lam_init); }
        else { const int v = u - NB * 8 * 16; diff_unit(F, a, l, v >> 3, v & 7, LS, true, lam, lam_init); }
    }
}
__device__ __forceinline__ void swa_unit(Frame& F, const Args& a, int l, int b, int kvh, int qrow, bool isctx) {
    bf16_t* sq = (bf16_t*)(F.ws + WS_SQ); const bf16_t* sk = (const bf16_t*)(F.ws + WS_SK); const bf16_t* sv = (const bf16_t*)(F.ws + WS_SV);
    const int lane = F.lane, r32 = lane & 31, hi = lane >> 5; const size_t brow = (size_t)b * LT; const int qh = kvh * 4 + (F.wave & 3), rh = F.wave >> 2;
    att::Pass P;
    P.Qw = sq + (brow + qrow + rh * 32) * 1024 + qh * 64; P.ldq = 1024;
    P.Kb = sk + brow * 256 + kvh * 64; P.ldk = 256; P.Vb = sv + brow * 256 + kvh * 64; P.ldv = 256;
    if (isctx) { P.nA = 0; P.ks = 0; P.nC = 4; P.band = 0; }
    else { const int ks = qrow >= 128 ? qrow - 128 : 0, ke = qrow + 192 <= LS ? qrow + 192 : LS; P.ks = ks; P.nA = (ke - ks) >> 6; P.nC = 4; P.band = 1; }
    P.qpos = (isctx ? 0 : qrow) + rh * 32; P.m0 = a.in[I_SINK][l * 16 + qh] * LOG2E; P.l0 = 1.0f; P.rope = isctx ? 0 : 1; P.rtab = (const LAS float*)(F.lds + ROPE_OFF);
    f32x16 o[2], lf;
    att::flash_pass<64>(F.shm, P, o, lf);
    att::normalize<64>(o, lf);
    { int ln_ = threadIdx.x & 63; asm volatile("" : "+v"(ln_)); const int r32 = ln_ & 31, hi = ln_ >> 5, lane = ln_;
      LAS bf16_t* stg = (LAS bf16_t*)F.lds + F.wave * 2048;
#pragma unroll
      for (int d = 0; d < 2; ++d)
#pragma unroll
        for (int r = 0; r < 16; ++r) stg[att::crow(r, hi) * 64 + 32 * d + r32] = (bf16_t)f2bf(o[d][r]);
      LDS_WAIT();
      unsigned long long yba = (unsigned long long)(sq + (brow + qrow + rh * 32) * 1024 + qh * 64); asm volatile("" : "+v"(yba)); GAS bf16_t* yb = (GAS bf16_t*)yba;
#pragma unroll
      for (int i = 0; i < 4; ++i) { const int row = i * 8 + (lane >> 3), ch = lane & 7; const u32x4 v = *(const LAS u32x4*)(stg + row * 64 + ch * 8); if (!F.dry) *(GAS u32x4*)(yb + row * 1024 + ch * 8) = v; }
      asm volatile("s_waitcnt lgkmcnt(0)\n\ts_barrier" ::: "memory"); }
}
__device__ __forceinline__ void p4_swa(Frame& F, const Args& a, int l, bool ctx_out) {
    const int nun = NB * 4 * 64 + (ctx_out ? NB * 4 * 4 : 0);
    const int vcu0 = (F.G % 8 == 0) ? (F.bid % 8) * (F.G / 8) + F.bid / 8 : F.bid;
    const int vcu = F.G - 1 - vcu0;
    for (int u = vcu; u < nun; u += F.G) {
        if (u < NB * 4 * 64) { const int b = u >> 8, kvh = (u >> 6) & 3, qb = u & 63; swa_unit(F, a, l, b, kvh, qb * 64, false); }
        else { const int v = u - NB * 4 * 64; swa_unit(F, a, l, v >> 4, (v >> 2) & 3, LS + (v & 3) * 64, true); }
    }
}
__device__ __forceinline__ void p8_norm2_router(Frame& F, const Args& a, int l) {
    float* rwT = (float*)F.shm;
    const float* rw = a.in[I_ROUTER] + (size_t)l * 1024 * 16;
    for (int i = F.tid; i < 16384; i += 512) { const int k = i >> 4, e = i & 15; rwT[e * 1024 + k] = rw[i]; }
    __syncthreads();
    const int gw = F.bid * NWAVES + F.wave, NGW = F.G * NWAVES;
    const float* xres = (const float*)(F.ws + WS_XRES); bf16_t* hb = (bf16_t*)(F.ws + WS_H); float* aff = (float*)(F.ws + WS_AFF);
    const float* mods = (const float*)(F.ws + WS_MODS); const float* g2 = a.in[I_N2G] + (size_t)l * 1024;
    constexpr int RPW = (TROWS + 2047) / 2048;
    const int rpw = (TROWS + NGW - 1) / NGW, r0 = gw * rpw, r1 = r0 + rpw < TROWS ? r0 + rpw : TROWS; (void)RPW;
    f32x4 gq[4], shq[4], sclq[4]; int mr_cur = -1;
#pragma unroll
    for (int j = 0; j < 4; ++j) gq[j] = *(const f32x4*)(g2 + 4 * F.lane + 256 * j);
    f32x4 vn[4];
    if (r0 < r1) {
#pragma unroll
        for (int j = 0; j < 4; ++j) vn[j] = *(const f32x4*)(xres + (size_t)r0 * 1024 + 4 * F.lane + 256 * j); }
    for (int row = r0; row < r1; ++row) {
        asm volatile("" ::: "memory");
        const int b = row / LT, t = row - b * LT; const int mr = t < LS ? b : 8;
        if (mr != mr_cur) { mr_cur = mr; const float* mrow = mods + ((size_t)l * 9 + mr) * 6144;
#pragma unroll
            for (int j = 0; j < 4; ++j) { shq[j] = *(const f32x4*)(mrow + 3 * 1024 + 4 * F.lane + 256 * j); sclq[j] = *(const f32x4*)(mrow + 4 * 1024 + 4 * F.lane + 256 * j) + 1.0f; } }
        f32x4 v[4]; float ss = 0.f;
#pragma unroll
        for (int j = 0; j < 4; ++j) { v[j] = vn[j]; ss += (v[j][0] * v[j][0] + v[j][1] * v[j][1]) + (v[j][2] * v[j][2] + v[j][3] * v[j][3]); }
        if (row + 1 < r1) {
#pragma unroll
            for (int j = 0; j < 4; ++j) vn[j] = *(const f32x4*)(xres + (size_t)(row + 1) * 1024 + 4 * F.lane + 256 * j); }
        const float rstd = 1.0f / sqrtf(wave_sum(ss) * (1.0f / 1024.0f) + EPS);
#pragma unroll
        for (int j = 0; j < 4; ++j) { const int c = 4 * F.lane + 256 * j;
            v[j] = (v[j] * rstd * gq[j]) * sclq[j] + shq[j];
            u32x2 w; w.x = cvtpk(v[j][0], v[j][1]); w.y = cvtpk(v[j][2], v[j][3]); *(u32x2*)(hb + (size_t)row * 1024 + c) = w; }
        float lg[16];
#pragma unroll
        for (int e = 0; e < 16; ++e) { float s = 0.f;
#pragma unroll
            for (int j = 0; j < 4; ++j) { const f32x4 w = *(const f32x4*)(rwT + e * 1024 + 4 * F.lane + 256 * j); s += (v[j][0] * w[0] + v[j][1] * w[1]) + (v[j][2] * w[2] + v[j][3] * w[3]); }
            lg[e] = wave_sum(s); }
        float mx = lg[0];
#pragma unroll
        for (int e = 1; e < 16; ++e) mx = fmaxf(mx, lg[e]);
        float den = 0.f;
#pragma unroll
        for (int e = 0; e < 16; ++e) { lg[e] = __expf(lg[e] - mx); den += lg[e]; }
        const float inv = 1.0f / den;
        float mine = 0.f;
#pragma unroll
        for (int e = 0; e < 16; ++e) mine = (F.lane == e) ? lg[e] * inv : mine;
        if (F.lane < 16) aff[(size_t)row * 16 + F.lane] = mine;
    }
}
__device__ __forceinline__ void p9_topk_gather(Frame& F) {
    unsigned* hist = (unsigned*)F.shm;
    unsigned* sh = hist + 256;
    int* rowlist = (int*)(sh + 32);
    const float* aff = (const float*)(F.ws + WS_AFF); int* slotof = (int*)(F.ws + WS_SLOTOF); float* gate = (float*)(F.ws + WS_GATE);
    const bf16_t* hb = (const bf16_t*)(F.ws + WS_H); bf16_t* xg = (bf16_t*)(F.ws + WS_XG);
    for (int item = F.bid; item < 256; item += F.G) {
        const int q = item >> 1, part = item & 1, b = q >> 4, e = q & 15;
#pragma unroll 1
        for (int cx = 0; cx < 2; ++cx) {
            const bool isctx = cx == 1;
            const int N = isctx ? LC : LS, cap = N / 8, per = isctx ? 1 : 8;
            const int rbase = b * LT + (isctx ? LS : 0);
            const bool act = isctx ? (F.tid < 256) : true;
            unsigned key[8];
#pragma unroll
            for (int j = 0; j < 8; ++j) { key[j] = 0u; if (act && j < per) key[j] = __float_as_uint(aff[(size_t)(rbase + F.tid * per + j) * 16 + e]); }
            unsigned prefix = 0u, krem = (unsigned)cap;
#pragma unroll 1
            for (int pass = 3; pass >= 0; --pass) {
                const int shft = pass * 8; const unsigned himask = pass == 3 ? 0u : (0xffffffffu << (shft + 8));
                __syncthreads();
                if (F.tid < 256) hist[F.tid] = 0u;
                __syncthreads();
#pragma unroll
                for (int j = 0; j < 8; ++j) if (act && j < per && (key[j] & himask) == prefix) atomicAdd(&hist[(key[j] >> shft) & 255u], 1u);
                __syncthreads();
                if (F.wave == 0) {
                    const unsigned h0 = hist[4 * F.lane], h1 = hist[4 * F.lane + 1], h2 = hist[4 * F.lane + 2], h3 = hist[4 * F.lane + 3];
                    const unsigned own = h0 + h1 + h2 + h3; unsigned inc = own;
#pragma unroll
                    for (int off = 1; off < 64; off <<= 1) { const unsigned o = __shfl_down(inc, off); if (F.lane + off < 64) inc += o; }
                    const unsigned S = inc - own;
                    if (S < krem && krem <= S + own) {
                        unsigned cum = S; int bin;
                        if (cum + h3 >= krem) bin = 3; else { cum += h3; if (cum + h2 >= krem) bin = 2; else { cum += h2; if (cum + h1 >= krem) bin = 1; else { cum += h1; bin = 0; } } }
                        sh[0] = prefix | ((unsigned)(4 * F.lane + bin) << shft); sh[1] = krem - cum;
                    }
                }
                __syncthreads();
                prefix = sh[0]; krem = sh[1];
            }
            unsigned cg = 0u, ce = 0u;
#pragma unroll
            for (int j = 0; j < 8; ++j) if (act && j < per) { cg += key[j] > prefix ? 1u : 0u; ce += key[j] == prefix ? 1u : 0u; }
            unsigned pk = cg | (ce << 16), inc = pk;
#pragma unroll
            for (int off = 1; off < 64; off <<= 1) { const unsigned o = __shfl_up(inc, off); if (F.lane >= off) inc += o; }
            __syncthreads();
            if (F.lane == 63) sh[16 + F.wave] = inc;
            __syncthreads();
            unsigned base = 0u;
            for (int w = 0; w < F.wave; ++w) base += sh[16 + w];
            unsigned ex = base + inc - pk; unsigned gb = ex & 0xffffu, eb = ex >> 16;
            const int sbase = isctx ? SLOT_L + (e * NB + b) * CAP_C : (e * NB + b) * CAP_L;
#pragma unroll
            for (int j = 0; j < 8; ++j) if (act && j < per) {
                const int row = rbase + F.tid * per + j; int slot = -1;
                if (key[j] > prefix) { slot = (int)(gb + (eb < krem ? eb : krem)); gb++; }
                else if (key[j] == prefix) { if (eb < krem) slot = (int)(gb + eb); eb++; }
                if (slot >= 0) { rowlist[slot] = row; if (part == 0) gate[sbase + slot] = __uint_as_float(key[j]); slot += sbase; }
                if (part == 0) slotof[(size_t)row * 16 + e] = slot;
            }
            __syncthreads();
            const int hcap = cap >> 1;
            for (int s0 = part * hcap + 4 * F.wave; s0 < (part + 1) * hcap; s0 += 4 * NWAVES) {
                u32x4 d[4][2];
#pragma unroll
                for (int i = 0; i < 4; ++i) { const u32x4* src = (const u32x4*)(hb + (size_t)rowlist[s0 + i] * 1024) + F.lane; d[i][0] = src[0]; d[i][1] = src[64]; }
#pragma unroll
                for (int i = 0; i < 4; ++i) { u32x4* dst = (u32x4*)(xg + (size_t)(sbase + s0 + i) * 1024) + F.lane; dst[0] = d[i][0]; dst[64] = d[i][1]; }
            }
        }
    }
}
constexpr int PPL = 12;
constexpr int NPHASE = 1 + DEPTH * PPL + 1;

__global__ void __launch_bounds__(NWAVES * 64, 2) mk_fwd(Args args) {
    extern __shared__ __attribute__((aligned(16))) unsigned char lds[];
    Frame F;
    F.lds = (LAS unsigned char*)lds; F.shm = (char*)lds;
    F.tid = threadIdx.x; F.lane = F.tid & 63; F.wave = __builtin_amdgcn_readfirstlane(F.tid >> 6);
    F.G = gridDim.x; F.bid = blockIdx.x; F.ws = args.ws; F.outb = (unsigned char*)args.out; F.dry = 0;
    volatile LAS unsigned* MISC = (volatile LAS unsigned*)(F.lds + MISC_OFF);
    for (int u = F.tid; u < (LDS_BYTES - LDSCTL_OFF) / 4; u += NWAVES * 64) ((LAS unsigned*)(F.lds + LDSCTL_OFF))[u] = 0u;
    __syncthreads();
    { LAS float* rt_ = (LAS float*)(F.lds + ROPE_OFF);
      for (int i = F.tid; i < 1024; i += NWAVES * 64) { const int pos = i >> 4, f = i & 15; const float inv = __builtin_amdgcn_exp2f(-(float)f * (13.287712379549449f / 16.0f));
          const float rev = (float)pos * inv * 0.15915494309189535f; rt_[i] = cos_rev(rev); rt_[1024 + i] = sin_rev(rev); } }
    __syncthreads();
    unsigned* ctl = (unsigned*)(F.ws + WS_CTL);
    const int lo = args.ph_lo, hi = args.ph_hi;
    XcdBarrier bar; bar.bar = ctl + CW_BAR; bar.x = 0; bar.st = nullptr;
    if (hi - lo > 1) bar = xcd_barrier_post(ctl + CW_BAR, MISC + 8);
#ifdef MK_ONLY
#define PHON(j) ((j) == MK_ONLY)
#else
#define PHON(j) true
#endif
#define IN(k) (lo <= (k) && (k) < hi)
#ifndef MK_DUP
#define MK_DUP 0
#endif
#define NREP(bit) (((MK_DUP >> (bit)) & 1) ? 2 : 1)
#define REP(bit) _Pragma("unroll 1") for (int rep = 0; rep < NREP(bit); ++rep)
#define REPEND(bit) do { if (rep + 1 < NREP(bit)) xcd_barrier(bar); } while (0)
#define DRY(bit) (rep + 1 < NREP(bit))
#define LOCALF Frame Fp = F; Fp.tid = threadIdx.x; asm volatile("" : "+v"(Fp.tid)); Fp.lane = Fp.tid & 63
#define SEAM(k) do { if (IN((k) + 1)) xcd_barrier(bar); } while (0)
#define STAMP(k) do { } while (0)

    if (PHON(100) && IN(0)) { STAMP(0); REP(12) { LOCALF; p0_mods_zfeat(Fp, args); REPEND(12); } SEAM(0); }

    for (int l = 0; l < DEPTH; ++l) {
        const int pb = 1 + l * PPL;
        const float* mods_l = (const float*)(F.ws + WS_MODS) + (size_t)l * 9 * 6144;
        const int lastl = l == DEPTH - 1;
        if (PHON(0) && IN(pb + 0)) { STAMP(pb + 0);
#ifndef MK_SUB0
#define MK_SUB0 7
#endif
            REP(0) { LOCALF; Fp.dry = DRY(0);
            if (MK_SUB0 & 1) { p1_weights(Fp, args, l); __syncthreads(); }
            if (MK_SUB0 & 2) { p1_filters(Fp, args, l); __syncthreads(); }
            if (MK_SUB0 & 4) { p1_norm1(Fp, args, l); }
            REPEND(0); }
            SEAM(pb + 0); }
        if (PHON(1) && IN(pb + 1)) { STAMP(pb + 1);
            pg8::SchedPlain S; S.init((const bf16_t*)(F.ws + WS_H), (const bf16_t*)(F.ws + WS_WIN), TROWS, DIN, 1024, F.G, F.bid);
            pg8::EpiProj E; E.ws = F.ws; E.rope = (const LAS float*)(F.lds + ROPE_OFF);
            REP(1) { pg8::gemm_phase<pg8::EpiProj, pg8::SchedPlain>(F.lds, 1024, S, E); REPEND(1); }
            SEAM(pb + 1);
        }
        if (PHON(2) && IN(pb + 2)) { STAMP(pb + 2); REP(2) { LOCALF; Fp.dry = DRY(2); p3_hyena_pre(Fp, args, l); REPEND(2); } SEAM(pb + 2); }
        if (PHON(3) && IN(pb + 3)) { STAMP(pb + 3);
#ifndef MK_SUB
#define MK_SUB 15
#endif
            if (MK_SUB & 1) { REP(3) { LOCALF; Fp.dry = DRY(3); p4_diff(Fp, args, l, !lastl); __syncthreads(); REPEND(3); } }
            if (MK_SUB & 2) { REP(4) { LOCALF; Fp.dry = DRY(4); p4_swa(Fp, args, l, !lastl); __syncthreads(); REPEND(4); } }
            REP(5) { if (MK_SUB & 4) { LOCALF; p4_hyena_lat(Fp); __syncthreads(); }
            if ((MK_SUB & 8) && !lastl) { LOCALF; p4_hyena_ctx(Fp, args, l); } REPEND(5); }
            SEAM(pb + 3); }
        if (PHON(4) && IN(pb + 4)) { STAMP(pb + 4); REP(6) { LOCALF; p5_hyena_post(Fp, args, l); REPEND(6); } SEAM(pb + 4); }
        if (PHON(5) && IN(pb + 5)) { STAMP(pb + 5);
            pg8::SchedBranch S; S.latonly = lastl; S.T.init(lastl ? NB * 16 : TROWS / 256, 4); S.G = F.G; S.c = F.bid; S.ws = (const char*)F.ws;
            S.B = (const char*)(F.ws + WS_WBR); S.tstep = (size_t)256 * 1024 * 2; S.bstep = (size_t)1024 * 1024 * 2;
            pg8::EpiBranch E; E.ws = F.ws; static_assert(WS_MERGED == OFF_DK && WS_GT == OFF_GT, "branch epilogue offsets");
            REP(7) { pg8::gemm_phase<pg8::EpiBranch, pg8::SchedBranch>(F.lds, 1024, S, E); REPEND(7); }
            SEAM(pb + 5);
        }
        if (PHON(6) && IN(pb + 6)) { STAMP(pb + 6);
            pg8::SchedPlain S; S.init((const bf16_t*)(F.ws + WS_MERGED), (const bf16_t*)(F.ws + WS_WOUT), TROWS, 1024, 1024, F.G, F.bid, lastl);
            pg8::EpiResid E; E.xres = (float*)(F.ws + WS_XRES); E.mod = mods_l;
            REP(8) { E.dry = DRY(8); pg8::gemm_phase<pg8::EpiResid, pg8::SchedPlain>(F.lds, 1024, S, E); REPEND(8); }
            SEAM(pb + 6);
        }
        if (PHON(7) && IN(pb + 7)) { STAMP(pb + 7); REP(9) { LOCALF; p8_norm2_router(Fp, args, l); REPEND(9); } SEAM(pb + 7); }
        if (PHON(8) && IN(pb + 8)) { STAMP(pb + 8); REP(14) { LOCALF; p9_topk_gather(Fp); REPEND(14); } SEAM(pb + 8); }
        if (PHON(9) && IN(pb + 9)) { STAMP(pb + 9); }
        if (PHON(10) && IN(pb + 10)) { STAMP(pb + 10);
            pg8::SchedMoe S; S.T.init(lastl ? SLOT_L / 256 : SLOTS / 256, 8); S.G = F.G; S.c = F.bid; S.A = (const char*)(F.ws + WS_XG); S.B = (const char*)(F.ws + WS_W13); S.tstep = (size_t)256 * 1024 * 2; S.estep = (size_t)2048 * 1024 * 2;
            pg8::EpiSwiglu E; E.hid = (bf16_t*)(F.ws + WS_HID);
            REP(10) { pg8::gemm_phase<pg8::EpiSwiglu, pg8::SchedMoe>(F.lds, 1024, S, E); REPEND(10); }
            SEAM(pb + 10);
        }
        if (PHON(11) && IN(pb + 11)) { STAMP(pb + 11);
            pg8::SchedMoe S; S.T.init(lastl ? SLOT_L / 256 : SLOTS / 256, 4); S.G = F.G; S.c = F.bid; S.A = (const char*)(F.ws + WS_HID); S.B = (const char*)(F.ws + WS_W2); S.tstep = (size_t)256 * 1024 * 2; S.estep = (size_t)1024 * 1024 * 2;
            pg8::EpiRowScale E; E.out = (bf16_t*)(F.ws + WS_XG); E.gate = (const float*)(F.ws + WS_GATE);
            REP(11) { pg8::gemm_phase<pg8::EpiRowScale, pg8::SchedMoe>(F.lds, 1024, S, E); REPEND(11); }
            SEAM(pb + 11);
        }
    }
    if (PHON(101) && IN(NPHASE - 1)) { STAMP(NPHASE - 1); REP(13) { LOCALF; pf_final(Fp, args); REPEND(13); }
    }
#undef IN
#undef SEAM
}

extern "C" void kernel_launch(void* const* d_in, const int* in_sizes, int n_in, void* d_out, int out_size, void* d_ws, size_t ws_size, hipStream_t stream) {
    static int grid = 0;
    if (grid == 0) {
        if (n_in != 28 || out_size != NB * LS * D || ws_size < WS_TOTAL) { fprintf(stderr, "kernel_launch: unexpected shapes (n_in %d out %d ws %zu need %zu)\n", n_in, out_size, ws_size, (size_t)WS_TOTAL); grid = -1; return; }
        int dev = 0, cus = 0, per_cu = 0;
        if (hipGetDevice(&dev) != hipSuccess || hipDeviceGetAttribute(&cus, hipDeviceAttributeMultiprocessorCount, dev) != hipSuccess) { grid = -1; return; }
        if (hipFuncSetAttribute((const void*)mk_fwd, hipFuncAttributeMaxDynamicSharedMemorySize, LDS_BYTES) != hipSuccess) { fprintf(stderr, "kernel_launch: hipFuncSetAttribute failed\n"); grid = -1; return; }
        if (hipOccupancyMaxActiveBlocksPerMultiprocessor(&per_cu, (const void*)mk_fwd, NWAVES * 64, LDS_BYTES) != hipSuccess || per_cu < 1) { fprintf(stderr, "kernel_launch: occupancy query says %d\n", per_cu); }
        (void)hipGetLastError();
        grid = cus;
    }
    if (grid < 0) return;
    if (hipMemsetAsync((char*)d_ws + WS_CTL, 0, CTL_ZERO_BYTES, stream) != hipSuccess) return;
    Args a{};
    for (int i = 0; i < 28; ++i) a.in[i] = (const float*)d_in[i];
    a.out = (float*)d_out; a.ws = (unsigned char*)d_ws;
#if MK_N_LAUNCHES == 1
    a.ph_lo = 0; a.ph_hi = NPHASE;
    hipLaunchKernelGGL(mk_fwd, dim3(grid), dim3(NWAVES * 64), LDS_BYTES, stream, a);
#else
    for (int p = 0; p < NPHASE; ++p) { a.ph_lo = p; a.ph_hi = p + 1; hipLaunchKernelGGL(mk_fwd, dim3(grid), dim3(NWAVES * 64), LDS_BYTES, stream, a); }
#endif
}
```

```cpp
#include <hip/hip_runtime.h>
#include <cstdio>
#include <cstdint>
#include <type_traits>

#ifndef MK_N_LAUNCHES
#define MK_N_LAUNCHES 1
#endif

#define LAS __attribute__((address_space(3)))
#define GAS __attribute__((address_space(1)))
typedef unsigned short bf16_t;
typedef short bf16x8 __attribute__((ext_vector_type(8)));
typedef short s16x4 __attribute__((ext_vector_type(4)));
typedef float f32x2 __attribute__((ext_vector_type(2)));
typedef float f32x4 __attribute__((ext_vector_type(4)));
typedef float f32x16 __attribute__((ext_vector_type(16)));
typedef unsigned u32x2 __attribute__((ext_vector_type(2)));
typedef unsigned u32x4 __attribute__((ext_vector_type(4)));
typedef GAS unsigned gu32;
#define RLX_AGENT __ATOMIC_RELAXED, __HIP_MEMORY_SCOPE_AGENT
#define LDS_WAIT() asm volatile("s_waitcnt lgkmcnt(0)" ::: "memory")
#define VM_WAIT() asm volatile("s_waitcnt vmcnt(0)" ::: "memory")

constexpr int NB = 8, LS = 4096, LC = 256, LT = LS + LC;
constexpr int TROWS = NB * LT;
constexpr int D = 1024, DIN = 10752, DEPTH = 4, NEXP = 16;
constexpr int CAP_L = 512, CAP_C = 32;
constexpr int SLOT_L = NEXP * NB * CAP_L, SLOT_C = NEXP * NB * CAP_C, SLOTS = SLOT_L + SLOT_C;
constexpr float EPS = 1e-6f;
constexpr float LOG2E = 1.4426950408889634f;
constexpr float QSCALE = 0.125f * LOG2E;

__device__ __forceinline__ unsigned f2bf(float f) { unsigned u = __builtin_bit_cast(unsigned, f); return (u + 0x7fffu + ((u >> 16) & 1u)) >> 16; }
__device__ __forceinline__ unsigned pk2(float lo, float hi) { return f2bf(lo) | (f2bf(hi) << 16); }
__device__ __forceinline__ float bf2f(unsigned v) { return __builtin_bit_cast(float, v << 16); }
__device__ __forceinline__ float bflo(unsigned w) { return __builtin_bit_cast(float, w << 16); }
__device__ __forceinline__ float bfhi(unsigned w) { return __builtin_bit_cast(float, w & 0xffff0000u); }
typedef __bf16 bf16x2_t __attribute__((ext_vector_type(2)));
__device__ __forceinline__ unsigned cvtpk(float lo, float hi) { f32x2 v = {lo, hi}; bf16x2_t b = __builtin_convertvector(v, bf16x2_t); return __builtin_bit_cast(unsigned, b); }
__device__ __forceinline__ float wave_sum(float v) {
#pragma unroll
    for (int o = 1; o < 64; o <<= 1) v += __shfl_xor(v, o);
    return v;
}
__device__ __forceinline__ float sin_rev(float rev) { return __builtin_amdgcn_sinf(__builtin_amdgcn_fractf(rev)); }
__device__ __forceinline__ float cos_rev(float rev) { return __builtin_amdgcn_cosf(__builtin_amdgcn_fractf(rev)); }
__device__ __forceinline__ float sin_rad(float x) { return sin_rev(x * 0.15915494309189535f); }
__device__ __forceinline__ float fast_exp(float x) { return __builtin_amdgcn_exp2f(x * LOG2E); }
__device__ __forceinline__ float sigmoidf_(float x) { return __builtin_amdgcn_rcpf(1.0f + fast_exp(-x)); }

constexpr size_t SZ1K = (size_t)TROWS * 1024 * 2;
constexpr size_t OFF_PROJ = (size_t)353 << 20;
constexpr size_t OFF_DQ = OFF_PROJ, OFF_DK = OFF_DQ + SZ1K, OFF_DV = OFF_DK + SZ1K, OFF_HY = OFF_DV + SZ1K, OFF_SQ = OFF_HY + 3 * SZ1K, OFF_SK = OFF_SQ + SZ1K, OFF_SV = OFF_SK + SZ1K / 4, OFF_GT = OFF_SV + SZ1K / 4;
constexpr size_t OFF_YHY = OFF_HY + ((size_t)64 << 20);

namespace pg8 {
constexpr int BM = 256, BK = 64, HALF = 128, HTB = HALF * BK * 2, STAGE_BYTES = 8 * HTB, NXCD = 8, WGM = 8;
__host__ __device__ __forceinline__ int lds_byte(int r, int c) { const int st = (r >> 4) * 2 + (c >> 5), rr = r & 15, cc = c & 31, ob = rr * 64 + cc * 2; return st * 1024 + (ob ^ (((ob >> 9) & 1) << 5)); }
__host__ __device__ __forceinline__ void stage_rc(int b, int& R, int& C) { const int st = b / 1024, sb = b % 1024, swz = sb ^ (((sb >> 9) & 1) << 5); R = (st >> 1) * 16 + swz / 64; C = (st & 1) * 32 + (swz % 64) / 2; }
__host__ __device__ __forceinline__ int perm32(int rho) { const int n = rho >> 4, i = rho & 15; return 8 * (i >> 2) + 4 * n + (i & 3); }

struct Unit { int pm, pn, aux; const char* A; const char* B; };

struct TileOrder {
    int nM, nN, nwg;
    __device__ __forceinline__ void init(int nM_, int nN_) { nM = nM_; nN = nN_; nwg = nM * nN; }
    __device__ __forceinline__ void map(int L, int& pm, int& pn) const {
        int wgid = L; { const int q = nwg / NXCD, r = nwg % NXCD, xcd = wgid % NXCD, off = wgid / NXCD; wgid = (xcd < r ? xcd * (q + 1) : r * (q + 1) + (xcd - r) * q) + off; }
        const int nig = WGM * nN, gid = wgid / nig, fm = gid * WGM, gsz = (nM - fm) < WGM ? (nM - fm) : WGM;
        pm = fm + ((wgid % nig) % gsz); pn = (wgid % nig) / gsz;
    }
};

template <class E_, class = void> struct EpiFull { static constexpr bool value = false; };
template <class E_> struct EpiFull<E_, decltype((void)E_::FULL)> { static constexpr bool value = E_::FULL; };
template <class Epi, class Sched>
__device__ __forceinline__ void gemm_phase(LAS unsigned char* lds, const int K, const Sched& S, const Epi& E) {
    int tid_ = threadIdx.x; asm volatile("" : "+v"(tid_));
    const int tid = tid_, wid = __builtin_amdgcn_readfirstlane(tid >> 6), lane = tid & 63, wr = wid >> 2, wc = wid & 3, fr = lane & 15, fq = lane >> 4;
    const int nt = K / BK;
    unsigned voffA[2], voffB[2];
    constexpr bool FULL = EpiFull<Epi>::value;
#pragma unroll
    for (int i = 0; i < 2; ++i) { int R, C; stage_rc(tid * 16 + i * 8192, R, C); const int Rb = Epi::PERM ? ((FULL ? (R >> 5) * 64 : (R & ~31)) + perm32(R & 31)) : R;
        voffA[i] = (unsigned)(R * K + C) * 2u; voffB[i] = (unsigned)(Rb * K + C) * 2u; }
    const size_t kstep = (size_t)(BK * 2);
    const size_t hstep = (size_t)HALF * K * 2;
    const size_t hstepB = FULL ? (size_t)32 * K * 2 : hstep;
    const unsigned ldsw = (unsigned)wid * 1024u;
    const int aoff = lds_byte(wr * 64 + fr, fq * 8), boff = lds_byte(wc * 32 + fr, fq * 8);
#define PG8_SA(b, h) (((b) * 2 + (h)) * HTB)
#define PG8_SB(b, h) ((4 + (b) * 2 + (h)) * HTB)
#define PG8_STAGE(bufoff, gbase, voff) do { _Pragma("unroll") for (int _i = 0; _i < 2; ++_i) \
        __builtin_amdgcn_global_load_lds((const unsigned*)((const char*)(gbase) + (voff)[_i]), (LAS unsigned*)(lds + (bufoff) + ldsw + _i * 8192), 16, 0, 0); } while (0)
#define PG8_LDA(dst, b, h) do { _Pragma("unroll") for (int m = 0; m < 4; ++m) _Pragma("unroll") for (int k = 0; k < 2; ++k) dst[m][k] = *(const LAS bf16x8*)(lds + PG8_SA(b, h) + aoff + m * 2048 + k * 1024); } while (0)
#define PG8_LDB(dst, b, h) do { _Pragma("unroll") for (int n = 0; n < 2; ++n) _Pragma("unroll") for (int k = 0; k < 2; ++k) dst[n][k] = *(const LAS bf16x8*)(lds + PG8_SB(b, h) + boff + n * 2048 + k * 1024); } while (0)
#define PG8_MMA(ai, bj, At, Bt) do { __builtin_amdgcn_s_setprio(1); _Pragma("unroll") for (int m = 0; m < 4; ++m) _Pragma("unroll") for (int n = 0; n < 2; ++n) _Pragma("unroll") for (int k = 0; k < 2; ++k) \
        acc[ai][bj][m][n] = __builtin_amdgcn_mfma_f32_16x16x32_bf16(Bt[n][k], At[m][k], acc[ai][bj][m][n], 0, 0, 0); __builtin_amdgcn_s_setprio(0); } while (0)
#define PG8_WAIT_V(n) asm volatile("s_waitcnt vmcnt(" #n ")" ::: "memory")
#define PG8_WAIT_L(n) asm volatile("s_waitcnt lgkmcnt(" #n ")" ::: "memory")
#define PG8_BAR __builtin_amdgcn_s_barrier()
#define PG8_SCHED __builtin_amdgcn_sched_barrier(0)
    Unit cur, nxt; int ui = 0;
    if (!S.next(0, cur)) return;
    f32x4 acc[2][2][4][2];
#pragma unroll
    for (int a = 0; a < 2; ++a)
#pragma unroll
        for (int b = 0; b < 2; ++b)
#pragma unroll
            for (int m = 0; m < 4; ++m)
#pragma unroll
                for (int n = 0; n < 2; ++n) acc[a][b][m][n] = (f32x4){0.f, 0.f, 0.f, 0.f};
    bf16x8 At[4][2], B0[2][2], B1[2][2];
    const char* cA = cur.A; const char* cB = cur.B;
    PG8_STAGE(PG8_SB(0, 0), cB, voffB); PG8_STAGE(PG8_SB(0, 1), cB + hstepB, voffB); PG8_STAGE(PG8_SA(0, 0), cA, voffA); PG8_STAGE(PG8_SA(0, 1), cA + hstep, voffA);
    if (wr == 1) PG8_BAR;
    PG8_WAIT_V(2); PG8_BAR;
    PG8_STAGE(PG8_SB(1, 0), cB + kstep, voffB); PG8_STAGE(PG8_SA(1, 0), cA + kstep, voffA); PG8_STAGE(PG8_SB(1, 1), cB + hstepB + kstep, voffB);
    PG8_WAIT_V(6); PG8_BAR;
    for (;;) {
        const bool has_next = S.next(ui + 1, nxt);
        const char* nA = has_next ? nxt.A : cA; const char* nB = has_next ? nxt.B : cB;
        for (int t = 0; t < nt; t += 2) {
            const bool last = (t == nt - 2);
            const char* a1 = cA + (size_t)(t + 1) * kstep;
            const char* a2 = last ? nA : cA + (size_t)(t + 2) * kstep; const char* b2 = last ? nB : cB + (size_t)(t + 2) * kstep;
            const char* a3 = a2 + kstep; const char* b3 = b2 + kstep;
            PG8_LDB(B0, 0, 0); PG8_LDB(B1, 0, 1); PG8_SCHED; PG8_LDA(At, 0, 0); PG8_STAGE(PG8_SA(1, 1), a1 + hstep, voffA);
            PG8_WAIT_V(8); PG8_WAIT_L(0); PG8_BAR; PG8_MMA(0, 0, At, B0); PG8_MMA(0, 1, At, B1); PG8_BAR; PG8_SCHED;
            PG8_LDA(At, 0, 1); PG8_STAGE(PG8_SB(0, 0), b2, voffB); PG8_STAGE(PG8_SB(0, 1), b2 + hstepB, voffB); PG8_STAGE(PG8_SA(0, 0), a2, voffA);
            PG8_WAIT_V(8); PG8_WAIT_L(0); PG8_BAR; PG8_MMA(1, 0, At, B0); PG8_MMA(1, 1, At, B1); PG8_BAR; PG8_SCHED;
            PG8_LDB(B0, 1, 0); PG8_LDB(B1, 1, 1); PG8_SCHED; PG8_LDA(At, 1, 0); PG8_STAGE(PG8_SA(0, 1), a2 + hstep, voffA);
            PG8_WAIT_V(8); PG8_WAIT_L(0); PG8_BAR; PG8_MMA(0, 0, At, B0); PG8_MMA(0, 1, At, B1); PG8_BAR; PG8_SCHED;
            PG8_LDA(At, 1, 1); PG8_STAGE(PG8_SB(1, 0), b3, voffB); PG8_STAGE(PG8_SB(1, 1), b3 + hstepB, voffB); PG8_STAGE(PG8_SA(1, 0), a3, voffA);
            PG8_WAIT_V(8); PG8_WAIT_L(0); PG8_BAR; PG8_MMA(1, 0, At, B0); PG8_MMA(1, 1, At, B1); PG8_BAR; PG8_SCHED;
        }
        if (wr == 0) PG8_BAR;
        E(acc, cur, wr, wc, fr, fq);
        if (!has_next) break;
        if (!E.keep(cur)) {
#pragma unroll
            for (int a = 0; a < 2; ++a)
#pragma unroll
                for (int b = 0; b < 2; ++b)
#pragma unroll
                    for (int m = 0; m < 4; ++m)
#pragma unroll
                        for (int n = 0; n < 2; ++n) acc[a][b][m][n] = (f32x4){0.f, 0.f, 0.f, 0.f};
        }
        cur = nxt; cA = nA; cB = nB; ++ui;
        if (wr == 1) PG8_BAR;
    }
    PG8_WAIT_V(0);
    PG8_BAR;
#undef PG8_SA
#undef PG8_SB
#undef PG8_STAGE
#undef PG8_LDA
#undef PG8_LDB
#undef PG8_MMA
#undef PG8_WAIT_V
#undef PG8_WAIT_L
#undef PG8_BAR
#undef PG8_SCHED
}
}
namespace pg8 {

struct SchedPlain {
    TileOrder T; int G, c; const char* A; const char* B; size_t tstep; int latonly;
    __device__ __forceinline__ void init(const bf16_t* A_, const bf16_t* B_, int M, int N, int K, int G_, int c_, int latonly_ = 0) { latonly = latonly_; T.init(latonly_ ? NB * 16 : M / BM, N / BM); G = G_; c = c_; A = (const char*)A_; B = (const char*)B_; tstep = (size_t)BM * K * 2; }
    __device__ __forceinline__ bool next(int i, Unit& u) const {
        const long L = (long)i * G + c; if (L >= T.nwg) return false;
        T.map((int)L, u.pm, u.pn); if (latonly) u.pm = (u.pm >> 4) * 17 + (u.pm & 15); u.aux = 0; u.A = A + (size_t)u.pm * tstep; u.B = B + (size_t)u.pn * tstep; return true;
    }
};

struct EpiProj {
    static constexpr bool PERM = true;
    static constexpr bool FULL = true;
    unsigned char* ws;
    const LAS float* rope;
    int dry = 0;
    __device__ __forceinline__ bool keep(const Unit&) const { return false; }
    static __device__ __forceinline__ void trade(const u32x4& w0, const u32x4& w1, u32x4& X, u32x4& Y) {
#pragma unroll
        for (int j = 0; j < 4; ++j) {
            X[j] = (unsigned)__builtin_amdgcn_update_dpp((int)w0[j], (int)w1[j], 0x128, 0xf, 0xc, false);
            Y[j] = (unsigned)__builtin_amdgcn_update_dpp((int)w1[j], (int)w0[j], 0x128, 0xf, 0x3, false); }
    }
    __device__ __forceinline__ void operator()(f32x4 (&acc)[2][2][4][2], const Unit& u, int wr, int wc, int fr, int fq) const {
        if (dry) return;
        const int pn = u.pn; int t0, ldc; size_t boff; bool roped = false; float scl = 1.0f;
        if (pn < 4) { boff = OFF_DQ; t0 = 0; ldc = 1024; }                           else if (pn < 8) { boff = OFF_DK; t0 = 4; ldc = 1024; roped = true; } else if (pn < 12) { boff = OFF_DV; t0 = 8; ldc = 1024; }
        else if (pn < 24) { boff = OFF_HY; t0 = 12; ldc = 3072; } else if (pn < 28) { boff = OFF_SQ; t0 = 24; ldc = 1024; } else if (pn < 29) { boff = OFF_SK; t0 = 28; ldc = 256; roped = true; }
        else if (pn < 30) { boff = OFF_SV; t0 = 29; ldc = 256; } else { boff = OFF_GT; t0 = 30; ldc = 3072; }
        bf16_t* base = (bf16_t*)(ws + boff);
        const int row0 = u.pm * BM + wr * 64 + (fr & 7), col0 = (pn - t0) * BM + wc * 64 + 32 * (fr >> 3) + 8 * fq;
        const int tb = (u.pm % 17) * BM;
        const bool lat = tb < LS;
        if (roped) {
            const int half = fq >> 1, f0 = 8 * (fq & 1);
#pragma unroll
            for (int ai = 0; ai < 2; ++ai)
#pragma unroll
                for (int m = 0; m < 4; ++m) {
                    const int t = tb + wr * 64 + fr + ai * HALF + m * 16;
                    u32x4 wv[2];
#pragma unroll
                    for (int bj = 0; bj < 2; ++bj) { const int pos = bj == 0 ? (t >> 6) : (t & 63);
                        f32x4 c0 = (f32x4){1.f, 1.f, 1.f, 1.f}, c1 = c0, s0 = (f32x4){0.f, 0.f, 0.f, 0.f}, s1 = s0;
                        if (lat) { const LAS float* cp = rope + pos * 16 + f0; c0 = *(const LAS f32x4*)cp; c1 = *(const LAS f32x4*)(cp + 4); s0 = *(const LAS f32x4*)(cp + 1024); s1 = *(const LAS f32x4*)(cp + 1028); }
                        if (half == 0) { s0 = -s0; s1 = -s1; }
                        const f32x4 v0 = acc[ai][bj][m][0], v1 = acc[ai][bj][m][1];
                        f32x4 q0, q1;
#pragma unroll
                        for (int j = 0; j < 4; ++j) {
                            const auto r0 = __builtin_amdgcn_permlane32_swap(__float_as_uint(v0[j]), __float_as_uint(v0[j]), false, false);
                            const auto r1 = __builtin_amdgcn_permlane32_swap(__float_as_uint(v1[j]), __float_as_uint(v1[j]), false, false);
                            q0[j] = __uint_as_float(half == 0 ? r0[1] : r0[0]); q1[j] = __uint_as_float(half == 0 ? r1[1] : r1[0]); }
                        const f32x4 o0 = (v0 * c0 + q0 * s0) * scl, o1 = (v1 * c1 + q1 * s1) * scl;
                        wv[bj].x = cvtpk(o0[0], o0[1]); wv[bj].y = cvtpk(o0[2], o0[3]); wv[bj].z = cvtpk(o1[0], o1[1]); wv[bj].w = cvtpk(o1[2], o1[3]); }
                    u32x4 X, Y; trade(wv[0], wv[1], X, Y);
                    bf16_t* rowp = base + (size_t)(row0 + ai * HALF + m * 16) * ldc + col0;
                    *(u32x4*)rowp = X; *(u32x4*)(rowp + (size_t)8 * ldc) = Y;
                }
            return;
        }
#pragma unroll
        for (int ai = 0; ai < 2; ++ai)
#pragma unroll
            for (int m = 0; m < 4; ++m) { bf16_t* rowp = base + (size_t)(row0 + ai * HALF + m * 16) * ldc + col0;
                u32x4 wv[2];
#pragma unroll
                for (int bj = 0; bj < 2; ++bj) { const f32x4 v0 = acc[ai][bj][m][0], v1 = acc[ai][bj][m][1];
                    wv[bj].x = cvtpk(v0[0], v0[1]); wv[bj].y = cvtpk(v0[2], v0[3]); wv[bj].z = cvtpk(v1[0], v1[1]); wv[bj].w = cvtpk(v1[2], v1[3]); }
                u32x4 X, Y; trade(wv[0], wv[1], X, Y);
                *(u32x4*)rowp = X; *(u32x4*)(rowp + (size_t)8 * ldc) = Y; }
    }
};

struct SchedBranch {
    TileOrder T; int G, c; const char* ws; const char* B; size_t tstep, bstep; int latonly;
    __device__ __forceinline__ bool next(int i, Unit& u) const {
        const int ti = i / 3, br = i - ti * 3; const long L = (long)ti * G + c; if (L >= T.nwg) return false;
        T.map((int)L, u.pm, u.pn); if (latonly) u.pm = (u.pm >> 4) * 17 + (u.pm & 15); u.aux = br; size_t ao = br == 0 ? OFF_DQ : (br == 1 ? OFF_YHY : OFF_SQ); asm volatile("" : "+s"(ao));     u.A = ws + ao + (size_t)u.pm * tstep; u.B = B + (size_t)br * bstep + (size_t)u.pn * tstep; return true;
    }
};
struct EpiBranch {
    static constexpr bool PERM = true;
    unsigned char* ws;
    __device__ __forceinline__ bool keep(const Unit& u) const { return u.aux < 2; }
    __device__ __forceinline__ void operator()(f32x4 (&acc)[2][2][4][2], const Unit& u, int wr, int wc, int fr, int fq) const {
        const int br = u.aux;
        const bf16_t* gt = (const bf16_t*)(ws + OFF_GT); bf16_t* out = (bf16_t*)(ws + OFF_DK);
        const int row0 = u.pm * BM + wr * 64 + fr, col0 = u.pn * BM + wc * 32 + 8 * fq;
#pragma unroll
        for (int ai = 0; ai < 2; ++ai) {
            u32x4 GA[4][2], GB[4][2];
#pragma unroll
            for (int m = 0; m < 4; ++m)
#pragma unroll
                for (int bj = 0; bj < 2; ++bj) { const bf16_t* gp = gt + (size_t)(row0 + ai * HALF + m * 16) * 3072 + br * 1024 + col0 + bj * HALF;
                    GA[m][bj] = *(const u32x4*)gp; GB[m][bj] = br < 2 ? *(const u32x4*)(gp + 1024) : (u32x4){0u, 0u, 0u, 0u}; }
#pragma unroll
            for (int m = 0; m < 4; ++m) { const size_t row = (size_t)(row0 + ai * HALF + m * 16);
#pragma unroll
                for (int bj = 0; bj < 2; ++bj) {
                    const u32x4 ga = GA[m][bj], gb = GB[m][bj];
                    float s[8];
                    if (br < 2) {
#pragma unroll
                        for (int j = 0; j < 4; ++j) {
                            const float a0 = bflo(ga[j]), a1 = bfhi(ga[j]), b0 = bflo(gb[j]), b1 = bfhi(gb[j]);
                            s[2 * j]     = (1.0f + fast_exp(fminf(-b0, 80.f))) * __builtin_amdgcn_rcpf(1.0f + fast_exp(fminf(-a0, 80.f)));
                            s[2 * j + 1] = (1.0f + fast_exp(fminf(-b1, 80.f))) * __builtin_amdgcn_rcpf(1.0f + fast_exp(fminf(-a1, 80.f)));
                        }
                    } else {
#pragma unroll
                        for (int j = 0; j < 4; ++j) { s[2 * j] = __builtin_amdgcn_rcpf(1.0f + fast_exp(fminf(-bflo(ga[j]), 80.f))); s[2 * j + 1] = __builtin_amdgcn_rcpf(1.0f + fast_exp(fminf(-bfhi(ga[j]), 80.f))); }
                    }
                    f32x4 v0 = acc[ai][bj][m][0], v1 = acc[ai][bj][m][1];
                    v0[0] *= s[0]; v0[1] *= s[1]; v0[2] *= s[2]; v0[3] *= s[3]; v1[0] *= s[4]; v1[1] *= s[5]; v1[2] *= s[6]; v1[3] *= s[7];
                    if (br < 2) { acc[ai][bj][m][0] = v0; acc[ai][bj][m][1] = v1; }
                    else { u32x4 w; w.x = cvtpk(v0[0], v0[1]); w.y = cvtpk(v0[2], v0[3]); w.z = cvtpk(v1[0], v1[1]); w.w = cvtpk(v1[2], v1[3]);
                        *(u32x4*)(out + row * 1024 + col0 + bj * HALF) = w; }
                } }
            asm volatile("" ::: "memory"); }
    }
};

struct EpiResid {
    static constexpr bool PERM = false;
    float* xres; const float* mod; int dry;
    __device__ __forceinline__ bool keep(const Unit&) const { return false; }
    __device__ __forceinline__ void operator()(f32x4 (&acc)[2][2][4][2], const Unit& u, int wr, int wc, int fr, int fq) const {
        const int b = u.pm / 17, isctx = (u.pm - b * 17) == 16; const float* mrow = mod + (size_t)(isctx ? 8 : b) * 6144 + 2 * 1024;
        const int row0 = u.pm * BM + wr * 64 + fr, col0 = u.pn * BM + wc * 32 + 4 * fq;
        f32x4 mv[2][2];
#pragma unroll
        for (int bj = 0; bj < 2; ++bj)
#pragma unroll
            for (int n = 0; n < 2; ++n) mv[bj][n] = *(const f32x4*)(mrow + col0 + bj * HALF + n * 16);
#pragma unroll
        for (int ai = 0; ai < 2; ++ai)
#pragma unroll
            for (int m = 0; m < 4; ++m) { float* rowp = xres + (size_t)(row0 + ai * HALF + m * 16) * 1024 + col0;
#pragma unroll
                for (int bj = 0; bj < 2; ++bj)
#pragma unroll
                    for (int n = 0; n < 2; ++n) { f32x4* p = (f32x4*)(rowp + bj * HALF + n * 16); const f32x4 x = *p; if (!dry) *p = x + mv[bj][n] * acc[ai][bj][m][n]; }
                if (m == 3) asm volatile("" ::: "memory"); }
    }
};

struct SchedMoe {
    TileOrder T; int G, c; const char* A; const char* B; size_t tstep, estep;
    __device__ __forceinline__ bool next(int i, Unit& u) const {
        const long L = (long)i * G + c; if (L >= T.nwg) return false;
        T.map((int)L, u.pm, u.pn); const int e = u.pm < 256 ? (u.pm >> 4) : (u.pm - 256); u.aux = e;
        u.A = A + (size_t)u.pm * tstep; u.B = B + (size_t)e * estep + (size_t)u.pn * tstep; return true;
    }
};
struct EpiSwiglu {
    static constexpr bool PERM = true;
    bf16_t* hid;
    __device__ __forceinline__ bool keep(const Unit&) const { return false; }
    __device__ __forceinline__ void operator()(f32x4 (&acc)[2][2][4][2], const Unit& u, int wr, int wc, int fr, int fq) const {
        const int row0 = u.pm * BM + wr * 64 + fr, col0 = u.pn * HALF + wc * 32 + 8 * fq;
#pragma unroll
        for (int ai = 0; ai < 2; ++ai)
#pragma unroll
            for (int m = 0; m < 4; ++m) { bf16_t* rowp = hid + (size_t)(row0 + ai * HALF + m * 16) * 1024 + col0;
                float h[8];
#pragma unroll
                for (int n = 0; n < 2; ++n)
#pragma unroll
                    for (int j = 0; j < 4; ++j) { const float a = acc[ai][0][m][n][j], b = acc[ai][1][m][n][j]; h[4 * n + j] = a * __builtin_amdgcn_rcpf(1.0f + fast_exp(-a)) * b; }
                u32x4 w; w.x = cvtpk(h[0], h[1]); w.y = cvtpk(h[2], h[3]); w.z = cvtpk(h[4], h[5]); w.w = cvtpk(h[6], h[7]);
                *(u32x4*)rowp = w; }
    }
};
struct EpiRowScale {
    static constexpr bool PERM = true;
    bf16_t* out; const float* gate;
    __device__ __forceinline__ bool keep(const Unit&) const { return false; }
    __device__ __forceinline__ void operator()(f32x4 (&acc)[2][2][4][2], const Unit& u, int wr, int wc, int fr, int fq) const {
        const int row0 = u.pm * BM + wr * 64 + fr, col0 = u.pn * BM + wc * 32 + 8 * fq;
#pragma unroll
        for (int ai = 0; ai < 2; ++ai)
#pragma unroll
            for (int m = 0; m < 4; ++m) { const int row = row0 + ai * HALF + m * 16; const float g = gate[row]; bf16_t* rowp = out + (size_t)row * 1024 + col0;
#pragma unroll
                for (int bj = 0; bj < 2; ++bj) { const f32x4 v0 = acc[ai][bj][m][0] * g, v1 = acc[ai][bj][m][1] * g;
                    u32x4 w; w.x = cvtpk(v0[0], v0[1]); w.y = cvtpk(v0[2], v0[3]); w.z = cvtpk(v1[0], v1[1]); w.w = cvtpk(v1[2], v1[3]);
                    *(u32x4*)(rowp + bj * HALF) = w; } }
    }
};
}
namespace att {
__device__ __forceinline__ int crow(int r, int hi) { return (r & 3) + 8 * (r >> 2) + 4 * hi; }
__device__ __forceinline__ void glds16(const void* gsrc, unsigned lds_dst) { unsigned keep;
    asm volatile("s_mov_b32 %0, m0\n\ts_mov_b32 m0, %2\n\ts_nop 0\n\tglobal_load_lds_dwordx4 %1, off\n\ts_mov_b32 m0, %0" : "=&s"(keep) : "v"(gsrc), "s"(lds_dst) : "memory"); }
#define ATT_WAIT_BAR() asm volatile("s_waitcnt vmcnt(0) lgkmcnt(0)\n\ts_barrier" ::: "memory")

constexpr int KSLOT = 8192;
constexpr int NSLOT = 4;
template <int DV> struct Lay { static constexpr int VSLOT = DV * 128, K0 = 0, V0 = NSLOT * KSLOT, WS = V0 + NSLOT * VSLOT, BYTES = WS + 8 * 256; };

struct Pass {
    const bf16_t* Qw; int ldq;
    const bf16_t* Kb; int ldk;
    const bf16_t* Vb; int ldv;
    int nA, ks, nC;
    int band;
    int qpos;
    float m0, l0;
    int rope; const LAS float* rtab;
};

__device__ __forceinline__ float max3f(float a, float b, float c) { float r; asm("v_max3_f32 %0, %1, %2, %3" : "=v"(r) : "v"(a), "v"(b), "v"(c)); return r; }
constexpr float ATT_THR = 8.0f;

template <int DV>
__device__ __forceinline__ void flash_pass(char* shm, const Pass& P, f32x16 (&o)[DV / 32], f32x16& osum) {
    typedef Lay<DV> L;
    int tid_ = threadIdx.x; asm volatile("" : "+v"(tid_));
    const int tid = tid_, lane = tid & 63, r32 = lane & 31, hi = lane >> 5; const int wid = __builtin_amdgcn_readfirstlane(tid >> 6);
    const unsigned lds0 = (unsigned)(uintptr_t)shm;
    float* wsf = (float*)(shm + L::WS) + wid * 64;
    const int NT = P.nA + P.nC;
    bf16x8 qr[4];
#pragma unroll
    for (int d0 = 0; d0 < 4; ++d0) qr[d0] = *reinterpret_cast<const bf16x8*>(P.Qw + (size_t)r32 * P.ldq + d0 * 16 + hi * 8);
    { const int tq = P.qpos + r32;
#pragma unroll
      for (int ax = 0; ax < 2; ++ax) {
          f32x4 c0 = (f32x4){1.f, 1.f, 1.f, 1.f}, c1 = c0, s0 = (f32x4){0.f, 0.f, 0.f, 0.f}, s1 = s0;
          if (P.rope) { const LAS float* cp = P.rtab + (ax == 0 ? (tq >> 6) : (tq & 63)) * 16 + 8 * hi; c0 = *(const LAS f32x4*)cp; c1 = *(const LAS f32x4*)(cp + 4); s0 = *(const LAS f32x4*)(cp + 1024); s1 = *(const LAS f32x4*)(cp + 1028); }
          const u32x4 a = __builtin_bit_cast(u32x4, qr[2 * ax]), b = __builtin_bit_cast(u32x4, qr[2 * ax + 1]); u32x4 oa, ob;
#pragma unroll
          for (int j = 0; j < 4; ++j) { const float cl = j < 2 ? c0[2 * j] : c1[2 * j - 4], ch = j < 2 ? c0[2 * j + 1] : c1[2 * j - 3], sl_ = j < 2 ? s0[2 * j] : s1[2 * j - 4], sh_ = j < 2 ? s0[2 * j + 1] : s1[2 * j - 3];
              const float x1l = bflo(a[j]), x1h = bfhi(a[j]), x2l = bflo(b[j]), x2h = bfhi(b[j]);
              oa[j] = cvtpk((x1l * cl - x2l * sl_) * QSCALE, (x1h * ch - x2h * sh_) * QSCALE); ob[j] = cvtpk((x2l * cl + x1l * sl_) * QSCALE, (x2h * ch + x1h * sh_) * QSCALE); }
          qr[2 * ax] = __builtin_bit_cast(bf16x8, oa); qr[2 * ax + 1] = __builtin_bit_cast(bf16x8, ob); } }
#pragma unroll
    for (int d = 0; d < DV / 32; ++d) o[d] = f32x16{};
    float lsum = (hi == 0) ? P.l0 : 0.f;
    const bf16_t* ksrc = P.Kb + (size_t)lane * P.ldk + wid * 8;
    const bf16_t* vsrc = P.Vb + (size_t)(16 * (wid & 3) + (lane >> 2)) * P.ldv + (wid >> 2) * 32 + (lane & 3) * 8;
#define ATT_KEYROW(t) ((t) < P.nA ? P.ks + 64 * (t) : LS + 64 * ((t) - P.nA))
#define ATT_DMA_K(t, slot) do { const int kr_ = ATT_KEYROW(t); \
        glds16(ksrc + (size_t)kr_ * P.ldk, (unsigned)__builtin_amdgcn_readfirstlane(lds0 + L::K0 + (slot) * KSLOT + wid * 1024)); } while (0)
#define ATT_DMA_V(t, slot, s2_) do { const int kr_ = ATT_KEYROW(t); \
        glds16(vsrc + (size_t)kr_ * P.ldv + (s2_) * 64, (unsigned)__builtin_amdgcn_readfirstlane(lds0 + L::V0 + (slot) * L::VSLOT + (s2_) * 8192 + wid * 1024)); } while (0)
#define ATT_DMA(t, slot) do { ATT_DMA_K(t, slot); _Pragma("unroll") for (int s2__ = 0; s2__ < DV / 64; ++s2__) ATT_DMA_V(t, slot, s2__); } while (0)
#define ATT_QK(p0_, p1_, slot, cinit) do { const char* kb_ = shm + L::K0 + (slot) * KSLOT + hi * 1024 + r32 * 16; bf16x8 kf_[4]; \
        _Pragma("unroll") for (int d0 = 0; d0 < 2; ++d0) { kf_[2 * d0] = *reinterpret_cast<const bf16x8*>(kb_ + d0 * 2048); kf_[2 * d0 + 1] = *reinterpret_cast<const bf16x8*>(kb_ + d0 * 2048 + 512); } \
        __builtin_amdgcn_sched_barrier(0);        \
        p0_ = __builtin_amdgcn_mfma_f32_32x32x16_bf16(kf_[0], qr[0], cinit, 0, 0, 0); p1_ = __builtin_amdgcn_mfma_f32_32x32x16_bf16(kf_[1], qr[0], cinit, 0, 0, 0); \
        p0_ = __builtin_amdgcn_mfma_f32_32x32x16_bf16(kf_[2], qr[1], p0_, 0, 0, 0); p1_ = __builtin_amdgcn_mfma_f32_32x32x16_bf16(kf_[3], qr[1], p1_, 0, 0, 0); \
        __builtin_amdgcn_sched_barrier(0); \
        _Pragma("unroll") for (int d0 = 2; d0 < 4; ++d0) { kf_[2 * d0 - 4] = *reinterpret_cast<const bf16x8*>(kb_ + d0 * 2048); kf_[2 * d0 - 3] = *reinterpret_cast<const bf16x8*>(kb_ + d0 * 2048 + 512); } \
        __builtin_amdgcn_sched_barrier(0); \
        p0_ = __builtin_amdgcn_mfma_f32_32x32x16_bf16(kf_[0], qr[2], p0_, 0, 0, 0); p1_ = __builtin_amdgcn_mfma_f32_32x32x16_bf16(kf_[1], qr[2], p1_, 0, 0, 0); \
        p0_ = __builtin_amdgcn_mfma_f32_32x32x16_bf16(kf_[2], qr[3], p0_, 0, 0, 0); p1_ = __builtin_amdgcn_mfma_f32_32x32x16_bf16(kf_[3], qr[3], p1_, 0, 0, 0); } while (0)
#define ATT_ROWMAX(rm_, p0_, p1_) do { float a_ = max3f(p0_[0], p0_[1], p1_[0]), b_ = max3f(p0_[2], p0_[3], p1_[1]); a_ = max3f(a_, p1_[2], p1_[3]); \
        _Pragma("unroll") for (int r = 4; r < 16; r += 4) { a_ = max3f(a_, p0_[r], p0_[r + 1]); b_ = max3f(b_, p0_[r + 2], p0_[r + 3]); a_ = max3f(a_, p1_[r], p1_[r + 1]); b_ = max3f(b_, p1_[r + 2], p1_[r + 3]); } \
        rm_ = fmaxf(a_, b_); auto rr_ = __builtin_amdgcn_permlane32_swap(__float_as_uint(rm_), __float_as_uint(rm_), false, false); rm_ = fmaxf(__uint_as_float(rr_[0]), __uint_as_float(rr_[1])); } while (0)
    ATT_DMA(0, 0);
#define ATT_WAITV(ktiles) do { if ((ktiles) == 0) asm volatile("s_waitcnt vmcnt(0)" ::: "memory"); \
        else if ((ktiles) == 1) { if (DV == 128) asm volatile("s_waitcnt vmcnt(3)" ::: "memory"); else asm volatile("s_waitcnt vmcnt(2)" ::: "memory"); } \
        else { if (DV == 128) asm volatile("s_waitcnt vmcnt(6)" ::: "memory"); else asm volatile("s_waitcnt vmcnt(4)" ::: "memory"); } } while (0)
    if (NT > 1) ATT_DMA(1, 1);
    if (NT > 2) ATT_DMA(2, 2);
    { const int younger = NT > 2 ? 2 : (NT > 1 ? 1 : 0); ATT_WAITV(younger); }
    asm volatile("s_waitcnt lgkmcnt(0)\n\ts_barrier" ::: "memory");
    f32x16 p0, p1, n0, n1, negm;
    { const f32x16 zero = f32x16{}; ATT_QK(p0, p1, 0, zero); }
    asm volatile("s_nop 15\n\ts_nop 7" : "+v"(p0), "+v"(p1));
#define ATT_NEEDMASK(tt) (P.band && (tt) < P.nA && !(P.ks + 64 * (tt) >= P.qpos - 97 && P.ks + 64 * (tt) <= P.qpos + 65))
#define ATT_MASK(v0_, v1_, tt) do { const int q_ = P.qpos + r32, kb0_ = P.ks + 64 * (tt) + 4 * hi; \
        _Pragma("unroll") for (int r = 0; r < 16; ++r) { const int kv_ = kb0_ + (r & 3) + 8 * (r >> 2); int dd_ = kv_ - q_; dd_ = dd_ < 0 ? -dd_ : dd_; int d1_ = kv_ + 32 - q_; d1_ = d1_ < 0 ? -d1_ : d1_; \
            if (dd_ > 128) v0_[r] = -INFINITY; if (d1_ > 128) v1_[r] = -INFINITY; } } while (0)
    if (ATT_NEEDMASK(0)) ATT_MASK(p0, p1, 0);
    float m; { float rm0; ATT_ROWMAX(rm0, p0, p1); m = fmaxf(P.m0, rm0); }
    lsum *= __builtin_amdgcn_exp2f(P.m0 - m);
#pragma unroll
    for (int r = 0; r < 16; ++r) { p0[r] -= m; p1[r] -= m; negm[r] = -m; }
    n0 = p0; n1 = p1;
    int sl = 0;
    for (int t = 0; t < NT; ++t) {
        { const int younger = t + 2 < NT ? 1 : 0; ATT_WAITV(younger); }
        asm volatile("s_waitcnt lgkmcnt(0)\n\ts_barrier" ::: "memory");
        const int sl1 = (sl + 1) & (NSLOT - 1), sl2 = (sl + 3) & (NSLOT - 1);
        if (t + 1 < NT) { ATT_QK(n0, n1, sl1, negm); }
        __builtin_amdgcn_sched_barrier(0);
        const bool pre = t + 3 < NT;
        if (pre) ATT_DMA_K(t + 3, sl2);
        { float sacc = 0.f;
#pragma unroll
          for (int r = 0; r < 16; ++r) { p0[r] = __builtin_amdgcn_exp2f(p0[r]); p1[r] = __builtin_amdgcn_exp2f(p1[r]); sacc += p0[r] + p1[r]; }
          lsum += sacc; }
        u32x4 pw0, pw1, pw2, pw3;
        pw0 = (u32x4){cvtpk(p0[0], p0[1]), cvtpk(p0[2], p0[3]), cvtpk(p0[4], p0[5]), cvtpk(p0[6], p0[7])};
        pw1 = (u32x4){cvtpk(p0[8], p0[9]), cvtpk(p0[10], p0[11]), cvtpk(p0[12], p0[13]), cvtpk(p0[14], p0[15])};
        pw2 = (u32x4){cvtpk(p1[0], p1[1]), cvtpk(p1[2], p1[3]), cvtpk(p1[4], p1[5]), cvtpk(p1[6], p1[7])};
        pw3 = (u32x4){cvtpk(p1[8], p1[9]), cvtpk(p1[10], p1[11]), cvtpk(p1[12], p1[13]), cvtpk(p1[14], p1[15])};
        const int vb = (int)(lds0 + L::V0 + sl * L::VSLOT) + ((lane >> 4) & 1) * 32 + (lane & 3) * 8 + (4 * hi + ((lane & 15) >> 2)) * 64;
        s16x4 loA[4], hhA[4], loB[4], hhB[4];
        asm volatile("s_waitcnt lgkmcnt(0)" ::: "memory");
#define ATT_VRD(lo_, hh_, d0) do { _Pragma("unroll") for (int ks = 0; ks < 4; ++ks) { \
            asm volatile("ds_read_b64_tr_b16 %0,%1 offset:%c2" : "=&v"(lo_[ks]) : "v"(vb), "i"(((d0) >> 1) * 8192 + ((d0) & 1) * 4096 + ks * 1024) : "memory"); \
            asm volatile("ds_read_b64_tr_b16 %0,%1 offset:%c2" : "=&v"(hh_[ks]) : "v"(vb), "i"(((d0) >> 1) * 8192 + ((d0) & 1) * 4096 + ks * 1024 + 512) : "memory"); } } while (0)
#define ATT_PK(lo_, hh_, k) (bf16x8){lo_[k][0], lo_[k][1], lo_[k][2], lo_[k][3], hh_[k][0], hh_[k][1], hh_[k][2], hh_[k][3]}
        float ra_ = 0.f, rb_ = 0.f, rm = 0.f;
#define ATT_RMSTEP(s_) do { \
            if ((s_) == 0) { if (t + 1 < NT && ATT_NEEDMASK(t + 1)) ATT_MASK(n0, n1, t + 1); ra_ = max3f(n0[0], n0[1], n1[0]); rb_ = max3f(n0[2], n0[3], n1[1]); } \
            else if ((s_) == 1) { ra_ = max3f(ra_, n1[2], n1[3]); } \
            else if ((s_) == 2 || (s_) == 4 || (s_) == 6) { ra_ = max3f(ra_, n0[(2 * (s_)) & 15], n0[(2 * (s_) + 1) & 15]); rb_ = max3f(rb_, n0[(2 * (s_) + 2) & 15], n0[(2 * (s_) + 3) & 15]); } \
            else if ((s_) == 3 || (s_) == 5 || (s_) == 7) { ra_ = max3f(ra_, n1[(2 * (s_) - 2) & 15], n1[(2 * (s_) - 1) & 15]); rb_ = max3f(rb_, n1[(2 * (s_)) & 15], n1[(2 * (s_) + 1) & 15]); } \
            else if ((s_) == 8) { rm = fmaxf(ra_, rb_); auto rr_ = __builtin_amdgcn_permlane32_swap(__float_as_uint(rm), __float_as_uint(rm), false, false); rm = fmaxf(__uint_as_float(rr_[0]), __uint_as_float(rr_[1])); } } while (0)
#define ATT_SLOT(i_) do { if (DV == 128) { ATT_RMSTEP(i_); } else { ATT_RMSTEP(2 * (i_)); ATT_RMSTEP(2 * (i_) + 1); } __builtin_amdgcn_sched_barrier(0); } while (0)
#define ATT_PV(lo_, hh_, d0) do { \
            o[d0] = __builtin_amdgcn_mfma_f32_32x32x16_bf16(__builtin_bit_cast(bf16x8, pw0), ATT_PK(lo_, hh_, 0), o[d0], 0, 0, 0); ATT_SLOT(4 * (d0)); \
            o[d0] = __builtin_amdgcn_mfma_f32_32x32x16_bf16(__builtin_bit_cast(bf16x8, pw1), ATT_PK(lo_, hh_, 1), o[d0], 0, 0, 0); ATT_SLOT(4 * (d0) + 1); \
            o[d0] = __builtin_amdgcn_mfma_f32_32x32x16_bf16(__builtin_bit_cast(bf16x8, pw2), ATT_PK(lo_, hh_, 2), o[d0], 0, 0, 0); ATT_SLOT(4 * (d0) + 2); \
            o[d0] = __builtin_amdgcn_mfma_f32_32x32x16_bf16(__builtin_bit_cast(bf16x8, pw3), ATT_PK(lo_, hh_, 3), o[d0], 0, 0, 0); ATT_SLOT(4 * (d0) + 3); } while (0)
        ATT_VRD(loA, hhA, 0);
#pragma unroll
        for (int d0 = 0; d0 < DV / 32; d0 += 2) {
            ATT_VRD(loB, hhB, d0 + 1);
            asm volatile("s_waitcnt lgkmcnt(8)" ::: "memory"); __builtin_amdgcn_sched_barrier(0);
            ATT_PV(loA, hhA, d0);
            __builtin_amdgcn_sched_barrier(0);
            if (pre) ATT_DMA_V(t + 3, sl2, d0 >> 1);
            if (d0 + 2 < DV / 32) { ATT_VRD(loA, hhA, d0 + 2); asm volatile("s_waitcnt lgkmcnt(8)" ::: "memory"); }
            else asm volatile("s_waitcnt lgkmcnt(0)" ::: "memory");
            __builtin_amdgcn_sched_barrier(0);
            ATT_PV(loB, hhB, d0 + 1);
            __builtin_amdgcn_sched_barrier(0);
        }
#undef ATT_VRD
#undef ATT_PK
#undef ATT_PV
#undef ATT_SLOT
#undef ATT_RMSTEP
        if (t + 1 < NT && __any(rm > ATT_THR)) {
            const float dl = fmaxf(rm, 0.f), f = __builtin_amdgcn_exp2f(-dl);
            m += dl; lsum *= f; if (hi == 0) wsf[r32] = f;
#pragma unroll
            for (int r = 0; r < 16; ++r) { n0[r] -= dl; n1[r] -= dl; negm[r] = -m; }
            LDS_WAIT();
#pragma unroll
            for (int r = 0; r < 16; ++r) { const float fr_ = wsf[crow(r, hi)];
#pragma unroll
                for (int d = 0; d < DV / 32; ++d) o[d][r] *= fr_; }
        }
        p0 = n0; p1 = n1; sl = sl1;
    }
    asm volatile("s_waitcnt lgkmcnt(0)\n\ts_barrier" ::: "memory");
    { auto rr = __builtin_amdgcn_permlane32_swap(__float_as_uint(lsum), __float_as_uint(lsum), false, false); const float l = __uint_as_float(rr[0]) + __uint_as_float(rr[1]);
      if (hi == 0) wsf[r32] = l; LDS_WAIT();
#pragma unroll
      for (int r = 0; r < 16; ++r) osum[r] = wsf[crow(r, hi)];
      LDS_WAIT(); }
#undef ATT_KEYROW
#undef ATT_WAITV
#undef ATT_DMA
#undef ATT_QK
#undef ATT_ROWMAX
#undef ATT_NEEDMASK
#undef ATT_MASK
}

template <int DV>
__device__ __forceinline__ void normalize(f32x16 (&o)[DV / 32], const f32x16& osum) {
#pragma unroll
    for (int r = 0; r < 16; ++r) { const float rl = 1.0f / osum[r];
#pragma unroll
        for (int d = 0; d < DV / 32; ++d) o[d][r] *= rl; }
}
}
namespace hy {
constexpr int UPAD = 20 * 64;
constexpr int UROW = UPAD + 4096 * 2 + UPAD + 16;
constexpr int LDS_U = 0, LDS_R = 8 * UROW, LDS_R1 = LDS_R + 16384 + 64, LDS_BYTES = LDS_R1 + 16384;
static_assert(LDS_BYTES <= 131072 && UROW % 16 == 0, "hyena LDS");

__device__ __forceinline__ void conv_init(char* shm) {
    constexpr int Q = UPAD / 16;
    unsigned z_ = 0u; asm volatile("" : "+v"(z_));
    for (int i = threadIdx.x; i < 8 * 2 * Q; i += 512) { const int b = i / (2 * Q), r = i % (2 * Q), side = r / Q, q = r % Q;
        *(u32x4*)(shm + LDS_U + b * UROW + (side ? UPAD + 8192 : 0) + q * 16) = (u32x4){z_, z_, z_, z_}; }
}
__device__ __forceinline__ void conv_channel(char* shm, const bf16_t* zc, const bf16_t* Rc, bf16_t* outc) {
    int tid_ = threadIdx.x; asm volatile("" : "+v"(tid_));
    const int tid = tid_, lane = tid & 63, n = lane & 31, kg = lane >> 5; const int w = __builtin_amdgcn_readfirstlane(tid >> 6);
    asm volatile("s_waitcnt lgkmcnt(0)\n\ts_barrier" ::: "memory");
#pragma unroll
    for (int j = 0; j < 8; ++j) { const int id = tid + 512 * j, b = id >> 9, off = (id & 511) * 16; *(u32x4*)(shm + LDS_U + b * UROW + UPAD + off) = *(const u32x4*)((const char*)zc + (size_t)b * 8192 + off); }
#pragma unroll
    for (int j = 0; j < 2; ++j) { const int ci = tid + 512 * j, off = ci * 16; const u32x4 a = *(const u32x4*)((const char*)Rc + off);
        const unsigned e8 = ci < 1023 ? (unsigned)Rc[8 * ci + 8] : 0u;
        *(u32x4*)(shm + LDS_R + off) = a;
        u32x4 sft; sft.x = (a.x >> 16) | (a.y << 16); sft.y = (a.y >> 16) | (a.z << 16); sft.z = (a.z >> 16) | (a.w << 16); sft.w = (a.w >> 16) | (e8 << 16);
        *(u32x4*)(shm + LDS_R1 + off) = sft; }
    asm volatile("s_waitcnt vmcnt(0) lgkmcnt(0)\n\ts_barrier" ::: "memory");
    f32x16 acc[4];
#pragma unroll
    for (int k = 0; k < 4; ++k) acc[k] = f32x16{};
    const int bcol = n >> 2, il = n & 3;
    const LAS char* Abase = (const LAS char*)shm + ((n & 1) ? (LDS_R1 - 2) : LDS_R) + (4096 - n + 8 * kg) * 2;
    const LAS char* Ubase = (const LAS char*)shm + LDS_U + bcol * UROW + UPAD + kg * 16 + 64 * (16 * w + il);
    const int dlo = 16 * w - 127, dhi = 16 * w + 15;
#define HY_LDA(dst, d, sc) do { const volatile LAS unsigned* ap_ = (const volatile LAS unsigned*)(Abase + (16 * (sc) - 32 * (d)) * 2); u32x4 aw_; aw_.x = ap_[0]; aw_.y = ap_[1]; aw_.z = ap_[2]; aw_.w = ap_[3]; dst = __builtin_bit_cast(bf16x8, aw_); } while (0)
#define HY_LDB(dst, m, sc) dst = *(const LAS bf16x8*)(Ubase + 64 * (m) + 32 * (sc))
#pragma unroll 1
    for (int rho = 0; rho < 4; ++rho) {
        int d = dlo + rho;
        bf16x8 A0, A1, X0[5], X1[5];
        HY_LDA(A0, d, 0); HY_LDA(A1, d, 1);
#pragma unroll
        for (int k = 0; k < 4; ++k) { HY_LDB(X0[k], 4 * k - d, 0); HY_LDB(X1[k], 4 * k - d, 1); }
#define HY_STEP(s) { if (d > dhi) break; \
            bf16x8 nA0, nA1;                   \
            HY_LDA(nA0, d + 4, 0); HY_LDA(nA1, d + 4, 1); HY_LDB(X0[(4 - (s) + 5) % 5], -(d + 4), 0); HY_LDB(X1[(4 - (s) + 5) % 5], -(d + 4), 1); \
            _Pragma("unroll") for (int k = 0; k < 4; ++k) { acc[k] = __builtin_amdgcn_mfma_f32_32x32x16_bf16(A0, X0[(k - (s) + 5) % 5], acc[k], 0, 0, 0); acc[k] = __builtin_amdgcn_mfma_f32_32x32x16_bf16(A1, X1[(k - (s) + 5) % 5], acc[k], 0, 0, 0); } \
            A0 = nA0; A1 = nA1; d += 4; }
        for (;;) { HY_STEP(0) HY_STEP(1) HY_STEP(2) HY_STEP(3) HY_STEP(4) }
#undef HY_STEP
    }
#undef HY_LDA
#undef HY_LDB
#pragma unroll
    for (int k = 0; k < 4; ++k) { const int i = 16 * w + 4 * k + il; bf16_t* op = outc + (size_t)bcol * 4096 + 32 * i + 4 * kg;
#pragma unroll
        for (int g = 0; g < 4; ++g) { u32x2 v; v.x = cvtpk(acc[k][4 * g], acc[k][4 * g + 1]); v.y = cvtpk(acc[k][4 * g + 2], acc[k][4 * g + 3]); *(u32x2*)(op + 8 * g) = v; } }
}
}
constexpr int NWAVES = 8;
constexpr size_t MiB = 1u << 20;
constexpr size_t WS_CTL = 0, CTL_ZERO_BYTES = 1 * MiB;
constexpr size_t WS_MODS = 1 * MiB;
constexpr size_t WS_FCTX = 2 * MiB;
constexpr size_t WS_ZFEAT = 4 * MiB;
constexpr size_t WS_AFF = 9 * MiB;
constexpr size_t WS_SLOTOF = 12 * MiB;
constexpr size_t WS_GATE = 16 * MiB;
constexpr size_t WS_ZCTX = 17 * MiB;
constexpr size_t WS_XRES = 24 * MiB;
constexpr size_t WS_H = WS_XRES + 136 * MiB;
constexpr size_t WS_W = WS_H + 68 * MiB;
constexpr size_t WS_WIN = WS_W, WS_WBR = WS_WIN + 21 * MiB, WS_WOUT = WS_WBR + 6 * MiB, WS_W13 = WS_WOUT + 2 * MiB, WS_W2 = WS_W13 + 64 * MiB;
constexpr size_t WS_PROJ = WS_W2 + 32 * MiB;
static_assert(WS_PROJ == OFF_PROJ, "projection base");
constexpr size_t WS_DQ = OFF_DQ, WS_DK = OFF_DK, WS_DV = OFF_DV, WS_HY = OFF_HY, WS_SQ = OFF_SQ, WS_SK = OFF_SK, WS_SV = OFF_SV, WS_GT = OFF_GT;
constexpr size_t WS_END = WS_GT + 3 * SZ1K;
constexpr size_t WS_HRAW = WS_END;
constexpr size_t WS_TOTAL = WS_HRAW + 32 * MiB;
constexpr size_t WS_CONVT = WS_HY;
constexpr size_t WS_YHY = OFF_YHY;
constexpr size_t WS_MERGED = WS_DK;
constexpr size_t WS_XG = WS_HY;
constexpr size_t WS_HID = WS_GT;
static_assert(WS_YHY + SZ1K <= WS_SQ && WS_XG + (size_t)SLOTS * 2048 <= WS_SQ && WS_HID + (size_t)SLOTS * 2048 <= WS_END, "overlays");
constexpr size_t OUT_ZT = 0;
constexpr size_t OUT_FILT = 64 * MiB;
constexpr size_t OUT_STASH = 80 * MiB;
static_assert(OUT_STASH + 32 * MiB <= (size_t)NB * LS * D * 4, "d_out scratch");

constexpr int CW_TMO = 0, CW_CODE = 1, CW_CHK = 64, CW_BAR = 4096;

constexpr int RING_BYTES = 131072, LDSCTL_OFF = RING_BYTES, MISC_OFF = LDSCTL_OFF + 320, ROPE_OFF = LDSCTL_OFF + 1024  , LDS_BYTES = 147456;
static_assert(ROPE_OFF + 8192 <= LDS_BYTES, "LDS map");

#define XB_TMO      128
#define XB_XCNT(j)  (256  + 64 * (j))
#define XB_XSUB(j)  (1280 + 64 * (j))
#define XB_XGEN(j)  (2304 + 64 * (j))
#define XB_TOP      3328
#define XB_TOPGEN   3392
#define XCD_BAR_WORDS 3456
#define XB_SPIN_CAP (1u << 22)
__device__ __forceinline__ unsigned xb_ld(unsigned* p)              { return __hip_atomic_load(p, __ATOMIC_RELAXED, __HIP_MEMORY_SCOPE_AGENT); }
__device__ __forceinline__ unsigned xb_add(unsigned* p, unsigned v) { return __hip_atomic_fetch_add(p, v, __ATOMIC_RELAXED, __HIP_MEMORY_SCOPE_AGENT); }
__device__ __forceinline__ unsigned xb_xcc_id() { return (unsigned)__builtin_amdgcn_s_getreg((3 << 11) | 20) & 0xFu; }
#define XB_SPIN(cond, bar) do { unsigned _sp = 0; while (cond) { __builtin_amdgcn_s_sleep(1); \
    if ((++_sp & 255u) == 0u) { if (xb_ld(&(bar)[XB_TMO])) break; if (_sp > XB_SPIN_CAP) { atomicAdd(&(bar)[XB_TMO], 1u); break; } } } } while (0)
struct XcdBarrier { unsigned* bar; unsigned x; volatile LAS unsigned* st; };
__device__ __forceinline__ XcdBarrier xcd_barrier_post(unsigned* bar, volatile LAS unsigned* st) {
    XcdBarrier b; b.bar = bar; b.x = xb_xcc_id(); b.st = st;
    if (threadIdx.x == 0) (void)xb_add(&bar[XB_XCNT(b.x)], 1u);
    return b;
}
__device__ __forceinline__ void xcd_barrier_complete(unsigned* bar, unsigned x, unsigned& nloc, unsigned& nx) {
    const unsigned G = gridDim.x * gridDim.y * gridDim.z;
    unsigned sum, cnt, mine, sp = 0u;
    for (;;) {
        sum = 0u; cnt = 0u; mine = 0u;
#pragma unroll
        for (unsigned j = 0; j < 16; ++j) { const unsigned c = xb_ld(&bar[XB_XCNT(j)]); sum += c; cnt += (c > 0u) ? 1u : 0u; mine = (j == x) ? c : mine; }
        if (sum == G) break;
        __builtin_amdgcn_s_sleep(1);
        if ((++sp & 255u) == 0u) { if (xb_ld(&bar[XB_TMO])) break; if (sp > XB_SPIN_CAP) { atomicAdd(&bar[XB_TMO], 1u); break; } }
    }
    nloc = mine > 0u ? mine : 1u; nx = cnt > 0u ? cnt : 1u;
}
__device__ __forceinline__ void xcd_barrier(const XcdBarrier& b) {
    asm volatile("s_waitcnt vmcnt(0)" ::: "memory");
    __syncthreads();
    if (threadIdx.x == 0) {
        unsigned* bar = b.bar;
        __builtin_amdgcn_s_waitcnt(0);
        unsigned nloc = b.st[0], nx = b.st[1];
        if (nloc == 0u) { xcd_barrier_complete(bar, b.x, nloc, nx); b.st[0] = nloc; b.st[1] = nx; }
        const unsigned old = xb_add(&bar[XB_XSUB(b.x)], 1u);
        const unsigned gen = old / nloc;
        if (old + 1u == (gen + 1u) * nloc) {
            __builtin_amdgcn_fence(__ATOMIC_RELEASE, "agent");
            asm volatile("s_waitcnt vmcnt(0)" ::: "memory");
            const unsigned og = xb_add(&bar[XB_TOP], 1u);
            const unsigned tg = og / nx;
            if (og + 1u == (tg + 1u) * nx) xb_add(&bar[XB_TOPGEN], 1u);
            else XB_SPIN(xb_ld(&bar[XB_TOPGEN]) == tg, bar);
            __builtin_amdgcn_fence(__ATOMIC_ACQUIRE, "agent");
            xb_add(&bar[XB_XGEN(b.x)], 1u);
            asm volatile("s_waitcnt vmcnt(0)" ::: "memory");
        } else {
            XB_SPIN(xb_ld(&bar[XB_XGEN(b.x)]) == gen, bar);
            __builtin_amdgcn_fence(__ATOMIC_ACQUIRE, "agent");
            asm volatile("s_waitcnt vmcnt(0)" ::: "memory");
        }
    }
    __syncthreads();
}

struct Args {
    const float* in[28]; float* out; unsigned char* ws; int ph_lo, ph_hi;
};
struct Frame {
    LAS unsigned char* lds; char* shm;
    int tid, lane, wave, G, bid;
    int dry;
    unsigned char* ws; unsigned char* outb;
};
enum { I_X = 0, I_C, I_CTX, I_CCTX, I_WMOD, I_BMOD, I_N1G, I_N2G, I_WIN, I_DLAM, I_SUBLN, I_HCW, I_HCB, I_FW1, I_FB1, I_FW2, I_FB2, I_FW3, I_FREQ, I_HBIAS, I_SINK, I_WBR, I_WOUT, I_ROUTER, I_W1, I_W3, I_W2, I_FINALG };
__device__ __forceinline__ void p0_mods_zfeat(Frame& F, const Args& a) {
    float* sc = (float*)F.shm;
    float* part = (float*)(F.shm + 9 * 1024 * 4);
    for (int i = F.tid; i < 9 * 1024; i += 512) { const int r = i >> 10, k = i & 1023; const float v = r < 8 ? a.in[I_C][r * 1024 + k] : a.in[I_CCTX][k]; sc[i] = v * sigmoidf_(v); }
    __syncthreads();
    float* mods = (float*)(F.ws + WS_MODS);
    for (int ch = F.bid; ch < 192; ch += F.G) {
        const int l = ch / 48, c0 = (ch % 48) * 128, col = F.tid & 127, kq = F.tid >> 7;
        const float* w = a.in[I_WMOD] + ((size_t)l * 1024 + kq * 256) * 6144 + c0 + col;
        float acc[9];
#pragma unroll
        for (int r = 0; r < 9; ++r) acc[r] = 0.f;
        for (int k = 0; k < 256; ++k) { const float wv = w[(size_t)k * 6144];
#pragma unroll
            for (int r = 0; r < 9; ++r) acc[r] += sc[r * 1024 + kq * 256 + k] * wv; }
#pragma unroll
        for (int r = 0; r < 9; ++r) part[(kq * 9 + r) * 128 + col] = acc[r];
        __syncthreads();
        for (int i = F.tid; i < 9 * 128; i += 512) { const int r = i >> 7, cc = i & 127;
            const float s = part[(0 * 9 + r) * 128 + cc] + part[(1 * 9 + r) * 128 + cc] + part[(2 * 9 + r) * 128 + cc] + part[(3 * 9 + r) * 128 + cc];
            mods[((size_t)l * 9 + r) * 6144 + c0 + cc] = s + a.in[I_BMOD][l * 6144 + c0 + cc]; }
        __syncthreads();
    }
    float* zf = (float*)(F.ws + WS_ZFEAT);
    const int gw = F.bid * NWAVES + F.wave, NGW = F.G * NWAVES;
    for (int it = gw; it < DEPTH * LT; it += NGW) {
        const int l = it / LT, row = it - l * LT; const int Lf = row < LS ? LS : LC, ii = row < LS ? row : row - LS;
        const float tt = (float)ii / (float)(Lf - 1);
        const float wrev = (float)ii / (float)Lf;
        const int j = F.lane & 15; const float fj = 1e-4f + (float)j * ((15.0f - 1e-4f) / 15.0f);
        const float cs = cos_rev(fj * wrev), sn = -sin_rev(fj * wrev);
        const float* w1 = a.in[I_FW1] + (size_t)l * 33 * 64; const float* w2 = a.in[I_FW2] + (size_t)l * 64 * 64;
        const float fq = a.in[I_FREQ][l * 64 + F.lane];
        float s = tt * w1[F.lane] + a.in[I_FB1][l * 64 + F.lane];
#pragma unroll
        for (int k = 0; k < 16; ++k) { s += __shfl(cs, k) * w1[(1 + k) * 64 + F.lane]; s += __shfl(sn, k) * w1[(17 + k) * 64 + F.lane]; }
        const float z1 = sin_rad(fq * s);
        float s2 = a.in[I_FB2][l * 64 + F.lane];
#pragma unroll 8
        for (int k = 0; k < 64; ++k) s2 += __shfl(z1, k) * w2[k * 64 + F.lane];
        zf[((size_t)l * 64 + F.lane) * LT + row] = sin_rad(fq * s2);
    }
}

__device__ __forceinline__ void transpose_item(const float* W, int K, int N, bf16_t* WT, int k0, int n0, int drow, LAS float* scr, int lane) {
#pragma unroll 8
    for (int i = 0; i < 32; ++i) { const int kk = 2 * i + (lane >> 5); scr[kk * 33 + (lane & 31)] = W[(size_t)(k0 + kk) * N + n0 + (lane & 31)]; }
    LDS_WAIT(); asm volatile("" ::: "memory");
    const int c = lane & 7;
#pragma unroll
    for (int j = 0; j < 4; ++j) { const int n = (lane >> 3) + 8 * j; const LAS float* s = scr + (8 * c) * 33 + n;
        u32x4 o; o.x = pk2(s[0 * 33], s[1 * 33]); o.y = pk2(s[2 * 33], s[3 * 33]); o.z = pk2(s[4 * 33], s[5 * 33]); o.w = pk2(s[6 * 33], s[7 * 33]);
        *(GAS u32x4*)(WT + (size_t)(drow + n) * K + k0 + 8 * c) = o; }
    LDS_WAIT(); asm volatile("" ::: "memory");
}
__device__ __forceinline__ void p1_weights(Frame& F, const Args& a, int l) {
    LAS float* scr = (LAS float*)(F.lds + F.wave * 8448);
    const int gw = F.bid * NWAVES + F.wave, NGW = F.G * NWAVES;
    constexpr int I_IN = 16 * 336, I_SQ = 16 * 32;
    constexpr int NITEMS = I_IN + 4 * I_SQ + 48 * I_SQ;
    bf16_t* WinT = (bf16_t*)(F.ws + WS_WIN); bf16_t* WbrT = (bf16_t*)(F.ws + WS_WBR); bf16_t* WoutT = (bf16_t*)(F.ws + WS_WOUT);
    bf16_t* W13T = (bf16_t*)(F.ws + WS_W13); bf16_t* W2T = (bf16_t*)(F.ws + WS_W2);
    for (int it = gw; it < NITEMS; it += NGW) {
        int r = it;
        if (r < I_IN) { const int kb = r / 336, nb = r % 336; transpose_item(a.in[I_WIN] + (size_t)l * 1024 * DIN, 1024, DIN, WinT, 64 * kb, 32 * nb, 32 * nb, scr, F.lane); continue; }
        r -= I_IN;
        const int mi = r / I_SQ, q = r % I_SQ, kb = q / 32, nb = q % 32, n0 = 32 * nb;
        if (mi < 3) { transpose_item(a.in[I_WBR] + ((size_t)l * 3 + mi) * 1048576, 1024, 1024, WbrT + (size_t)mi * 1048576, 64 * kb, n0, n0, scr, F.lane); continue; }
        if (mi == 3) { transpose_item(a.in[I_WOUT] + (size_t)l * 1048576, 1024, 1024, WoutT, 64 * kb, n0, n0, scr, F.lane); continue; }
        const int e = (mi - 4) / 3, which = (mi - 4) % 3; const size_t eo = ((size_t)l * 16 + e) * 1048576;
        if (which == 0) transpose_item(a.in[I_W1] + eo, 1024, 1024, W13T + (size_t)e * 2097152, 64 * kb, n0, (n0 >> 7) * 256 + (n0 & 127), scr, F.lane);
        else if (which == 1) transpose_item(a.in[I_W3] + eo, 1024, 1024, W13T + (size_t)e * 2097152, 64 * kb, n0, (n0 >> 7) * 256 + 128 + (n0 & 127), scr, F.lane);
        else transpose_item(a.in[I_W2] + eo, 1024, 1024, W2T + (size_t)e * 1048576, 64 * kb, n0, n0, scr, F.lane);
    }
}

__device__ __forceinline__ void p1_filters(Frame& F, const Args& a, int l) {
    float* w3s = (float*)(F.shm + 72 * 1024);
    float* red = w3s + 512;
    float* nrm = red + 32;
    const float* zf = (const float*)(F.ws + WS_ZFEAT) + (size_t)l * LT * 64;
    bf16_t* filtR = (bf16_t*)(F.outb + OUT_FILT); float* fctx = (float*)(F.ws + WS_FCTX);
    const float da = -15.350567286626973f, db = -3.0701134573253946f;
    for (int cg = F.bid; cg < 256; cg += F.G) {
        const int c0 = 4 * cg;
        __syncthreads();
        { const int k = F.tid >> 3, q = F.tid & 7; w3s[F.tid] = a.in[I_FW3][((size_t)l * 64 + k) * 2048 + (q >> 2) * 1024 + c0 + (q & 3)]; }
        __syncthreads();
        float delta[4];
#pragma unroll
        for (int cc = 0; cc < 4; ++cc) delta[cc] = fabsf(da + (float)(c0 + cc) * ((db - da) / 1023.0f));
        float asum[4] = {0.f, 0.f, 0.f, 0.f};
        f32x4* slab = (f32x4*)(F.ws + WS_HRAW) + ((size_t)F.bid * 4096 + 8 * F.tid) * 2;
        { float h[8][8];
#pragma unroll
          for (int j = 0; j < 8; ++j)
#pragma unroll
            for (int q = 0; q < 8; ++q) h[j][q] = 0.f;
          const float* zc = zf + 8 * F.tid;
#pragma unroll 2
          for (int k = 0; k < 64; ++k) { const f32x4 za = *(const f32x4*)(zc + (size_t)k * LT), zb = *(const f32x4*)(zc + (size_t)k * LT + 4);
              const f32x4 wa = *(const f32x4*)(w3s + k * 8), wb = *(const f32x4*)(w3s + k * 8 + 4);
#pragma unroll
              for (int j = 0; j < 8; ++j) { const float z = j < 4 ? za[j] : zb[j - 4];
#pragma unroll
                  for (int q = 0; q < 4; ++q) { h[j][q] += z * wa[q]; h[j][4 + q] += z * wb[q]; } } }
#pragma unroll
          for (int j = 0; j < 8; ++j) { const int i = 8 * F.tid + j; const float tt = (float)i / 4095.0f; f32x4 hf, hbk;
#pragma unroll
              for (int cc = 0; cc < 4; ++cc) { const float dec = fast_exp(-tt * delta[cc]); hf[cc] = h[j][cc] * dec; hbk[cc] = h[j][4 + cc] * dec; asum[cc] += fabsf(hf[cc]) + fabsf(hbk[cc]); }
              slab[2 * j] = hf; slab[2 * j + 1] = hbk; } }
#pragma unroll
        for (int cc = 0; cc < 4; ++cc) { const float s = wave_sum(asum[cc]); if (F.lane == 0) red[F.wave * 4 + cc] = s; }
        __syncthreads();
        if (F.tid < 4) { float s = 0.f; for (int w = 0; w < 8; ++w) s += red[w * 4 + F.tid]; nrm[F.tid] = 1.0f / (s + EPS); }
        __syncthreads();
        { bf16_t* img = (bf16_t*)F.shm;
          if (F.tid < 4) img[F.tid * 8192] = 0;
#pragma unroll 1
          for (int j = 0; j < 8; ++j) { const int i = 8 * F.tid + j; const f32x4 hf = slab[2 * j], hbk = slab[2 * j + 1];
#pragma unroll
              for (int cc = 0; cc < 4; ++cc) { const float inv = nrm[cc];
                  img[cc * 8192 + 4096 - i] = (bf16_t)f2bf(hf[cc] * inv);
                  if (i > 0) img[cc * 8192 + 4096 + i] = (bf16_t)f2bf(hbk[cc] * inv); } }
          __syncthreads();
          for (int q = F.tid; q < 4096; q += 512) *(u32x4*)(filtR + (size_t)c0 * 8192 + q * 8) = *(const u32x4*)(img + q * 8);
        }
        __syncthreads();
        float hc[8]; float cs4[4] = {0.f, 0.f, 0.f, 0.f};
        if (F.tid < 256) {
            const float* zr = zf + LS + F.tid;
#pragma unroll
            for (int q = 0; q < 8; ++q) hc[q] = 0.f;
            for (int k = 0; k < 64; ++k) { const float z = zr[(size_t)k * LT];
#pragma unroll
                for (int q = 0; q < 8; ++q) hc[q] += z * w3s[k * 8 + q]; }
            const float tt = (float)F.tid / 255.0f;
#pragma unroll
            for (int cc = 0; cc < 4; ++cc) { const float dec = fast_exp(-tt * delta[cc]); hc[cc] *= dec; hc[4 + cc] *= dec; cs4[cc] = fabsf(hc[cc]) + fabsf(hc[4 + cc]); }
        }
#pragma unroll
        for (int cc = 0; cc < 4; ++cc) { const float s = wave_sum(cs4[cc]); if (F.lane == 0) red[F.wave * 4 + cc] = s; }
        __syncthreads();
        if (F.tid < 4) { float s = 0.f; for (int w = 0; w < 8; ++w) s += red[w * 4 + F.tid]; nrm[F.tid] = 1.0f / (s + EPS); }
        __syncthreads();
        if (F.tid < 256) {
#pragma unroll
            for (int q = 0; q < 8; ++q) fctx[((size_t)(q >> 2) * 256 + F.tid) * 1024 + c0 + (q & 3)] = hc[q] * nrm[q & 3];
        }
    }
}

__device__ __forceinline__ int load_sov(Frame& F, int row) { return F.lane < 16 ? ((const int*)(F.ws + WS_SLOTOF))[(size_t)row * 16 + F.lane] : -1; }
__device__ __forceinline__ void combine_row(Frame& F, f32x4 (&v)[4], const int sov, const f32x4 (&m5q)[4]) {
    const bf16_t* ys = (const bf16_t*)(F.ws + WS_XG) + 4 * F.lane;
    unsigned mask = (unsigned)(__ballot(sov >= 0) & 0xffffull);
    f32x4 s[4];
#pragma unroll
    for (int j = 0; j < 4; ++j) s[j] = (f32x4){0.f, 0.f, 0.f, 0.f};
    while (mask) {
        const int e0 = __builtin_ctz(mask); mask &= mask - 1; const bool two = mask != 0u; int e1 = e0; if (two) { e1 = __builtin_ctz(mask); mask &= mask - 1; }
        const int s0 = __builtin_amdgcn_readlane(sov, e0), s1 = __builtin_amdgcn_readlane(sov, e1); const float w1 = two ? 1.f : 0.f;
        const bf16_t* y0 = ys + (size_t)s0 * 1024; const bf16_t* y1 = ys + (size_t)s1 * 1024;
        u32x2 a[4], b[4];
#pragma unroll
        for (int j = 0; j < 4; ++j) { a[j] = *(const u32x2*)(y0 + 256 * j); b[j] = *(const u32x2*)(y1 + 256 * j); }
#pragma unroll
        for (int j = 0; j < 4; ++j) { s[j][0] += bflo(a[j].x) + w1 * bflo(b[j].x); s[j][1] += bfhi(a[j].x) + w1 * bfhi(b[j].x); s[j][2] += bflo(a[j].y) + w1 * bflo(b[j].y); s[j][3] += bfhi(a[j].y) + w1 * bfhi(b[j].y); }
    }
#pragma unroll
    for (int j = 0; j < 4; ++j) v[j] += m5q[j] * s[j];
}
__device__ __forceinline__ void p1_norm1(Frame& F, const Args& a, int l) {
    const int gw = F.bid * NWAVES + F.wave, NGW = F.G * NWAVES;
    float* xres = (float*)(F.ws + WS_XRES); bf16_t* hb = (bf16_t*)(F.ws + WS_H);
    const float* mods = (const float*)(F.ws + WS_MODS);
    const float* g1 = a.in[I_N1G] + (size_t)l * 1024;
#define N1_SRC(row_) ((l == 0) ? (((row_) % LT) < LS ? a.in[I_X] + ((size_t)((row_) / LT) * LS + ((row_) % LT)) * 1024 : a.in[I_CTX] + ((size_t)((row_) / LT) * LC + (((row_) % LT) - LS)) * 1024) : xres + (size_t)(row_) * 1024)
    const int rpw = (TROWS + NGW - 1) / NGW, r0 = gw * rpw, r1 = r0 + rpw < TROWS ? r0 + rpw : TROWS;
    f32x4 gq[4], shq[4], sclq[4], m5q[4]; int mr_cur = -1;
#pragma unroll
    for (int j = 0; j < 4; ++j) { gq[j] = *(const f32x4*)(g1 + 4 * F.lane + 256 * j); m5q[j] = (f32x4){0.f, 0.f, 0.f, 0.f}; }
    f32x4 vn[4]; int sovn = -1;
    if (r0 < r1) { const float* src = N1_SRC(r0);
#pragma unroll
        for (int j = 0; j < 4; ++j) vn[j] = *(const f32x4*)(src + 4 * F.lane + 256 * j);
        if (l > 0) sovn = load_sov(F, r0); }
    for (int row = r0; row < r1; ++row) {
        const int b = row / LT, t = row - b * LT; const int mr = t < LS ? b : 8;
        if (mr != mr_cur) { mr_cur = mr; const float* mrow = mods + ((size_t)l * 9 + mr) * 6144;
#pragma unroll
            for (int j = 0; j < 4; ++j) { shq[j] = *(const f32x4*)(mrow + 4 * F.lane + 256 * j); sclq[j] = *(const f32x4*)(mrow + 1024 + 4 * F.lane + 256 * j) + 1.0f;
                if (l > 0) m5q[j] = *(const f32x4*)(mods + ((size_t)(l - 1) * 9 + mr) * 6144 + 5 * 1024 + 4 * F.lane + 256 * j); } }
        f32x4 v[4]; const int sov = sovn;
#pragma unroll
        for (int j = 0; j < 4; ++j) v[j] = vn[j];
        if (row + 1 < r1) { const float* src = N1_SRC(row + 1);
#pragma unroll
            for (int j = 0; j < 4; ++j) vn[j] = *(const f32x4*)(src + 4 * F.lane + 256 * j);
            if (l > 0) sovn = load_sov(F, row + 1); }
        if (l > 0) combine_row(F, v, sov, m5q);
        float ss = 0.f;
#pragma unroll
        for (int j = 0; j < 4; ++j) { if (!F.dry) *(f32x4*)(xres + (size_t)row * 1024 + 4 * F.lane + 256 * j) = v[j]; ss += (v[j][0] * v[j][0] + v[j][1] * v[j][1]) + (v[j][2] * v[j][2] + v[j][3] * v[j][3]); }
        const float rstd = 1.0f / sqrtf(wave_sum(ss) * (1.0f / 1024.0f) + EPS);
#pragma unroll
        for (int j = 0; j < 4; ++j) { const int c = 4 * F.lane + 256 * j;
            const f32x4 y = (v[j] * rstd * gq[j]) * sclq[j] + shq[j];
            u32x2 w; w.x = cvtpk(y[0], y[1]); w.y = cvtpk(y[2], y[3]); *(u32x2*)(hb + (size_t)row * 1024 + c) = w; }
    }
#undef N1_SRC
}
__device__ __forceinline__ void pf_final(Frame& F, const Args& a) {
    const int gw = F.bid * NWAVES + F.wave, NGW = F.G * NWAVES;
    const float* xres = (const float*)(F.ws + WS_XRES); const float* mods = (const float*)(F.ws + WS_MODS);
    const float* g = a.in[I_FINALG];
#define FN_ROW(r_) (((r_) / LS) * LT + ((r_) % LS))
    const int rpw = (NB * LS + NGW - 1) / NGW, r0 = gw * rpw, r1 = r0 + rpw < NB * LS ? r0 + rpw : NB * LS;
    f32x4 gq[4], m5q[4]; int b_cur = -1;
#pragma unroll
    for (int j = 0; j < 4; ++j) gq[j] = *(const f32x4*)(g + 4 * F.lane + 256 * j);
    f32x4 vn[4]; int sovn = -1;
    if (r0 < r1) { const int row = FN_ROW(r0);
#pragma unroll
        for (int j = 0; j < 4; ++j) vn[j] = *(const f32x4*)(xres + (size_t)row * 1024 + 4 * F.lane + 256 * j);
        sovn = load_sov(F, row); }
    for (int r = r0; r < r1; ++r) {
        const int b = r / LS;
        if (b != b_cur) { b_cur = b;
#pragma unroll
            for (int j = 0; j < 4; ++j) m5q[j] = *(const f32x4*)(mods + ((size_t)(DEPTH - 1) * 9 + b) * 6144 + 5 * 1024 + 4 * F.lane + 256 * j); }
        f32x4 v[4]; const int sov = sovn;
#pragma unroll
        for (int j = 0; j < 4; ++j) v[j] = vn[j];
        if (r + 1 < r1) { const int row = FN_ROW(r + 1);
#pragma unroll
            for (int j = 0; j < 4; ++j) vn[j] = *(const f32x4*)(xres + (size_t)row * 1024 + 4 * F.lane + 256 * j);
            sovn = load_sov(F, row); }
        combine_row(F, v, sov, m5q);
        float ss = 0.f;
#pragma unroll
        for (int j = 0; j < 4; ++j) ss += (v[j][0] * v[j][0] + v[j][1] * v[j][1]) + (v[j][2] * v[j][2] + v[j][3] * v[j][3]);
        const float rstd = 1.0f / sqrtf(wave_sum(ss) * (1.0f / 1024.0f) + EPS);
#pragma unroll
        for (int j = 0; j < 4; ++j) { const int c = 4 * F.lane + 256 * j; *(f32x4*)(a.out + (size_t)r * 1024 + c) = v[j] * rstd * gq[j]; }
    }
#undef FN_ROW
}
__device__ __forceinline__ void p3_rope(Frame& F) {
    float* cst = (float*)F.shm;
    float* snt = cst + 1024;
    for (int i = F.tid; i < 1024; i += 512) { const int pos = i >> 4, f = i & 15; const float inv = __builtin_amdgcn_exp2f(-(float)f * (13.287712379549449f / 16.0f));
        const float ang = (float)pos * inv, rev = ang * 0.15915494309189535f; cst[i] = cos_rev(rev); snt[i] = sin_rev(rev); }
    __syncthreads();
    bf16_t* dq = (bf16_t*)(F.ws + WS_DQ); bf16_t* dk = (bf16_t*)(F.ws + WS_DK); bf16_t* sq = (bf16_t*)(F.ws + WS_SQ); bf16_t* sk = (bf16_t*)(F.ws + WS_SK);
    const int gw = F.bid * NWAVES + F.wave, NGW = F.G * NWAVES;
    for (int row = gw; row < TROWS; row += NGW) {
        const int b = row / LT, t = row - b * LT; const bool lat = t < LS;
        for (int it = F.lane; it < 208; it += 64) {
            const int hs = it >> 2, ax = (it >> 1) & 1, fc = it & 1;
            bf16_t* base; float scl;
            if (hs < 16) { base = dq + (size_t)row * 1024 + hs * 64; scl = QSCALE; }
            else if (hs < 32) { base = dk + (size_t)row * 1024 + (hs - 16) * 64; scl = 1.f; }
            else if (hs < 48) { base = sq + (size_t)row * 1024 + (hs - 32) * 64; scl = QSCALE; }
            else { base = sk + (size_t)row * 256 + (hs - 48) * 64; scl = 1.f; }
            if (!lat && scl == 1.f) continue;
            bf16_t* p1 = base + ax * 32 + fc * 8; bf16_t* p2 = p1 + 16;
            const u32x4 a = *(const u32x4*)p1, c = *(const u32x4*)p2;
            float x1[8], x2[8];
#pragma unroll
            for (int j = 0; j < 4; ++j) { x1[2 * j] = bflo(a[j]); x1[2 * j + 1] = bfhi(a[j]); x2[2 * j] = bflo(c[j]); x2[2 * j + 1] = bfhi(c[j]); }
            float o1[8], o2[8];
            if (lat) { const int pos = ax == 0 ? (t >> 6) : (t & 63);
#pragma unroll
                for (int j = 0; j < 8; ++j) { const float cs = cst[pos * 16 + fc * 8 + j], sn = snt[pos * 16 + fc * 8 + j]; o1[j] = (x1[j] * cs - x2[j] * sn) * scl; o2[j] = (x2[j] * cs + x1[j] * sn) * scl; }
            } else {
#pragma unroll
                for (int j = 0; j < 8; ++j) { o1[j] = x1[j] * scl; o2[j] = x2[j] * scl; }
            }
            u32x4 w1, w2;
#pragma unroll
            for (int j = 0; j < 4; ++j) { w1[j] = cvtpk(o1[2 * j], o1[2 * j + 1]); w2[j] = cvtpk(o2[2 * j], o2[2 * j + 1]); }
            if (!F.dry) { *(u32x4*)p1 = w1; *(u32x4*)p2 = w2; }
        }
    }
}
struct PreTile { int b, t0, c0, Lseq, tbase; bool lat; };
__device__ __forceinline__ PreTile pre_tile(int tile) {
    constexpr int NT_L = NB * 64 * 16;
    PreTile T; T.lat = tile < NT_L;
    if (T.lat) { T.b = tile / 1024; const int r = tile % 1024; T.t0 = (r >> 4) * 64; T.c0 = (r & 15) * 64; T.Lseq = LS; T.tbase = 0; }
    else { const int q = tile - NT_L; T.b = q / 64; const int r = q % 64; T.t0 = (r >> 4) * 64; T.c0 = (r & 15) * 64; T.Lseq = LC; T.tbase = LS; }
    return T;
}
__device__ __forceinline__ void pre_load(const bf16_t* hyb, const PreTile& T, int tl, int cc, u32x4 (&x)[3][3]) {
    const int t = T.t0 + tl, c = T.c0 + cc; const size_t row = (size_t)T.b * LT + T.tbase + t;
#pragma unroll
    for (int g = 0; g < 3; ++g)
#pragma unroll
        for (int k = 0; k < 3; ++k) { const int ts = t + k - 1; x[g][k] = (u32x4){0u, 0u, 0u, 0u};
            if (ts >= 0 && ts < T.Lseq) x[g][k] = *(const u32x4*)(hyb + (row + k - 1) * 3072 + g * 1024 + c); }
}
__device__ __forceinline__ void p3_hyena_pre(Frame& F, const Args& a, int l) {
    const bf16_t* hyb = (const bf16_t*)(F.ws + WS_HY); bf16_t* x0c = (bf16_t*)(F.ws + WS_H); bf16_t* zT = (bf16_t*)(F.outb + OUT_ZT); bf16_t* zctx = (bf16_t*)(F.ws + WS_ZCTX);
    const float* cw = a.in[I_HCW] + (size_t)l * 3 * 3072; const float* cb = a.in[I_HCB] + (size_t)l * 3072;
    bf16_t* zt = (bf16_t*)(F.shm + 40960);
    constexpr int NTILES = NB * 64 * 16 + NB * 4 * 16;
    const int tl = F.tid >> 3, cc = (F.tid & 7) * 8;
    u32x4 xn[3][3];
    float wq[3][3][8], bq[3][8]; int cw_c = -1;
    if (F.bid < NTILES) { const PreTile T = pre_tile(F.bid); pre_load(hyb, T, tl, cc, xn); }
    for (int tile = F.bid; tile < NTILES; tile += F.G) {
        const PreTile T = pre_tile(tile);
        u32x4 x[3][3];
#pragma unroll
        for (int g = 0; g < 3; ++g)
#pragma unroll
            for (int k = 0; k < 3; ++k) x[g][k] = xn[g][k];
        if (tile + F.G < NTILES) { const PreTile Tn = pre_tile(tile + F.G); pre_load(hyb, Tn, tl, cc, xn); }
        const int t = T.t0 + tl, c = T.c0 + cc;
        const size_t row = (size_t)T.b * LT + T.tbase + t;
        if (c != cw_c) { cw_c = c;
#pragma unroll
            for (int g = 0; g < 3; ++g) { const int ch = g * 1024 + c;
                const f32x4 bb0 = *(const f32x4*)(cb + ch), bb1 = *(const f32x4*)(cb + ch + 4);
#pragma unroll
                for (int j = 0; j < 4; ++j) { bq[g][j] = bb0[j]; bq[g][4 + j] = bb1[j]; }
#pragma unroll
                for (int k = 0; k < 3; ++k) { const f32x4 w0 = *(const f32x4*)(cw + k * 3072 + ch), w1 = *(const f32x4*)(cw + k * 3072 + ch + 4);
#pragma unroll
                    for (int j = 0; j < 4; ++j) { wq[g][k][j] = w0[j]; wq[g][k][4 + j] = w1[j]; } } } }
        float u[3][8];
#pragma unroll
        for (int g = 0; g < 3; ++g) {
#pragma unroll
            for (int j = 0; j < 8; ++j) u[g][j] = bq[g][j];
#pragma unroll
            for (int k = 0; k < 3; ++k) { const u32x4 xv = x[g][k];
#pragma unroll
                for (int j = 0; j < 4; ++j) { u[g][2 * j] += bflo(xv[j]) * wq[g][k][2 * j]; u[g][2 * j + 1] += bfhi(xv[j]) * wq[g][k][2 * j + 1]; } }
        }
        u32x4 w;
#pragma unroll
        for (int j = 0; j < 4; ++j) w[j] = cvtpk(u[0][2 * j], u[0][2 * j + 1]);
        *(u32x4*)(x0c + row * 1024 + c) = w;
        float z[8];
#pragma unroll
        for (int j = 0; j < 8; ++j) z[j] = u[1][j] * u[2][j];
        if (!T.lat) {
#pragma unroll
            for (int j = 0; j < 4; ++j) w[j] = cvtpk(z[2 * j], z[2 * j + 1]);
            *(u32x4*)(zctx + ((size_t)T.b * LC + t) * 1024 + c) = w;
        } else {
            __syncthreads();
#pragma unroll
            for (int j = 0; j < 8; ++j) zt[(cc + j) * 72 + tl] = (bf16_t)f2bf(z[j]);
            __syncthreads();
            const int cr = F.tid >> 3, ch8 = (F.tid & 7) * 8;
            const u32x4 v = *(const u32x4*)(zt + cr * 72 + ch8);
            *(u32x4*)(zT + ((size_t)(T.c0 + cr) * NB + T.b) * LS + T.t0 + ch8) = v;
        }
    }
}
__device__ __forceinline__ void p5_hyena_post(Frame& F, const Args& a, int l) {
    const bf16_t* convT = (const bf16_t*)(F.ws + WS_CONVT); const bf16_t* zT = (const bf16_t*)(F.outb + OUT_ZT); const bf16_t* x0c = (const bf16_t*)(F.ws + WS_H); bf16_t* yhy = (bf16_t*)(F.ws + WS_YHY);
    const float* hb = a.in[I_HBIAS] + (size_t)l * 1024;
    float* tl_ = (float*)(F.shm + 49152);
    constexpr int NTILES = NB * 64 * 16;
    const int cr = F.tid >> 3, ch8 = (F.tid & 7) * 8, tl = F.tid >> 3, cc = (F.tid & 7) * 8;
#define P5_LOAD(tile_, cv_, zv_, xv_) do { const int b_ = (tile_) / 1024, r_ = (tile_) % 1024, t0_ = (r_ >> 4) * 64, c0_ = (r_ & 15) * 64; \
        const size_t off_ = ((size_t)(c0_ + cr) * NB + b_) * LS + t0_ + ch8; cv_ = *(const u32x4*)(convT + off_); zv_ = *(const u32x4*)(zT + off_); \
        xv_ = *(const u32x4*)(x0c + ((size_t)b_ * LT + t0_ + tl) * 1024 + c0_ + cc); } while (0)
    u32x4 cvn, zvn, xvn;
    if (F.bid < NTILES) P5_LOAD(F.bid, cvn, zvn, xvn);
    for (int tile = F.bid; tile < NTILES; tile += F.G) {
        const int b = tile / 1024, r = tile % 1024, t0 = (r >> 4) * 64, c0 = (r & 15) * 64;
        const u32x4 cv = cvn, zv = zvn, xv = xvn;
        if (tile + F.G < NTILES) P5_LOAD(tile + F.G, cvn, zvn, xvn);
        __syncthreads();
        { const float bias = hb[c0 + cr];
#pragma unroll
          for (int j = 0; j < 4; ++j) { tl_[cr * 65 + ch8 + 2 * j] = bflo(cv[j]) + bflo(zv[j]) * bias; tl_[cr * 65 + ch8 + 2 * j + 1] = bfhi(cv[j]) + bfhi(zv[j]) * bias; } }
        __syncthreads();
        const size_t row = (size_t)b * LT + t0 + tl;
        u32x4 w;
#pragma unroll
        for (int j = 0; j < 4; ++j) w[j] = cvtpk(bflo(xv[j]) * tl_[(cc + 2 * j) * 65 + tl], bfhi(xv[j]) * tl_[(cc + 2 * j + 1) * 65 + tl]);
        *(u32x4*)(yhy + row * 1024 + c0 + cc) = w;
    }
#undef P5_LOAD
}
__device__ __forceinline__ void p4_hyena_ctx(Frame& F, const Args& a, int l) {
    const bf16_t* zctx = (const bf16_t*)(F.ws + WS_ZCTX); const float* fctx = (const float*)(F.ws + WS_FCTX); const bf16_t* x0c = (const bf16_t*)(F.ws + WS_H); bf16_t* yhy = (bf16_t*)(F.ws + WS_YHY);
    const float* hb = a.in[I_HBIAS] + (size_t)l * 1024;
    float* g = (float*)F.shm;
    float* zs = g + 512 * 32;
    for (int it = F.bid; it < 256; it += F.G) {
        const int b = it >> 5, c0 = (it & 31) * 32, c = F.tid & 31, tg = F.tid >> 5, t0 = tg * 16;
        __syncthreads();
        for (int i = F.tid; i < 512 * 32; i += 512) { const int x = i >> 5, cc = i & 31, lag = x - 256;
            g[i] = x == 0 ? 0.f : (lag >= 0 ? fctx[(size_t)lag * 1024 + c0 + cc] : fctx[(size_t)(256 - lag) * 1024 + c0 + cc]); }
        for (int i = F.tid; i < 256 * 32; i += 512) { const int s = i >> 5, cc = i & 31; zs[i] = bf2f(zctx[((size_t)b * LC + s) * 1024 + c0 + cc]); }
        __syncthreads();
        float acc[16];
#pragma unroll
        for (int j = 0; j < 16; ++j) acc[j] = 0.f;
#pragma unroll 1
        for (int sb = 0; sb < 8; ++sb) { const int s0 = 32 * sb;
            float fw[47], zv[32];
#pragma unroll
            for (int k = 0; k < 47; ++k) fw[k] = g[(t0 - s0 + 225 + k) * 32 + c];
#pragma unroll
            for (int si = 0; si < 32; ++si) zv[si] = zs[(s0 + si) * 32 + c];
#pragma unroll
            for (int si = 0; si < 32; ++si)
#pragma unroll
                for (int j = 0; j < 16; ++j) acc[j] += fw[j - si + 31] * zv[si];
        }
        const float bias = hb[c0 + c];
#pragma unroll
        for (int j = 0; j < 16; ++j) { const size_t row = (size_t)b * LT + LS + t0 + j;
            yhy[row * 1024 + c0 + c] = (bf16_t)f2bf(bf2f(x0c[row * 1024 + c0 + c]) * (acc[j] + zs[(t0 + j) * 32 + c] * bias)); }
    }
}
__device__ __forceinline__ void p4_hyena_lat(Frame& F) {
    const bf16_t* zT = (const bf16_t*)(F.outb + OUT_ZT); const bf16_t* filtR = (const bf16_t*)(F.outb + OUT_FILT); bf16_t* convT = (bf16_t*)(F.ws + WS_CONVT);
    hy::conv_init(F.shm);
    for (int c = F.bid; c < 1024; c += F.G) hy::conv_channel(F.shm, zT + (size_t)c * NB * LS, filtR + (size_t)c * 8192, convT + (size_t)c * NB * LS);
    asm volatile("s_waitcnt lgkmcnt(0)\n\ts_barrier" ::: "memory");
}

__device__ __forceinline__ void diff_unit(Frame& F, const Args& a, int l, int b, int h, int qrow, bool isctx, float lam, float lam_init) {
    bf16_t* dq = (bf16_t*)(F.ws + WS_DQ); const bf16_t* dk = (const bf16_t*)(F.ws + WS_DK); const bf16_t* dv = (const bf16_t*)(F.ws + WS_DV);
    f32x4* stash = (f32x4*)(F.outb + OUT_STASH) + (size_t)F.bid * 16 * 512 + F.tid;
    const int lane = F.lane, r32 = lane & 31, hi = lane >> 5;
    const size_t brow = (size_t)b * LT;
    f32x16 o[4], lf;
#pragma unroll 1
    for (int m = 0; m < 2; ++m) {
        att::Pass P;
        P.Qw = dq + (brow + qrow + F.wave * 32) * 1024 + h * 128 + m * 64; P.ldq = 1024;
        P.Kb = dk + brow * 1024 + h * 128 + m * 64; P.ldk = 1024;
        P.Vb = dv + brow * 1024 + h * 128; P.ldv = 1024;
        if (isctx) { P.nA = 0; P.ks = 0; P.nC = 4; } else { P.nA = LT / 64; P.ks = 0; P.nC = 0; }
        P.band = 0; P.qpos = qrow + F.wave * 32; P.m0 = -INFINITY; P.l0 = 0.f; P.rope = isctx ? 0 : 1; P.rtab = (const LAS float*)(F.lds + ROPE_OFF);
        att::flash_pass<128>(F.shm, P, o, lf);
        att::normalize<128>(o, lf);
        if (m == 0) {
            unsigned long long spa = (unsigned long long)stash; asm volatile("" : "+v"(spa)); GAS f32x4* sp = (GAS f32x4*)spa;
#pragma unroll
            for (int d = 0; d < 4; ++d)
#pragma unroll
                for (int g = 0; g < 4; ++g) sp[(d * 4 + g) * 512] = (f32x4){o[d][4 * g], o[d][4 * g + 1], o[d][4 * g + 2], o[d][4 * g + 3]};
        }
    }
    float ss[16];
#pragma unroll
    for (int r = 0; r < 16; ++r) ss[r] = 0.f;
    { unsigned long long spa = (unsigned long long)stash; asm volatile("" : "+v"(spa)); const GAS f32x4* sp = (const GAS f32x4*)spa;
#pragma unroll
      for (int d = 0; d < 4; ++d)
#pragma unroll
        for (int g = 0; g < 4; ++g) { const f32x4 o0 = sp[(d * 4 + g) * 512];
#pragma unroll
            for (int j = 0; j < 4; ++j) { const float y = o0[j] - lam * o[d][4 * g + j]; o[d][4 * g + j] = y; ss[4 * g + j] += y * y; } } }
#pragma unroll
    for (int r = 0; r < 16; ++r) { float s = ss[r];
#pragma unroll
        for (int off = 1; off < 32; off <<= 1) s += __shfl_xor(s, off);
        ss[r] = 1.0f / sqrtf(s * (1.0f / 128.0f) + EPS) * (1.0f - lam_init); }
    const float* sg = a.in[I_SUBLN] + (size_t)l * 128;
    { int ln_ = threadIdx.x & 63; asm volatile("" : "+v"(ln_)); const int r32 = ln_ & 31, hi = ln_ >> 5, lane = ln_;
      LAS bf16_t* stg = (LAS bf16_t*)F.lds + F.wave * 4096;
#pragma unroll
      for (int d = 0; d < 4; ++d) { const float g = sg[32 * d + r32];
#pragma unroll
        for (int r = 0; r < 16; ++r) stg[att::crow(r, hi) * 128 + 32 * d + r32] = (bf16_t)f2bf(o[d][r] * ss[r] * g); }
      LDS_WAIT();
      unsigned long long yba = (unsigned long long)(dq + (brow + qrow + F.wave * 32) * 1024 + h * 128); asm volatile("" : "+v"(yba)); GAS bf16_t* yb = (GAS bf16_t*)yba;
#pragma unroll
      for (int i = 0; i < 8; ++i) { const int row = i * 4 + (lane >> 4), ch = lane & 15; const u32x4 v = *(const LAS u32x4*)(stg + row * 128 + ch * 8); if (!F.dry) *(GAS u32x4*)(yb + row * 1024 + ch * 8) = v; }
      asm volatile("s_waitcnt lgkmcnt(0)\n\ts_barrier" ::: "memory"); }
}
__device__ __forceinline__ void p4_diff(Frame& F, const Args& a, int l, bool ctx_out) {
    const float* lp = a.in[I_DLAM] + (size_t)l * 256;
    const float d01 = wave_sum(lp[F.lane] * lp[64 + F.lane]), d23 = wave_sum(lp[128 + F.lane] * lp[192 + F.lane]);
    const float lam_init = 0.8f - 0.6f * expf(-0.3f * (float)l);
    const float lam = __uint_as_float(__builtin_amdgcn_readfirstlane(__float_as_uint(expf(d01) - expf(d23) + lam_init)));
    const int nun = NB * 8 * 16 + (ctx_out ? NB * 8 : 0);
    const int vcu = (F.G % 8 == 0) ? (F.bid % 8) * (F.G / 8) + F.bid / 8 : F.bid;
    for (int u = vcu; u < nun; u += F.G) {
        if (u < NB * 8 * 16) { const int b = u >> 7, h = (u >> 4) & 7, qb = u & 15; diff_unit(F, a, l, b, h, qb * 256, false, lam, lam_init); }
        else { const int v = u - NB * 8 * 16; diff_unit(F, a, l, v >> 3, v & 7, LS, true, lam, lam_init); }
    }
}
__device__ __forceinline__ void swa_unit(Frame& F, const Args& a, int l, int b, int kvh, int qrow, bool isctx) {
    bf16_t* sq = (bf16_t*)(F.ws + WS_SQ); const bf16_t* sk = (const bf16_t*)(F.ws + WS_SK); const bf16_t* sv = (const bf16_t*)(F.ws + WS_SV);
    const int lane = F.lane, r32 = lane & 31, hi = lane >> 5; const size_t brow = (size_t)b * LT; const int qh = kvh * 4 + (F.wave & 3), rh = F.wave >> 2;
    att::Pass P;
    P.Qw = sq + (brow + qrow + rh * 32) * 1024 + qh * 64; P.ldq = 1024;
    P.Kb = sk + brow * 256 + kvh * 64; P.ldk = 256; P.Vb = sv + brow * 256 + kvh * 64; P.ldv = 256;
    if (isctx) { P.nA = 0; P.ks = 0; P.nC = 4; P.band = 0; }
    else { const int ks = qrow >= 128 ? qrow - 128 : 0, ke = qrow + 192 <= LS ? qrow + 192 : LS; P.ks = ks; P.nA = (ke - ks) >> 6; P.nC = 4; P.band = 1; }
    P.qpos = (isctx ? 0 : qrow) + rh * 32; P.m0 = a.in[I_SINK][l * 16 + qh] * LOG2E; P.l0 = 1.0f; P.rope = isctx ? 0 : 1; P.rtab = (const LAS float*)(F.lds + ROPE_OFF);
    f32x16 o[2], lf;
    att::flash_pass<64>(F.shm, P, o, lf);
    att::normalize<64>(o, lf);
    { int ln_ = threadIdx.x & 63; asm volatile("" : "+v"(ln_)); const int r32 = ln_ & 31, hi = ln_ >> 5, lane = ln_;
      LAS bf16_t* stg = (LAS bf16_t*)F.lds + F.wave * 2048;
#pragma unroll
      for (int d = 0; d < 2; ++d)
#pragma unroll
        for (int r = 0; r < 16; ++r) stg[att::crow(r, hi) * 64 + 32 * d + r32] = (bf16_t)f2bf(o[d][r]);
      LDS_WAIT();
      unsigned long long yba = (unsigned long long)(sq + (brow + qrow + rh * 32) * 1024 + qh * 64); asm volatile("" : "+v"(yba)); GAS bf16_t* yb = (GAS bf16_t*)yba;
#pragma unroll
      for (int i = 0; i < 4; ++i) { const int row = i * 8 + (lane >> 3), ch = lane & 7; const u32x4 v = *(const LAS u32x4*)(stg + row * 64 + ch * 8); if (!F.dry) *(GAS u32x4*)(yb + row * 1024 + ch * 8) = v; }
      asm volatile("s_waitcnt lgkmcnt(0)\n\ts_barrier" ::: "memory"); }
}
__device__ __forceinline__ void p4_swa(Frame& F, const Args& a, int l, bool ctx_out) {
    const int nun = NB * 4 * 64 + (ctx_out ? NB * 4 * 4 : 0);
    const int vcu0 = (F.G % 8 == 0) ? (F.bid % 8) * (F.G / 8) + F.bid / 8 : F.bid;
    const int vcu = F.G - 1 - vcu0;
    for (int u = vcu; u < nun; u += F.G) {
        if (u < NB * 4 * 64) { const int b = u >> 8, kvh = (u >> 6) & 3, qb = u & 63; swa_unit(F, a, l, b, kvh, qb * 64, false); }
        else { const int v = u - NB * 4 * 64; swa_unit(F, a, l, v >> 4, (v >> 2) & 3, LS + (v & 3) * 64, true); }
    }
}
__device__ __forceinline__ void p8_norm2_router(Frame& F, const Args& a, int l) {
    float* rwT = (float*)F.shm;
    const float* rw = a.in[I_ROUTER] + (size_t)l * 1024 * 16;
    for (int i = F.tid; i < 16384; i += 512) { const int k = i >> 4, e = i & 15; rwT[e * 1024 + k] = rw[i]; }
    __syncthreads();
    const int gw = F.bid * NWAVES + F.wave, NGW = F.G * NWAVES;
    const float* xres = (const float*)(F.ws + WS_XRES); bf16_t* hb = (bf16_t*)(F.ws + WS_H); float* aff = (float*)(F.ws + WS_AFF);
    const float* mods = (const float*)(F.ws + WS_MODS); const float* g2 = a.in[I_N2G] + (size_t)l * 1024;
    constexpr int RPW = (TROWS + 2047) / 2048;
    const int rpw = (TROWS + NGW - 1) / NGW, r0 = gw * rpw, r1 = r0 + rpw < TROWS ? r0 + rpw : TROWS; (void)RPW;
    f32x4 gq[4], shq[4], sclq[4]; int mr_cur = -1;
#pragma unroll
    for (int j = 0; j < 4; ++j) gq[j] = *(const f32x4*)(g2 + 4 * F.lane + 256 * j);
    f32x4 vn[4];
    if (r0 < r1) {
#pragma unroll
        for (int j = 0; j < 4; ++j) vn[j] = *(const f32x4*)(xres + (size_t)r0 * 1024 + 4 * F.lane + 256 * j); }
    for (int row = r0; row < r1; ++row) {
        asm volatile("" ::: "memory");
        const int b = row / LT, t = row - b * LT; const int mr = t < LS ? b : 8;
        if (mr != mr_cur) { mr_cur = mr; const float* mrow = mods + ((size_t)l * 9 + mr) * 6144;
#pragma unroll
            for (int j = 0; j < 4; ++j) { shq[j] = *(const f32x4*)(mrow + 3 * 1024 + 4 * F.lane + 256 * j); sclq[j] = *(const f32x4*)(mrow + 4 * 1024 + 4 * F.lane + 256 * j) + 1.0f; } }
        f32x4 v[4]; float ss = 0.f;
#pragma unroll
        for (int j = 0; j < 4; ++j) { v[j] = vn[j]; ss += (v[j][0] * v[j][0] + v[j][1] * v[j][1]) + (v[j][2] * v[j][2] + v[j][3] * v[j][3]); }
        if (row + 1 < r1) {
#pragma unroll
            for (int j = 0; j < 4; ++j) vn[j] = *(const f32x4*)(xres + (size_t)(row + 1) * 1024 + 4 * F.lane + 256 * j); }
        const float rstd = 1.0f / sqrtf(wave_sum(ss) * (1.0f / 1024.0f) + EPS);
#pragma unroll
        for (int j = 0; j < 4; ++j) { const int c = 4 * F.lane + 256 * j;
            v[j] = (v[j] * rstd * gq[j]) * sclq[j] + shq[j];
            u32x2 w; w.x = cvtpk(v[j][0], v[j][1]); w.y = cvtpk(v[j][2], v[j][3]); *(u32x2*)(hb + (size_t)row * 1024 + c) = w; }
        float lg[16];
#pragma unroll
        for (int e = 0; e < 16; ++e) { float s = 0.f;
#pragma unroll
            for (int j = 0; j < 4; ++j) { const f32x4 w = *(const f32x4*)(rwT + e * 1024 + 4 * F.lane + 256 * j); s += (v[j][0] * w[0] + v[j][1] * w[1]) + (v[j][2] * w[2] + v[j][3] * w[3]); }
            lg[e] = wave_sum(s); }
        float mx = lg[0];
#pragma unroll
        for (int e = 1; e < 16; ++e) mx = fmaxf(mx, lg[e]);
        float den = 0.f;
#pragma unroll
        for (int e = 0; e < 16; ++e) { lg[e] = __expf(lg[e] - mx); den += lg[e]; }
        const float inv = 1.0f / den;
        float mine = 0.f;
#pragma unroll
        for (int e = 0; e < 16; ++e) mine = (F.lane == e) ? lg[e] * inv : mine;
        if (F.lane < 16) aff[(size_t)row * 16 + F.lane] = mine;
    }
}
__device__ __forceinline__ void p9_topk_gather(Frame& F) {
    unsigned* hist = (unsigned*)F.shm;
    unsigned* sh = hist + 256;
    int* rowlist = (int*)(sh + 32);
    const float* aff = (const float*)(F.ws + WS_AFF); int* slotof = (int*)(F.ws + WS_SLOTOF); float* gate = (float*)(F.ws + WS_GATE);
    const bf16_t* hb = (const bf16_t*)(F.ws + WS_H); bf16_t* xg = (bf16_t*)(F.ws + WS_XG);
    for (int item = F.bid; item < 256; item += F.G) {
        const int q = item >> 1, part = item & 1, b = q >> 4, e = q & 15;
#pragma unroll 1
        for (int cx = 0; cx < 2; ++cx) {
            const bool isctx = cx == 1;
            const int N = isctx ? LC : LS, cap = N / 8, per = isctx ? 1 : 8;
            const int rbase = b * LT + (isctx ? LS : 0);
            const bool act = isctx ? (F.tid < 256) : true;
            unsigned key[8];
#pragma unroll
            for (int j = 0; j < 8; ++j) { key[j] = 0u; if (act && j < per) key[j] = __float_as_uint(aff[(size_t)(rbase + F.tid * per + j) * 16 + e]); }
            unsigned prefix = 0u, krem = (unsigned)cap;
#pragma unroll 1
            for (int pass = 3; pass >= 0; --pass) {
                const int shft = pass * 8; const unsigned himask = pass == 3 ? 0u : (0xffffffffu << (shft + 8));
                __syncthreads();
                if (F.tid < 256) hist[F.tid] = 0u;
                __syncthreads();
#pragma unroll
                for (int j = 0; j < 8; ++j) if (act && j < per && (key[j] & himask) == prefix) atomicAdd(&hist[(key[j] >> shft) & 255u], 1u);
                __syncthreads();
                if (F.wave == 0) {
                    const unsigned h0 = hist[4 * F.lane], h1 = hist[4 * F.lane + 1], h2 = hist[4 * F.lane + 2], h3 = hist[4 * F.lane + 3];
                    const unsigned own = h0 + h1 + h2 + h3; unsigned inc = own;
#pragma unroll
                    for (int off = 1; off < 64; off <<= 1) { const unsigned o = __shfl_down(inc, off); if (F.lane + off < 64) inc += o; }
                    const unsigned S = inc - own;
                    if (S < krem && krem <= S + own) {
                        unsigned cum = S; int bin;
                        if (cum + h3 >= krem) bin = 3; else { cum += h3; if (cum + h2 >= krem) bin = 2; else { cum += h2; if (cum + h1 >= krem) bin = 1; else { cum += h1; bin = 0; } } }
                        sh[0] = prefix | ((unsigned)(4 * F.lane + bin) << shft); sh[1] = krem - cum;
                    }
                }
                __syncthreads();
                prefix = sh[0]; krem = sh[1];
            }
            unsigned cg = 0u, ce = 0u;
#pragma unroll
            for (int j = 0; j < 8; ++j) if (act && j < per) { cg += key[j] > prefix ? 1u : 0u; ce += key[j] == prefix ? 1u : 0u; }
            unsigned pk = cg | (ce << 16), inc = pk;
#pragma unroll
            for (int off = 1; off < 64; off <<= 1) { const unsigned o = __shfl_up(inc, off); if (F.lane >= off) inc += o; }
            __syncthreads();
            if (F.lane == 63) sh[16 + F.wave] = inc;
            __syncthreads();
            unsigned base = 0u;
            for (int w = 0; w < F.wave; ++w) base += sh[16 + w];
            unsigned ex = base + inc - pk; unsigned gb = ex & 0xffffu, eb = ex >> 16;
            const int sbase = isctx ? SLOT_L + (e * NB + b) * CAP_C : (e * NB + b) * CAP_L;
#pragma unroll
            for (int j = 0; j < 8; ++j) if (act && j < per) {
                const int row = rbase + F.tid * per + j; int slot = -1;
                if (key[j] > prefix) { slot = (int)(gb + (eb < krem ? eb : krem)); gb++; }
                else if (key[j] == prefix) { if (eb < krem) slot = (int)(gb + eb); eb++; }
                if (slot >= 0) { rowlist[slot] = row; if (part == 0) gate[sbase + slot] = __uint_as_float(key[j]); slot += sbase; }
                if (part == 0) slotof[(size_t)row * 16 + e] = slot;
            }
            __syncthreads();
            const int hcap = cap >> 1;
            for (int s0 = part * hcap + 4 * F.wave; s0 < (part + 1) * hcap; s0 += 4 * NWAVES) {
                u32x4 d[4][2];
#pragma unroll
                for (int i = 0; i < 4; ++i) { const u32x4* src = (const u32x4*)(hb + (size_t)rowlist[s0 + i] * 1024) + F.lane; d[i][0] = src[0]; d[i][1] = src[64]; }
#pragma unroll
                for (int i = 0; i < 4; ++i) { u32x4* dst = (u32x4*)(xg + (size_t)(sbase + s0 + i) * 1024) + F.lane; dst[0] = d[i][0]; dst[64] = d[i][1]; }
            }
        }
    }
}
constexpr int PPL = 12;
constexpr int NPHASE = 1 + DEPTH * PPL + 1;

__device__ __forceinline__ void phase_stagger(int nunits, int G, int c, int unit_ticks) {
#ifndef MK_NOSTAGGER
    const int rem = nunits % G;
    if (rem == 0 || c < rem) return;
    const int g = ((c - rem) >> 3) % 3 + 1;
    const unsigned long long t0 = __builtin_amdgcn_s_memrealtime(); const unsigned long long d = (unsigned long long)(g * unit_ticks / 4);
    while (__builtin_amdgcn_s_memrealtime() - t0 < d) __builtin_amdgcn_s_sleep(8);
#endif
}

__global__ void __launch_bounds__(NWAVES * 64, 2) mk_fwd(Args args) {
    extern __shared__ __attribute__((aligned(16))) unsigned char lds[];
    Frame F;
    F.lds = (LAS unsigned char*)lds; F.shm = (char*)lds;
    F.tid = threadIdx.x; F.lane = F.tid & 63; F.wave = __builtin_amdgcn_readfirstlane(F.tid >> 6);
    F.G = gridDim.x; F.bid = blockIdx.x; F.ws = args.ws; F.outb = (unsigned char*)args.out; F.dry = 0;
    volatile LAS unsigned* MISC = (volatile LAS unsigned*)(F.lds + MISC_OFF);
    for (int u = F.tid; u < (LDS_BYTES - LDSCTL_OFF) / 4; u += NWAVES * 64) ((LAS unsigned*)(F.lds + LDSCTL_OFF))[u] = 0u;
    __syncthreads();
    { LAS float* rt_ = (LAS float*)(F.lds + ROPE_OFF);
      for (int i = F.tid; i < 1024; i += NWAVES * 64) { const int pos = i >> 4, f = i & 15; const float inv = __builtin_amdgcn_exp2f(-(float)f * (13.287712379549449f / 16.0f));
          const float rev = (float)pos * inv * 0.15915494309189535f; rt_[i] = cos_rev(rev); rt_[1024 + i] = sin_rev(rev); } }
    __syncthreads();
    unsigned* ctl = (unsigned*)(F.ws + WS_CTL);
    const int lo = args.ph_lo, hi = args.ph_hi;
    XcdBarrier bar; bar.bar = ctl + CW_BAR; bar.x = 0; bar.st = nullptr;
    if (hi - lo > 1) bar = xcd_barrier_post(ctl + CW_BAR, MISC + 8);
#ifdef MK_ONLY
#define PHON(j) ((j) == MK_ONLY)
#else
#define PHON(j) true
#endif
#define IN(k) (lo <= (k) && (k) < hi)
#ifndef MK_DUP
#define MK_DUP 0
#endif
#define NREP(bit) (((MK_DUP >> (bit)) & 1) ? 2 : 1)
#define REP(bit) _Pragma("unroll 1") for (int rep = 0; rep < NREP(bit); ++rep)
#define REPEND(bit) do { if (rep + 1 < NREP(bit)) xcd_barrier(bar); } while (0)
#define DRY(bit) (rep + 1 < NREP(bit))
#define LOCALF Frame Fp = F; Fp.tid = threadIdx.x; asm volatile("" : "+v"(Fp.tid)); Fp.lane = Fp.tid & 63
#define SEAM(k) do { if (IN((k) + 1)) xcd_barrier(bar); } while (0)
#define STAMP(k) do { } while (0)

    if (PHON(100) && IN(0)) { STAMP(0); REP(12) { LOCALF; p0_mods_zfeat(Fp, args); REPEND(12); } SEAM(0); }

    for (int l = 0; l < DEPTH; ++l) {
        const int pb = 1 + l * PPL;
        const float* mods_l = (const float*)(F.ws + WS_MODS) + (size_t)l * 9 * 6144;
        const int lastl = l == DEPTH - 1;
        if (PHON(0) && IN(pb + 0)) { STAMP(pb + 0);
#ifndef MK_SUB0
#define MK_SUB0 7
#endif
            REP(0) { LOCALF; Fp.dry = DRY(0);
            if (MK_SUB0 & 1) { p1_weights(Fp, args, l); __syncthreads(); }
            if (MK_SUB0 & 2) { p1_filters(Fp, args, l); __syncthreads(); }
            if (MK_SUB0 & 4) { p1_norm1(Fp, args, l); }
            REPEND(0); }
            SEAM(pb + 0); }
        if (PHON(1) && IN(pb + 1)) { STAMP(pb + 1);
            pg8::SchedPlain S; S.init((const bf16_t*)(F.ws + WS_H), (const bf16_t*)(F.ws + WS_WIN), TROWS, DIN, 1024, F.G, F.bid);
            pg8::EpiProj E; E.ws = F.ws; E.rope = (const LAS float*)(F.lds + ROPE_OFF);
            REP(1) { E.dry = DRY(1); pg8::gemm_phase<pg8::EpiProj, pg8::SchedPlain>(F.lds, 1024, S, E); REPEND(1); }
            SEAM(pb + 1);
        }
        if (PHON(2) && IN(pb + 2)) { STAMP(pb + 2); REP(2) { LOCALF; Fp.dry = DRY(2); p3_hyena_pre(Fp, args, l); REPEND(2); } SEAM(pb + 2); }
        if (PHON(3) && IN(pb + 3)) { STAMP(pb + 3);
#ifndef MK_SUB
#define MK_SUB 15
#endif
            if (MK_SUB & 1) { REP(3) { LOCALF; Fp.dry = DRY(3); p4_diff(Fp, args, l, !lastl); __syncthreads(); REPEND(3); } }
            if (MK_SUB & 2) { REP(4) { LOCALF; Fp.dry = DRY(4); p4_swa(Fp, args, l, !lastl); __syncthreads(); REPEND(4); } }
            REP(5) { if (MK_SUB & 4) { LOCALF; p4_hyena_lat(Fp); __syncthreads(); }
            if ((MK_SUB & 8) && !lastl) { LOCALF; p4_hyena_ctx(Fp, args, l); } REPEND(5); }
            SEAM(pb + 3); }
        if (PHON(4) && IN(pb + 4)) { STAMP(pb + 4); REP(6) { LOCALF; p5_hyena_post(Fp, args, l); REPEND(6); } SEAM(pb + 4); }
        if (PHON(5) && IN(pb + 5)) { STAMP(pb + 5);
            pg8::SchedBranch S; S.latonly = lastl; S.T.init(lastl ? NB * 16 : TROWS / 256, 4); S.G = F.G; S.c = F.bid; S.ws = (const char*)F.ws;
            S.B = (const char*)(F.ws + WS_WBR); S.tstep = (size_t)256 * 1024 * 2; S.bstep = (size_t)1024 * 1024 * 2;
            pg8::EpiBranch E; E.ws = F.ws; static_assert(WS_MERGED == OFF_DK && WS_GT == OFF_GT, "branch epilogue offsets");
            REP(7) { pg8::gemm_phase<pg8::EpiBranch, pg8::SchedBranch>(F.lds, 1024, S, E); REPEND(7); }
            SEAM(pb + 5);
        }
        if (PHON(6) && IN(pb + 6)) { STAMP(pb + 6);
            pg8::SchedPlain S; S.init((const bf16_t*)(F.ws + WS_MERGED), (const bf16_t*)(F.ws + WS_WOUT), TROWS, 1024, 1024, F.G, F.bid, lastl);
            pg8::EpiResid E; E.xres = (float*)(F.ws + WS_XRES); E.mod = mods_l;
            REP(8) { E.dry = DRY(8); pg8::gemm_phase<pg8::EpiResid, pg8::SchedPlain>(F.lds, 1024, S, E); REPEND(8); }
            SEAM(pb + 6);
        }
        if (PHON(7) && IN(pb + 7)) { STAMP(pb + 7); REP(9) { LOCALF; p8_norm2_router(Fp, args, l); REPEND(9); } SEAM(pb + 7); }
        if (PHON(8) && IN(pb + 8)) { STAMP(pb + 8); REP(14) { LOCALF; p9_topk_gather(Fp); REPEND(14); } SEAM(pb + 8); }
        if (PHON(9) && IN(pb + 9)) { STAMP(pb + 9); }
        if (PHON(10) && IN(pb + 10)) { STAMP(pb + 10);
            pg8::SchedMoe S; S.T.init(lastl ? SLOT_L / 256 : SLOTS / 256, 8); S.G = F.G; S.c = F.bid; S.A = (const char*)(F.ws + WS_XG); S.B = (const char*)(F.ws + WS_W13); S.tstep = (size_t)256 * 1024 * 2; S.estep = (size_t)2048 * 1024 * 2;
            pg8::EpiSwiglu E; E.hid = (bf16_t*)(F.ws + WS_HID);
            REP(10) { pg8::gemm_phase<pg8::EpiSwiglu, pg8::SchedMoe>(F.lds, 1024, S, E); REPEND(10); }
            SEAM(pb + 10);
        }
        if (PHON(11) && IN(pb + 11)) { STAMP(pb + 11);
            pg8::SchedMoe S; S.T.init(lastl ? SLOT_L / 256 : SLOTS / 256, 4); S.G = F.G; S.c = F.bid; S.A = (const char*)(F.ws + WS_HID); S.B = (const char*)(F.ws + WS_W2); S.tstep = (size_t)256 * 1024 * 2; S.estep = (size_t)1024 * 1024 * 2;
            pg8::EpiRowScale E; E.out = (bf16_t*)(F.ws + WS_XG); E.gate = (const float*)(F.ws + WS_GATE);
            REP(11) { pg8::gemm_phase<pg8::EpiRowScale, pg8::SchedMoe>(F.lds, 1024, S, E); REPEND(11); }
            SEAM(pb + 11);
        }
    }
    if (PHON(101) && IN(NPHASE - 1)) { STAMP(NPHASE - 1); REP(13) { LOCALF; pf_final(Fp, args); REPEND(13); }
    }
#undef IN
#undef SEAM
}

extern "C" void kernel_launch(void* const* d_in, const int* in_sizes, int n_in, void* d_out, int out_size, void* d_ws, size_t ws_size, hipStream_t stream) {
    static int grid = 0;
    if (grid == 0) {
        if (n_in != 28 || out_size != NB * LS * D || ws_size < WS_TOTAL) { fprintf(stderr, "kernel_launch: unexpected shapes (n_in %d out %d ws %zu need %zu)\n", n_in, out_size, ws_size, (size_t)WS_TOTAL); grid = -1; return; }
        int dev = 0, cus = 0, per_cu = 0;
        if (hipGetDevice(&dev) != hipSuccess || hipDeviceGetAttribute(&cus, hipDeviceAttributeMultiprocessorCount, dev) != hipSuccess) { grid = -1; return; }
        if (hipFuncSetAttribute((const void*)mk_fwd, hipFuncAttributeMaxDynamicSharedMemorySize, LDS_BYTES) != hipSuccess) { fprintf(stderr, "kernel_launch: hipFuncSetAttribute failed\n"); grid = -1; return; }
        if (hipOccupancyMaxActiveBlocksPerMultiprocessor(&per_cu, (const void*)mk_fwd, NWAVES * 64, LDS_BYTES) != hipSuccess || per_cu < 1) { fprintf(stderr, "kernel_launch: occupancy query says %d\n", per_cu); }
        (void)hipGetLastError();
        grid = cus;
    }
    if (grid < 0) return;
    if (hipMemsetAsync((char*)d_ws + WS_CTL, 0, CTL_ZERO_BYTES, stream) != hipSuccess) return;
    Args a{};
    for (int i = 0; i < 28; ++i) a.in[i] = (const float*)d_in[i];
    a.out = (float*)d_out; a.ws = (unsigned char*)d_ws;
#if MK_N_LAUNCHES == 1
    a.ph_lo = 0; a.ph_hi = NPHASE;
    hipLaunchKernelGGL(mk_fwd, dim3(grid), dim3(NWAVES * 64), LDS_BYTES, stream, a);
#else
    for (int p = 0; p < NPHASE; ++p) { a.ph_lo = p; a.ph_hi = p + 1; hipLaunchKernelGGL(mk_fwd, dim3(grid), dim3(NWAVES * 64), LDS_BYTES, stream, a); }
#endif
}
```

```cpp
#include <hip/hip_runtime.h>
#include <cstdio>
#include <cstdint>
#include <type_traits>

#ifndef MK_N_LAUNCHES
#define MK_N_LAUNCHES 1
#endif

#define LAS __attribute__((address_space(3)))
#define GAS __attribute__((address_space(1)))
typedef unsigned short bf16_t;
typedef short bf16x8 __attribute__((ext_vector_type(8)));
typedef short s16x4 __attribute__((ext_vector_type(4)));
typedef float f32x2 __attribute__((ext_vector_type(2)));
typedef float f32x4 __attribute__((ext_vector_type(4)));
typedef float f32x16 __attribute__((ext_vector_type(16)));
typedef unsigned u32x2 __attribute__((ext_vector_type(2)));
typedef unsigned u32x4 __attribute__((ext_vector_type(4)));
typedef GAS unsigned gu32;
#define RLX_AGENT __ATOMIC_RELAXED, __HIP_MEMORY_SCOPE_AGENT
#define LDS_WAIT() asm volatile("s_waitcnt lgkmcnt(0)" ::: "memory")
#define VM_WAIT() asm volatile("s_waitcnt vmcnt(0)" ::: "memory")

constexpr int NB = 8, LS = 4096, LC = 256, LT = LS + LC;
constexpr int TROWS = NB * LT;
constexpr int D = 1024, DIN = 10752, DEPTH = 4, NEXP = 16;
constexpr int CAP_L = 512, CAP_C = 32;
constexpr int SLOT_L = NEXP * NB * CAP_L, SLOT_C = NEXP * NB * CAP_C, SLOTS = SLOT_L + SLOT_C;
constexpr float EPS = 1e-6f;
constexpr float LOG2E = 1.4426950408889634f;
constexpr float QSCALE = 0.125f * LOG2E;

__device__ __forceinline__ unsigned f2bf(float f) { unsigned u = __builtin_bit_cast(unsigned, f); return (u + 0x7fffu + ((u >> 16) & 1u)) >> 16; }
__device__ __forceinline__ unsigned pk2(float lo, float hi) { return f2bf(lo) | (f2bf(hi) << 16); }
__device__ __forceinline__ float bf2f(unsigned v) { return __builtin_bit_cast(float, v << 16); }
__device__ __forceinline__ float bflo(unsigned w) { return __builtin_bit_cast(float, w << 16); }
__device__ __forceinline__ float bfhi(unsigned w) { return __builtin_bit_cast(float, w & 0xffff0000u); }
typedef __bf16 bf16x2_t __attribute__((ext_vector_type(2)));
__device__ __forceinline__ unsigned cvtpk(float lo, float hi) { f32x2 v = {lo, hi}; bf16x2_t b = __builtin_convertvector(v, bf16x2_t); return __builtin_bit_cast(unsigned, b); }
__device__ __forceinline__ float wave_sum(float v) {
    v += __builtin_bit_cast(float, __builtin_amdgcn_update_dpp(0, __builtin_bit_cast(int, v), 0x128, 0xf, 0xf, false));
    v += __builtin_bit_cast(float, __builtin_amdgcn_update_dpp(0, __builtin_bit_cast(int, v), 0x124, 0xf, 0xf, false));
    v += __builtin_bit_cast(float, __builtin_amdgcn_update_dpp(0, __builtin_bit_cast(int, v), 0x122, 0xf, 0xf, false));
    v += __builtin_bit_cast(float, __builtin_amdgcn_update_dpp(0, __builtin_bit_cast(int, v), 0x121, 0xf, 0xf, false));
    { const auto r = __builtin_amdgcn_permlane16_swap(__float_as_uint(v), __float_as_uint(v), false, false); v = __uint_as_float(r[0]) + __uint_as_float(r[1]); }
    { const auto r = __builtin_amdgcn_permlane32_swap(__float_as_uint(v), __float_as_uint(v), false, false); v = __uint_as_float(r[0]) + __uint_as_float(r[1]); }
    return v;
}
__device__ __forceinline__ float sin_rev(float rev) { return __builtin_amdgcn_sinf(__builtin_amdgcn_fractf(rev)); }
__device__ __forceinline__ float cos_rev(float rev) { return __builtin_amdgcn_cosf(__builtin_amdgcn_fractf(rev)); }
__device__ __forceinline__ float sin_rad(float x) { return sin_rev(x * 0.15915494309189535f); }
__device__ __forceinline__ float fast_exp(float x) { return __builtin_amdgcn_exp2f(x * LOG2E); }
__device__ __forceinline__ float sigmoidf_(float x) { return __builtin_amdgcn_rcpf(1.0f + fast_exp(-x)); }

constexpr size_t SZ1K = (size_t)TROWS * 1024 * 2;
constexpr size_t OFF_PROJ = (size_t)353 << 20;
constexpr size_t OFF_DQ = OFF_PROJ, OFF_DK = OFF_DQ + SZ1K, OFF_DV = OFF_DK + SZ1K, OFF_HY = OFF_DV + SZ1K, OFF_SQ = OFF_HY + 3 * SZ1K, OFF_SK = OFF_SQ + SZ1K, OFF_SV = OFF_SK + SZ1K / 4, OFF_GT = OFF_SV + SZ1K / 4;
constexpr size_t OFF_YHY = OFF_HY + ((size_t)64 << 20);

namespace pg8 {
constexpr int BM = 256, BK = 64, HALF = 128, HTB = HALF * BK * 2, STAGE_BYTES = 8 * HTB, NXCD = 8, WGM = 8;
__host__ __device__ __forceinline__ int lds_byte(int r, int c) { const int st = (r >> 4) * 2 + (c >> 5), rr = r & 15, cc = c & 31, ob = rr * 64 + cc * 2; return st * 1024 + (ob ^ (((ob >> 9) & 1) << 5)); }
__host__ __device__ __forceinline__ void stage_rc(int b, int& R, int& C) { const int st = b / 1024, sb = b % 1024, swz = sb ^ (((sb >> 9) & 1) << 5); R = (st >> 1) * 16 + swz / 64; C = (st & 1) * 32 + (swz % 64) / 2; }
__host__ __device__ __forceinline__ int perm32(int rho) { const int n = rho >> 4, i = rho & 15; return 8 * (i >> 2) + 4 * n + (i & 3); }

struct Unit { int pm, pn, aux; const char* A; const char* B; };

struct TileOrder {
    int nM, nN, nwg;
    __device__ __forceinline__ void init(int nM_, int nN_) { nM = nM_; nN = nN_; nwg = nM * nN; }
    __device__ __forceinline__ void map(int L, int& pm, int& pn) const {
        int wgid = L; { const int q = nwg / NXCD, r = nwg % NXCD, xcd = wgid % NXCD, off = wgid / NXCD; wgid = (xcd < r ? xcd * (q + 1) : r * (q + 1) + (xcd - r) * q) + off; }
        const int nig = WGM * nN, gid = wgid / nig, fm = gid * WGM, gsz = (nM - fm) < WGM ? (nM - fm) : WGM;
        pm = fm + ((wgid % nig) % gsz); pn = (wgid % nig) / gsz;
    }
};

template <class E_, class = void> struct EpiFull { static constexpr bool value = false; };
template <class E_> struct EpiFull<E_, decltype((void)E_::FULL)> { static constexpr bool value = E_::FULL; };
template <class Epi, class Sched>
__device__ __forceinline__ void gemm_phase(LAS unsigned char* lds, const int K, const Sched& S, const Epi& E) {
    int tid_ = threadIdx.x; asm volatile("" : "+v"(tid_));
    const int tid = tid_, wid = __builtin_amdgcn_readfirstlane(tid >> 6), lane = tid & 63, wr = wid >> 2, wc = wid & 3, fr = lane & 15, fq = lane >> 4;
    const int nt = K / BK;
    unsigned voffA[2], voffB[2];
    constexpr bool FULL = EpiFull<Epi>::value;
#pragma unroll
    for (int i = 0; i < 2; ++i) { int R, C; stage_rc(tid * 16 + i * 8192, R, C); const int Rb = Epi::PERM ? ((FULL ? (R >> 5) * 64 : (R & ~31)) + perm32(R & 31)) : R;
        voffA[i] = (unsigned)(R * K + C) * 2u; voffB[i] = (unsigned)(Rb * K + C) * 2u; }
    const size_t kstep = (size_t)(BK * 2);
    const size_t hstep = (size_t)HALF * K * 2;
    const size_t hstepB = FULL ? (size_t)32 * K * 2 : hstep;
    const unsigned ldsw = (unsigned)wid * 1024u;
    const int aoff = lds_byte(wr * 64 + fr, fq * 8), boff = lds_byte(wc * 32 + fr, fq * 8);
#define PG8_SA(b, h) (((b) * 2 + (h)) * HTB)
#define PG8_SB(b, h) ((4 + (b) * 2 + (h)) * HTB)
#define PG8_STAGE(bufoff, gbase, voff) do { _Pragma("unroll") for (int _i = 0; _i < 2; ++_i) \
        __builtin_amdgcn_global_load_lds((const unsigned*)((const char*)(gbase) + (voff)[_i]), (LAS unsigned*)(lds + (bufoff) + ldsw + _i * 8192), 16, 0, 0); } while (0)
#define PG8_LDA(dst, b, h) do { _Pragma("unroll") for (int m = 0; m < 4; ++m) _Pragma("unroll") for (int k = 0; k < 2; ++k) dst[m][k] = *(const LAS bf16x8*)(lds + PG8_SA(b, h) + aoff + m * 2048 + k * 1024); } while (0)
#define PG8_LDB(dst, b, h) do { _Pragma("unroll") for (int n = 0; n < 2; ++n) _Pragma("unroll") for (int k = 0; k < 2; ++k) dst[n][k] = *(const LAS bf16x8*)(lds + PG8_SB(b, h) + boff + n * 2048 + k * 1024); } while (0)
#define PG8_MMA(ai, bj, At, Bt) do { __builtin_amdgcn_s_setprio(1); _Pragma("unroll") for (int m = 0; m < 4; ++m) _Pragma("unroll") for (int n = 0; n < 2; ++n) _Pragma("unroll") for (int k = 0; k < 2; ++k) \
        acc[ai][bj][m][n] = __builtin_amdgcn_mfma_f32_16x16x32_bf16(Bt[n][k], At[m][k], acc[ai][bj][m][n], 0, 0, 0); __builtin_amdgcn_s_setprio(0); } while (0)
#define PG8_WAIT_V(n) asm volatile("s_waitcnt vmcnt(" #n ")" ::: "memory")
#define PG8_WAIT_L(n) asm volatile("s_waitcnt lgkmcnt(" #n ")" ::: "memory")
#define PG8_BAR __builtin_amdgcn_s_barrier()
#define PG8_SCHED __builtin_amdgcn_sched_barrier(0)
    Unit cur, nxt; int ui = 0;
    if (!S.next(0, cur)) return;
    f32x4 acc[2][2][4][2];
#pragma unroll
    for (int a = 0; a < 2; ++a)
#pragma unroll
        for (int b = 0; b < 2; ++b)
#pragma unroll
            for (int m = 0; m < 4; ++m)
#pragma unroll
                for (int n = 0; n < 2; ++n) acc[a][b][m][n] = (f32x4){0.f, 0.f, 0.f, 0.f};
    bf16x8 At[4][2], B0[2][2], B1[2][2];
    const char* cA = cur.A; const char* cB = cur.B;
    PG8_STAGE(PG8_SB(0, 0), cB, voffB); PG8_STAGE(PG8_SB(0, 1), cB + hstepB, voffB); PG8_STAGE(PG8_SA(0, 0), cA, voffA); PG8_STAGE(PG8_SA(0, 1), cA + hstep, voffA);
    if (wr == 1) PG8_BAR;
    PG8_WAIT_V(2); PG8_BAR;
    PG8_STAGE(PG8_SB(1, 0), cB + kstep, voffB); PG8_STAGE(PG8_SA(1, 0), cA + kstep, voffA); PG8_STAGE(PG8_SB(1, 1), cB + hstepB + kstep, voffB);
    PG8_WAIT_V(6); PG8_BAR;
    for (;;) {
        const bool has_next = S.next(ui + 1, nxt);
        const char* nA = has_next ? nxt.A : cA; const char* nB = has_next ? nxt.B : cB;
        for (int t = 0; t < nt; t += 2) {
            const bool last = (t == nt - 2);
            const char* a1 = cA + (size_t)(t + 1) * kstep;
            const char* a2 = last ? nA : cA + (size_t)(t + 2) * kstep; const char* b2 = last ? nB : cB + (size_t)(t + 2) * kstep;
            const char* a3 = a2 + kstep; const char* b3 = b2 + kstep;
            PG8_LDB(B0, 0, 0); PG8_LDB(B1, 0, 1); PG8_SCHED; PG8_LDA(At, 0, 0); PG8_STAGE(PG8_SA(1, 1), a1 + hstep, voffA);
            PG8_WAIT_V(8); PG8_WAIT_L(0); PG8_BAR; PG8_MMA(0, 0, At, B0); PG8_MMA(0, 1, At, B1); PG8_BAR; PG8_SCHED;
            PG8_LDA(At, 0, 1); PG8_STAGE(PG8_SB(0, 0), b2, voffB); PG8_STAGE(PG8_SB(0, 1), b2 + hstepB, voffB); PG8_STAGE(PG8_SA(0, 0), a2, voffA);
            PG8_WAIT_V(8); PG8_WAIT_L(0); PG8_BAR; PG8_MMA(1, 0, At, B0); PG8_MMA(1, 1, At, B1); PG8_BAR; PG8_SCHED;
            PG8_LDB(B0, 1, 0); PG8_LDB(B1, 1, 1); PG8_SCHED; PG8_LDA(At, 1, 0); PG8_STAGE(PG8_SA(0, 1), a2 + hstep, voffA);
            PG8_WAIT_V(8); PG8_WAIT_L(0); PG8_BAR; PG8_MMA(0, 0, At, B0); PG8_MMA(0, 1, At, B1); PG8_BAR; PG8_SCHED;
            PG8_LDA(At, 1, 1); PG8_STAGE(PG8_SB(1, 0), b3, voffB); PG8_STAGE(PG8_SB(1, 1), b3 + hstepB, voffB); PG8_STAGE(PG8_SA(1, 0), a3, voffA);
            PG8_WAIT_V(8); PG8_WAIT_L(0); PG8_BAR; PG8_MMA(1, 0, At, B0); PG8_MMA(1, 1, At, B1); PG8_BAR; PG8_SCHED;
        }
#ifndef PG8_NOALIGN
        if (wr == 0) PG8_BAR;
#else
        if (wr == 0 && !has_next) PG8_BAR;
#endif
        E(acc, cur, wr, wc, fr, fq);
        if (!has_next) break;
        if (!E.keep(cur)) {
#pragma unroll
            for (int a = 0; a < 2; ++a)
#pragma unroll
                for (int b = 0; b < 2; ++b)
#pragma unroll
                    for (int m = 0; m < 4; ++m)
#pragma unroll
                        for (int n = 0; n < 2; ++n) acc[a][b][m][n] = (f32x4){0.f, 0.f, 0.f, 0.f};
        }
        cur = nxt; cA = nA; cB = nB; ++ui;
#ifndef PG8_NOALIGN
        if (wr == 1) PG8_BAR;
#endif
    }
    PG8_WAIT_V(0);
    PG8_BAR;
#undef PG8_SA
#undef PG8_SB
#undef PG8_STAGE
#undef PG8_LDA
#undef PG8_LDB
#undef PG8_MMA
#undef PG8_WAIT_V
#undef PG8_WAIT_L
#undef PG8_BAR
#undef PG8_SCHED
}
}
namespace pg8 {

struct SchedPlain {
    TileOrder T; int G, c; const char* A; const char* B; size_t tstep; int latonly;
    __device__ __forceinline__ void init(const bf16_t* A_, const bf16_t* B_, int M, int N, int K, int G_, int c_, int latonly_ = 0) { latonly = latonly_; T.init(latonly_ ? NB * 16 : M / BM, N / BM); G = G_; c = c_; A = (const char*)A_; B = (const char*)B_; tstep = (size_t)BM * K * 2; }
    __device__ __forceinline__ bool next(int i, Unit& u) const {
        const long L = (long)i * G + c; if (L >= T.nwg) return false;
        T.map((int)L, u.pm, u.pn); if (latonly) u.pm = (u.pm >> 4) * 17 + (u.pm & 15); u.aux = 0; u.A = A + (size_t)u.pm * tstep; u.B = B + (size_t)u.pn * tstep; return true;
    }
};

struct EpiProj {
    static constexpr bool PERM = true;
    static constexpr bool FULL = true;
    unsigned char* ws;
    const LAS float* rope;
    int dry = 0;
    __device__ __forceinline__ bool keep(const Unit&) const { return false; }
    static __device__ __forceinline__ void trade(const u32x4& w0, const u32x4& w1, u32x4& X, u32x4& Y) {
#pragma unroll
        for (int j = 0; j < 4; ++j) {
            X[j] = (unsigned)__builtin_amdgcn_update_dpp((int)w0[j], (int)w1[j], 0x128, 0xf, 0xc, false);
            Y[j] = (unsigned)__builtin_amdgcn_update_dpp((int)w1[j], (int)w0[j], 0x128, 0xf, 0x3, false); }
    }
    __device__ __forceinline__ void operator()(f32x4 (&acc)[2][2][4][2], const Unit& u, int wr, int wc, int fr, int fq) const {
        if (dry) return;
        const int pn = u.pn; int t0, ldc; size_t boff; bool roped = false; float scl = 1.0f;
        if (pn < 4) { boff = OFF_DQ; t0 = 0; ldc = 1024; }                           else if (pn < 8) { boff = OFF_DK; t0 = 4; ldc = 1024; roped = true; } else if (pn < 12) { boff = OFF_DV; t0 = 8; ldc = 1024; }
        else if (pn < 24) { boff = OFF_HY; t0 = 12; ldc = 3072; } else if (pn < 28) { boff = OFF_SQ; t0 = 24; ldc = 1024; } else if (pn < 29) { boff = OFF_SK; t0 = 28; ldc = 256; roped = true; }
        else if (pn < 30) { boff = OFF_SV; t0 = 29; ldc = 256; } else { boff = OFF_GT; t0 = 30; ldc = 3072; }
        bf16_t* base = (bf16_t*)(ws + boff);
        const int row0 = u.pm * BM + wr * 64 + (fr & 7), col0 = (pn - t0) * BM + wc * 64 + 32 * (fr >> 3) + 8 * fq;
        const int tb = (u.pm % 17) * BM;
        const bool lat = tb < LS;
        if (roped) {
            const int half = fq >> 1, f0 = 8 * (fq & 1);
#pragma unroll
            for (int ai = 0; ai < 2; ++ai)
#pragma unroll
                for (int m = 0; m < 4; ++m) {
                    const int t = tb + wr * 64 + fr + ai * HALF + m * 16;
                    u32x4 wv[2];
#pragma unroll
                    for (int bj = 0; bj < 2; ++bj) { const int pos = bj == 0 ? (t >> 6) : (t & 63);
                        f32x4 c0 = (f32x4){1.f, 1.f, 1.f, 1.f}, c1 = c0, s0 = (f32x4){0.f, 0.f, 0.f, 0.f}, s1 = s0;
                        if (lat) { const LAS float* cp = rope + pos * 16 + f0; c0 = *(const LAS f32x4*)cp; c1 = *(const LAS f32x4*)(cp + 4); s0 = *(const LAS f32x4*)(cp + 1024); s1 = *(const LAS f32x4*)(cp + 1028); }
                        if (half == 0) { s0 = -s0; s1 = -s1; }
                        const f32x4 v0 = acc[ai][bj][m][0], v1 = acc[ai][bj][m][1];
                        f32x4 q0, q1;
#pragma unroll
                        for (int j = 0; j < 4; ++j) {
                            const auto r0 = __builtin_amdgcn_permlane32_swap(__float_as_uint(v0[j]), __float_as_uint(v0[j]), false, false);
                            const auto r1 = __builtin_amdgcn_permlane32_swap(__float_as_uint(v1[j]), __float_as_uint(v1[j]), false, false);
                            q0[j] = __uint_as_float(half == 0 ? r0[1] : r0[0]); q1[j] = __uint_as_float(half == 0 ? r1[1] : r1[0]); }
                        const f32x4 o0 = (v0 * c0 + q0 * s0) * scl, o1 = (v1 * c1 + q1 * s1) * scl;
                        wv[bj].x = cvtpk(o0[0], o0[1]); wv[bj].y = cvtpk(o0[2], o0[3]); wv[bj].z = cvtpk(o1[0], o1[1]); wv[bj].w = cvtpk(o1[2], o1[3]); }
                    u32x4 X, Y; trade(wv[0], wv[1], X, Y);
                    bf16_t* rowp = base + (size_t)(row0 + ai * HALF + m * 16) * ldc + col0;
                    *(u32x4*)rowp = X; *(u32x4*)(rowp + (size_t)8 * ldc) = Y;
                }
            return;
        }
#pragma unroll
        for (int ai = 0; ai < 2; ++ai)
#pragma unroll
            for (int m = 0; m < 4; ++m) { bf16_t* rowp = base + (size_t)(row0 + ai * HALF + m * 16) * ldc + col0;
                u32x4 wv[2];
#pragma unroll
                for (int bj = 0; bj < 2; ++bj) { const f32x4 v0 = acc[ai][bj][m][0], v1 = acc[ai][bj][m][1];
                    wv[bj].x = cvtpk(v0[0], v0[1]); wv[bj].y = cvtpk(v0[2], v0[3]); wv[bj].z = cvtpk(v1[0], v1[1]); wv[bj].w = cvtpk(v1[2], v1[3]); }
                u32x4 X, Y; trade(wv[0], wv[1], X, Y);
                *(u32x4*)rowp = X; *(u32x4*)(rowp + (size_t)8 * ldc) = Y; }
    }
};

struct SchedBranch {
    TileOrder T; int G, c; const char* ws; const char* B; size_t tstep, bstep; int latonly;
    __device__ __forceinline__ bool next(int i, Unit& u) const {
        const int ti = i / 3, br = i - ti * 3; const long L = (long)ti * G + c; if (L >= T.nwg) return false;
        T.map((int)L, u.pm, u.pn); if (latonly) u.pm = (u.pm >> 4) * 17 + (u.pm & 15); u.aux = br; size_t ao = br == 0 ? OFF_DQ : (br == 1 ? OFF_YHY : OFF_SQ); asm volatile("" : "+s"(ao));     u.A = ws + ao + (size_t)u.pm * tstep; u.B = B + (size_t)br * bstep + (size_t)u.pn * tstep; return true;
    }
};
struct EpiBranch {
    static constexpr bool PERM = true;
    unsigned char* ws;
    __device__ __forceinline__ bool keep(const Unit& u) const { return u.aux < 2; }
    __device__ __forceinline__ void operator()(f32x4 (&acc)[2][2][4][2], const Unit& u, int wr, int wc, int fr, int fq) const {
        const int br = u.aux;
        const bf16_t* gt = (const bf16_t*)(ws + OFF_GT); bf16_t* out = (bf16_t*)(ws + OFF_DK);
        const int row0 = u.pm * BM + wr * 64 + fr, col0 = u.pn * BM + wc * 32 + 8 * fq;
#pragma unroll
        for (int ai = 0; ai < 2; ++ai) {
            u32x4 GA[4][2], GB[4][2];
#pragma unroll
            for (int m = 0; m < 4; ++m)
#pragma unroll
                for (int bj = 0; bj < 2; ++bj) { const bf16_t* gp = gt + (size_t)(row0 + ai * HALF + m * 16) * 3072 + br * 1024 + col0 + bj * HALF;
                    GA[m][bj] = *(const u32x4*)gp; GB[m][bj] = br < 2 ? *(const u32x4*)(gp + 1024) : (u32x4){0u, 0u, 0u, 0u}; }
#pragma unroll
            for (int m = 0; m < 4; ++m) { const size_t row = (size_t)(row0 + ai * HALF + m * 16);
#pragma unroll
                for (int bj = 0; bj < 2; ++bj) {
                    const u32x4 ga = GA[m][bj], gb = GB[m][bj];
                    float s[8];
                    if (br < 2) {
#pragma unroll
                        for (int j = 0; j < 4; ++j) {
                            const float a0 = bflo(ga[j]), a1 = bfhi(ga[j]), b0 = bflo(gb[j]), b1 = bfhi(gb[j]);
                            s[2 * j]     = (1.0f + fast_exp(fminf(-b0, 80.f))) * __builtin_amdgcn_rcpf(1.0f + fast_exp(fminf(-a0, 80.f)));
                            s[2 * j + 1] = (1.0f + fast_exp(fminf(-b1, 80.f))) * __builtin_amdgcn_rcpf(1.0f + fast_exp(fminf(-a1, 80.f)));
                        }
                    } else {
#pragma unroll
                        for (int j = 0; j < 4; ++j) { s[2 * j] = __builtin_amdgcn_rcpf(1.0f + fast_exp(fminf(-bflo(ga[j]), 80.f))); s[2 * j + 1] = __builtin_amdgcn_rcpf(1.0f + fast_exp(fminf(-bfhi(ga[j]), 80.f))); }
                    }
                    f32x4 v0 = acc[ai][bj][m][0], v1 = acc[ai][bj][m][1];
                    v0[0] *= s[0]; v0[1] *= s[1]; v0[2] *= s[2]; v0[3] *= s[3]; v1[0] *= s[4]; v1[1] *= s[5]; v1[2] *= s[6]; v1[3] *= s[7];
                    if (br < 2) { acc[ai][bj][m][0] = v0; acc[ai][bj][m][1] = v1; }
                    else { u32x4 w; w.x = cvtpk(v0[0], v0[1]); w.y = cvtpk(v0[2], v0[3]); w.z = cvtpk(v1[0], v1[1]); w.w = cvtpk(v1[2], v1[3]);
                        *(u32x4*)(out + row * 1024 + col0 + bj * HALF) = w; }
                } }
            asm volatile("" ::: "memory"); }
    }
};

struct EpiResid {
    static constexpr bool PERM = false;
    float* xres; const float* mod; int dry;
    __device__ __forceinline__ bool keep(const Unit&) const { return false; }
    __device__ __forceinline__ void operator()(f32x4 (&acc)[2][2][4][2], const Unit& u, int wr, int wc, int fr, int fq) const {
        const int b = u.pm / 17, isctx = (u.pm - b * 17) == 16; const float* mrow = mod + (size_t)(isctx ? 8 : b) * 6144 + 2 * 1024;
        const int row0 = u.pm * BM + wr * 64 + fr, col0 = u.pn * BM + wc * 32 + 4 * fq;
        f32x4 mv[2][2];
#pragma unroll
        for (int bj = 0; bj < 2; ++bj)
#pragma unroll
            for (int n = 0; n < 2; ++n) mv[bj][n] = *(const f32x4*)(mrow + col0 + bj * HALF + n * 16);
#pragma unroll
        for (int ai = 0; ai < 2; ++ai)
#pragma unroll
            for (int m = 0; m < 4; ++m) { float* rowp = xres + (size_t)(row0 + ai * HALF + m * 16) * 1024 + col0;
#pragma unroll
                for (int bj = 0; bj < 2; ++bj)
#pragma unroll
                    for (int n = 0; n < 2; ++n) { f32x4* p = (f32x4*)(rowp + bj * HALF + n * 16); const f32x4 x = *p; if (!dry) *p = x + mv[bj][n] * acc[ai][bj][m][n]; }
                if (m == 3) asm volatile("" ::: "memory"); }
    }
};

struct SchedMoe {
    TileOrder T; int G, c; const char* A; const char* B; size_t tstep, estep;
    __device__ __forceinline__ bool next(int i, Unit& u) const {
        const long L = (long)i * G + c; if (L >= T.nwg) return false;
        T.map((int)L, u.pm, u.pn); const int e = u.pm < 256 ? (u.pm >> 4) : (u.pm - 256); u.aux = e;
        u.A = A + (size_t)u.pm * tstep; u.B = B + (size_t)e * estep + (size_t)u.pn * tstep; return true;
    }
};
struct EpiSwiglu {
    static constexpr bool PERM = true;
    bf16_t* hid;
    __device__ __forceinline__ bool keep(const Unit&) const { return false; }
    __device__ __forceinline__ void operator()(f32x4 (&acc)[2][2][4][2], const Unit& u, int wr, int wc, int fr, int fq) const {
        const int row0 = u.pm * BM + wr * 64 + fr, col0 = u.pn * HALF + wc * 32 + 8 * fq;
#pragma unroll
        for (int ai = 0; ai < 2; ++ai)
#pragma unroll
            for (int m = 0; m < 4; ++m) { bf16_t* rowp = hid + (size_t)(row0 + ai * HALF + m * 16) * 1024 + col0;
                float h[8];
#pragma unroll
                for (int n = 0; n < 2; ++n)
#pragma unroll
                    for (int j = 0; j < 4; ++j) { const float a = acc[ai][0][m][n][j], b = acc[ai][1][m][n][j]; h[4 * n + j] = a * __builtin_amdgcn_rcpf(1.0f + fast_exp(-a)) * b; }
                u32x4 w; w.x = cvtpk(h[0], h[1]); w.y = cvtpk(h[2], h[3]); w.z = cvtpk(h[4], h[5]); w.w = cvtpk(h[6], h[7]);
                *(u32x4*)rowp = w; }
    }
};
struct EpiRowScale {
    static constexpr bool PERM = true;
    bf16_t* out; const float* gate;
    __device__ __forceinline__ bool keep(const Unit&) const { return false; }
    __device__ __forceinline__ void operator()(f32x4 (&acc)[2][2][4][2], const Unit& u, int wr, int wc, int fr, int fq) const {
        const int row0 = u.pm * BM + wr * 64 + fr, col0 = u.pn * BM + wc * 32 + 8 * fq;
#pragma unroll
        for (int ai = 0; ai < 2; ++ai)
#pragma unroll
            for (int m = 0; m < 4; ++m) { const int row = row0 + ai * HALF + m * 16; const float g = gate[row]; bf16_t* rowp = out + (size_t)row * 1024 + col0;
#pragma unroll
                for (int bj = 0; bj < 2; ++bj) { const f32x4 v0 = acc[ai][bj][m][0] * g, v1 = acc[ai][bj][m][1] * g;
                    u32x4 w; w.x = cvtpk(v0[0], v0[1]); w.y = cvtpk(v0[2], v0[3]); w.z = cvtpk(v1[0], v1[1]); w.w = cvtpk(v1[2], v1[3]);
                    *(u32x4*)(rowp + bj * HALF) = w; } }
    }
};
}
namespace att {
__device__ __forceinline__ int crow(int r, int hi) { return (r & 3) + 8 * (r >> 2) + 4 * hi; }
__device__ __forceinline__ void glds16(const void* gsrc, unsigned lds_dst) { unsigned keep;
    asm volatile("s_mov_b32 %0, m0\n\ts_mov_b32 m0, %2\n\ts_nop 0\n\tglobal_load_lds_dwordx4 %1, off\n\ts_mov_b32 m0, %0" : "=&s"(keep) : "v"(gsrc), "s"(lds_dst) : "memory"); }
#define ATT_WAIT_BAR() asm volatile("s_waitcnt vmcnt(0) lgkmcnt(0)\n\ts_barrier" ::: "memory")

constexpr int KSLOT = 8192;
constexpr int NSLOT = 4;
template <int DV> struct Lay { static constexpr int VSLOT = DV * 128, K0 = 0, V0 = NSLOT * KSLOT, WS = V0 + NSLOT * VSLOT, BYTES = WS + 8 * 256; };

struct Pass {
    const bf16_t* Qw; int ldq;
    const bf16_t* Kb; int ldk;
    const bf16_t* Vb; int ldv;
    int nA, ks, nC;
    int band;
    int qpos;
    float m0, l0;
    int rope; const LAS float* rtab;
};

__device__ __forceinline__ float max3f(float a, float b, float c) { float r; asm("v_max3_f32 %0, %1, %2, %3" : "=v"(r) : "v"(a), "v"(b), "v"(c)); return r; }
constexpr float ATT_THR = 8.0f;

template <int DV>
__device__ __forceinline__ void flash_pass(char* shm, const Pass& P, f32x16 (&o)[DV / 32], f32x16& osum) {
    typedef Lay<DV> L;
    int tid_ = threadIdx.x; asm volatile("" : "+v"(tid_));
    const int tid = tid_, lane = tid & 63, r32 = lane & 31, hi = lane >> 5; const int wid = __builtin_amdgcn_readfirstlane(tid >> 6);
    const unsigned lds0 = (unsigned)(uintptr_t)shm;
    float* wsf = (float*)(shm + L::WS) + wid * 64;
    const int NT = P.nA + P.nC;
    bf16x8 qr[4];
#pragma unroll
    for (int d0 = 0; d0 < 4; ++d0) qr[d0] = *reinterpret_cast<const bf16x8*>(P.Qw + (size_t)r32 * P.ldq + d0 * 16 + hi * 8);
    { const int tq = P.qpos + r32;
#pragma unroll
      for (int ax = 0; ax < 2; ++ax) {
          f32x4 c0 = (f32x4){1.f, 1.f, 1.f, 1.f}, c1 = c0, s0 = (f32x4){0.f, 0.f, 0.f, 0.f}, s1 = s0;
          if (P.rope) { const LAS float* cp = P.rtab + (ax == 0 ? (tq >> 6) : (tq & 63)) * 16 + 8 * hi; c0 = *(const LAS f32x4*)cp; c1 = *(const LAS f32x4*)(cp + 4); s0 = *(const LAS f32x4*)(cp + 1024); s1 = *(const LAS f32x4*)(cp + 1028); }
          const u32x4 a = __builtin_bit_cast(u32x4, qr[2 * ax]), b = __builtin_bit_cast(u32x4, qr[2 * ax + 1]); u32x4 oa, ob;
#pragma unroll
          for (int j = 0; j < 4; ++j) { const float cl = j < 2 ? c0[2 * j] : c1[2 * j - 4], ch = j < 2 ? c0[2 * j + 1] : c1[2 * j - 3], sl_ = j < 2 ? s0[2 * j] : s1[2 * j - 4], sh_ = j < 2 ? s0[2 * j + 1] : s1[2 * j - 3];
              const float x1l = bflo(a[j]), x1h = bfhi(a[j]), x2l = bflo(b[j]), x2h = bfhi(b[j]);
              oa[j] = cvtpk((x1l * cl - x2l * sl_) * QSCALE, (x1h * ch - x2h * sh_) * QSCALE); ob[j] = cvtpk((x2l * cl + x1l * sl_) * QSCALE, (x2h * ch + x1h * sh_) * QSCALE); }
          qr[2 * ax] = __builtin_bit_cast(bf16x8, oa); qr[2 * ax + 1] = __builtin_bit_cast(bf16x8, ob); } }
#pragma unroll
    for (int d = 0; d < DV / 32; ++d) o[d] = f32x16{};
    float lsum = (hi == 0) ? P.l0 : 0.f;
    const bf16_t* ksrc = P.Kb + (size_t)lane * P.ldk + wid * 8;
    const bf16_t* vsrc = P.Vb + (size_t)(16 * (wid & 3) + (lane >> 2)) * P.ldv + (wid >> 2) * 32 + (lane & 3) * 8;
#define ATT_KEYROW(t) ((t) < P.nA ? P.ks + 64 * (t) : LS + 64 * ((t) - P.nA))
#define ATT_DMA_K(t, slot) do { const int kr_ = ATT_KEYROW(t); \
        glds16(ksrc + (size_t)kr_ * P.ldk, (unsigned)__builtin_amdgcn_readfirstlane(lds0 + L::K0 + (slot) * KSLOT + wid * 1024)); } while (0)
#define ATT_DMA_V(t, slot, s2_) do { const int kr_ = ATT_KEYROW(t); \
        glds16(vsrc + (size_t)kr_ * P.ldv + (s2_) * 64, (unsigned)__builtin_amdgcn_readfirstlane(lds0 + L::V0 + (slot) * L::VSLOT + (s2_) * 8192 + wid * 1024)); } while (0)
#define ATT_DMA(t, slot) do { ATT_DMA_K(t, slot); _Pragma("unroll") for (int s2__ = 0; s2__ < DV / 64; ++s2__) ATT_DMA_V(t, slot, s2__); } while (0)
#define ATT_QK(p0_, p1_, slot, cinit) do { const char* kb_ = shm + L::K0 + (slot) * KSLOT + hi * 1024 + r32 * 16; bf16x8 kf_[4]; \
        _Pragma("unroll") for (int d0 = 0; d0 < 2; ++d0) { kf_[2 * d0] = *reinterpret_cast<const bf16x8*>(kb_ + d0 * 2048); kf_[2 * d0 + 1] = *reinterpret_cast<const bf16x8*>(kb_ + d0 * 2048 + 512); } \
        __builtin_amdgcn_sched_barrier(0);        \
        p0_ = __builtin_amdgcn_mfma_f32_32x32x16_bf16(kf_[0], qr[0], cinit, 0, 0, 0); p1_ = __builtin_amdgcn_mfma_f32_32x32x16_bf16(kf_[1], qr[0], cinit, 0, 0, 0); \
        p0_ = __builtin_amdgcn_mfma_f32_32x32x16_bf16(kf_[2], qr[1], p0_, 0, 0, 0); p1_ = __builtin_amdgcn_mfma_f32_32x32x16_bf16(kf_[3], qr[1], p1_, 0, 0, 0); \
        __builtin_amdgcn_sched_barrier(0); \
        _Pragma("unroll") for (int d0 = 2; d0 < 4; ++d0) { kf_[2 * d0 - 4] = *reinterpret_cast<const bf16x8*>(kb_ + d0 * 2048); kf_[2 * d0 - 3] = *reinterpret_cast<const bf16x8*>(kb_ + d0 * 2048 + 512); } \
        __builtin_amdgcn_sched_barrier(0); \
        p0_ = __builtin_amdgcn_mfma_f32_32x32x16_bf16(kf_[0], qr[2], p0_, 0, 0, 0); p1_ = __builtin_amdgcn_mfma_f32_32x32x16_bf16(kf_[1], qr[2], p1_, 0, 0, 0); \
        p0_ = __builtin_amdgcn_mfma_f32_32x32x16_bf16(kf_[2], qr[3], p0_, 0, 0, 0); p1_ = __builtin_amdgcn_mfma_f32_32x32x16_bf16(kf_[3], qr[3], p1_, 0, 0, 0); } while (0)
#define ATT_ROWMAX(rm_, p0_, p1_) do { float a_ = max3f(p0_[0], p0_[1], p1_[0]), b_ = max3f(p0_[2], p0_[3], p1_[1]); a_ = max3f(a_, p1_[2], p1_[3]); \
        _Pragma("unroll") for (int r = 4; r < 16; r += 4) { a_ = max3f(a_, p0_[r], p0_[r + 1]); b_ = max3f(b_, p0_[r + 2], p0_[r + 3]); a_ = max3f(a_, p1_[r], p1_[r + 1]); b_ = max3f(b_, p1_[r + 2], p1_[r + 3]); } \
        rm_ = fmaxf(a_, b_); auto rr_ = __builtin_amdgcn_permlane32_swap(__float_as_uint(rm_), __float_as_uint(rm_), false, false); rm_ = fmaxf(__uint_as_float(rr_[0]), __uint_as_float(rr_[1])); } while (0)
    ATT_DMA(0, 0);
#define ATT_WAITV(ktiles) do { if ((ktiles) == 0) asm volatile("s_waitcnt vmcnt(0)" ::: "memory"); \
        else if ((ktiles) == 1) { if (DV == 128) asm volatile("s_waitcnt vmcnt(3)" ::: "memory"); else asm volatile("s_waitcnt vmcnt(2)" ::: "memory"); } \
        else { if (DV == 128) asm volatile("s_waitcnt vmcnt(6)" ::: "memory"); else asm volatile("s_waitcnt vmcnt(4)" ::: "memory"); } } while (0)
    if (NT > 1) ATT_DMA(1, 1);
    if (NT > 2) ATT_DMA(2, 2);
    { const int younger = NT > 2 ? 2 : (NT > 1 ? 1 : 0); ATT_WAITV(younger); }
    asm volatile("s_waitcnt lgkmcnt(0)\n\ts_barrier" ::: "memory");
    f32x16 p0, p1, n0, n1, negm;
    { const f32x16 zero = f32x16{}; ATT_QK(p0, p1, 0, zero); }
    asm volatile("s_nop 15\n\ts_nop 7" : "+v"(p0), "+v"(p1));
#define ATT_NEEDMASK(tt) (P.band && (tt) < P.nA && !(P.ks + 64 * (tt) >= P.qpos - 97 && P.ks + 64 * (tt) <= P.qpos + 65))
#define ATT_MASK(v0_, v1_, tt) do { const int q_ = P.qpos + r32, kb0_ = P.ks + 64 * (tt) + 4 * hi; \
        _Pragma("unroll") for (int r = 0; r < 16; ++r) { const int kv_ = kb0_ + (r & 3) + 8 * (r >> 2); int dd_ = kv_ - q_; dd_ = dd_ < 0 ? -dd_ : dd_; int d1_ = kv_ + 32 - q_; d1_ = d1_ < 0 ? -d1_ : d1_; \
            if (dd_ > 128) v0_[r] = -INFINITY; if (d1_ > 128) v1_[r] = -INFINITY; } } while (0)
    if (ATT_NEEDMASK(0)) ATT_MASK(p0, p1, 0);
    float m; { float rm0; ATT_ROWMAX(rm0, p0, p1); m = fmaxf(P.m0, rm0); }
    lsum *= __builtin_amdgcn_exp2f(P.m0 - m);
#pragma unroll
    for (int r = 0; r < 16; ++r) { p0[r] -= m; p1[r] -= m; negm[r] = -m; }
    n0 = p0; n1 = p1;
    int sl = 0;
    for (int t = 0; t < NT; ++t) {
        { const int younger = t + 2 < NT ? 1 : 0; ATT_WAITV(younger); }
        asm volatile("s_waitcnt lgkmcnt(0)\n\ts_barrier" ::: "memory");
        const int sl1 = (sl + 1) & (NSLOT - 1), sl2 = (sl + 3) & (NSLOT - 1);
        if (t + 1 < NT) { ATT_QK(n0, n1, sl1, negm); }
        __builtin_amdgcn_sched_barrier(0);
        const bool pre = t + 3 < NT;
        if (pre) ATT_DMA_K(t + 3, sl2);
        { float sacc = 0.f;
#pragma unroll
          for (int r = 0; r < 16; ++r) { p0[r] = __builtin_amdgcn_exp2f(p0[r]); p1[r] = __builtin_amdgcn_exp2f(p1[r]); sacc += p0[r] + p1[r]; }
          lsum += sacc; }
        u32x4 pw0, pw1, pw2, pw3;
        pw0 = (u32x4){cvtpk(p0[0], p0[1]), cvtpk(p0[2], p0[3]), cvtpk(p0[4], p0[5]), cvtpk(p0[6], p0[7])};
        pw1 = (u32x4){cvtpk(p0[8], p0[9]), cvtpk(p0[10], p0[11]), cvtpk(p0[12], p0[13]), cvtpk(p0[14], p0[15])};
        pw2 = (u32x4){cvtpk(p1[0], p1[1]), cvtpk(p1[2], p1[3]), cvtpk(p1[4], p1[5]), cvtpk(p1[6], p1[7])};
        pw3 = (u32x4){cvtpk(p1[8], p1[9]), cvtpk(p1[10], p1[11]), cvtpk(p1[12], p1[13]), cvtpk(p1[14], p1[15])};
        const int vb = (int)(lds0 + L::V0 + sl * L::VSLOT) + ((lane >> 4) & 1) * 32 + (lane & 3) * 8 + (4 * hi + ((lane & 15) >> 2)) * 64;
        s16x4 loA[4], hhA[4], loB[4], hhB[4];
        asm volatile("s_waitcnt lgkmcnt(0)" ::: "memory");
#define ATT_VRD(lo_, hh_, d0) do { _Pragma("unroll") for (int ks = 0; ks < 4; ++ks) { \
            asm volatile("ds_read_b64_tr_b16 %0,%1 offset:%c2" : "=&v"(lo_[ks]) : "v"(vb), "i"(((d0) >> 1) * 8192 + ((d0) & 1) * 4096 + ks * 1024) : "memory"); \
            asm volatile("ds_read_b64_tr_b16 %0,%1 offset:%c2" : "=&v"(hh_[ks]) : "v"(vb), "i"(((d0) >> 1) * 8192 + ((d0) & 1) * 4096 + ks * 1024 + 512) : "memory"); } } while (0)
#define ATT_PK(lo_, hh_, k) (bf16x8){lo_[k][0], lo_[k][1], lo_[k][2], lo_[k][3], hh_[k][0], hh_[k][1], hh_[k][2], hh_[k][3]}
        float ra_ = 0.f, rb_ = 0.f, rm = 0.f;
#define ATT_RMSTEP(s_) do { \
            if ((s_) == 0) { if (t + 1 < NT && ATT_NEEDMASK(t + 1)) ATT_MASK(n0, n1, t + 1); ra_ = max3f(n0[0], n0[1], n1[0]); rb_ = max3f(n0[2], n0[3], n1[1]); } \
            else if ((s_) == 1) { ra_ = max3f(ra_, n1[2], n1[3]); } \
            else if ((s_) == 2 || (s_) == 4 || (s_) == 6) { ra_ = max3f(ra_, n0[(2 * (s_)) & 15], n0[(2 * (s_) + 1) & 15]); rb_ = max3f(rb_, n0[(2 * (s_) + 2) & 15], n0[(2 * (s_) + 3) & 15]); } \
            else if ((s_) == 3 || (s_) == 5 || (s_) == 7) { ra_ = max3f(ra_, n1[(2 * (s_) - 2) & 15], n1[(2 * (s_) - 1) & 15]); rb_ = max3f(rb_, n1[(2 * (s_)) & 15], n1[(2 * (s_) + 1) & 15]); } \
            else if ((s_) == 8) { rm = fmaxf(ra_, rb_); auto rr_ = __builtin_amdgcn_permlane32_swap(__float_as_uint(rm), __float_as_uint(rm), false, false); rm = fmaxf(__uint_as_float(rr_[0]), __uint_as_float(rr_[1])); } } while (0)
#define ATT_SLOT(i_) do { if (DV == 128) { ATT_RMSTEP(i_); } else { ATT_RMSTEP(2 * (i_)); ATT_RMSTEP(2 * (i_) + 1); } __builtin_amdgcn_sched_barrier(0); } while (0)
#define ATT_PV(lo_, hh_, d0) do { \
            o[d0] = __builtin_amdgcn_mfma_f32_32x32x16_bf16(__builtin_bit_cast(bf16x8, pw0), ATT_PK(lo_, hh_, 0), o[d0], 0, 0, 0); ATT_SLOT(4 * (d0)); \
            o[d0] = __builtin_amdgcn_mfma_f32_32x32x16_bf16(__builtin_bit_cast(bf16x8, pw1), ATT_PK(lo_, hh_, 1), o[d0], 0, 0, 0); ATT_SLOT(4 * (d0) + 1); \
            o[d0] = __builtin_amdgcn_mfma_f32_32x32x16_bf16(__builtin_bit_cast(bf16x8, pw2), ATT_PK(lo_, hh_, 2), o[d0], 0, 0, 0); ATT_SLOT(4 * (d0) + 2); \
            o[d0] = __builtin_amdgcn_mfma_f32_32x32x16_bf16(__builtin_bit_cast(bf16x8, pw3), ATT_PK(lo_, hh_, 3), o[d0], 0, 0, 0); ATT_SLOT(4 * (d0) + 3); } while (0)
        ATT_VRD(loA, hhA, 0);
#pragma unroll
        for (int d0 = 0; d0 < DV / 32; d0 += 2) {
            ATT_VRD(loB, hhB, d0 + 1);
            asm volatile("s_waitcnt lgkmcnt(8)" ::: "memory"); __builtin_amdgcn_sched_barrier(0);
            ATT_PV(loA, hhA, d0);
            __builtin_amdgcn_sched_barrier(0);
            if (pre) ATT_DMA_V(t + 3, sl2, d0 >> 1);
            if (d0 + 2 < DV / 32) { ATT_VRD(loA, hhA, d0 + 2); asm volatile("s_waitcnt lgkmcnt(8)" ::: "memory"); }
            else asm volatile("s_waitcnt lgkmcnt(0)" ::: "memory");
            __builtin_amdgcn_sched_barrier(0);
            ATT_PV(loB, hhB, d0 + 1);
            __builtin_amdgcn_sched_barrier(0);
        }
#undef ATT_VRD
#undef ATT_PK
#undef ATT_PV
#undef ATT_SLOT
#undef ATT_RMSTEP
        if (t + 1 < NT && __any(rm > ATT_THR)) {
            const float dl = fmaxf(rm, 0.f), f = __builtin_amdgcn_exp2f(-dl);
            m += dl; lsum *= f; if (hi == 0) wsf[r32] = f;
#pragma unroll
            for (int r = 0; r < 16; ++r) { n0[r] -= dl; n1[r] -= dl; negm[r] = -m; }
            LDS_WAIT();
#pragma unroll
            for (int r = 0; r < 16; ++r) { const float fr_ = wsf[crow(r, hi)];
#pragma unroll
                for (int d = 0; d < DV / 32; ++d) o[d][r] *= fr_; }
        }
        p0 = n0; p1 = n1; sl = sl1;
    }
    asm volatile("s_waitcnt lgkmcnt(0)\n\ts_barrier" ::: "memory");
    { auto rr = __builtin_amdgcn_permlane32_swap(__float_as_uint(lsum), __float_as_uint(lsum), false, false); const float l = __uint_as_float(rr[0]) + __uint_as_float(rr[1]);
      if (hi == 0) wsf[r32] = l; LDS_WAIT();
#pragma unroll
      for (int r = 0; r < 16; ++r) osum[r] = wsf[crow(r, hi)];
      LDS_WAIT(); }
#undef ATT_KEYROW
#undef ATT_WAITV
#undef ATT_DMA
#undef ATT_QK
#undef ATT_ROWMAX
#undef ATT_NEEDMASK
#undef ATT_MASK
}

template <int DV>
__device__ __forceinline__ void normalize(f32x16 (&o)[DV / 32], const f32x16& osum) {
#pragma unroll
    for (int r = 0; r < 16; ++r) { const float rl = 1.0f / osum[r];
#pragma unroll
        for (int d = 0; d < DV / 32; ++d) o[d][r] *= rl; }
}
}
namespace hy {
constexpr int UPAD = 20 * 64;
constexpr int UROW = UPAD + 4096 * 2 + UPAD + 16;
constexpr int LDS_U = 0, LDS_R = 8 * UROW, LDS_R1 = LDS_R + 16384 + 64, LDS_BYTES = LDS_R1 + 16384;
static_assert(LDS_BYTES <= 131072 && UROW % 16 == 0, "hyena LDS");

__device__ __forceinline__ void conv_init(char* shm) {
    constexpr int Q = UPAD / 16;
    unsigned z_ = 0u; asm volatile("" : "+v"(z_));
    for (int i = threadIdx.x; i < 8 * 2 * Q; i += 512) { const int b = i / (2 * Q), r = i % (2 * Q), side = r / Q, q = r % Q;
        *(u32x4*)(shm + LDS_U + b * UROW + (side ? UPAD + 8192 : 0) + q * 16) = (u32x4){z_, z_, z_, z_}; }
}
__device__ __forceinline__ void conv_channel(char* shm, const bf16_t* zc, const bf16_t* Rc, bf16_t* outc) {
    int tid_ = threadIdx.x; asm volatile("" : "+v"(tid_));
    const int tid = tid_, lane = tid & 63, n = lane & 31, kg = lane >> 5; const int w = __builtin_amdgcn_readfirstlane(tid >> 6);
    asm volatile("s_waitcnt lgkmcnt(0)\n\ts_barrier" ::: "memory");
#pragma unroll
    for (int j = 0; j < 8; ++j) { const int id = tid + 512 * j, b = id >> 9, off = (id & 511) * 16; *(u32x4*)(shm + LDS_U + b * UROW + UPAD + off) = *(const u32x4*)((const char*)zc + (size_t)b * 8192 + off); }
#pragma unroll
    for (int j = 0; j < 2; ++j) { const int ci = tid + 512 * j, off = ci * 16; const u32x4 a = *(const u32x4*)((const char*)Rc + off);
        const unsigned e8 = ci < 1023 ? (unsigned)Rc[8 * ci + 8] : 0u;
        *(u32x4*)(shm + LDS_R + off) = a;
        u32x4 sft; sft.x = (a.x >> 16) | (a.y << 16); sft.y = (a.y >> 16) | (a.z << 16); sft.z = (a.z >> 16) | (a.w << 16); sft.w = (a.w >> 16) | (e8 << 16);
        *(u32x4*)(shm + LDS_R1 + off) = sft; }
    asm volatile("s_waitcnt vmcnt(0) lgkmcnt(0)\n\ts_barrier" ::: "memory");
    f32x16 acc[4];
#pragma unroll
    for (int k = 0; k < 4; ++k) acc[k] = f32x16{};
    const int bcol = n >> 2, il = n & 3;
    const LAS char* Abase = (const LAS char*)shm + ((n & 1) ? (LDS_R1 - 2) : LDS_R) + (4096 - n + 8 * kg) * 2;
    const LAS char* Ubase = (const LAS char*)shm + LDS_U + bcol * UROW + UPAD + kg * 16 + 64 * (16 * w + il);
    const int dlo = 16 * w - 127, dhi = 16 * w + 15;
#define HY_LDA(dst, d, sc) do { const volatile LAS unsigned* ap_ = (const volatile LAS unsigned*)(Abase + (16 * (sc) - 32 * (d)) * 2); u32x4 aw_; aw_.x = ap_[0]; aw_.y = ap_[1]; aw_.z = ap_[2]; aw_.w = ap_[3]; dst = __builtin_bit_cast(bf16x8, aw_); } while (0)
#define HY_LDB(dst, m, sc) dst = *(const LAS bf16x8*)(Ubase + 64 * (m) + 32 * (sc))
#pragma unroll 1
    for (int rho = 0; rho < 4; ++rho) {
        int d = dlo + rho;
        bf16x8 A0, A1, X0[5], X1[5];
        HY_LDA(A0, d, 0); HY_LDA(A1, d, 1);
#pragma unroll
        for (int k = 0; k < 4; ++k) { HY_LDB(X0[k], 4 * k - d, 0); HY_LDB(X1[k], 4 * k - d, 1); }
#define HY_STEP(s) { if (d > dhi) break; \
            bf16x8 nA0, nA1;                   \
            HY_LDA(nA0, d + 4, 0); HY_LDA(nA1, d + 4, 1); HY_LDB(X0[(4 - (s) + 5) % 5], -(d + 4), 0); HY_LDB(X1[(4 - (s) + 5) % 5], -(d + 4), 1); \
            _Pragma("unroll") for (int k = 0; k < 4; ++k) { acc[k] = __builtin_amdgcn_mfma_f32_32x32x16_bf16(A0, X0[(k - (s) + 5) % 5], acc[k], 0, 0, 0); acc[k] = __builtin_amdgcn_mfma_f32_32x32x16_bf16(A1, X1[(k - (s) + 5) % 5], acc[k], 0, 0, 0); } \
            A0 = nA0; A1 = nA1; d += 4; }
        for (;;) { HY_STEP(0) HY_STEP(1) HY_STEP(2) HY_STEP(3) HY_STEP(4) }
#undef HY_STEP
    }
#undef HY_LDA
#undef HY_LDB
#pragma unroll
    for (int k = 0; k < 4; ++k) { const int i = 16 * w + 4 * k + il; bf16_t* op = outc + (size_t)bcol * 4096 + 32 * i + 4 * kg;
#pragma unroll
        for (int g = 0; g < 4; ++g) { u32x2 v; v.x = cvtpk(acc[k][4 * g], acc[k][4 * g + 1]); v.y = cvtpk(acc[k][4 * g + 2], acc[k][4 * g + 3]); *(u32x2*)(op + 8 * g) = v; } }
}
}
constexpr int NWAVES = 8;
constexpr size_t MiB = 1u << 20;
constexpr size_t WS_CTL = 0, CTL_ZERO_BYTES = 1 * MiB;
constexpr size_t WS_MODS = 1 * MiB;
constexpr size_t WS_FCTX = 2 * MiB;
constexpr size_t WS_ZFEAT = 4 * MiB;
constexpr size_t WS_AFF = 9 * MiB;
constexpr size_t WS_SLOTOF = 12 * MiB;
constexpr size_t WS_GATE = 16 * MiB;
constexpr size_t WS_ZCTX = 17 * MiB;
constexpr size_t WS_XRES = 24 * MiB;
constexpr size_t WS_H = WS_XRES + 136 * MiB;
constexpr size_t WS_W = WS_H + 68 * MiB;
constexpr size_t WS_WIN = WS_W, WS_WBR = WS_WIN + 21 * MiB, WS_WOUT = WS_WBR + 6 * MiB, WS_W13 = WS_WOUT + 2 * MiB, WS_W2 = WS_W13 + 64 * MiB;
constexpr size_t WS_PROJ = WS_W2 + 32 * MiB;
static_assert(WS_PROJ == OFF_PROJ, "projection base");
constexpr size_t WS_DQ = OFF_DQ, WS_DK = OFF_DK, WS_DV = OFF_DV, WS_HY = OFF_HY, WS_SQ = OFF_SQ, WS_SK = OFF_SK, WS_SV = OFF_SV, WS_GT = OFF_GT;
constexpr size_t WS_END = WS_GT + 3 * SZ1K;
constexpr size_t WS_HRAW = WS_END;
constexpr size_t WS_TOTAL = WS_HRAW + 32 * MiB;
constexpr size_t WS_CONVT = WS_HY;
constexpr size_t WS_YHY = OFF_YHY;
constexpr size_t WS_MERGED = WS_DK;
constexpr size_t WS_XG = WS_HY;
constexpr size_t WS_HID = WS_GT;
static_assert(WS_YHY + SZ1K <= WS_SQ && WS_XG + (size_t)SLOTS * 2048 <= WS_SQ && WS_HID + (size_t)SLOTS * 2048 <= WS_END, "overlays");
constexpr size_t OUT_ZT = 0;
constexpr size_t OUT_FILT = 64 * MiB;
constexpr size_t OUT_STASH = 80 * MiB;
static_assert(OUT_STASH + 32 * MiB <= (size_t)NB * LS * D * 4, "d_out scratch");

constexpr int CW_TMO = 0, CW_CODE = 1, CW_CHK = 64, CW_BAR = 4096;

constexpr int RING_BYTES = 131072, LDSCTL_OFF = RING_BYTES, MISC_OFF = LDSCTL_OFF + 320, ROPE_OFF = LDSCTL_OFF + 1024  , LDS_BYTES = 147456;
static_assert(ROPE_OFF + 8192 <= LDS_BYTES, "LDS map");

#define XB_TMO      128
#define XB_XCNT(j)  (256  + 64 * (j))
#define XB_XSUB(j)  (1280 + 64 * (j))
#define XB_XGEN(j)  (2304 + 64 * (j))
#define XB_TOP      3328
#define XB_TOPGEN   3392
#define XCD_BAR_WORDS 3456
#define XB_SPIN_CAP (1u << 22)
__device__ __forceinline__ unsigned xb_ld(unsigned* p)              { return __hip_atomic_load(p, __ATOMIC_RELAXED, __HIP_MEMORY_SCOPE_AGENT); }
__device__ __forceinline__ unsigned xb_add(unsigned* p, unsigned v) { return __hip_atomic_fetch_add(p, v, __ATOMIC_RELAXED, __HIP_MEMORY_SCOPE_AGENT); }
__device__ __forceinline__ unsigned xb_xcc_id() { return (unsigned)__builtin_amdgcn_s_getreg((3 << 11) | 20) & 0xFu; }
#define XB_SPIN(cond, bar) do { unsigned _sp = 0; while (cond) { __builtin_amdgcn_s_sleep(1); \
    if ((++_sp & 255u) == 0u) { if (xb_ld(&(bar)[XB_TMO])) break; if (_sp > XB_SPIN_CAP) { atomicAdd(&(bar)[XB_TMO], 1u); break; } } } } while (0)
struct XcdBarrier { unsigned* bar; unsigned x; volatile LAS unsigned* st; };
__device__ __forceinline__ XcdBarrier xcd_barrier_post(unsigned* bar, volatile LAS unsigned* st) {
    XcdBarrier b; b.bar = bar; b.x = xb_xcc_id(); b.st = st;
    if (threadIdx.x == 0) (void)xb_add(&bar[XB_XCNT(b.x)], 1u);
    return b;
}
__device__ __forceinline__ void xcd_barrier_complete(unsigned* bar, unsigned x, unsigned& nloc, unsigned& nx) {
    const unsigned G = gridDim.x * gridDim.y * gridDim.z;
    unsigned sum, cnt, mine, sp = 0u;
    for (;;) {
        sum = 0u; cnt = 0u; mine = 0u;
#pragma unroll
        for (unsigned j = 0; j < 16; ++j) { const unsigned c = xb_ld(&bar[XB_XCNT(j)]); sum += c; cnt += (c > 0u) ? 1u : 0u; mine = (j == x) ? c : mine; }
        if (sum == G) break;
        __builtin_amdgcn_s_sleep(1);
        if ((++sp & 255u) == 0u) { if (xb_ld(&bar[XB_TMO])) break; if (sp > XB_SPIN_CAP) { atomicAdd(&bar[XB_TMO], 1u); break; } }
    }
    nloc = mine > 0u ? mine : 1u; nx = cnt > 0u ? cnt : 1u;
}
__device__ __forceinline__ void xcd_barrier(const XcdBarrier& b) {
    asm volatile("s_waitcnt vmcnt(0)" ::: "memory");
    __syncthreads();
    if (threadIdx.x == 0) {
        unsigned* bar = b.bar;
        __builtin_amdgcn_s_waitcnt(0);
        unsigned nloc = b.st[0], nx = b.st[1];
        if (nloc == 0u) { xcd_barrier_complete(bar, b.x, nloc, nx); b.st[0] = nloc; b.st[1] = nx; }
#ifdef XB_EARLY_WB
        __builtin_amdgcn_fence(__ATOMIC_RELEASE, "agent");
        asm volatile("s_waitcnt vmcnt(0)" ::: "memory");
#endif
        const unsigned old = xb_add(&bar[XB_XSUB(b.x)], 1u);
        const unsigned gen = old / nloc;
        if (old + 1u == (gen + 1u) * nloc) {
            __builtin_amdgcn_fence(__ATOMIC_RELEASE, "agent");
            asm volatile("s_waitcnt vmcnt(0)" ::: "memory");
            const unsigned og = xb_add(&bar[XB_TOP], 1u);
            const unsigned tg = og / nx;
            if (og + 1u == (tg + 1u) * nx) xb_add(&bar[XB_TOPGEN], 1u);
            else XB_SPIN(xb_ld(&bar[XB_TOPGEN]) == tg, bar);
            __builtin_amdgcn_fence(__ATOMIC_ACQUIRE, "agent");
            xb_add(&bar[XB_XGEN(b.x)], 1u);
            asm volatile("s_waitcnt vmcnt(0)" ::: "memory");
        } else {
            XB_SPIN(xb_ld(&bar[XB_XGEN(b.x)]) == gen, bar);
            __builtin_amdgcn_fence(__ATOMIC_ACQUIRE, "agent");
            asm volatile("s_waitcnt vmcnt(0)" ::: "memory");
        }
    }
    __syncthreads();
}

struct Args {
    const float* in[28]; float* out; unsigned char* ws; int ph_lo, ph_hi;
};
struct Frame {
    LAS unsigned char* lds; char* shm;
    int tid, lane, wave, G, bid;
    int dry;
    unsigned char* ws; unsigned char* outb;
};
enum { I_X = 0, I_C, I_CTX, I_CCTX, I_WMOD, I_BMOD, I_N1G, I_N2G, I_WIN, I_DLAM, I_SUBLN, I_HCW, I_HCB, I_FW1, I_FB1, I_FW2, I_FB2, I_FW3, I_FREQ, I_HBIAS, I_SINK, I_WBR, I_WOUT, I_ROUTER, I_W1, I_W3, I_W2, I_FINALG };
__device__ __forceinline__ void p0_mods_zfeat(Frame& F, const Args& a) {
    float* sc = (float*)F.shm;
    float* part = (float*)(F.shm + 9 * 1024 * 4);
    for (int i = F.tid; i < 9 * 1024; i += 512) { const int r = i >> 10, k = i & 1023; const float v = r < 8 ? a.in[I_C][r * 1024 + k] : a.in[I_CCTX][k]; sc[i] = v * sigmoidf_(v); }
    __syncthreads();
    float* mods = (float*)(F.ws + WS_MODS);
    for (int ch = F.bid; ch < 192; ch += F.G) {
        const int l = ch / 48, c0 = (ch % 48) * 128, col = F.tid & 127, kq = F.tid >> 7;
        const float* w = a.in[I_WMOD] + ((size_t)l * 1024 + kq * 256) * 6144 + c0 + col;
        float acc[9];
#pragma unroll
        for (int r = 0; r < 9; ++r) acc[r] = 0.f;
        for (int k = 0; k < 256; ++k) { const float wv = w[(size_t)k * 6144];
#pragma unroll
            for (int r = 0; r < 9; ++r) acc[r] += sc[r * 1024 + kq * 256 + k] * wv; }
#pragma unroll
        for (int r = 0; r < 9; ++r) part[(kq * 9 + r) * 128 + col] = acc[r];
        __syncthreads();
        for (int i = F.tid; i < 9 * 128; i += 512) { const int r = i >> 7, cc = i & 127;
            const float s = part[(0 * 9 + r) * 128 + cc] + part[(1 * 9 + r) * 128 + cc] + part[(2 * 9 + r) * 128 + cc] + part[(3 * 9 + r) * 128 + cc];
            mods[((size_t)l * 9 + r) * 6144 + c0 + cc] = s + a.in[I_BMOD][l * 6144 + c0 + cc]; }
        __syncthreads();
    }
    float* zf = (float*)(F.ws + WS_ZFEAT);
    const int gw = F.bid * NWAVES + F.wave, NGW = F.G * NWAVES;
    for (int it = gw; it < DEPTH * LT; it += NGW) {
        const int l = it / LT, row = it - l * LT; const int Lf = row < LS ? LS : LC, ii = row < LS ? row : row - LS;
        const float tt = (float)ii / (float)(Lf - 1);
        const float wrev = (float)ii / (float)Lf;
        const int j = F.lane & 15; const float fj = 1e-4f + (float)j * ((15.0f - 1e-4f) / 15.0f);
        const float cs = cos_rev(fj * wrev), sn = -sin_rev(fj * wrev);
        const float* w1 = a.in[I_FW1] + (size_t)l * 33 * 64; const float* w2 = a.in[I_FW2] + (size_t)l * 64 * 64;
        const float fq = a.in[I_FREQ][l * 64 + F.lane];
        float s = tt * w1[F.lane] + a.in[I_FB1][l * 64 + F.lane];
#pragma unroll
        for (int k = 0; k < 16; ++k) { s += __shfl(cs, k) * w1[(1 + k) * 64 + F.lane]; s += __shfl(sn, k) * w1[(17 + k) * 64 + F.lane]; }
        const float z1 = sin_rad(fq * s);
        float s2 = a.in[I_FB2][l * 64 + F.lane];
#pragma unroll 8
        for (int k = 0; k < 64; ++k) s2 += __shfl(z1, k) * w2[k * 64 + F.lane];
        zf[((size_t)l * 64 + F.lane) * LT + row] = sin_rad(fq * s2);
    }
}

__device__ __forceinline__ void transpose_item(const float* W, int K, int N, bf16_t* WT, int k0, int n0, int drow, LAS float* scr, int lane) {
#pragma unroll 8
    for (int i = 0; i < 32; ++i) { const int kk = 2 * i + (lane >> 5); scr[kk * 33 + (lane & 31)] = W[(size_t)(k0 + kk) * N + n0 + (lane & 31)]; }
    LDS_WAIT(); asm volatile("" ::: "memory");
    const int c = lane & 7;
#pragma unroll
    for (int j = 0; j < 4; ++j) { const int n = (lane >> 3) + 8 * j; const LAS float* s = scr + (8 * c) * 33 + n;
        u32x4 o; o.x = pk2(s[0 * 33], s[1 * 33]); o.y = pk2(s[2 * 33], s[3 * 33]); o.z = pk2(s[4 * 33], s[5 * 33]); o.w = pk2(s[6 * 33], s[7 * 33]);
        *(GAS u32x4*)(WT + (size_t)(drow + n) * K + k0 + 8 * c) = o; }
    LDS_WAIT(); asm volatile("" ::: "memory");
}
__device__ __forceinline__ void p1_weights(Frame& F, const Args& a, int l) {
    LAS float* scr = (LAS float*)(F.lds + F.wave * 8448);
    const int gw = F.bid * NWAVES + F.wave, NGW = F.G * NWAVES;
    constexpr int I_IN = 16 * 336, I_SQ = 16 * 32;
    constexpr int NITEMS = I_IN + 4 * I_SQ + 48 * I_SQ;
    bf16_t* WinT = (bf16_t*)(F.ws + WS_WIN); bf16_t* WbrT = (bf16_t*)(F.ws + WS_WBR); bf16_t* WoutT = (bf16_t*)(F.ws + WS_WOUT);
    bf16_t* W13T = (bf16_t*)(F.ws + WS_W13); bf16_t* W2T = (bf16_t*)(F.ws + WS_W2);
    for (int it = gw; it < NITEMS; it += NGW) {
        int r = it;
        if (r < I_IN) { const int kb = r / 336, nb = r % 336; transpose_item(a.in[I_WIN] + (size_t)l * 1024 * DIN, 1024, DIN, WinT, 64 * kb, 32 * nb, 32 * nb, scr, F.lane); continue; }
        r -= I_IN;
        const int mi = r / I_SQ, q = r % I_SQ, kb = q / 32, nb = q % 32, n0 = 32 * nb;
        if (mi < 3) { transpose_item(a.in[I_WBR] + ((size_t)l * 3 + mi) * 1048576, 1024, 1024, WbrT + (size_t)mi * 1048576, 64 * kb, n0, n0, scr, F.lane); continue; }
        if (mi == 3) { transpose_item(a.in[I_WOUT] + (size_t)l * 1048576, 1024, 1024, WoutT, 64 * kb, n0, n0, scr, F.lane); continue; }
        const int e = (mi - 4) / 3, which = (mi - 4) % 3; const size_t eo = ((size_t)l * 16 + e) * 1048576;
        if (which == 0) transpose_item(a.in[I_W1] + eo, 1024, 1024, W13T + (size_t)e * 2097152, 64 * kb, n0, (n0 >> 7) * 256 + (n0 & 127), scr, F.lane);
        else if (which == 1) transpose_item(a.in[I_W3] + eo, 1024, 1024, W13T + (size_t)e * 2097152, 64 * kb, n0, (n0 >> 7) * 256 + 128 + (n0 & 127), scr, F.lane);
        else transpose_item(a.in[I_W2] + eo, 1024, 1024, W2T + (size_t)e * 1048576, 64 * kb, n0, n0, scr, F.lane);
    }
}

__device__ __forceinline__ void p1_filters(Frame& F, const Args& a, int l) {
    float* w3s = (float*)(F.shm + 72 * 1024);
    float* red = w3s + 512;
    float* nrm = red + 32;
    const float* zf = (const float*)(F.ws + WS_ZFEAT) + (size_t)l * LT * 64;
    bf16_t* filtR = (bf16_t*)(F.outb + OUT_FILT); float* fctx = (float*)(F.ws + WS_FCTX);
    const float da = -15.350567286626973f, db = -3.0701134573253946f;
    for (int cg = F.bid; cg < 256; cg += F.G) {
        const int c0 = 4 * cg;
        __syncthreads();
        { const int k = F.tid >> 3, q = F.tid & 7; w3s[F.tid] = a.in[I_FW3][((size_t)l * 64 + k) * 2048 + (q >> 2) * 1024 + c0 + (q & 3)]; }
        __syncthreads();
        float delta[4];
#pragma unroll
        for (int cc = 0; cc < 4; ++cc) delta[cc] = fabsf(da + (float)(c0 + cc) * ((db - da) / 1023.0f));
        float asum[4] = {0.f, 0.f, 0.f, 0.f};
        f32x4* slab = (f32x4*)(F.ws + WS_HRAW) + ((size_t)F.bid * 4096 + 8 * F.tid) * 2;
        { float h[8][8];
#pragma unroll
          for (int j = 0; j < 8; ++j)
#pragma unroll
            for (int q = 0; q < 8; ++q) h[j][q] = 0.f;
          const float* zc = zf + 8 * F.tid;
#pragma unroll 2
          for (int k = 0; k < 64; ++k) { const f32x4 za = *(const f32x4*)(zc + (size_t)k * LT), zb = *(const f32x4*)(zc + (size_t)k * LT + 4);
              const f32x4 wa = *(const f32x4*)(w3s + k * 8), wb = *(const f32x4*)(w3s + k * 8 + 4);
#pragma unroll
              for (int j = 0; j < 8; ++j) { const float z = j < 4 ? za[j] : zb[j - 4];
#pragma unroll
                  for (int q = 0; q < 4; ++q) { h[j][q] += z * wa[q]; h[j][4 + q] += z * wb[q]; } } }
#pragma unroll
          for (int j = 0; j < 8; ++j) { const int i = 8 * F.tid + j; const float tt = (float)i / 4095.0f; f32x4 hf, hbk;
#pragma unroll
              for (int cc = 0; cc < 4; ++cc) { const float dec = fast_exp(-tt * delta[cc]); hf[cc] = h[j][cc] * dec; hbk[cc] = h[j][4 + cc] * dec; asum[cc] += fabsf(hf[cc]) + fabsf(hbk[cc]); }
              slab[2 * j] = hf; slab[2 * j + 1] = hbk; } }
#pragma unroll
        for (int cc = 0; cc < 4; ++cc) { const float s = wave_sum(asum[cc]); if (F.lane == 0) red[F.wave * 4 + cc] = s; }
        __syncthreads();
        if (F.tid < 4) { float s = 0.f; for (int w = 0; w < 8; ++w) s += red[w * 4 + F.tid]; nrm[F.tid] = 1.0f / (s + EPS); }
        __syncthreads();
        { bf16_t* img = (bf16_t*)F.shm;
          if (F.tid < 4) img[F.tid * 8192] = 0;
#pragma unroll 1
          for (int j = 0; j < 8; ++j) { const int i = 8 * F.tid + j; const f32x4 hf = slab[2 * j], hbk = slab[2 * j + 1];
#pragma unroll
              for (int cc = 0; cc < 4; ++cc) { const float inv = nrm[cc];
                  img[cc * 8192 + 4096 - i] = (bf16_t)f2bf(hf[cc] * inv);
                  if (i > 0) img[cc * 8192 + 4096 + i] = (bf16_t)f2bf(hbk[cc] * inv); } }
          __syncthreads();
          for (int q = F.tid; q < 4096; q += 512) *(u32x4*)(filtR + (size_t)c0 * 8192 + q * 8) = *(const u32x4*)(img + q * 8);
        }
        __syncthreads();
        float hc[8]; float cs4[4] = {0.f, 0.f, 0.f, 0.f};
        if (F.tid < 256) {
            const float* zr = zf + LS + F.tid;
#pragma unroll
            for (int q = 0; q < 8; ++q) hc[q] = 0.f;
            for (int k = 0; k < 64; ++k) { const float z = zr[(size_t)k * LT];
#pragma unroll
                for (int q = 0; q < 8; ++q) hc[q] += z * w3s[k * 8 + q]; }
            const float tt = (float)F.tid / 255.0f;
#pragma unroll
            for (int cc = 0; cc < 4; ++cc) { const float dec = fast_exp(-tt * delta[cc]); hc[cc] *= dec; hc[4 + cc] *= dec; cs4[cc] = fabsf(hc[cc]) + fabsf(hc[4 + cc]); }
        }
#pragma unroll
        for (int cc = 0; cc < 4; ++cc) { const float s = wave_sum(cs4[cc]); if (F.lane == 0) red[F.wave * 4 + cc] = s; }
        __syncthreads();
        if (F.tid < 4) { float s = 0.f; for (int w = 0; w < 8; ++w) s += red[w * 4 + F.tid]; nrm[F.tid] = 1.0f / (s + EPS); }
        __syncthreads();
        if (F.tid < 256) {
#pragma unroll
            for (int q = 0; q < 8; ++q) fctx[((size_t)(q >> 2) * 256 + F.tid) * 1024 + c0 + (q & 3)] = hc[q] * nrm[q & 3];
        }
    }
}

__device__ __forceinline__ int load_sov(Frame& F, int row) { return F.lane < 16 ? ((const int*)(F.ws + WS_SLOTOF))[(size_t)row * 16 + F.lane] : -1; }
__device__ __forceinline__ void combine_row(Frame& F, f32x4 (&v)[4], const int sov, const f32x4 (&m5q)[4]) {
    const bf16_t* ys = (const bf16_t*)(F.ws + WS_XG) + 4 * F.lane;
    unsigned mask = (unsigned)(__ballot(sov >= 0) & 0xffffull);
    f32x4 s[4];
#pragma unroll
    for (int j = 0; j < 4; ++j) s[j] = (f32x4){0.f, 0.f, 0.f, 0.f};
    while (mask) {
        const int e0 = __builtin_ctz(mask); mask &= mask - 1; const bool two = mask != 0u; int e1 = e0; if (two) { e1 = __builtin_ctz(mask); mask &= mask - 1; }
        const int s0 = __builtin_amdgcn_readlane(sov, e0), s1 = __builtin_amdgcn_readlane(sov, e1); const float w1 = two ? 1.f : 0.f;
        const bf16_t* y0 = ys + (size_t)s0 * 1024; const bf16_t* y1 = ys + (size_t)s1 * 1024;
        u32x2 a[4], b[4];
#pragma unroll
        for (int j = 0; j < 4; ++j) { a[j] = *(const u32x2*)(y0 + 256 * j); b[j] = *(const u32x2*)(y1 + 256 * j); }
#pragma unroll
        for (int j = 0; j < 4; ++j) { s[j][0] += bflo(a[j].x) + w1 * bflo(b[j].x); s[j][1] += bfhi(a[j].x) + w1 * bfhi(b[j].x); s[j][2] += bflo(a[j].y) + w1 * bflo(b[j].y); s[j][3] += bfhi(a[j].y) + w1 * bfhi(b[j].y); }
    }
#pragma unroll
    for (int j = 0; j < 4; ++j) v[j] += m5q[j] * s[j];
}
__device__ __forceinline__ void p1_norm1(Frame& F, const Args& a, int l) {
    const int gw = F.bid * NWAVES + F.wave, NGW = F.G * NWAVES;
    float* xres = (float*)(F.ws + WS_XRES); bf16_t* hb = (bf16_t*)(F.ws + WS_H);
    const float* mods = (const float*)(F.ws + WS_MODS);
    const float* g1 = a.in[I_N1G] + (size_t)l * 1024;
#define N1_SRC(row_) ((l == 0) ? (((row_) % LT) < LS ? a.in[I_X] + ((size_t)((row_) / LT) * LS + ((row_) % LT)) * 1024 : a.in[I_CTX] + ((size_t)((row_) / LT) * LC + (((row_) % LT) - LS)) * 1024) : xres + (size_t)(row_) * 1024)
    const int rpw = (TROWS + NGW - 1) / NGW, r0 = gw * rpw, r1 = r0 + rpw < TROWS ? r0 + rpw : TROWS;
    f32x4 gq[4], shq[4], sclq[4], m5q[4]; int mr_cur = -1;
#pragma unroll
    for (int j = 0; j < 4; ++j) { gq[j] = *(const f32x4*)(g1 + 4 * F.lane + 256 * j); m5q[j] = (f32x4){0.f, 0.f, 0.f, 0.f}; }
    f32x4 vn[4]; int sovn = -1;
    if (r0 < r1) { const float* src = N1_SRC(r0);
#pragma unroll
        for (int j = 0; j < 4; ++j) vn[j] = *(const f32x4*)(src + 4 * F.lane + 256 * j);
        if (l > 0) sovn = load_sov(F, r0); }
    for (int row = r0; row < r1; ++row) {
        const int b = row / LT, t = row - b * LT; const int mr = t < LS ? b : 8;
        if (mr != mr_cur) { mr_cur = mr; const float* mrow = mods + ((size_t)l * 9 + mr) * 6144;
#pragma unroll
            for (int j = 0; j < 4; ++j) { shq[j] = *(const f32x4*)(mrow + 4 * F.lane + 256 * j); sclq[j] = *(const f32x4*)(mrow + 1024 + 4 * F.lane + 256 * j) + 1.0f;
                if (l > 0) m5q[j] = *(const f32x4*)(mods + ((size_t)(l - 1) * 9 + mr) * 6144 + 5 * 1024 + 4 * F.lane + 256 * j); } }
        f32x4 v[4]; const int sov = sovn;
#pragma unroll
        for (int j = 0; j < 4; ++j) v[j] = vn[j];
        if (row + 1 < r1) { const float* src = N1_SRC(row + 1);
#pragma unroll
            for (int j = 0; j < 4; ++j) vn[j] = *(const f32x4*)(src + 4 * F.lane + 256 * j);
            if (l > 0) sovn = load_sov(F, row + 1); }
        if (l > 0) combine_row(F, v, sov, m5q);
        float ss = 0.f;
#pragma unroll
        for (int j = 0; j < 4; ++j) { if (!F.dry) *(f32x4*)(xres + (size_t)row * 1024 + 4 * F.lane + 256 * j) = v[j]; ss += (v[j][0] * v[j][0] + v[j][1] * v[j][1]) + (v[j][2] * v[j][2] + v[j][3] * v[j][3]); }
        const float rstd = 1.0f / sqrtf(wave_sum(ss) * (1.0f / 1024.0f) + EPS);
#pragma unroll
        for (int j = 0; j < 4; ++j) { const int c = 4 * F.lane + 256 * j;
            const f32x4 y = (v[j] * rstd * gq[j]) * sclq[j] + shq[j];
            u32x2 w; w.x = cvtpk(y[0], y[1]); w.y = cvtpk(y[2], y[3]); *(u32x2*)(hb + (size_t)row * 1024 + c) = w; }
    }
#undef N1_SRC
}
__device__ __forceinline__ void pf_final(Frame& F, const Args& a) {
    const int gw = F.bid * NWAVES + F.wave, NGW = F.G * NWAVES;
    const float* xres = (const float*)(F.ws + WS_XRES); const float* mods = (const float*)(F.ws + WS_MODS);
    const float* g = a.in[I_FINALG];
#define FN_ROW(r_) (((r_) / LS) * LT + ((r_) % LS))
    const int rpw = (NB * LS + NGW - 1) / NGW, r0 = gw * rpw, r1 = r0 + rpw < NB * LS ? r0 + rpw : NB * LS;
    f32x4 gq[4], m5q[4]; int b_cur = -1;
#pragma unroll
    for (int j = 0; j < 4; ++j) gq[j] = *(const f32x4*)(g + 4 * F.lane + 256 * j);
    f32x4 vn[4]; int sovn = -1;
    if (r0 < r1) { const int row = FN_ROW(r0);
#pragma unroll
        for (int j = 0; j < 4; ++j) vn[j] = *(const f32x4*)(xres + (size_t)row * 1024 + 4 * F.lane + 256 * j);
        sovn = load_sov(F, row); }
    for (int r = r0; r < r1; ++r) {
        const int b = r / LS;
        if (b != b_cur) { b_cur = b;
#pragma unroll
            for (int j = 0; j < 4; ++j) m5q[j] = *(const f32x4*)(mods + ((size_t)(DEPTH - 1) * 9 + b) * 6144 + 5 * 1024 + 4 * F.lane + 256 * j); }
        f32x4 v[4]; const int sov = sovn;
#pragma unroll
        for (int j = 0; j < 4; ++j) v[j] = vn[j];
        if (r + 1 < r1) { const int row = FN_ROW(r + 1);
#pragma unroll
            for (int j = 0; j < 4; ++j) vn[j] = *(const f32x4*)(xres + (size_t)row * 1024 + 4 * F.lane + 256 * j);
            sovn = load_sov(F, row); }
        combine_row(F, v, sov, m5q);
        float ss = 0.f;
#pragma unroll
        for (int j = 0; j < 4; ++j) ss += (v[j][0] * v[j][0] + v[j][1] * v[j][1]) + (v[j][2] * v[j][2] + v[j][3] * v[j][3]);
        const float rstd = 1.0f / sqrtf(wave_sum(ss) * (1.0f / 1024.0f) + EPS);
#pragma unroll
        for (int j = 0; j < 4; ++j) { const int c = 4 * F.lane + 256 * j; *(f32x4*)(a.out + (size_t)r * 1024 + c) = v[j] * rstd * gq[j]; }
    }
#undef FN_ROW
}
__device__ __forceinline__ void p3_rope(Frame& F) {
    float* cst = (float*)F.shm;
    float* snt = cst + 1024;
    for (int i = F.tid; i < 1024; i += 512) { const int pos = i >> 4, f = i & 15; const float inv = __builtin_amdgcn_exp2f(-(float)f * (13.287712379549449f / 16.0f));
        const float ang = (float)pos * inv, rev = ang * 0.15915494309189535f; cst[i] = cos_rev(rev); snt[i] = sin_rev(rev); }
    __syncthreads();
    bf16_t* dq = (bf16_t*)(F.ws + WS_DQ); bf16_t* dk = (bf16_t*)(F.ws + WS_DK); bf16_t* sq = (bf16_t*)(F.ws + WS_SQ); bf16_t* sk = (bf16_t*)(F.ws + WS_SK);
    const int gw = F.bid * NWAVES + F.wave, NGW = F.G * NWAVES;
    for (int row = gw; row < TROWS; row += NGW) {
        const int b = row / LT, t = row - b * LT; const bool lat = t < LS;
        for (int it = F.lane; it < 208; it += 64) {
            const int hs = it >> 2, ax = (it >> 1) & 1, fc = it & 1;
            bf16_t* base; float scl;
            if (hs < 16) { base = dq + (size_t)row * 1024 + hs * 64; scl = QSCALE; }
            else if (hs < 32) { base = dk + (size_t)row * 1024 + (hs - 16) * 64; scl = 1.f; }
            else if (hs < 48) { base = sq + (size_t)row * 1024 + (hs - 32) * 64; scl = QSCALE; }
            else { base = sk + (size_t)row * 256 + (hs - 48) * 64; scl = 1.f; }
            if (!lat && scl == 1.f) continue;
            bf16_t* p1 = base + ax * 32 + fc * 8; bf16_t* p2 = p1 + 16;
            const u32x4 a = *(const u32x4*)p1, c = *(const u32x4*)p2;
            float x1[8], x2[8];
#pragma unroll
            for (int j = 0; j < 4; ++j) { x1[2 * j] = bflo(a[j]); x1[2 * j + 1] = bfhi(a[j]); x2[2 * j] = bflo(c[j]); x2[2 * j + 1] = bfhi(c[j]); }
            float o1[8], o2[8];
            if (lat) { const int pos = ax == 0 ? (t >> 6) : (t & 63);
#pragma unroll
                for (int j = 0; j < 8; ++j) { const float cs = cst[pos * 16 + fc * 8 + j], sn = snt[pos * 16 + fc * 8 + j]; o1[j] = (x1[j] * cs - x2[j] * sn) * scl; o2[j] = (x2[j] * cs + x1[j] * sn) * scl; }
            } else {
#pragma unroll
                for (int j = 0; j < 8; ++j) { o1[j] = x1[j] * scl; o2[j] = x2[j] * scl; }
            }
            u32x4 w1, w2;
#pragma unroll
            for (int j = 0; j < 4; ++j) { w1[j] = cvtpk(o1[2 * j], o1[2 * j + 1]); w2[j] = cvtpk(o2[2 * j], o2[2 * j + 1]); }
            if (!F.dry) { *(u32x4*)p1 = w1; *(u32x4*)p2 = w2; }
        }
    }
}
struct PreTile { int b, t0, c0, Lseq, tbase; bool lat; };
__device__ __forceinline__ PreTile pre_tile(int tile) {
    constexpr int NT_L = NB * 64 * 16;
    PreTile T; T.lat = tile < NT_L;
    if (T.lat) { T.b = tile / 1024; const int r = tile % 1024; T.t0 = (r >> 4) * 64; T.c0 = (r & 15) * 64; T.Lseq = LS; T.tbase = 0; }
    else { const int q = tile - NT_L; T.b = q / 64; const int r = q % 64; T.t0 = (r >> 4) * 64; T.c0 = (r & 15) * 64; T.Lseq = LC; T.tbase = LS; }
    return T;
}
__device__ __forceinline__ void pre_load(const bf16_t* hyb, const PreTile& T, int tl, int cc, u32x4 (&x)[3][3]) {
    const int t = T.t0 + tl, c = T.c0 + cc; const size_t row = (size_t)T.b * LT + T.tbase + t;
#pragma unroll
    for (int g = 0; g < 3; ++g)
#pragma unroll
        for (int k = 0; k < 3; ++k) { const int ts = t + k - 1; x[g][k] = (u32x4){0u, 0u, 0u, 0u};
            if (ts >= 0 && ts < T.Lseq) x[g][k] = *(const u32x4*)(hyb + (row + k - 1) * 3072 + g * 1024 + c); }
}
__device__ __forceinline__ void p3_hyena_pre(Frame& F, const Args& a, int l) {
    const bf16_t* hyb = (const bf16_t*)(F.ws + WS_HY); bf16_t* x0c = (bf16_t*)(F.ws + WS_H); bf16_t* zT = (bf16_t*)(F.outb + OUT_ZT); bf16_t* zctx = (bf16_t*)(F.ws + WS_ZCTX);
    const float* cw = a.in[I_HCW] + (size_t)l * 3 * 3072; const float* cb = a.in[I_HCB] + (size_t)l * 3072;
    bf16_t* zt = (bf16_t*)(F.shm + 40960);
    constexpr int NTILES = NB * 64 * 16 + NB * 4 * 16;
    const int tl = F.tid >> 3, cc = (F.tid & 7) * 8;
    u32x4 xn[3][3];
    float wq[3][3][8], bq[3][8]; int cw_c = -1;
    if (F.bid < NTILES) { const PreTile T = pre_tile(F.bid); pre_load(hyb, T, tl, cc, xn); }
    for (int tile = F.bid; tile < NTILES; tile += F.G) {
        const PreTile T = pre_tile(tile);
        u32x4 x[3][3];
#pragma unroll
        for (int g = 0; g < 3; ++g)
#pragma unroll
            for (int k = 0; k < 3; ++k) x[g][k] = xn[g][k];
        if (tile + F.G < NTILES) { const PreTile Tn = pre_tile(tile + F.G); pre_load(hyb, Tn, tl, cc, xn); }
        const int t = T.t0 + tl, c = T.c0 + cc;
        const size_t row = (size_t)T.b * LT + T.tbase + t;
        if (c != cw_c) { cw_c = c;
#pragma unroll
            for (int g = 0; g < 3; ++g) { const int ch = g * 1024 + c;
                const f32x4 bb0 = *(const f32x4*)(cb + ch), bb1 = *(const f32x4*)(cb + ch + 4);
#pragma unroll
                for (int j = 0; j < 4; ++j) { bq[g][j] = bb0[j]; bq[g][4 + j] = bb1[j]; }
#pragma unroll
                for (int k = 0; k < 3; ++k) { const f32x4 w0 = *(const f32x4*)(cw + k * 3072 + ch), w1 = *(const f32x4*)(cw + k * 3072 + ch + 4);
#pragma unroll
                    for (int j = 0; j < 4; ++j) { wq[g][k][j] = w0[j]; wq[g][k][4 + j] = w1[j]; } } } }
        float u[3][8];
#pragma unroll
        for (int g = 0; g < 3; ++g) {
#pragma unroll
            for (int j = 0; j < 8; ++j) u[g][j] = bq[g][j];
#pragma unroll
            for (int k = 0; k < 3; ++k) { const u32x4 xv = x[g][k];
#pragma unroll
                for (int j = 0; j < 4; ++j) { u[g][2 * j] += bflo(xv[j]) * wq[g][k][2 * j]; u[g][2 * j + 1] += bfhi(xv[j]) * wq[g][k][2 * j + 1]; } }
        }
        u32x4 w;
#pragma unroll
        for (int j = 0; j < 4; ++j) w[j] = cvtpk(u[0][2 * j], u[0][2 * j + 1]);
        *(u32x4*)(x0c + row * 1024 + c) = w;
        float z[8];
#pragma unroll
        for (int j = 0; j < 8; ++j) z[j] = u[1][j] * u[2][j];
        if (!T.lat) {
#pragma unroll
            for (int j = 0; j < 4; ++j) w[j] = cvtpk(z[2 * j], z[2 * j + 1]);
            *(u32x4*)(zctx + ((size_t)T.b * LC + t) * 1024 + c) = w;
        } else {
            __syncthreads();
#pragma unroll
            for (int j = 0; j < 8; ++j) zt[(cc + j) * 72 + tl] = (bf16_t)f2bf(z[j]);
            __syncthreads();
            const int cr = F.tid >> 3, ch8 = (F.tid & 7) * 8;
            const u32x4 v = *(const u32x4*)(zt + cr * 72 + ch8);
            *(u32x4*)(zT + ((size_t)(T.c0 + cr) * NB + T.b) * LS + T.t0 + ch8) = v;
        }
    }
}
__device__ __forceinline__ void p5_hyena_post(Frame& F, const Args& a, int l) {
    const bf16_t* convT = (const bf16_t*)(F.ws + WS_CONVT); const bf16_t* zT = (const bf16_t*)(F.outb + OUT_ZT); const bf16_t* x0c = (const bf16_t*)(F.ws + WS_H); bf16_t* yhy = (bf16_t*)(F.ws + WS_YHY);
    const float* hb = a.in[I_HBIAS] + (size_t)l * 1024;
    float* tl_ = (float*)(F.shm + 49152);
    constexpr int NTILES = NB * 64 * 16;
    const int cr = F.tid >> 3, ch8 = (F.tid & 7) * 8, tl = F.tid >> 3, cc = (F.tid & 7) * 8;
#define P5_LOAD(tile_, cv_, zv_, xv_) do { const int b_ = (tile_) / 1024, r_ = (tile_) % 1024, t0_ = (r_ >> 4) * 64, c0_ = (r_ & 15) * 64; \
        const size_t off_ = ((size_t)(c0_ + cr) * NB + b_) * LS + t0_ + ch8; cv_ = *(const u32x4*)(convT + off_); zv_ = *(const u32x4*)(zT + off_); \
        xv_ = *(const u32x4*)(x0c + ((size_t)b_ * LT + t0_ + tl) * 1024 + c0_ + cc); } while (0)
    u32x4 cvn, zvn, xvn;
    if (F.bid < NTILES) P5_LOAD(F.bid, cvn, zvn, xvn);
    for (int tile = F.bid; tile < NTILES; tile += F.G) {
        const int b = tile / 1024, r = tile % 1024, t0 = (r >> 4) * 64, c0 = (r & 15) * 64;
        const u32x4 cv = cvn, zv = zvn, xv = xvn;
        if (tile + F.G < NTILES) P5_LOAD(tile + F.G, cvn, zvn, xvn);
        __syncthreads();
        { const float bias = hb[c0 + cr];
#pragma unroll
          for (int j = 0; j < 4; ++j) { tl_[cr * 65 + ch8 + 2 * j] = bflo(cv[j]) + bflo(zv[j]) * bias; tl_[cr * 65 + ch8 + 2 * j + 1] = bfhi(cv[j]) + bfhi(zv[j]) * bias; } }
        __syncthreads();
        const size_t row = (size_t)b * LT + t0 + tl;
        u32x4 w;
#pragma unroll
        for (int j = 0; j < 4; ++j) w[j] = cvtpk(bflo(xv[j]) * tl_[(cc + 2 * j) * 65 + tl], bfhi(xv[j]) * tl_[(cc + 2 * j + 1) * 65 + tl]);
        *(u32x4*)(yhy + row * 1024 + c0 + cc) = w;
    }
#undef P5_LOAD
}
__device__ __forceinline__ void p4_hyena_ctx(Frame& F, const Args& a, int l) {
    const bf16_t* zctx = (const bf16_t*)(F.ws + WS_ZCTX); const float* fctx = (const float*)(F.ws + WS_FCTX); const bf16_t* x0c = (const bf16_t*)(F.ws + WS_H); bf16_t* yhy = (bf16_t*)(F.ws + WS_YHY);
    const float* hb = a.in[I_HBIAS] + (size_t)l * 1024;
    float* g = (float*)F.shm;
    float* zs = g + 512 * 32;
    for (int it = F.bid; it < 256; it += F.G) {
        const int b = it >> 5, c0 = (it & 31) * 32, c = F.tid & 31, tg = F.tid >> 5, t0 = tg * 16;
        __syncthreads();
        for (int i = F.tid; i < 512 * 32; i += 512) { const int x = i >> 5, cc = i & 31, lag = x - 256;
            g[i] = x == 0 ? 0.f : (lag >= 0 ? fctx[(size_t)lag * 1024 + c0 + cc] : fctx[(size_t)(256 - lag) * 1024 + c0 + cc]); }
        for (int i = F.tid; i < 256 * 32; i += 512) { const int s = i >> 5, cc = i & 31; zs[i] = bf2f(zctx[((size_t)b * LC + s) * 1024 + c0 + cc]); }
        __syncthreads();
        float acc[16];
#pragma unroll
        for (int j = 0; j < 16; ++j) acc[j] = 0.f;
#pragma unroll 1
        for (int sb = 0; sb < 8; ++sb) { const int s0 = 32 * sb;
            float fw[47], zv[32];
#pragma unroll
            for (int k = 0; k < 47; ++k) fw[k] = g[(t0 - s0 + 225 + k) * 32 + c];
#pragma unroll
            for (int si = 0; si < 32; ++si) zv[si] = zs[(s0 + si) * 32 + c];
#pragma unroll
            for (int si = 0; si < 32; ++si)
#pragma unroll
                for (int j = 0; j < 16; ++j) acc[j] += fw[j - si + 31] * zv[si];
        }
        const float bias = hb[c0 + c];
#pragma unroll
        for (int j = 0; j < 16; ++j) { const size_t row = (size_t)b * LT + LS + t0 + j;
            yhy[row * 1024 + c0 + c] = (bf16_t)f2bf(bf2f(x0c[row * 1024 + c0 + c]) * (acc[j] + zs[(t0 + j) * 32 + c] * bias)); }
    }
}
__device__ __forceinline__ void p4_hyena_lat(Frame& F) {
    const bf16_t* zT = (const bf16_t*)(F.outb + OUT_ZT); const bf16_t* filtR = (const bf16_t*)(F.outb + OUT_FILT); bf16_t* convT = (bf16_t*)(F.ws + WS_CONVT);
    hy::conv_init(F.shm);
    for (int c = F.bid; c < 1024; c += F.G) hy::conv_channel(F.shm, zT + (size_t)c * NB * LS, filtR + (size_t)c * 8192, convT + (size_t)c * NB * LS);
    asm volatile("s_waitcnt lgkmcnt(0)\n\ts_barrier" ::: "memory");
}

__device__ __forceinline__ void diff_unit(Frame& F, const Args& a, int l, int b, int h, int qrow, bool isctx, float lam, float lam_init) {
    bf16_t* dq = (bf16_t*)(F.ws + WS_DQ); const bf16_t* dk = (const bf16_t*)(F.ws + WS_DK); const bf16_t* dv = (const bf16_t*)(F.ws + WS_DV);
    f32x4* stash = (f32x4*)(F.outb + OUT_STASH) + (size_t)F.bid * 16 * 512 + F.tid;
    const int lane = F.lane, r32 = lane & 31, hi = lane >> 5;
    const size_t brow = (size_t)b * LT;
    f32x16 o[4], lf;
#pragma unroll 1
    for (int m = 0; m < 2; ++m) {
        att::Pass P;
        P.Qw = dq + (brow + qrow + F.wave * 32) * 1024 + h * 128 + m * 64; P.ldq = 1024;
        P.Kb = dk + brow * 1024 + h * 128 + m * 64; P.ldk = 1024;
        P.Vb = dv + brow * 1024 + h * 128; P.ldv = 1024;
        if (isctx) { P.nA = 0; P.ks = 0; P.nC = 4; } else { P.nA = LT / 64; P.ks = 0; P.nC = 0; }
        P.band = 0; P.qpos = qrow + F.wave * 32; P.m0 = -INFINITY; P.l0 = 0.f; P.rope = isctx ? 0 : 1; P.rtab = (const LAS float*)(F.lds + ROPE_OFF);
        att::flash_pass<128>(F.shm, P, o, lf);
        att::normalize<128>(o, lf);
        if (m == 0) {
            unsigned long long spa = (unsigned long long)stash; asm volatile("" : "+v"(spa)); GAS f32x4* sp = (GAS f32x4*)spa;
#pragma unroll
            for (int d = 0; d < 4; ++d)
#pragma unroll
                for (int g = 0; g < 4; ++g) sp[(d * 4 + g) * 512] = (f32x4){o[d][4 * g], o[d][4 * g + 1], o[d][4 * g + 2], o[d][4 * g + 3]};
        }
    }
    float ss[16];
#pragma unroll
    for (int r = 0; r < 16; ++r) ss[r] = 0.f;
    { unsigned long long spa = (unsigned long long)stash; asm volatile("" : "+v"(spa)); const GAS f32x4* sp = (const GAS f32x4*)spa;
#pragma unroll
      for (int d = 0; d < 4; ++d)
#pragma unroll
        for (int g = 0; g < 4; ++g) { const f32x4 o0 = sp[(d * 4 + g) * 512];
#pragma unroll
            for (int j = 0; j < 4; ++j) { const float y = o0[j] - lam * o[d][4 * g + j]; o[d][4 * g + j] = y; ss[4 * g + j] += y * y; } } }
#pragma unroll
    for (int r = 0; r < 16; ++r) { float s = ss[r];
#pragma unroll
        for (int off = 1; off < 32; off <<= 1) s += __shfl_xor(s, off);
        ss[r] = 1.0f / sqrtf(s * (1.0f / 128.0f) + EPS) * (1.0f - lam_init); }
    const float* sg = a.in[I_SUBLN] + (size_t)l * 128;
    { int ln_ = threadIdx.x & 63; asm volatile("" : "+v"(ln_)); const int r32 = ln_ & 31, hi = ln_ >> 5, lane = ln_;
      LAS bf16_t* stg = (LAS bf16_t*)F.lds + F.wave * 4096;
#pragma unroll
      for (int d = 0; d < 4; ++d) { const float g = sg[32 * d + r32];
#pragma unroll
        for (int r = 0; r < 16; ++r) stg[att::crow(r, hi) * 128 + 32 * d + r32] = (bf16_t)f2bf(o[d][r] * ss[r] * g); }
      LDS_WAIT();
      unsigned long long yba = (unsigned long long)(dq + (brow + qrow + F.wave * 32) * 1024 + h * 128); asm volatile("" : "+v"(yba)); GAS bf16_t* yb = (GAS bf16_t*)yba;
#pragma unroll
      for (int i = 0; i < 8; ++i) { const int row = i * 4 + (lane >> 4), ch = lane & 15; const u32x4 v = *(const LAS u32x4*)(stg + row * 128 + ch * 8); if (!F.dry) *(GAS u32x4*)(yb + row * 1024 + ch * 8) = v; }
      asm volatile("s_waitcnt lgkmcnt(0)\n\ts_barrier" ::: "memory"); }
}
__device__ __forceinline__ void p4_diff(Frame& F, const Args& a, int l, bool ctx_out) {
    const float* lp = a.in[I_DLAM] + (size_t)l * 256;
    const float d01 = wave_sum(lp[F.lane] * lp[64 + F.lane]), d23 = wave_sum(lp[128 + F.lane] * lp[192 + F.lane]);
    const float lam_init = 0.8f - 0.6f * expf(-0.3f * (float)l);
    const float lam = __uint_as_float(__builtin_amdgcn_readfirstlane(__float_as_uint(expf(d01) - expf(d23) + lam_init)));
    const int nun = NB * 8 * 16 + (ctx_out ? NB * 8 : 0);
    const int vcu = (F.G % 8 == 0) ? (F.bid % 8) * (F.G / 8) + F.bid / 8 : F.bid;
    for (int u = vcu; u < nun; u += F.G) {
        if (u < NB * 8 * 16) { const int b = u >> 7, h = (u >> 4) & 7, qb = u & 15; diff_unit(F, a, l, b, h, qb * 256, false, lam, lam_init); }
        else { const int v = u - NB * 8 * 16; diff_unit(F, a, l, v >> 3, v & 7, LS, true, lam, lam_init); }
    }
}
__device__ __forceinline__ void swa_unit(Frame& F, const Args& a, int l, int b, int kvh, int qrow, bool isctx) {
    bf16_t* sq = (bf16_t*)(F.ws + WS_SQ); const bf16_t* sk = (const bf16_t*)(F.ws + WS_SK); const bf16_t* sv = (const bf16_t*)(F.ws + WS_SV);
    const int lane = F.lane, r32 = lane & 31, hi = lane >> 5; const size_t brow = (size_t)b * LT; const int qh = kvh * 4 + (F.wave & 3), rh = F.wave >> 2;
    att::Pass P;
    P.Qw = sq + (brow + qrow + rh * 32) * 1024 + qh * 64; P.ldq = 1024;
    P.Kb = sk + brow * 256 + kvh * 64; P.ldk = 256; P.Vb = sv + brow * 256 + kvh * 64; P.ldv = 256;
    if (isctx) { P.nA = 0; P.ks = 0; P.nC = 4; P.band = 0; }
    else { const int ks = qrow >= 128 ? qrow - 128 : 0, ke = qrow + 192 <= LS ? qrow + 192 : LS; P.ks = ks; P.nA = (ke - ks) >> 6; P.nC = 4; P.band = 1; }
    P.qpos = (isctx ? 0 : qrow) + rh * 32; P.m0 = a.in[I_SINK][l * 16 + qh] * LOG2E; P.l0 = 1.0f; P.rope = isctx ? 0 : 1; P.rtab = (const LAS float*)(F.lds + ROPE_OFF);
    f32x16 o[2], lf;
    att::flash_pass<64>(F.shm, P, o, lf);
    att::normalize<64>(o, lf);
    { int ln_ = threadIdx.x & 63; asm volatile("" : "+v"(ln_)); const int r32 = ln_ & 31, hi = ln_ >> 5, lane = ln_;
      LAS bf16_t* stg = (LAS bf16_t*)F.lds + F.wave * 2048;
#pragma unroll
      for (int d = 0; d < 2; ++d)
#pragma unroll
        for (int r = 0; r < 16; ++r) stg[att::crow(r, hi) * 64 + 32 * d + r32] = (bf16_t)f2bf(o[d][r]);
      LDS_WAIT();
      unsigned long long yba = (unsigned long long)(sq + (brow + qrow + rh * 32) * 1024 + qh * 64); asm volatile("" : "+v"(yba)); GAS bf16_t* yb = (GAS bf16_t*)yba;
#pragma unroll
      for (int i = 0; i < 4; ++i) { const int row = i * 8 + (lane >> 3), ch = lane & 7; const u32x4 v = *(const LAS u32x4*)(stg + row * 64 + ch * 8); if (!F.dry) *(GAS u32x4*)(yb + row * 1024 + ch * 8) = v; }
      asm volatile("s_waitcnt lgkmcnt(0)\n\ts_barrier" ::: "memory"); }
}
__device__ __forceinline__ void p4_swa(Frame& F, const Args& a, int l, bool ctx_out) {
    const int nun = NB * 4 * 64 + (ctx_out ? NB * 4 * 4 : 0);
    const int vcu0 = (F.G % 8 == 0) ? (F.bid % 8) * (F.G / 8) + F.bid / 8 : F.bid;
    const int vcu = F.G - 1 - vcu0;
    for (int u = vcu; u < nun; u += F.G) {
        if (u < NB * 4 * 64) { const int b = u >> 8, kvh = (u >> 6) & 3, qb = u & 63; swa_unit(F, a, l, b, kvh, qb * 64, false); }
        else { const int v = u - NB * 4 * 64; swa_unit(F, a, l, v >> 4, (v >> 2) & 3, LS + (v & 3) * 64, true); }
    }
}
__device__ __forceinline__ void p8_norm2_router(Frame& F, const Args& a, int l) {
    float* rwT = (float*)F.shm;
    const float* rw = a.in[I_ROUTER] + (size_t)l * 1024 * 16;
    for (int i = F.tid; i < 16384; i += 512) { const int k = i >> 4, e = i & 15; rwT[e * 1024 + k] = rw[i]; }
    __syncthreads();
    const int gw = F.bid * NWAVES + F.wave, NGW = F.G * NWAVES;
    const float* xres = (const float*)(F.ws + WS_XRES); bf16_t* hb = (bf16_t*)(F.ws + WS_H); float* aff = (float*)(F.ws + WS_AFF);
    const float* mods = (const float*)(F.ws + WS_MODS); const float* g2 = a.in[I_N2G] + (size_t)l * 1024;
    constexpr int RPW = (TROWS + 2047) / 2048;
    const int rpw = (TROWS + NGW - 1) / NGW, r0 = gw * rpw, r1 = r0 + rpw < TROWS ? r0 + rpw : TROWS; (void)RPW;
    f32x4 gq[4], shq[4], sclq[4]; int mr_cur = -1;
#pragma unroll
    for (int j = 0; j < 4; ++j) gq[j] = *(const f32x4*)(g2 + 4 * F.lane + 256 * j);
    f32x4 vn[4];
    if (r0 < r1) {
#pragma unroll
        for (int j = 0; j < 4; ++j) vn[j] = *(const f32x4*)(xres + (size_t)r0 * 1024 + 4 * F.lane + 256 * j); }
    for (int row = r0; row < r1; ++row) {
        asm volatile("" ::: "memory");
        const int b = row / LT, t = row - b * LT; const int mr = t < LS ? b : 8;
        if (mr != mr_cur) { mr_cur = mr; const float* mrow = mods + ((size_t)l * 9 + mr) * 6144;
#pragma unroll
            for (int j = 0; j < 4; ++j) { shq[j] = *(const f32x4*)(mrow + 3 * 1024 + 4 * F.lane + 256 * j); sclq[j] = *(const f32x4*)(mrow + 4 * 1024 + 4 * F.lane + 256 * j) + 1.0f; } }
        f32x4 v[4]; float ss = 0.f;
#pragma unroll
        for (int j = 0; j < 4; ++j) { v[j] = vn[j]; ss += (v[j][0] * v[j][0] + v[j][1] * v[j][1]) + (v[j][2] * v[j][2] + v[j][3] * v[j][3]); }
        if (row + 1 < r1) {
#pragma unroll
            for (int j = 0; j < 4; ++j) vn[j] = *(const f32x4*)(xres + (size_t)(row + 1) * 1024 + 4 * F.lane + 256 * j); }
        const float rstd = 1.0f / sqrtf(wave_sum(ss) * (1.0f / 1024.0f) + EPS);
#pragma unroll
        for (int j = 0; j < 4; ++j) { const int c = 4 * F.lane + 256 * j;
            v[j] = (v[j] * rstd * gq[j]) * sclq[j] + shq[j];
            u32x2 w; w.x = cvtpk(v[j][0], v[j][1]); w.y = cvtpk(v[j][2], v[j][3]); *(u32x2*)(hb + (size_t)row * 1024 + c) = w; }
        float lg[16];
#pragma unroll
        for (int e = 0; e < 16; ++e) { float s = 0.f;
#pragma unroll
            for (int j = 0; j < 4; ++j) { const f32x4 w = *(const f32x4*)(rwT + e * 1024 + 4 * F.lane + 256 * j); s += (v[j][0] * w[0] + v[j][1] * w[1]) + (v[j][2] * w[2] + v[j][3] * w[3]); }
            lg[e] = wave_sum(s); }
        float mx = lg[0];
#pragma unroll
        for (int e = 1; e < 16; ++e) mx = fmaxf(mx, lg[e]);
        float den = 0.f;
#pragma unroll
        for (int e = 0; e < 16; ++e) { lg[e] = __expf(lg[e] - mx); den += lg[e]; }
        const float inv = 1.0f / den;
        float mine = 0.f;
#pragma unroll
        for (int e = 0; e < 16; ++e) mine = (F.lane == e) ? lg[e] * inv : mine;
        if (F.lane < 16) aff[(size_t)row * 16 + F.lane] = mine;
    }
}
__device__ __forceinline__ void p9_topk_gather(Frame& F) {
    unsigned* hist = (unsigned*)F.shm;
    unsigned* sh = hist + 256;
    int* rowlist = (int*)(sh + 32);
    const float* aff = (const float*)(F.ws + WS_AFF); int* slotof = (int*)(F.ws + WS_SLOTOF); float* gate = (float*)(F.ws + WS_GATE);
    const bf16_t* hb = (const bf16_t*)(F.ws + WS_H); bf16_t* xg = (bf16_t*)(F.ws + WS_XG);
    for (int item = F.bid; item < 256; item += F.G) {
        const int q = item >> 1, part = item & 1, b = q >> 4, e = q & 15;
#pragma unroll 1
        for (int cx = 0; cx < 2; ++cx) {
            const bool isctx = cx == 1;
            const int N = isctx ? LC : LS, cap = N / 8, per = isctx ? 1 : 8;
            const int rbase = b * LT + (isctx ? LS : 0);
            const bool act = isctx ? (F.tid < 256) : true;
            unsigned key[8];
#pragma unroll
            for (int j = 0; j < 8; ++j) { key[j] = 0u; if (act && j < per) key[j] = __float_as_uint(aff[(size_t)(rbase + F.tid * per + j) * 16 + e]); }
            unsigned prefix = 0u, krem = (unsigned)cap;
#pragma unroll 1
            for (int pass = 3; pass >= 0; --pass) {
                const int shft = pass * 8; const unsigned himask = pass == 3 ? 0u : (0xffffffffu << (shft + 8));
                __syncthreads();
                if (F.tid < 256) hist[F.tid] = 0u;
                __syncthreads();
#pragma unroll
                for (int j = 0; j < 8; ++j) if (act && j < per && (key[j] & himask) == prefix) atomicAdd(&hist[(key[j] >> shft) & 255u], 1u);
                __syncthreads();
                if (F.wave == 0) {
                    const unsigned h0 = hist[4 * F.lane], h1 = hist[4 * F.lane + 1], h2 = hist[4 * F.lane + 2], h3 = hist[4 * F.lane + 3];
                    const unsigned own = h0 + h1 + h2 + h3; unsigned inc = own;
#pragma unroll
                    for (int off = 1; off < 64; off <<= 1) { const unsigned o = __shfl_down(inc, off); if (F.lane + off < 64) inc += o; }
                    const unsigned S = inc - own;
                    if (S < krem && krem <= S + own) {
                        unsigned cum = S; int bin;
                        if (cum + h3 >= krem) bin = 3; else { cum += h3; if (cum + h2 >= krem) bin = 2; else { cum += h2; if (cum + h1 >= krem) bin = 1; else { cum += h1; bin = 0; } } }
                        sh[0] = prefix | ((unsigned)(4 * F.lane + bin) << shft); sh[1] = krem - cum;
                    }
                }
                __syncthreads();
                prefix = sh[0]; krem = sh[1];
            }
            unsigned cg = 0u, ce = 0u;
#pragma unroll
            for (int j = 0; j < 8; ++j) if (act && j < per) { cg += key[j] > prefix ? 1u : 0u; ce += key[j] == prefix ? 1u : 0u; }
            unsigned pk = cg | (ce << 16), inc = pk;
#pragma unroll
            for (int off = 1; off < 64; off <<= 1) { const unsigned o = __shfl_up(inc, off); if (F.lane >= off) inc += o; }
            __syncthreads();
            if (F.lane == 63) sh[16 + F.wave] = inc;
            __syncthreads();
            unsigned base = 0u;
            for (int w = 0; w < F.wave; ++w) base += sh[16 + w];
            unsigned ex = base + inc - pk; unsigned gb = ex & 0xffffu, eb = ex >> 16;
            const int sbase = isctx ? SLOT_L + (e * NB + b) * CAP_C : (e * NB + b) * CAP_L;
#pragma unroll
            for (int j = 0; j < 8; ++j) if (act && j < per) {
                const int row = rbase + F.tid * per + j; int slot = -1;
                if (key[j] > prefix) { slot = (int)(gb + (eb < krem ? eb : krem)); gb++; }
                else if (key[j] == prefix) { if (eb < krem) slot = (int)(gb + eb); eb++; }
                if (slot >= 0) { rowlist[slot] = row; if (part == 0) gate[sbase + slot] = __uint_as_float(key[j]); slot += sbase; }
                if (part == 0) slotof[(size_t)row * 16 + e] = slot;
            }
            __syncthreads();
            const int hcap = cap >> 1;
            for (int s0 = part * hcap + 4 * F.wave; s0 < (part + 1) * hcap; s0 += 4 * NWAVES) {
                u32x4 d[4][2];
#pragma unroll
                for (int i = 0; i < 4; ++i) { const u32x4* src = (const u32x4*)(hb + (size_t)rowlist[s0 + i] * 1024) + F.lane; d[i][0] = src[0]; d[i][1] = src[64]; }
#pragma unroll
                for (int i = 0; i < 4; ++i) { u32x4* dst = (u32x4*)(xg + (size_t)(sbase + s0 + i) * 1024) + F.lane; dst[0] = d[i][0]; dst[64] = d[i][1]; }
            }
        }
    }
}
constexpr int PPL = 12;
constexpr int NPHASE = 1 + DEPTH * PPL + 1;

__device__ __forceinline__ void phase_stagger(int nunits, int G, int c, int unit_ticks) {
#ifndef MK_NOSTAGGER
    const int rem = nunits % G;
    if (rem == 0 || c < rem) return;
    const int g = ((c - rem) >> 3) % 3 + 1;
    const unsigned long long t0 = __builtin_amdgcn_s_memrealtime(); const unsigned long long d = (unsigned long long)(g * unit_ticks / 4);
    while (__builtin_amdgcn_s_memrealtime() - t0 < d) __builtin_amdgcn_s_sleep(8);
#endif
}

__global__ void __launch_bounds__(NWAVES * 64, 2) mk_fwd(Args args) {
    extern __shared__ __attribute__((aligned(16))) unsigned char lds[];
    Frame F;
    F.lds = (LAS unsigned char*)lds; F.shm = (char*)lds;
    F.tid = threadIdx.x; F.lane = F.tid & 63; F.wave = __builtin_amdgcn_readfirstlane(F.tid >> 6);
    F.G = gridDim.x; F.bid = blockIdx.x; F.ws = args.ws; F.outb = (unsigned char*)args.out; F.dry = 0;
    volatile LAS unsigned* MISC = (volatile LAS unsigned*)(F.lds + MISC_OFF);
    for (int u = F.tid; u < (LDS_BYTES - LDSCTL_OFF) / 4; u += NWAVES * 64) ((LAS unsigned*)(F.lds + LDSCTL_OFF))[u] = 0u;
    __syncthreads();
    { LAS float* rt_ = (LAS float*)(F.lds + ROPE_OFF);
      for (int i = F.tid; i < 1024; i += NWAVES * 64) { const int pos = i >> 4, f = i & 15; const float inv = __builtin_amdgcn_exp2f(-(float)f * (13.287712379549449f / 16.0f));
          const float rev = (float)pos * inv * 0.15915494309189535f; rt_[i] = cos_rev(rev); rt_[1024 + i] = sin_rev(rev); } }
    __syncthreads();
    unsigned* ctl = (unsigned*)(F.ws + WS_CTL);
    const int lo = args.ph_lo, hi = args.ph_hi;
    XcdBarrier bar; bar.bar = ctl + CW_BAR; bar.x = 0; bar.st = nullptr;
    if (hi - lo > 1) bar = xcd_barrier_post(ctl + CW_BAR, MISC + 8);
#ifdef MK_ONLY
#define PHON(j) ((j) == MK_ONLY)
#else
#define PHON(j) true
#endif
#define IN(k) (lo <= (k) && (k) < hi)
#ifndef MK_DUP
#define MK_DUP 0
#endif
#define NREP(bit) (((MK_DUP >> (bit)) & 1) ? 2 : 1)
#define REP(bit) _Pragma("unroll 1") for (int rep = 0; rep < NREP(bit); ++rep)
#define REPEND(bit) do { if (rep + 1 < NREP(bit)) xcd_barrier(bar); } while (0)
#define DRY(bit) (rep + 1 < NREP(bit))
#define LOCALF Frame Fp = F; Fp.tid = threadIdx.x; asm volatile("" : "+v"(Fp.tid)); Fp.lane = Fp.tid & 63
#define SEAM(k) do { if (IN((k) + 1)) xcd_barrier(bar); } while (0)
#define STAMP(k) do { } while (0)

    if (PHON(100) && IN(0)) { STAMP(0); REP(12) { LOCALF; p0_mods_zfeat(Fp, args); REPEND(12); } SEAM(0); }

    for (int l = 0; l < DEPTH; ++l) {
        const int pb = 1 + l * PPL;
        const float* mods_l = (const float*)(F.ws + WS_MODS) + (size_t)l * 9 * 6144;
        const int lastl = l == DEPTH - 1;
        if (PHON(0) && IN(pb + 0)) { STAMP(pb + 0);
#ifndef MK_SUB0
#define MK_SUB0 7
#endif
            REP(0) { LOCALF; Fp.dry = DRY(0);
            if (MK_SUB0 & 1) { p1_weights(Fp, args, l); __syncthreads(); }
            if (MK_SUB0 & 2) { p1_filters(Fp, args, l); __syncthreads(); }
            if (MK_SUB0 & 4) { p1_norm1(Fp, args, l); }
            REPEND(0); }
            SEAM(pb + 0); }
        if (PHON(1) && IN(pb + 1)) { STAMP(pb + 1);
            pg8::SchedPlain S; S.init((const bf16_t*)(F.ws + WS_H), (const bf16_t*)(F.ws + WS_WIN), TROWS, DIN, 1024, F.G, F.bid);
            pg8::EpiProj E; E.ws = F.ws; E.rope = (const LAS float*)(F.lds + ROPE_OFF);
            REP(1) { E.dry = DRY(1); pg8::gemm_phase<pg8::EpiProj, pg8::SchedPlain>(F.lds, 1024, S, E); REPEND(1); }
            SEAM(pb + 1);
        }
        if (PHON(2) && IN(pb + 2)) { STAMP(pb + 2); REP(2) { LOCALF; Fp.dry = DRY(2); p3_hyena_pre(Fp, args, l); REPEND(2); } SEAM(pb + 2); }
        if (PHON(3) && IN(pb + 3)) { STAMP(pb + 3);
#ifndef MK_SUB
#define MK_SUB 15
#endif
            if (MK_SUB & 1) { REP(3) { LOCALF; Fp.dry = DRY(3); p4_diff(Fp, args, l, !lastl); __syncthreads(); REPEND(3); } }
            if (MK_SUB & 2) { REP(4) { LOCALF; Fp.dry = DRY(4); p4_swa(Fp, args, l, !lastl); __syncthreads(); REPEND(4); } }
            REP(5) { if (MK_SUB & 4) { LOCALF; p4_hyena_lat(Fp); __syncthreads(); }
            if ((MK_SUB & 8) && !lastl) { LOCALF; p4_hyena_ctx(Fp, args, l); } REPEND(5); }
            SEAM(pb + 3); }
        if (PHON(4) && IN(pb + 4)) { STAMP(pb + 4); REP(6) { LOCALF; p5_hyena_post(Fp, args, l); REPEND(6); } SEAM(pb + 4); }
        if (PHON(5) && IN(pb + 5)) { STAMP(pb + 5);
            pg8::SchedBranch S; S.latonly = lastl; S.T.init(lastl ? NB * 16 : TROWS / 256, 4); S.G = F.G; S.c = F.bid; S.ws = (const char*)F.ws;
            S.B = (const char*)(F.ws + WS_WBR); S.tstep = (size_t)256 * 1024 * 2; S.bstep = (size_t)1024 * 1024 * 2;
            pg8::EpiBranch E; E.ws = F.ws; static_assert(WS_MERGED == OFF_DK && WS_GT == OFF_GT, "branch epilogue offsets");
            REP(7) { pg8::gemm_phase<pg8::EpiBranch, pg8::SchedBranch>(F.lds, 1024, S, E); REPEND(7); }
            SEAM(pb + 5);
        }
        if (PHON(6) && IN(pb + 6)) { STAMP(pb + 6);
            pg8::SchedPlain S; S.init((const bf16_t*)(F.ws + WS_MERGED), (const bf16_t*)(F.ws + WS_WOUT), TROWS, 1024, 1024, F.G, F.bid, lastl);
            pg8::EpiResid E; E.xres = (float*)(F.ws + WS_XRES); E.mod = mods_l;
            REP(8) { E.dry = DRY(8); pg8::gemm_phase<pg8::EpiResid, pg8::SchedPlain>(F.lds, 1024, S, E); REPEND(8); }
            SEAM(pb + 6);
        }
        if (PHON(7) && IN(pb + 7)) { STAMP(pb + 7); REP(9) { LOCALF; p8_norm2_router(Fp, args, l); REPEND(9); } SEAM(pb + 7); }
        if (PHON(8) && IN(pb + 8)) { STAMP(pb + 8); REP(14) { LOCALF; p9_topk_gather(Fp); REPEND(14); } SEAM(pb + 8); }
        if (PHON(9) && IN(pb + 9)) { STAMP(pb + 9); }
        if (PHON(10) && IN(pb + 10)) { STAMP(pb + 10);
            pg8::SchedMoe S; S.T.init(lastl ? SLOT_L / 256 : SLOTS / 256, 8); S.G = F.G; S.c = F.bid; S.A = (const char*)(F.ws + WS_XG); S.B = (const char*)(F.ws + WS_W13); S.tstep = (size_t)256 * 1024 * 2; S.estep = (size_t)2048 * 1024 * 2;
            pg8::EpiSwiglu E; E.hid = (bf16_t*)(F.ws + WS_HID);
            REP(10) { pg8::gemm_phase<pg8::EpiSwiglu, pg8::SchedMoe>(F.lds, 1024, S, E); REPEND(10); }
            SEAM(pb + 10);
        }
        if (PHON(11) && IN(pb + 11)) { STAMP(pb + 11);
            pg8::SchedMoe S; S.T.init(lastl ? SLOT_L / 256 : SLOTS / 256, 4); S.G = F.G; S.c = F.bid; S.A = (const char*)(F.ws + WS_HID); S.B = (const char*)(F.ws + WS_W2); S.tstep = (size_t)256 * 1024 * 2; S.estep = (size_t)1024 * 1024 * 2;
            pg8::EpiRowScale E; E.out = (bf16_t*)(F.ws + WS_XG); E.gate = (const float*)(F.ws + WS_GATE);
            REP(11) { pg8::gemm_phase<pg8::EpiRowScale, pg8::SchedMoe>(F.lds, 1024, S, E); REPEND(11); }
            SEAM(pb + 11);
        }
    }
    if (PHON(101) && IN(NPHASE - 1)) { STAMP(NPHASE - 1); REP(13) { LOCALF; pf_final(Fp, args); REPEND(13); }
    }
#undef IN
#undef SEAM
}

extern "C" void kernel_launch(void* const* d_in, const int* in_sizes, int n_in, void* d_out, int out_size, void* d_ws, size_t ws_size, hipStream_t stream) {
    static int grid = 0;
    if (grid == 0) {
        if (n_in != 28 || out_size != NB * LS * D || ws_size < WS_TOTAL) { fprintf(stderr, "kernel_launch: unexpected shapes (n_in %d out %d ws %zu need %zu)\n", n_in, out_size, ws_size, (size_t)WS_TOTAL); grid = -1; return; }
        int dev = 0, cus = 0, per_cu = 0;
        if (hipGetDevice(&dev) != hipSuccess || hipDeviceGetAttribute(&cus, hipDeviceAttributeMultiprocessorCount, dev) != hipSuccess) { grid = -1; return; }
        if (hipFuncSetAttribute((const void*)mk_fwd, hipFuncAttributeMaxDynamicSharedMemorySize, LDS_BYTES) != hipSuccess) { fprintf(stderr, "kernel_launch: hipFuncSetAttribute failed\n"); grid = -1; return; }
        if (hipOccupancyMaxActiveBlocksPerMultiprocessor(&per_cu, (const void*)mk_fwd, NWAVES * 64, LDS_BYTES) != hipSuccess || per_cu < 1) { fprintf(stderr, "kernel_launch: occupancy query says %d\n", per_cu); }
        (void)hipGetLastError();
        grid = cus;
    }
    if (grid < 0) return;
    if (hipMemsetAsync((char*)d_ws + WS_CTL, 0, CTL_ZERO_BYTES, stream) != hipSuccess) return;
    Args a{};
    for (int i = 0; i < 28; ++i) a.in[i] = (const float*)d_in[i];
    a.out = (float*)d_out; a.ws = (unsigned char*)d_ws;
#if MK_N_LAUNCHES == 1
    a.ph_lo = 0; a.ph_hi = NPHASE;
    hipLaunchKernelGGL(mk_fwd, dim3(grid), dim3(NWAVES * 64), LDS_BYTES, stream, a);
#else
    for (int p = 0; p < NPHASE; ++p) { a.ph_lo = p; a.ph_hi = p + 1; hipLaunchKernelGGL(mk_fwd, dim3(grid), dim3(NWAVES * 64), LDS_BYTES, stream, a); }
#endif
}
```

```cpp
#include <hip/hip_runtime.h>
#include <cstdio>
#include <cstdint>
#include <type_traits>

#ifndef MK_N_LAUNCHES
#define MK_N_LAUNCHES 1
#endif

#define LAS __attribute__((address_space(3)))
#define GAS __attribute__((address_space(1)))
typedef unsigned short bf16_t;
typedef short bf16x8 __attribute__((ext_vector_type(8)));
typedef short s16x4 __attribute__((ext_vector_type(4)));
typedef float f32x2 __attribute__((ext_vector_type(2)));
typedef float f32x4 __attribute__((ext_vector_type(4)));
typedef float f32x16 __attribute__((ext_vector_type(16)));
typedef unsigned u32x2 __attribute__((ext_vector_type(2)));
typedef unsigned u32x4 __attribute__((ext_vector_type(4)));
typedef GAS unsigned gu32;
#define RLX_AGENT __ATOMIC_RELAXED, __HIP_MEMORY_SCOPE_AGENT
#define LDS_WAIT() asm volatile("s_waitcnt lgkmcnt(0)" ::: "memory")
#define VM_WAIT() asm volatile("s_waitcnt vmcnt(0)" ::: "memory")

constexpr int NB = 8, LS = 4096, LC = 256, LT = LS + LC;
constexpr int TROWS = NB * LT;
constexpr int D = 1024, DIN = 10752, DEPTH = 4, NEXP = 16;
constexpr int CAP_L = 512, CAP_C = 32;
constexpr int SLOT_L = NEXP * NB * CAP_L, SLOT_C = NEXP * NB * CAP_C, SLOTS = SLOT_L + SLOT_C;
constexpr float EPS = 1e-6f;
constexpr float LOG2E = 1.4426950408889634f;
constexpr float QSCALE = 0.125f * LOG2E;

__device__ __forceinline__ unsigned f2bf(float f) { unsigned u = __builtin_bit_cast(unsigned, f); return (u + 0x7fffu + ((u >> 16) & 1u)) >> 16; }
__device__ __forceinline__ unsigned pk2(float lo, float hi) { return f2bf(lo) | (f2bf(hi) << 16); }
__device__ __forceinline__ float bf2f(unsigned v) { return __builtin_bit_cast(float, v << 16); }
__device__ __forceinline__ float bflo(unsigned w) { return __builtin_bit_cast(float, w << 16); }
__device__ __forceinline__ float bfhi(unsigned w) { return __builtin_bit_cast(float, w & 0xffff0000u); }
typedef __bf16 bf16x2_t __attribute__((ext_vector_type(2)));
__device__ __forceinline__ unsigned cvtpk(float lo, float hi) { f32x2 v = {lo, hi}; bf16x2_t b = __builtin_convertvector(v, bf16x2_t); return __builtin_bit_cast(unsigned, b); }
__device__ __forceinline__ float wave_sum(float v) {
    v += __builtin_bit_cast(float, __builtin_amdgcn_update_dpp(0, __builtin_bit_cast(int, v), 0x128, 0xf, 0xf, false));
    v += __builtin_bit_cast(float, __builtin_amdgcn_update_dpp(0, __builtin_bit_cast(int, v), 0x124, 0xf, 0xf, false));
    v += __builtin_bit_cast(float, __builtin_amdgcn_update_dpp(0, __builtin_bit_cast(int, v), 0x122, 0xf, 0xf, false));
    v += __builtin_bit_cast(float, __builtin_amdgcn_update_dpp(0, __builtin_bit_cast(int, v), 0x121, 0xf, 0xf, false));
    { const auto r = __builtin_amdgcn_permlane16_swap(__float_as_uint(v), __float_as_uint(v), false, false); v = __uint_as_float(r[0]) + __uint_as_float(r[1]); }
    { const auto r = __builtin_amdgcn_permlane32_swap(__float_as_uint(v), __float_as_uint(v), false, false); v = __uint_as_float(r[0]) + __uint_as_float(r[1]); }
    return v;
}
__device__ __forceinline__ float sin_rev(float rev) { return __builtin_amdgcn_sinf(__builtin_amdgcn_fractf(rev)); }
__device__ __forceinline__ float cos_rev(float rev) { return __builtin_amdgcn_cosf(__builtin_amdgcn_fractf(rev)); }
__device__ __forceinline__ float sin_rad(float x) { return sin_rev(x * 0.15915494309189535f); }
__device__ __forceinline__ float fast_exp(float x) { return __builtin_amdgcn_exp2f(x * LOG2E); }
__device__ __forceinline__ float sigmoidf_(float x) { return __builtin_amdgcn_rcpf(1.0f + fast_exp(-x)); }

constexpr size_t SZ1K = (size_t)TROWS * 1024 * 2;
constexpr size_t OFF_PROJ = (size_t)353 << 20;
constexpr size_t OFF_DQ = OFF_PROJ, OFF_DK = OFF_DQ + SZ1K, OFF_DV = OFF_DK + SZ1K, OFF_HY = OFF_DV + SZ1K, OFF_SQ = OFF_HY + 3 * SZ1K, OFF_SK = OFF_SQ + SZ1K, OFF_SV = OFF_SK + SZ1K / 4, OFF_GT = OFF_SV + SZ1K / 4;
constexpr size_t OFF_YHY = OFF_HY + ((size_t)64 << 20);

namespace pg8 {
constexpr int BM = 256, BK = 64, HALF = 128, HTB = HALF * BK * 2, STAGE_BYTES = 8 * HTB, NXCD = 8, WGM = 8;
__host__ __device__ __forceinline__ int lds_byte(int r, int c) { const int st = (r >> 4) * 2 + (c >> 5), rr = r & 15, cc = c & 31, ob = rr * 64 + cc * 2; return st * 1024 + (ob ^ (((ob >> 9) & 1) << 5)); }
__host__ __device__ __forceinline__ void stage_rc(int b, int& R, int& C) { const int st = b / 1024, sb = b % 1024, swz = sb ^ (((sb >> 9) & 1) << 5); R = (st >> 1) * 16 + swz / 64; C = (st & 1) * 32 + (swz % 64) / 2; }
__host__ __device__ __forceinline__ int perm32(int rho) { const int n = rho >> 4, i = rho & 15; return 8 * (i >> 2) + 4 * n + (i & 3); }

struct Unit { int pm, pn, aux; const char* A; const char* B; };

struct TileOrder {
    int nM, nN, nwg;
    __device__ __forceinline__ void init(int nM_, int nN_) { nM = nM_; nN = nN_; nwg = nM * nN; }
    __device__ __forceinline__ void map(int L, int& pm, int& pn) const {
        int wgid = L; { const int q = nwg / NXCD, r = nwg % NXCD, xcd = wgid % NXCD, off = wgid / NXCD; wgid = (xcd < r ? xcd * (q + 1) : r * (q + 1) + (xcd - r) * q) + off; }
        const int nig = WGM * nN, gid = wgid / nig, fm = gid * WGM, gsz = (nM - fm) < WGM ? (nM - fm) : WGM;
        pm = fm + ((wgid % nig) % gsz); pn = (wgid % nig) / gsz;
    }
};

template <class E_, class = void> struct EpiFull { static constexpr bool value = false; };
template <class E_> struct EpiFull<E_, decltype((void)E_::FULL)> { static constexpr bool value = E_::FULL; };
template <class Epi, class Sched>
__device__ __forceinline__ void gemm_phase(LAS unsigned char* lds, const int K, const Sched& S, const Epi& E) {
    int tid_ = threadIdx.x; asm volatile("" : "+v"(tid_));
    const int tid = tid_, wid = __builtin_amdgcn_readfirstlane(tid >> 6), lane = tid & 63, wr = wid >> 2, wc = wid & 3, fr = lane & 15, fq = lane >> 4;
    const int nt = K / BK;
    unsigned voffA[2], voffB[2];
    constexpr bool FULL = EpiFull<Epi>::value;
#pragma unroll
    for (int i = 0; i < 2; ++i) { int R, C; stage_rc(tid * 16 + i * 8192, R, C); const int Rb = Epi::PERM ? ((FULL ? (R >> 5) * 64 : (R & ~31)) + perm32(R & 31)) : R;
        voffA[i] = (unsigned)(R * K + C) * 2u; voffB[i] = (unsigned)(Rb * K + C) * 2u; }
    const size_t kstep = (size_t)(BK * 2);
    const size_t hstep = (size_t)HALF * K * 2;
    const size_t hstepB = FULL ? (size_t)32 * K * 2 : hstep;
    const unsigned ldsw = (unsigned)wid * 1024u;
    const int aoff = lds_byte(wr * 64 + fr, fq * 8), boff = lds_byte(wc * 32 + fr, fq * 8);
#define PG8_SA(b, h) (((b) * 2 + (h)) * HTB)
#define PG8_SB(b, h) ((4 + (b) * 2 + (h)) * HTB)
#define PG8_STAGE(bufoff, gbase, voff) do { _Pragma("unroll") for (int _i = 0; _i < 2; ++_i) \
        __builtin_amdgcn_global_load_lds((const unsigned*)((const char*)(gbase) + (voff)[_i]), (LAS unsigned*)(lds + (bufoff) + ldsw + _i * 8192), 16, 0, 0); } while (0)
#define PG8_LDA(dst, b, h) do { _Pragma("unroll") for (int m = 0; m < 4; ++m) _Pragma("unroll") for (int k = 0; k < 2; ++k) dst[m][k] = *(const LAS bf16x8*)(lds + PG8_SA(b, h) + aoff + m * 2048 + k * 1024); } while (0)
#define PG8_LDB(dst, b, h) do { _Pragma("unroll") for (int n = 0; n < 2; ++n) _Pragma("unroll") for (int k = 0; k < 2; ++k) dst[n][k] = *(const LAS bf16x8*)(lds + PG8_SB(b, h) + boff + n * 2048 + k * 1024); } while (0)
#define PG8_MMA(ai, bj, At, Bt) do { __builtin_amdgcn_s_setprio(1); _Pragma("unroll") for (int m = 0; m < 4; ++m) _Pragma("unroll") for (int n = 0; n < 2; ++n) _Pragma("unroll") for (int k = 0; k < 2; ++k) \
        acc[ai][bj][m][n] = __builtin_amdgcn_mfma_f32_16x16x32_bf16(Bt[n][k], At[m][k], acc[ai][bj][m][n], 0, 0, 0); __builtin_amdgcn_s_setprio(0); } while (0)
#define PG8_WAIT_V(n) asm volatile("s_waitcnt vmcnt(" #n ")" ::: "memory")
#define PG8_WAIT_L(n) asm volatile("s_waitcnt lgkmcnt(" #n ")" ::: "memory")
#define PG8_BAR __builtin_amdgcn_s_barrier()
#define PG8_SCHED __builtin_amdgcn_sched_barrier(0)
    Unit cur, nxt; int ui = 0;
    if (!S.next(0, cur)) return;
    f32x4 acc[2][2][4][2];
#pragma unroll
    for (int a = 0; a < 2; ++a)
#pragma unroll
        for (int b = 0; b < 2; ++b)
#pragma unroll
            for (int m = 0; m < 4; ++m)
#pragma unroll
                for (int n = 0; n < 2; ++n) acc[a][b][m][n] = (f32x4){0.f, 0.f, 0.f, 0.f};
    bf16x8 At[4][2], B0[2][2], B1[2][2];
    const char* cA = cur.A; const char* cB = cur.B;
    PG8_STAGE(PG8_SB(0, 0), cB, voffB); PG8_STAGE(PG8_SB(0, 1), cB + hstepB, voffB); PG8_STAGE(PG8_SA(0, 0), cA, voffA); PG8_STAGE(PG8_SA(0, 1), cA + hstep, voffA);
    if (wr == 1) PG8_BAR;
    PG8_WAIT_V(2); PG8_BAR;
    PG8_STAGE(PG8_SB(1, 0), cB + kstep, voffB); PG8_STAGE(PG8_SA(1, 0), cA + kstep, voffA); PG8_STAGE(PG8_SB(1, 1), cB + hstepB + kstep, voffB);
    PG8_WAIT_V(6); PG8_BAR;
    for (;;) {
        const bool has_next = S.next(ui + 1, nxt);
        const char* nA = has_next ? nxt.A : cA; const char* nB = has_next ? nxt.B : cB;
        for (int t = 0; t < nt; t += 2) {
            const bool last = (t == nt - 2);
            const char* a1 = cA + (size_t)(t + 1) * kstep;
            const char* a2 = last ? nA : cA + (size_t)(t + 2) * kstep; const char* b2 = last ? nB : cB + (size_t)(t + 2) * kstep;
            const char* a3 = a2 + kstep; const char* b3 = b2 + kstep;
            PG8_LDB(B0, 0, 0); PG8_LDB(B1, 0, 1); PG8_SCHED; PG8_LDA(At, 0, 0); PG8_STAGE(PG8_SA(1, 1), a1 + hstep, voffA);
            PG8_WAIT_V(8); PG8_WAIT_L(0); PG8_BAR; PG8_MMA(0, 0, At, B0); PG8_MMA(0, 1, At, B1); PG8_BAR; PG8_SCHED;
            PG8_LDA(At, 0, 1); PG8_STAGE(PG8_SB(0, 0), b2, voffB); PG8_STAGE(PG8_SB(0, 1), b2 + hstepB, voffB); PG8_STAGE(PG8_SA(0, 0), a2, voffA);
            PG8_WAIT_V(8); PG8_WAIT_L(0); PG8_BAR; PG8_MMA(1, 0, At, B0); PG8_MMA(1, 1, At, B1); PG8_BAR; PG8_SCHED;
            PG8_LDB(B0, 1, 0); PG8_LDB(B1, 1, 1); PG8_SCHED; PG8_LDA(At, 1, 0); PG8_STAGE(PG8_SA(0, 1), a2 + hstep, voffA);
            PG8_WAIT_V(8); PG8_WAIT_L(0); PG8_BAR; PG8_MMA(0, 0, At, B0); PG8_MMA(0, 1, At, B1); PG8_BAR; PG8_SCHED;
            PG8_LDA(At, 1, 1); PG8_STAGE(PG8_SB(1, 0), b3, voffB); PG8_STAGE(PG8_SB(1, 1), b3 + hstepB, voffB); PG8_STAGE(PG8_SA(1, 0), a3, voffA);
            PG8_WAIT_V(8); PG8_WAIT_L(0); PG8_BAR; PG8_MMA(1, 0, At, B0); PG8_MMA(1, 1, At, B1); PG8_BAR; PG8_SCHED;
        }
#ifndef PG8_NOALIGN
        if (wr == 0) PG8_BAR;
#else
        if (wr == 0 && !has_next) PG8_BAR;
#endif
        E(acc, cur, wr, wc, fr, fq);
        if (!has_next) break;
        if (!E.keep(cur)) {
#pragma unroll
            for (int a = 0; a < 2; ++a)
#pragma unroll
                for (int b = 0; b < 2; ++b)
#pragma unroll
                    for (int m = 0; m < 4; ++m)
#pragma unroll
                        for (int n = 0; n < 2; ++n) acc[a][b][m][n] = (f32x4){0.f, 0.f, 0.f, 0.f};
        }
        cur = nxt; cA = nA; cB = nB; ++ui;
#ifndef PG8_NOALIGN
        if (wr == 1) PG8_BAR;
#endif
    }
    PG8_WAIT_V(0);
    PG8_BAR;
#undef PG8_SA
#undef PG8_SB
#undef PG8_STAGE
#undef PG8_LDA
#undef PG8_LDB
#undef PG8_MMA
#undef PG8_WAIT_V
#undef PG8_WAIT_L
#undef PG8_BAR
#undef PG8_SCHED
}
}
namespace pg8 {

struct SchedPlain {
    TileOrder T; int G, c; const char* A; const char* B; size_t tstep; int latonly;
    __device__ __forceinline__ void init(const bf16_t* A_, const bf16_t* B_, int M, int N, int K, int G_, int c_, int latonly_ = 0) { latonly = latonly_; T.init(latonly_ ? NB * 16 : M / BM, N / BM); G = G_; c = c_; A = (const char*)A_; B = (const char*)B_; tstep = (size_t)BM * K * 2; }
    __device__ __forceinline__ bool next(int i, Unit& u) const {
        const long L = (long)i * G + c; if (L >= T.nwg) return false;
        T.map((int)L, u.pm, u.pn); if (latonly) u.pm = (u.pm >> 4) * 17 + (u.pm & 15); u.aux = 0; u.A = A + (size_t)u.pm * tstep; u.B = B + (size_t)u.pn * tstep; return true;
    }
};

struct EpiProj {
    static constexpr bool PERM = true;
    static constexpr bool FULL = true;
    unsigned char* ws;
    const LAS float* rope;
    int dry = 0;
    __device__ __forceinline__ bool keep(const Unit&) const { return false; }
    static __device__ __forceinline__ void trade(const u32x4& w0, const u32x4& w1, u32x4& X, u32x4& Y) {
#pragma unroll
        for (int j = 0; j < 4; ++j) {
            X[j] = (unsigned)__builtin_amdgcn_update_dpp((int)w0[j], (int)w1[j], 0x128, 0xf, 0xc, false);
            Y[j] = (unsigned)__builtin_amdgcn_update_dpp((int)w1[j], (int)w0[j], 0x128, 0xf, 0x3, false); }
    }
    __device__ __forceinline__ void operator()(f32x4 (&acc)[2][2][4][2], const Unit& u, int wr, int wc, int fr, int fq) const {
        if (dry) return;
        const int pn = u.pn; int t0, ldc; size_t boff; bool roped = false; float scl = 1.0f;
        if (pn < 4) { boff = OFF_DQ; t0 = 0; ldc = 1024; }                           else if (pn < 8) { boff = OFF_DK; t0 = 4; ldc = 1024; roped = true; } else if (pn < 12) { boff = OFF_DV; t0 = 8; ldc = 1024; }
        else if (pn < 24) { boff = OFF_HY; t0 = 12; ldc = 3072; } else if (pn < 28) { boff = OFF_SQ; t0 = 24; ldc = 1024; } else if (pn < 29) { boff = OFF_SK; t0 = 28; ldc = 256; roped = true; }
        else if (pn < 30) { boff = OFF_SV; t0 = 29; ldc = 256; } else { boff = OFF_GT; t0 = 30; ldc = 3072; }
        bf16_t* base = (bf16_t*)(ws + boff);
        const int row0 = u.pm * BM + wr * 64 + (fr & 7), col0 = (pn - t0) * BM + wc * 64 + 32 * (fr >> 3) + 8 * fq;
        const int tb = (u.pm % 17) * BM;
        const bool lat = tb < LS;
        if (roped) {
            const int half = fq >> 1, f0 = 8 * (fq & 1);
#pragma unroll
            for (int ai = 0; ai < 2; ++ai)
#pragma unroll
                for (int m = 0; m < 4; ++m) {
                    const int t = tb + wr * 64 + fr + ai * HALF + m * 16;
                    u32x4 wv[2];
#pragma unroll
                    for (int bj = 0; bj < 2; ++bj) { const int pos = bj == 0 ? (t >> 6) : (t & 63);
                        f32x4 c0 = (f32x4){1.f, 1.f, 1.f, 1.f}, c1 = c0, s0 = (f32x4){0.f, 0.f, 0.f, 0.f}, s1 = s0;
                        if (lat) { const LAS float* cp = rope + pos * 16 + f0; c0 = *(const LAS f32x4*)cp; c1 = *(const LAS f32x4*)(cp + 4); s0 = *(const LAS f32x4*)(cp + 1024); s1 = *(const LAS f32x4*)(cp + 1028); }
                        if (half == 0) { s0 = -s0; s1 = -s1; }
                        const f32x4 v0 = acc[ai][bj][m][0], v1 = acc[ai][bj][m][1];
                        f32x4 q0, q1;
#pragma unroll
                        for (int j = 0; j < 4; ++j) {
                            const auto r0 = __builtin_amdgcn_permlane32_swap(__float_as_uint(v0[j]), __float_as_uint(v0[j]), false, false);
                            const auto r1 = __builtin_amdgcn_permlane32_swap(__float_as_uint(v1[j]), __float_as_uint(v1[j]), false, false);
                            q0[j] = __uint_as_float(half == 0 ? r0[1] : r0[0]); q1[j] = __uint_as_float(half == 0 ? r1[1] : r1[0]); }
                        const f32x4 o0 = (v0 * c0 + q0 * s0) * scl, o1 = (v1 * c1 + q1 * s1) * scl;
                        wv[bj].x = cvtpk(o0[0], o0[1]); wv[bj].y = cvtpk(o0[2], o0[3]); wv[bj].z = cvtpk(o1[0], o1[1]); wv[bj].w = cvtpk(o1[2], o1[3]); }
                    u32x4 X, Y; trade(wv[0], wv[1], X, Y);
                    bf16_t* rowp = base + (size_t)(row0 + ai * HALF + m * 16) * ldc + col0;
                    *(u32x4*)rowp = X; *(u32x4*)(rowp + (size_t)8 * ldc) = Y;
                }
            return;
        }
#pragma unroll
        for (int ai = 0; ai < 2; ++ai)
#pragma unroll
            for (int m = 0; m < 4; ++m) { bf16_t* rowp = base + (size_t)(row0 + ai * HALF + m * 16) * ldc + col0;
                u32x4 wv[2];
#pragma unroll
                for (int bj = 0; bj < 2; ++bj) { const f32x4 v0 = acc[ai][bj][m][0], v1 = acc[ai][bj][m][1];
                    wv[bj].x = cvtpk(v0[0], v0[1]); wv[bj].y = cvtpk(v0[2], v0[3]); wv[bj].z = cvtpk(v1[0], v1[1]); wv[bj].w = cvtpk(v1[2], v1[3]); }
                u32x4 X, Y; trade(wv[0], wv[1], X, Y);
                *(u32x4*)rowp = X; *(u32x4*)(rowp + (size_t)8 * ldc) = Y; }
    }
};

struct SchedBranch {
    TileOrder T; int G, c; const char* ws; const char* B; size_t tstep, bstep; int latonly;
    __device__ __forceinline__ bool next(int i, Unit& u) const {
        const int ti = i / 3, br = i - ti * 3; const long L = (long)ti * G + c; if (L >= T.nwg) return false;
        T.map((int)L, u.pm, u.pn); if (latonly) u.pm = (u.pm >> 4) * 17 + (u.pm & 15); u.aux = br; size_t ao = br == 0 ? OFF_DQ : (br == 1 ? OFF_YHY : OFF_SQ); asm volatile("" : "+s"(ao));     u.A = ws + ao + (size_t)u.pm * tstep; u.B = B + (size_t)br * bstep + (size_t)u.pn * tstep; return true;
    }
};
struct EpiBranch {
    static constexpr bool PERM = true;
    unsigned char* ws;
    __device__ __forceinline__ bool keep(const Unit& u) const { return u.aux < 2; }
    __device__ __forceinline__ void operator()(f32x4 (&acc)[2][2][4][2], const Unit& u, int wr, int wc, int fr, int fq) const {
        const int br = u.aux;
        const bf16_t* gt = (const bf16_t*)(ws + OFF_GT); bf16_t* out = (bf16_t*)(ws + OFF_DK);
        const int row0 = u.pm * BM + wr * 64 + fr, col0 = u.pn * BM + wc * 32 + 8 * fq;
#pragma unroll
        for (int ai = 0; ai < 2; ++ai) {
            u32x4 GA[4][2], GB[4][2];
#pragma unroll
            for (int m = 0; m < 4; ++m)
#pragma unroll
                for (int bj = 0; bj < 2; ++bj) { const bf16_t* gp = gt + (size_t)(row0 + ai * HALF + m * 16) * 3072 + br * 1024 + col0 + bj * HALF;
                    GA[m][bj] = *(const u32x4*)gp; GB[m][bj] = br < 2 ? *(const u32x4*)(gp + 1024) : (u32x4){0u, 0u, 0u, 0u}; }
#pragma unroll
            for (int m = 0; m < 4; ++m) { const size_t row = (size_t)(row0 + ai * HALF + m * 16);
#pragma unroll
                for (int bj = 0; bj < 2; ++bj) {
                    const u32x4 ga = GA[m][bj], gb = GB[m][bj];
                    float s[8];
                    if (br < 2) {
#pragma unroll
                        for (int j = 0; j < 4; ++j) {
                            const float a0 = bflo(ga[j]), a1 = bfhi(ga[j]), b0 = bflo(gb[j]), b1 = bfhi(gb[j]);
                            s[2 * j]     = (1.0f + fast_exp(fminf(-b0, 80.f))) * __builtin_amdgcn_rcpf(1.0f + fast_exp(fminf(-a0, 80.f)));
                            s[2 * j + 1] = (1.0f + fast_exp(fminf(-b1, 80.f))) * __builtin_amdgcn_rcpf(1.0f + fast_exp(fminf(-a1, 80.f)));
                        }
                    } else {
#pragma unroll
                        for (int j = 0; j < 4; ++j) { s[2 * j] = __builtin_amdgcn_rcpf(1.0f + fast_exp(fminf(-bflo(ga[j]), 80.f))); s[2 * j + 1] = __builtin_amdgcn_rcpf(1.0f + fast_exp(fminf(-bfhi(ga[j]), 80.f))); }
                    }
                    f32x4 v0 = acc[ai][bj][m][0], v1 = acc[ai][bj][m][1];
                    v0[0] *= s[0]; v0[1] *= s[1]; v0[2] *= s[2]; v0[3] *= s[3]; v1[0] *= s[4]; v1[1] *= s[5]; v1[2] *= s[6]; v1[3] *= s[7];
                    if (br < 2) { acc[ai][bj][m][0] = v0; acc[ai][bj][m][1] = v1; }
                    else { u32x4 w; w.x = cvtpk(v0[0], v0[1]); w.y = cvtpk(v0[2], v0[3]); w.z = cvtpk(v1[0], v1[1]); w.w = cvtpk(v1[2], v1[3]);
                        *(u32x4*)(out + row * 1024 + col0 + bj * HALF) = w; }
                } }
            asm volatile("" ::: "memory"); }
    }
};

struct EpiResid {
    static constexpr bool PERM = false;
    float* xres; const float* mod; int dry;
    __device__ __forceinline__ bool keep(const Unit&) const { return false; }
    __device__ __forceinline__ void operator()(f32x4 (&acc)[2][2][4][2], const Unit& u, int wr, int wc, int fr, int fq) const {
        const int b = u.pm / 17, isctx = (u.pm - b * 17) == 16; const float* mrow = mod + (size_t)(isctx ? 8 : b) * 6144 + 2 * 1024;
        const int row0 = u.pm * BM + wr * 64 + fr, col0 = u.pn * BM + wc * 32 + 4 * fq;
        f32x4 mv[2][2];
#pragma unroll
        for (int bj = 0; bj < 2; ++bj)
#pragma unroll
            for (int n = 0; n < 2; ++n) mv[bj][n] = *(const f32x4*)(mrow + col0 + bj * HALF + n * 16);
#pragma unroll
        for (int ai = 0; ai < 2; ++ai)
#pragma unroll
            for (int m = 0; m < 4; ++m) { float* rowp = xres + (size_t)(row0 + ai * HALF + m * 16) * 1024 + col0;
#pragma unroll
                for (int bj = 0; bj < 2; ++bj)
#pragma unroll
                    for (int n = 0; n < 2; ++n) { f32x4* p = (f32x4*)(rowp + bj * HALF + n * 16); const f32x4 x = *p; if (!dry) *p = x + mv[bj][n] * acc[ai][bj][m][n]; }
                if (m == 3) asm volatile("" ::: "memory"); }
    }
};

struct SchedMoe {
    TileOrder T; int G, c; const char* A; const char* B; size_t tstep, estep;
    __device__ __forceinline__ bool next(int i, Unit& u) const {
        const long L = (long)i * G + c; if (L >= T.nwg) return false;
        T.map((int)L, u.pm, u.pn); const int e = u.pm < 256 ? (u.pm >> 4) : (u.pm - 256); u.aux = e;
        u.A = A + (size_t)u.pm * tstep; u.B = B + (size_t)e * estep + (size_t)u.pn * tstep; return true;
    }
};
struct EpiSwiglu {
    static constexpr bool PERM = true;
    bf16_t* hid;
    __device__ __forceinline__ bool keep(const Unit&) const { return false; }
    __device__ __forceinline__ void operator()(f32x4 (&acc)[2][2][4][2], const Unit& u, int wr, int wc, int fr, int fq) const {
        const int row0 = u.pm * BM + wr * 64 + fr, col0 = u.pn * HALF + wc * 32 + 8 * fq;
#pragma unroll
        for (int ai = 0; ai < 2; ++ai)
#pragma unroll
            for (int m = 0; m < 4; ++m) { bf16_t* rowp = hid + (size_t)(row0 + ai * HALF + m * 16) * 1024 + col0;
                float h[8];
#pragma unroll
                for (int n = 0; n < 2; ++n)
#pragma unroll
                    for (int j = 0; j < 4; ++j) { const float a = acc[ai][0][m][n][j], b = acc[ai][1][m][n][j]; h[4 * n + j] = a * __builtin_amdgcn_rcpf(1.0f + fast_exp(-a)) * b; }
                u32x4 w; w.x = cvtpk(h[0], h[1]); w.y = cvtpk(h[2], h[3]); w.z = cvtpk(h[4], h[5]); w.w = cvtpk(h[6], h[7]);
                *(u32x4*)rowp = w; }
    }
};
struct EpiRowScale {
    static constexpr bool PERM = true;
    bf16_t* out; const float* gate;
    __device__ __forceinline__ bool keep(const Unit&) const { return false; }
    __device__ __forceinline__ void operator()(f32x4 (&acc)[2][2][4][2], const Unit& u, int wr, int wc, int fr, int fq) const {
        const int row0 = u.pm * BM + wr * 64 + fr, col0 = u.pn * BM + wc * 32 + 8 * fq;
#pragma unroll
        for (int ai = 0; ai < 2; ++ai)
#pragma unroll
            for (int m = 0; m < 4; ++m) { const int row = row0 + ai * HALF + m * 16; const float g = gate[row]; bf16_t* rowp = out + (size_t)row * 1024 + col0;
#pragma unroll
                for (int bj = 0; bj < 2; ++bj) { const f32x4 v0 = acc[ai][bj][m][0] * g, v1 = acc[ai][bj][m][1] * g;
                    u32x4 w; w.x = cvtpk(v0[0], v0[1]); w.y = cvtpk(v0[2], v0[3]); w.z = cvtpk(v1[0], v1[1]); w.w = cvtpk(v1[2], v1[3]);
                    *(u32x4*)(rowp + bj * HALF) = w; } }
    }
};
}
namespace att {
__device__ __forceinline__ int crow(int r, int hi) { return (r & 3) + 8 * (r >> 2) + 4 * hi; }
__device__ __forceinline__ void glds16(const void* gsrc, unsigned lds_dst) { unsigned keep;
    asm volatile("s_mov_b32 %0, m0\n\ts_mov_b32 m0, %2\n\ts_nop 0\n\tglobal_load_lds_dwordx4 %1, off\n\ts_mov_b32 m0, %0" : "=&s"(keep) : "v"(gsrc), "s"(lds_dst) : "memory"); }
#define ATT_WAIT_BAR() asm volatile("s_waitcnt vmcnt(0) lgkmcnt(0)\n\ts_barrier" ::: "memory")

constexpr int KSLOT = 8192;
constexpr int NSLOT = 4;
template <int DV> struct Lay { static constexpr int VSLOT = DV * 128, K0 = 0, V0 = NSLOT * KSLOT, WS = V0 + NSLOT * VSLOT, BYTES = WS + 8 * 256; };

struct Pass {
    const bf16_t* Qw; int ldq;
    const bf16_t* Kb; int ldk;
    const bf16_t* Vb; int ldv;
    int nA, ks, nC;
    int band;
    int qpos;
    float m0, l0;
    int rope; const LAS float* rtab;
};

__device__ __forceinline__ float max3f(float a, float b, float c) { float r; asm("v_max3_f32 %0, %1, %2, %3" : "=v"(r) : "v"(a), "v"(b), "v"(c)); return r; }
constexpr float ATT_THR = 8.0f;

template <int DV>
__device__ __forceinline__ void flash_pass(char* shm, const Pass& P, f32x16 (&o)[DV / 32], f32x16& osum) {
    typedef Lay<DV> L;
    int tid_ = threadIdx.x; asm volatile("" : "+v"(tid_));
    const int tid = tid_, lane = tid & 63, r32 = lane & 31, hi = lane >> 5; const int wid = __builtin_amdgcn_readfirstlane(tid >> 6);
    const unsigned lds0 = (unsigned)(uintptr_t)shm;
    float* wsf = (float*)(shm + L::WS) + wid * 64;
    const int NT = P.nA + P.nC;
    bf16x8 qr[4];
#pragma unroll
    for (int d0 = 0; d0 < 4; ++d0) qr[d0] = *reinterpret_cast<const bf16x8*>(P.Qw + (size_t)r32 * P.ldq + d0 * 16 + hi * 8);
    { const int tq = P.qpos + r32;
#pragma unroll
      for (int ax = 0; ax < 2; ++ax) {
          f32x4 c0 = (f32x4){1.f, 1.f, 1.f, 1.f}, c1 = c0, s0 = (f32x4){0.f, 0.f, 0.f, 0.f}, s1 = s0;
          if (P.rope) { const LAS float* cp = P.rtab + (ax == 0 ? (tq >> 6) : (tq & 63)) * 16 + 8 * hi; c0 = *(const LAS f32x4*)cp; c1 = *(const LAS f32x4*)(cp + 4); s0 = *(const LAS f32x4*)(cp + 1024); s1 = *(const LAS f32x4*)(cp + 1028); }
          const u32x4 a = __builtin_bit_cast(u32x4, qr[2 * ax]), b = __builtin_bit_cast(u32x4, qr[2 * ax + 1]); u32x4 oa, ob;
#pragma unroll
          for (int j = 0; j < 4; ++j) { const float cl = j < 2 ? c0[2 * j] : c1[2 * j - 4], ch = j < 2 ? c0[2 * j + 1] : c1[2 * j - 3], sl_ = j < 2 ? s0[2 * j] : s1[2 * j - 4], sh_ = j < 2 ? s0[2 * j + 1] : s1[2 * j - 3];
              const float x1l = bflo(a[j]), x1h = bfhi(a[j]), x2l = bflo(b[j]), x2h = bfhi(b[j]);
              oa[j] = cvtpk((x1l * cl - x2l * sl_) * QSCALE, (x1h * ch - x2h * sh_) * QSCALE); ob[j] = cvtpk((x2l * cl + x1l * sl_) * QSCALE, (x2h * ch + x1h * sh_) * QSCALE); }
          qr[2 * ax] = __builtin_bit_cast(bf16x8, oa); qr[2 * ax + 1] = __builtin_bit_cast(bf16x8, ob); } }
#pragma unroll
    for (int d = 0; d < DV / 32; ++d) o[d] = f32x16{};
    float lsum = (hi == 0) ? P.l0 : 0.f;
    const bf16_t* ksrc = P.Kb + (size_t)lane * P.ldk + wid * 8;
    const bf16_t* vsrc = P.Vb + (size_t)(16 * (wid & 3) + (lane >> 2)) * P.ldv + (wid >> 2) * 32 + (lane & 3) * 8;
#define ATT_KEYROW(t) ((t) < P.nA ? P.ks + 64 * (t) : LS + 64 * ((t) - P.nA))
#define ATT_DMA_K(t, slot) do { const int kr_ = ATT_KEYROW(t); \
        glds16(ksrc + (size_t)kr_ * P.ldk, (unsigned)__builtin_amdgcn_readfirstlane(lds0 + L::K0 + (slot) * KSLOT + wid * 1024)); } while (0)
#define ATT_DMA_V(t, slot, s2_) do { const int kr_ = ATT_KEYROW(t); \
        glds16(vsrc + (size_t)kr_ * P.ldv + (s2_) * 64, (unsigned)__builtin_amdgcn_readfirstlane(lds0 + L::V0 + (slot) * L::VSLOT + (s2_) * 8192 + wid * 1024)); } while (0)
#define ATT_DMA(t, slot) do { ATT_DMA_K(t, slot); _Pragma("unroll") for (int s2__ = 0; s2__ < DV / 64; ++s2__) ATT_DMA_V(t, slot, s2__); } while (0)
#define ATT_QK(p0_, p1_, slot, cinit) do { const char* kb_ = shm + L::K0 + (slot) * KSLOT + hi * 1024 + r32 * 16; bf16x8 kf_[4]; \
        _Pragma("unroll") for (int d0 = 0; d0 < 2; ++d0) { kf_[2 * d0] = *reinterpret_cast<const bf16x8*>(kb_ + d0 * 2048); kf_[2 * d0 + 1] = *reinterpret_cast<const bf16x8*>(kb_ + d0 * 2048 + 512); } \
        __builtin_amdgcn_sched_barrier(0);        \
        p0_ = __builtin_amdgcn_mfma_f32_32x32x16_bf16(kf_[0], qr[0], cinit, 0, 0, 0); p1_ = __builtin_amdgcn_mfma_f32_32x32x16_bf16(kf_[1], qr[0], cinit, 0, 0, 0); \
        p0_ = __builtin_amdgcn_mfma_f32_32x32x16_bf16(kf_[2], qr[1], p0_, 0, 0, 0); p1_ = __builtin_amdgcn_mfma_f32_32x32x16_bf16(kf_[3], qr[1], p1_, 0, 0, 0); \
        __builtin_amdgcn_sched_barrier(0); \
        _Pragma("unroll") for (int d0 = 2; d0 < 4; ++d0) { kf_[2 * d0 - 4] = *reinterpret_cast<const bf16x8*>(kb_ + d0 * 2048); kf_[2 * d0 - 3] = *reinterpret_cast<const bf16x8*>(kb_ + d0 * 2048 + 512); } \
        __builtin_amdgcn_sched_barrier(0); \
        p0_ = __builtin_amdgcn_mfma_f32_32x32x16_bf16(kf_[0], qr[2], p0_, 0, 0, 0); p1_ = __builtin_amdgcn_mfma_f32_32x32x16_bf16(kf_[1], qr[2], p1_, 0, 0, 0); \
        p0_ = __builtin_amdgcn_mfma_f32_32x32x16_bf16(kf_[2], qr[3], p0_, 0, 0, 0); p1_ = __builtin_amdgcn_mfma_f32_32x32x16_bf16(kf_[3], qr[3], p1_, 0, 0, 0); } while (0)
#define ATT_ROWMAX(rm_, p0_, p1_) do { float a_ = max3f(p0_[0], p0_[1], p1_[0]), b_ = max3f(p0_[2], p0_[3], p1_[1]); a_ = max3f(a_, p1_[2], p1_[3]); \
        _Pragma("unroll") for (int r = 4; r < 16; r += 4) { a_ = max3f(a_, p0_[r], p0_[r + 1]); b_ = max3f(b_, p0_[r + 2], p0_[r + 3]); a_ = max3f(a_, p1_[r], p1_[r + 1]); b_ = max3f(b_, p1_[r + 2], p1_[r + 3]); } \
        rm_ = fmaxf(a_, b_); auto rr_ = __builtin_amdgcn_permlane32_swap(__float_as_uint(rm_), __float_as_uint(rm_), false, false); rm_ = fmaxf(__uint_as_float(rr_[0]), __uint_as_float(rr_[1])); } while (0)
    ATT_DMA(0, 0);
#define ATT_WAITV(ktiles) do { if ((ktiles) == 0) asm volatile("s_waitcnt vmcnt(0)" ::: "memory"); \
        else if ((ktiles) == 1) { if (DV == 128) asm volatile("s_waitcnt vmcnt(3)" ::: "memory"); else asm volatile("s_waitcnt vmcnt(2)" ::: "memory"); } \
        else { if (DV == 128) asm volatile("s_waitcnt vmcnt(6)" ::: "memory"); else asm volatile("s_waitcnt vmcnt(4)" ::: "memory"); } } while (0)
    if (NT > 1) ATT_DMA(1, 1);
    if (NT > 2) ATT_DMA(2, 2);
    { const int younger = NT > 2 ? 2 : (NT > 1 ? 1 : 0); ATT_WAITV(younger); }
    asm volatile("s_waitcnt lgkmcnt(0)\n\ts_barrier" ::: "memory");
    f32x16 p0, p1, n0, n1, negm;
    { const f32x16 zero = f32x16{}; ATT_QK(p0, p1, 0, zero); }
    asm volatile("s_nop 15\n\ts_nop 7" : "+v"(p0), "+v"(p1));
#define ATT_NEEDMASK(tt) (P.band && (tt) < P.nA && !(P.ks + 64 * (tt) >= P.qpos - 97 && P.ks + 64 * (tt) <= P.qpos + 65))
#define ATT_MASK(v0_, v1_, tt) do { const int q_ = P.qpos + r32, kb0_ = P.ks + 64 * (tt) + 4 * hi; \
        _Pragma("unroll") for (int r = 0; r < 16; ++r) { const int kv_ = kb0_ + (r & 3) + 8 * (r >> 2); int dd_ = kv_ - q_; dd_ = dd_ < 0 ? -dd_ : dd_; int d1_ = kv_ + 32 - q_; d1_ = d1_ < 0 ? -d1_ : d1_; \
            if (dd_ > 128) v0_[r] = -INFINITY; if (d1_ > 128) v1_[r] = -INFINITY; } } while (0)
    if (ATT_NEEDMASK(0)) ATT_MASK(p0, p1, 0);
    float m; { float rm0; ATT_ROWMAX(rm0, p0, p1); m = fmaxf(P.m0, rm0); }
    lsum *= __builtin_amdgcn_exp2f(P.m0 - m);
#pragma unroll
    for (int r = 0; r < 16; ++r) { p0[r] -= m; p1[r] -= m; negm[r] = -m; }
    n0 = p0; n1 = p1;
    int sl = 0;
    for (int t = 0; t < NT; ++t) {
        { const int younger = t + 2 < NT ? 1 : 0; ATT_WAITV(younger); }
        asm volatile("s_waitcnt lgkmcnt(0)\n\ts_barrier" ::: "memory");
        const int sl1 = (sl + 1) & (NSLOT - 1), sl2 = (sl + 3) & (NSLOT - 1);
        if (t + 1 < NT) { ATT_QK(n0, n1, sl1, negm); }
        __builtin_amdgcn_sched_barrier(0);
        const bool pre = t + 3 < NT;
        if (pre) ATT_DMA_K(t + 3, sl2);
        { float sacc = 0.f;
#pragma unroll
          for (int r = 0; r < 16; ++r) { p0[r] = __builtin_amdgcn_exp2f(p0[r]); p1[r] = __builtin_amdgcn_exp2f(p1[r]); sacc += p0[r] + p1[r]; }
          lsum += sacc; }
        u32x4 pw0, pw1, pw2, pw3;
        pw0 = (u32x4){cvtpk(p0[0], p0[1]), cvtpk(p0[2], p0[3]), cvtpk(p0[4], p0[5]), cvtpk(p0[6], p0[7])};
        pw1 = (u32x4){cvtpk(p0[8], p0[9]), cvtpk(p0[10], p0[11]), cvtpk(p0[12], p0[13]), cvtpk(p0[14], p0[15])};
        pw2 = (u32x4){cvtpk(p1[0], p1[1]), cvtpk(p1[2], p1[3]), cvtpk(p1[4], p1[5]), cvtpk(p1[6], p1[7])};
        pw3 = (u32x4){cvtpk(p1[8], p1[9]), cvtpk(p1[10], p1[11]), cvtpk(p1[12], p1[13]), cvtpk(p1[14], p1[15])};
        const int vb = (int)(lds0 + L::V0 + sl * L::VSLOT) + ((lane >> 4) & 1) * 32 + (lane & 3) * 8 + (4 * hi + ((lane & 15) >> 2)) * 64;
        s16x4 loA[4], hhA[4], loB[4], hhB[4];
        asm volatile("s_waitcnt lgkmcnt(0)" ::: "memory");
#define ATT_VRD(lo_, hh_, d0) do { _Pragma("unroll") for (int ks = 0; ks < 4; ++ks) { \
            asm volatile("ds_read_b64_tr_b16 %0,%1 offset:%c2" : "=&v"(lo_[ks]) : "v"(vb), "i"(((d0) >> 1) * 8192 + ((d0) & 1) * 4096 + ks * 1024) : "memory"); \
            asm volatile("ds_read_b64_tr_b16 %0,%1 offset:%c2" : "=&v"(hh_[ks]) : "v"(vb), "i"(((d0) >> 1) * 8192 + ((d0) & 1) * 4096 + ks * 1024 + 512) : "memory"); } } while (0)
#define ATT_PK(lo_, hh_, k) (bf16x8){lo_[k][0], lo_[k][1], lo_[k][2], lo_[k][3], hh_[k][0], hh_[k][1], hh_[k][2], hh_[k][3]}
        float ra_ = 0.f, rb_ = 0.f, rm = 0.f;
#define ATT_RMSTEP(s_) do { \
            if ((s_) == 0) { if (t + 1 < NT && ATT_NEEDMASK(t + 1)) ATT_MASK(n0, n1, t + 1); ra_ = max3f(n0[0], n0[1], n1[0]); rb_ = max3f(n0[2], n0[3], n1[1]); } \
            else if ((s_) == 1) { ra_ = max3f(ra_, n1[2], n1[3]); } \
            else if ((s_) == 2 || (s_) == 4 || (s_) == 6) { ra_ = max3f(ra_, n0[(2 * (s_)) & 15], n0[(2 * (s_) + 1) & 15]); rb_ = max3f(rb_, n0[(2 * (s_) + 2) & 15], n0[(2 * (s_) + 3) & 15]); } \
            else if ((s_) == 3 || (s_) == 5 || (s_) == 7) { ra_ = max3f(ra_, n1[(2 * (s_) - 2) & 15], n1[(2 * (s_) - 1) & 15]); rb_ = max3f(rb_, n1[(2 * (s_)) & 15], n1[(2 * (s_) + 1) & 15]); } \
            else if ((s_) == 8) { rm = fmaxf(ra_, rb_); auto rr_ = __builtin_amdgcn_permlane32_swap(__float_as_uint(rm), __float_as_uint(rm), false, false); rm = fmaxf(__uint_as_float(rr_[0]), __uint_as_float(rr_[1])); } } while (0)
#define ATT_SLOT(i_) do { if (DV == 128) { ATT_RMSTEP(i_); } else { ATT_RMSTEP(2 * (i_)); ATT_RMSTEP(2 * (i_) + 1); } __builtin_amdgcn_sched_barrier(0); } while (0)
#define ATT_PV(lo_, hh_, d0) do { \
            o[d0] = __builtin_amdgcn_mfma_f32_32x32x16_bf16(__builtin_bit_cast(bf16x8, pw0), ATT_PK(lo_, hh_, 0), o[d0], 0, 0, 0); ATT_SLOT(4 * (d0)); \
            o[d0] = __builtin_amdgcn_mfma_f32_32x32x16_bf16(__builtin_bit_cast(bf16x8, pw1), ATT_PK(lo_, hh_, 1), o[d0], 0, 0, 0); ATT_SLOT(4 * (d0) + 1); \
            o[d0] = __builtin_amdgcn_mfma_f32_32x32x16_bf16(__builtin_bit_cast(bf16x8, pw2), ATT_PK(lo_, hh_, 2), o[d0], 0, 0, 0); ATT_SLOT(4 * (d0) + 2); \
            o[d0] = __builtin_amdgcn_mfma_f32_32x32x16_bf16(__builtin_bit_cast(bf16x8, pw3), ATT_PK(lo_, hh_, 3), o[d0], 0, 0, 0); ATT_SLOT(4 * (d0) + 3); } while (0)
        ATT_VRD(loA, hhA, 0);
#pragma unroll
        for (int d0 = 0; d0 < DV / 32; d0 += 2) {
            ATT_VRD(loB, hhB, d0 + 1);
            asm volatile("s_waitcnt lgkmcnt(8)" ::: "memory"); __builtin_amdgcn_sched_barrier(0);
            ATT_PV(loA, hhA, d0);
            __builtin_amdgcn_sched_barrier(0);
            if (pre) ATT_DMA_V(t + 3, sl2, d0 >> 1);
            if (d0 + 2 < DV / 32) { ATT_VRD(loA, hhA, d0 + 2); asm volatile("s_waitcnt lgkmcnt(8)" ::: "memory"); }
            else asm volatile("s_waitcnt lgkmcnt(0)" ::: "memory");
            __builtin_amdgcn_sched_barrier(0);
            ATT_PV(loB, hhB, d0 + 1);
            __builtin_amdgcn_sched_barrier(0);
        }
#undef ATT_VRD
#undef ATT_PK
#undef ATT_PV
#undef ATT_SLOT
#undef ATT_RMSTEP
        if (t + 1 < NT && __any(rm > ATT_THR)) {
            const float dl = fmaxf(rm, 0.f), f = __builtin_amdgcn_exp2f(-dl);
            m += dl; lsum *= f; if (hi == 0) wsf[r32] = f;
#pragma unroll
            for (int r = 0; r < 16; ++r) { n0[r] -= dl; n1[r] -= dl; negm[r] = -m; }
            LDS_WAIT();
#pragma unroll
            for (int r = 0; r < 16; ++r) { const float fr_ = wsf[crow(r, hi)];
#pragma unroll
                for (int d = 0; d < DV / 32; ++d) o[d][r] *= fr_; }
        }
        p0 = n0; p1 = n1; sl = sl1;
    }
    asm volatile("s_waitcnt lgkmcnt(0)\n\ts_barrier" ::: "memory");
    { auto rr = __builtin_amdgcn_permlane32_swap(__float_as_uint(lsum), __float_as_uint(lsum), false, false); const float l = __uint_as_float(rr[0]) + __uint_as_float(rr[1]);
      if (hi == 0) wsf[r32] = l; LDS_WAIT();
#pragma unroll
      for (int r = 0; r < 16; ++r) osum[r] = wsf[crow(r, hi)];
      LDS_WAIT(); }
#undef ATT_KEYROW
#undef ATT_WAITV
#undef ATT_DMA
#undef ATT_QK
#undef ATT_ROWMAX
#undef ATT_NEEDMASK
#undef ATT_MASK
}

template <int DV>
__device__ __forceinline__ void normalize(f32x16 (&o)[DV / 32], const f32x16& osum) {
#pragma unroll
    for (int r = 0; r < 16; ++r) { const float rl = 1.0f / osum[r];
#pragma unroll
        for (int d = 0; d < DV / 32; ++d) o[d][r] *= rl; }
}
}
namespace hy {
constexpr int UPAD = 20 * 64;
constexpr int UROW = UPAD + 4096 * 2 + UPAD + 16;
constexpr int LDS_U = 0, LDS_R = 8 * UROW, LDS_R1 = LDS_R + 16384 + 64, LDS_BYTES = LDS_R1 + 16384;
static_assert(LDS_BYTES <= 131072 && UROW % 16 == 0, "hyena LDS");

__device__ __forceinline__ void conv_init(char* shm) {
    constexpr int Q = UPAD / 16;
    unsigned z_ = 0u; asm volatile("" : "+v"(z_));
    for (int i = threadIdx.x; i < 8 * 2 * Q; i += 512) { const int b = i / (2 * Q), r = i % (2 * Q), side = r / Q, q = r % Q;
        *(u32x4*)(shm + LDS_U + b * UROW + (side ? UPAD + 8192 : 0) + q * 16) = (u32x4){z_, z_, z_, z_}; }
}
__device__ __forceinline__ void conv_channel(char* shm, const bf16_t* zc, const bf16_t* Rc, bf16_t* outc) {
    int tid_ = threadIdx.x; asm volatile("" : "+v"(tid_));
    const int tid = tid_, lane = tid & 63, n = lane & 31, kg = lane >> 5; const int w = __builtin_amdgcn_readfirstlane(tid >> 6);
    asm volatile("s_waitcnt lgkmcnt(0)\n\ts_barrier" ::: "memory");
#pragma unroll
    for (int j = 0; j < 8; ++j) { const int id = tid + 512 * j, b = id >> 9, off = (id & 511) * 16; *(u32x4*)(shm + LDS_U + b * UROW + UPAD + off) = *(const u32x4*)((const char*)zc + (size_t)b * 8192 + off); }
#pragma unroll
    for (int j = 0; j < 2; ++j) { const int ci = tid + 512 * j, off = ci * 16; const u32x4 a = *(const u32x4*)((const char*)Rc + off);
        const unsigned e8 = ci < 1023 ? (unsigned)Rc[8 * ci + 8] : 0u;
        *(u32x4*)(shm + LDS_R + off) = a;
        u32x4 sft; sft.x = (a.x >> 16) | (a.y << 16); sft.y = (a.y >> 16) | (a.z << 16); sft.z = (a.z >> 16) | (a.w << 16); sft.w = (a.w >> 16) | (e8 << 16);
        *(u32x4*)(shm + LDS_R1 + off) = sft; }
    asm volatile("s_waitcnt vmcnt(0) lgkmcnt(0)\n\ts_barrier" ::: "memory");
    f32x16 acc[4];
#pragma unroll
    for (int k = 0; k < 4; ++k) acc[k] = f32x16{};
    const int bcol = n >> 2, il = n & 3;
    const LAS char* Abase = (const LAS char*)shm + ((n & 1) ? (LDS_R1 - 2) : LDS_R) + (4096 - n + 8 * kg) * 2;
    const LAS char* Ubase = (const LAS char*)shm + LDS_U + bcol * UROW + UPAD + kg * 16 + 64 * (16 * w + il);
    const int dlo = 16 * w - 127, dhi = 16 * w + 15;
#define HY_LDA(dst, d, sc) do { const volatile LAS unsigned* ap_ = (const volatile LAS unsigned*)(Abase + (16 * (sc) - 32 * (d)) * 2); u32x4 aw_; aw_.x = ap_[0]; aw_.y = ap_[1]; aw_.z = ap_[2]; aw_.w = ap_[3]; dst = __builtin_bit_cast(bf16x8, aw_); } while (0)
#define HY_LDB(dst, m, sc) dst = *(const LAS bf16x8*)(Ubase + 64 * (m) + 32 * (sc))
#pragma unroll 1
    for (int rho = 0; rho < 4; ++rho) {
        int d = dlo + rho;
        bf16x8 A0, A1, X0[5], X1[5];
        HY_LDA(A0, d, 0); HY_LDA(A1, d, 1);
#pragma unroll
        for (int k = 0; k < 4; ++k) { HY_LDB(X0[k], 4 * k - d, 0); HY_LDB(X1[k], 4 * k - d, 1); }
#define HY_STEP(s) { if (d > dhi) break; \
            bf16x8 nA0, nA1;                   \
            HY_LDA(nA0, d + 4, 0); HY_LDA(nA1, d + 4, 1); HY_LDB(X0[(4 - (s) + 5) % 5], -(d + 4), 0); HY_LDB(X1[(4 - (s) + 5) % 5], -(d + 4), 1); \
            _Pragma("unroll") for (int k = 0; k < 4; ++k) { acc[k] = __builtin_amdgcn_mfma_f32_32x32x16_bf16(A0, X0[(k - (s) + 5) % 5], acc[k], 0, 0, 0); acc[k] = __builtin_amdgcn_mfma_f32_32x32x16_bf16(A1, X1[(k - (s) + 5) % 5], acc[k], 0, 0, 0); } \
            A0 = nA0; A1 = nA1; d += 4; }
        for (;;) { HY_STEP(0) HY_STEP(1) HY_STEP(2) HY_STEP(3) HY_STEP(4) }
#undef HY_STEP
    }
#undef HY_LDA
#undef HY_LDB
#pragma unroll
    for (int k = 0; k < 4; ++k) { const int i = 16 * w + 4 * k + il; bf16_t* op = outc + (size_t)bcol * 4096 + 32 * i + 4 * kg;
#pragma unroll
        for (int g = 0; g < 4; ++g) { u32x2 v; v.x = cvtpk(acc[k][4 * g], acc[k][4 * g + 1]); v.y = cvtpk(acc[k][4 * g + 2], acc[k][4 * g + 3]); *(u32x2*)(op + 8 * g) = v; } }
}
}
constexpr int NWAVES = 8;
constexpr size_t MiB = 1u << 20;
constexpr size_t WS_CTL = 0, CTL_ZERO_BYTES = 1 * MiB;
constexpr size_t WS_MODS = 1 * MiB;
constexpr size_t WS_FCTX = 2 * MiB;
constexpr size_t WS_ZFEAT = 4 * MiB;
constexpr size_t WS_AFF = 9 * MiB;
constexpr size_t WS_SLOTOF = 12 * MiB;
constexpr size_t WS_GATE = 16 * MiB;
constexpr size_t WS_ZCTX = 17 * MiB;
constexpr size_t WS_XRES = 24 * MiB;
constexpr size_t WS_H = WS_XRES + 136 * MiB;
constexpr size_t WS_W = WS_H + 68 * MiB;
constexpr size_t WS_WIN = WS_W, WS_WBR = WS_WIN + 21 * MiB, WS_WOUT = WS_WBR + 6 * MiB, WS_W13 = WS_WOUT + 2 * MiB, WS_W2 = WS_W13 + 64 * MiB;
constexpr size_t WS_PROJ = WS_W2 + 32 * MiB;
static_assert(WS_PROJ == OFF_PROJ, "projection base");
constexpr size_t WS_DQ = OFF_DQ, WS_DK = OFF_DK, WS_DV = OFF_DV, WS_HY = OFF_HY, WS_SQ = OFF_SQ, WS_SK = OFF_SK, WS_SV = OFF_SV, WS_GT = OFF_GT;
constexpr size_t WS_END = WS_GT + 3 * SZ1K;
constexpr size_t WS_HRAW = WS_END;
constexpr size_t WS_TOTAL = WS_HRAW + 32 * MiB;
constexpr size_t WS_CONVT = WS_HY;
constexpr size_t WS_YHY = OFF_YHY;
constexpr size_t WS_MERGED = WS_DK;
constexpr size_t WS_XG = WS_HY;
constexpr size_t WS_HID = WS_GT;
static_assert(WS_YHY + SZ1K <= WS_SQ && WS_XG + (size_t)SLOTS * 2048 <= WS_SQ && WS_HID + (size_t)SLOTS * 2048 <= WS_END, "overlays");
constexpr size_t OUT_ZT = 0;
constexpr size_t OUT_FILT = 64 * MiB;
constexpr size_t OUT_STASH = 80 * MiB;
static_assert(OUT_STASH + 32 * MiB <= (size_t)NB * LS * D * 4, "d_out scratch");

constexpr int CW_TMO = 0, CW_CODE = 1, CW_CHK = 64, CW_BAR = 4096;

constexpr int RING_BYTES = 131072, LDSCTL_OFF = RING_BYTES, MISC_OFF = LDSCTL_OFF + 320, ROPE_OFF = LDSCTL_OFF + 1024  , LDS_BYTES = 147456;
static_assert(ROPE_OFF + 8192 <= LDS_BYTES, "LDS map");

#define XB_TMO      128
#define XB_XCNT(j)  (256  + 64 * (j))
#define XB_XSUB(j)  (1280 + 64 * (j))
#define XB_XGEN(j)  (2304 + 64 * (j))
#define XB_TOP      3328
#define XB_TOPGEN   3392
#define XCD_BAR_WORDS 3456
#define XB_SPIN_CAP (1u << 22)
__device__ __forceinline__ unsigned xb_ld(unsigned* p)              { return __hip_atomic_load(p, __ATOMIC_RELAXED, __HIP_MEMORY_SCOPE_AGENT); }
__device__ __forceinline__ unsigned xb_add(unsigned* p, unsigned v) { return __hip_atomic_fetch_add(p, v, __ATOMIC_RELAXED, __HIP_MEMORY_SCOPE_AGENT); }
__device__ __forceinline__ unsigned xb_xcc_id() { return (unsigned)__builtin_amdgcn_s_getreg((3 << 11) | 20) & 0xFu; }
#define XB_SPIN(cond, bar) do { unsigned _sp = 0; while (cond) { __builtin_amdgcn_s_sleep(1); \
    if ((++_sp & 255u) == 0u) { if (xb_ld(&(bar)[XB_TMO])) break; if (_sp > XB_SPIN_CAP) { atomicAdd(&(bar)[XB_TMO], 1u); break; } } } } while (0)
struct XcdBarrier { unsigned* bar; unsigned x; volatile LAS unsigned* st; };
__device__ __forceinline__ XcdBarrier xcd_barrier_post(unsigned* bar, volatile LAS unsigned* st) {
    XcdBarrier b; b.bar = bar; b.x = xb_xcc_id(); b.st = st;
    if (threadIdx.x == 0) (void)xb_add(&bar[XB_XCNT(b.x)], 1u);
    return b;
}
__device__ __forceinline__ void xcd_barrier_complete(unsigned* bar, unsigned x, unsigned& nloc, unsigned& nx) {
    const unsigned G = gridDim.x * gridDim.y * gridDim.z;
    unsigned sum, cnt, mine, sp = 0u;
    for (;;) {
        sum = 0u; cnt = 0u; mine = 0u;
#pragma unroll
        for (unsigned j = 0; j < 16; ++j) { const unsigned c = xb_ld(&bar[XB_XCNT(j)]); sum += c; cnt += (c > 0u) ? 1u : 0u; mine = (j == x) ? c : mine; }
        if (sum == G) break;
        __builtin_amdgcn_s_sleep(1);
        if ((++sp & 255u) == 0u) { if (xb_ld(&bar[XB_TMO])) break; if (sp > XB_SPIN_CAP) { atomicAdd(&bar[XB_TMO], 1u); break; } }
    }
    nloc = mine > 0u ? mine : 1u; nx = cnt > 0u ? cnt : 1u;
}
__device__ __forceinline__ void xcd_barrier(const XcdBarrier& b) {
    asm volatile("s_waitcnt vmcnt(0)" ::: "memory");
    __syncthreads();
    if (threadIdx.x == 0) {
        unsigned* bar = b.bar;
        __builtin_amdgcn_s_waitcnt(0);
        unsigned nloc = b.st[0], nx = b.st[1];
        if (nloc == 0u) { xcd_barrier_complete(bar, b.x, nloc, nx); b.st[0] = nloc; b.st[1] = nx; }
#ifdef XB_EARLY_WB
        __builtin_amdgcn_fence(__ATOMIC_RELEASE, "agent");
        asm volatile("s_waitcnt vmcnt(0)" ::: "memory");
#endif
        const unsigned old = xb_add(&bar[XB_XSUB(b.x)], 1u);
        const unsigned gen = old / nloc;
        if (old + 1u == (gen + 1u) * nloc) {
            __builtin_amdgcn_fence(__ATOMIC_RELEASE, "agent");
            asm volatile("s_waitcnt vmcnt(0)" ::: "memory");
            const unsigned og = xb_add(&bar[XB_TOP], 1u);
            const unsigned tg = og / nx;
            if (og + 1u == (tg + 1u) * nx) xb_add(&bar[XB_TOPGEN], 1u);
            else XB_SPIN(xb_ld(&bar[XB_TOPGEN]) == tg, bar);
            __builtin_amdgcn_fence(__ATOMIC_ACQUIRE, "agent");
            xb_add(&bar[XB_XGEN(b.x)], 1u);
            asm volatile("s_waitcnt vmcnt(0)" ::: "memory");
        } else {
            XB_SPIN(xb_ld(&bar[XB_XGEN(b.x)]) == gen, bar);
            __builtin_amdgcn_fence(__ATOMIC_ACQUIRE, "agent");
            asm volatile("s_waitcnt vmcnt(0)" ::: "memory");
        }
    }
    __syncthreads();
}

struct Args {
    const float* in[28]; float* out; unsigned char* ws; int ph_lo, ph_hi;
};
struct Frame {
    LAS unsigned char* lds; char* shm;
    int tid, lane, wave, G, bid;
    int dry;
    unsigned char* ws; unsigned char* outb;
};
enum { I_X = 0, I_C, I_CTX, I_CCTX, I_WMOD, I_BMOD, I_N1G, I_N2G, I_WIN, I_DLAM, I_SUBLN, I_HCW, I_HCB, I_FW1, I_FB1, I_FW2, I_FB2, I_FW3, I_FREQ, I_HBIAS, I_SINK, I_WBR, I_WOUT, I_ROUTER, I_W1, I_W3, I_W2, I_FINALG };
__device__ __forceinline__ void p0_mods_zfeat(Frame& F, const Args& a) {
    float* sc = (float*)F.shm;
    float* part = (float*)(F.shm + 9 * 1024 * 4);
    for (int i = F.tid; i < 9 * 1024; i += 512) { const int r = i >> 10, k = i & 1023; const float v = r < 8 ? a.in[I_C][r * 1024 + k] : a.in[I_CCTX][k]; sc[i] = v * sigmoidf_(v); }
    __syncthreads();
    float* mods = (float*)(F.ws + WS_MODS);
    for (int ch = F.bid; ch < 192; ch += F.G) {
        const int l = ch / 48, c0 = (ch % 48) * 128, col = F.tid & 127, kq = F.tid >> 7;
        const float* w = a.in[I_WMOD] + ((size_t)l * 1024 + kq * 256) * 6144 + c0 + col;
        float acc[9];
#pragma unroll
        for (int r = 0; r < 9; ++r) acc[r] = 0.f;
        for (int k = 0; k < 256; ++k) { const float wv = w[(size_t)k * 6144];
#pragma unroll
            for (int r = 0; r < 9; ++r) acc[r] += sc[r * 1024 + kq * 256 + k] * wv; }
#pragma unroll
        for (int r = 0; r < 9; ++r) part[(kq * 9 + r) * 128 + col] = acc[r];
        __syncthreads();
        for (int i = F.tid; i < 9 * 128; i += 512) { const int r = i >> 7, cc = i & 127;
            const float s = part[(0 * 9 + r) * 128 + cc] + part[(1 * 9 + r) * 128 + cc] + part[(2 * 9 + r) * 128 + cc] + part[(3 * 9 + r) * 128 + cc];
            mods[((size_t)l * 9 + r) * 6144 + c0 + cc] = s + a.in[I_BMOD][l * 6144 + c0 + cc]; }
        __syncthreads();
    }
    float* zf = (float*)(F.ws + WS_ZFEAT);
    const int gw = F.bid * NWAVES + F.wave, NGW = F.G * NWAVES;
    for (int it = gw; it < DEPTH * LT; it += NGW) {
        const int l = it / LT, row = it - l * LT; const int Lf = row < LS ? LS : LC, ii = row < LS ? row : row - LS;
        const float tt = (float)ii / (float)(Lf - 1);
        const float wrev = (float)ii / (float)Lf;
        const int j = F.lane & 15; const float fj = 1e-4f + (float)j * ((15.0f - 1e-4f) / 15.0f);
        const float cs = cos_rev(fj * wrev), sn = -sin_rev(fj * wrev);
        const float* w1 = a.in[I_FW1] + (size_t)l * 33 * 64; const float* w2 = a.in[I_FW2] + (size_t)l * 64 * 64;
        const float fq = a.in[I_FREQ][l * 64 + F.lane];
        float s = tt * w1[F.lane] + a.in[I_FB1][l * 64 + F.lane];
#pragma unroll
        for (int k = 0; k < 16; ++k) { s += __shfl(cs, k) * w1[(1 + k) * 64 + F.lane]; s += __shfl(sn, k) * w1[(17 + k) * 64 + F.lane]; }
        const float z1 = sin_rad(fq * s);
        float s2 = a.in[I_FB2][l * 64 + F.lane];
#pragma unroll 8
        for (int k = 0; k < 64; ++k) s2 += __shfl(z1, k) * w2[k * 64 + F.lane];
        zf[((size_t)l * 64 + F.lane) * LT + row] = sin_rad(fq * s2);
    }
}

__device__ __forceinline__ void transpose_item(const float* W, int K, int N, bf16_t* WT, int k0, int n0, int drow, LAS float* scr, int lane) {
#pragma unroll 8
    for (int i = 0; i < 32; ++i) { const int kk = 2 * i + (lane >> 5); scr[kk * 33 + (lane & 31)] = W[(size_t)(k0 + kk) * N + n0 + (lane & 31)]; }
    LDS_WAIT(); asm volatile("" ::: "memory");
    const int c = lane & 7;
#pragma unroll
    for (int j = 0; j < 4; ++j) { const int n = (lane >> 3) + 8 * j; const LAS float* s = scr + (8 * c) * 33 + n;
        u32x4 o; o.x = pk2(s[0 * 33], s[1 * 33]); o.y = pk2(s[2 * 33], s[3 * 33]); o.z = pk2(s[4 * 33], s[5 * 33]); o.w = pk2(s[6 * 33], s[7 * 33]);
        *(GAS u32x4*)(WT + (size_t)(drow + n) * K + k0 + 8 * c) = o; }
    LDS_WAIT(); asm volatile("" ::: "memory");
}
__device__ __forceinline__ void p1_weights(Frame& F, const Args& a, int l) {
    LAS float* scr = (LAS float*)(F.lds + F.wave * 8448);
    const int gw = F.bid * NWAVES + F.wave, NGW = F.G * NWAVES;
    constexpr int I_IN = 16 * 336, I_SQ = 16 * 32;
    constexpr int NITEMS = I_IN + 4 * I_SQ + 48 * I_SQ;
    bf16_t* WinT = (bf16_t*)(F.ws + WS_WIN); bf16_t* WbrT = (bf16_t*)(F.ws + WS_WBR); bf16_t* WoutT = (bf16_t*)(F.ws + WS_WOUT);
    bf16_t* W13T = (bf16_t*)(F.ws + WS_W13); bf16_t* W2T = (bf16_t*)(F.ws + WS_W2);
    for (int it = gw; it < NITEMS; it += NGW) {
        int r = it;
        if (r < I_IN) { const int kb = r / 336, nb = r % 336; transpose_item(a.in[I_WIN] + (size_t)l * 1024 * DIN, 1024, DIN, WinT, 64 * kb, 32 * nb, 32 * nb, scr, F.lane); continue; }
        r -= I_IN;
        const int mi = r / I_SQ, q = r % I_SQ, kb = q / 32, nb = q % 32, n0 = 32 * nb;
        if (mi < 3) { transpose_item(a.in[I_WBR] + ((size_t)l * 3 + mi) * 1048576, 1024, 1024, WbrT + (size_t)mi * 1048576, 64 * kb, n0, n0, scr, F.lane); continue; }
        if (mi == 3) { transpose_item(a.in[I_WOUT] + (size_t)l * 1048576, 1024, 1024, WoutT, 64 * kb, n0, n0, scr, F.lane); continue; }
        const int e = (mi - 4) / 3, which = (mi - 4) % 3; const size_t eo = ((size_t)l * 16 + e) * 1048576;
        if (which == 0) transpose_item(a.in[I_W1] + eo, 1024, 1024, W13T + (size_t)e * 2097152, 64 * kb, n0, (n0 >> 7) * 256 + (n0 & 127), scr, F.lane);
        else if (which == 1) transpose_item(a.in[I_W3] + eo, 1024, 1024, W13T + (size_t)e * 2097152, 64 * kb, n0, (n0 >> 7) * 256 + 128 + (n0 & 127), scr, F.lane);
        else transpose_item(a.in[I_W2] + eo, 1024, 1024, W2T + (size_t)e * 1048576, 64 * kb, n0, n0, scr, F.lane);
    }
}

__device__ __forceinline__ void p1_filters(Frame& F, const Args& a, int l) {
    float* w3s = (float*)(F.shm + 72 * 1024);
    float* red = w3s + 512;
    float* nrm = red + 32;
    const float* zf = (const float*)(F.ws + WS_ZFEAT) + (size_t)l * LT * 64;
    bf16_t* filtR = (bf16_t*)(F.outb + OUT_FILT); float* fctx = (float*)(F.ws + WS_FCTX);
    const float da = -15.350567286626973f, db = -3.0701134573253946f;
    for (int cg = F.bid; cg < 256; cg += F.G) {
        const int c0 = 4 * cg;
        __syncthreads();
        { const int k = F.tid >> 3, q = F.tid & 7; w3s[F.tid] = a.in[I_FW3][((size_t)l * 64 + k) * 2048 + (q >> 2) * 1024 + c0 + (q & 3)]; }
        __syncthreads();
        float delta[4];
#pragma unroll
        for (int cc = 0; cc < 4; ++cc) delta[cc] = fabsf(da + (float)(c0 + cc) * ((db - da) / 1023.0f));
        float asum[4] = {0.f, 0.f, 0.f, 0.f};
        f32x4* slab = (f32x4*)(F.ws + WS_HRAW) + ((size_t)F.bid * 4096 + 8 * F.tid) * 2;
        { float h[8][8];
#pragma unroll
          for (int j = 0; j < 8; ++j)
#pragma unroll
            for (int q = 0; q < 8; ++q) h[j][q] = 0.f;
          const float* zc = zf + 8 * F.tid;
#pragma unroll 2
          for (int k = 0; k < 64; ++k) { const f32x4 za = *(const f32x4*)(zc + (size_t)k * LT), zb = *(const f32x4*)(zc + (size_t)k * LT + 4);
              const f32x4 wa = *(const f32x4*)(w3s + k * 8), wb = *(const f32x4*)(w3s + k * 8 + 4);
#pragma unroll
              for (int j = 0; j < 8; ++j) { const float z = j < 4 ? za[j] : zb[j - 4];
#pragma unroll
                  for (int q = 0; q < 4; ++q) { h[j][q] += z * wa[q]; h[j][4 + q] += z * wb[q]; } } }
#pragma unroll
          for (int j = 0; j < 8; ++j) { const int i = 8 * F.tid + j; const float tt = (float)i / 4095.0f; f32x4 hf, hbk;
#pragma unroll
              for (int cc = 0; cc < 4; ++cc) { const float dec = fast_exp(-tt * delta[cc]); hf[cc] = h[j][cc] * dec; hbk[cc] = h[j][4 + cc] * dec; asum[cc] += fabsf(hf[cc]) + fabsf(hbk[cc]); }
              slab[2 * j] = hf; slab[2 * j + 1] = hbk; } }
#pragma unroll
        for (int cc = 0; cc < 4; ++cc) { const float s = wave_sum(asum[cc]); if (F.lane == 0) red[F.wave * 4 + cc] = s; }
        __syncthreads();
        if (F.tid < 4) { float s = 0.f; for (int w = 0; w < 8; ++w) s += red[w * 4 + F.tid]; nrm[F.tid] = 1.0f / (s + EPS); }
        __syncthreads();
        { bf16_t* img = (bf16_t*)F.shm;
          if (F.tid < 4) img[F.tid * 8192] = 0;
#pragma unroll 1
          for (int j = 0; j < 8; ++j) { const int i = 8 * F.tid + j; const f32x4 hf = slab[2 * j], hbk = slab[2 * j + 1];
#pragma unroll
              for (int cc = 0; cc < 4; ++cc) { const float inv = nrm[cc];
                  img[cc * 8192 + 4096 - i] = (bf16_t)f2bf(hf[cc] * inv);
                  if (i > 0) img[cc * 8192 + 4096 + i] = (bf16_t)f2bf(hbk[cc] * inv); } }
          __syncthreads();
          for (int q = F.tid; q < 4096; q += 512) *(u32x4*)(filtR + (size_t)c0 * 8192 + q * 8) = *(const u32x4*)(img + q * 8);
        }
        __syncthreads();
        float hc[8]; float cs4[4] = {0.f, 0.f, 0.f, 0.f};
        if (F.tid < 256) {
            const float* zr = zf + LS + F.tid;
#pragma unroll
            for (int q = 0; q < 8; ++q) hc[q] = 0.f;
            for (int k = 0; k < 64; ++k) { const float z = zr[(size_t)k * LT];
#pragma unroll
                for (int q = 0; q < 8; ++q) hc[q] += z * w3s[k * 8 + q]; }
            const float tt = (float)F.tid / 255.0f;
#pragma unroll
            for (int cc = 0; cc < 4; ++cc) { const float dec = fast_exp(-tt * delta[cc]); hc[cc] *= dec; hc[4 + cc] *= dec; cs4[cc] = fabsf(hc[cc]) + fabsf(hc[4 + cc]); }
        }
#pragma unroll
        for (int cc = 0; cc < 4; ++cc) { const float s = wave_sum(cs4[cc]); if (F.lane == 0) red[F.wave * 4 + cc] = s; }
        __syncthreads();
        if (F.tid < 4) { float s = 0.f; for (int w = 0; w < 8; ++w) s += red[w * 4 + F.tid]; nrm[F.tid] = 1.0f / (s + EPS); }
        __syncthreads();
        if (F.tid < 256) {
#pragma unroll
            for (int q = 0; q < 8; ++q) fctx[((size_t)(q >> 2) * 256 + F.tid) * 1024 + c0 + (q & 3)] = hc[q] * nrm[q & 3];
        }
    }
}

__device__ __forceinline__ int load_sov(Frame& F, int row) { return F.lane < 16 ? ((const int*)(F.ws + WS_SLOTOF))[(size_t)row * 16 + F.lane] : -1; }
__device__ __forceinline__ void combine_row(Frame& F, f32x4 (&v)[4], const int sov, const f32x4 (&m5q)[4]) {
    const bf16_t* ys = (const bf16_t*)(F.ws + WS_XG) + 4 * F.lane;
    unsigned mask = (unsigned)(__ballot(sov >= 0) & 0xffffull);
    f32x4 s[4];
#pragma unroll
    for (int j = 0; j < 4; ++j) s[j] = (f32x4){0.f, 0.f, 0.f, 0.f};
    while (mask) {
        const int e0 = __builtin_ctz(mask); mask &= mask - 1; const bool two = mask != 0u; int e1 = e0; if (two) { e1 = __builtin_ctz(mask); mask &= mask - 1; }
        const int s0 = __builtin_amdgcn_readlane(sov, e0), s1 = __builtin_amdgcn_readlane(sov, e1); const float w1 = two ? 1.f : 0.f;
        const bf16_t* y0 = ys + (size_t)s0 * 1024; const bf16_t* y1 = ys + (size_t)s1 * 1024;
        u32x2 a[4], b[4];
#pragma unroll
        for (int j = 0; j < 4; ++j) { a[j] = *(const u32x2*)(y0 + 256 * j); b[j] = *(const u32x2*)(y1 + 256 * j); }
#pragma unroll
        for (int j = 0; j < 4; ++j) { s[j][0] += bflo(a[j].x) + w1 * bflo(b[j].x); s[j][1] += bfhi(a[j].x) + w1 * bfhi(b[j].x); s[j][2] += bflo(a[j].y) + w1 * bflo(b[j].y); s[j][3] += bfhi(a[j].y) + w1 * bfhi(b[j].y); }
    }
#pragma unroll
    for (int j = 0; j < 4; ++j) v[j] += m5q[j] * s[j];
}
__device__ __forceinline__ void p1_norm1(Frame& F, const Args& a, int l) {
    const int gw = F.bid * NWAVES + F.wave, NGW = F.G * NWAVES;
    float* xres = (float*)(F.ws + WS_XRES); bf16_t* hb = (bf16_t*)(F.ws + WS_H);
    const float* mods = (const float*)(F.ws + WS_MODS);
    const float* g1 = a.in[I_N1G] + (size_t)l * 1024;
#define N1_SRC(row_) ((l == 0) ? (((row_) % LT) < LS ? a.in[I_X] + ((size_t)((row_) / LT) * LS + ((row_) % LT)) * 1024 : a.in[I_CTX] + ((size_t)((row_) / LT) * LC + (((row_) % LT) - LS)) * 1024) : xres + (size_t)(row_) * 1024)
    const int rpw = (TROWS + NGW - 1) / NGW, r0 = gw * rpw, r1 = r0 + rpw < TROWS ? r0 + rpw : TROWS;
    f32x4 gq[4], shq[4], sclq[4], m5q[4]; int mr_cur = -1;
#pragma unroll
    for (int j = 0; j < 4; ++j) { gq[j] = *(const f32x4*)(g1 + 4 * F.lane + 256 * j); m5q[j] = (f32x4){0.f, 0.f, 0.f, 0.f}; }
    f32x4 vn[4]; int sovn = -1;
    if (r0 < r1) { const float* src = N1_SRC(r0);
#pragma unroll
        for (int j = 0; j < 4; ++j) vn[j] = *(const f32x4*)(src + 4 * F.lane + 256 * j);
        if (l > 0) sovn = load_sov(F, r0); }
    for (int row = r0; row < r1; ++row) {
        const int b = row / LT, t = row - b * LT; const int mr = t < LS ? b : 8;
        if (mr != mr_cur) { mr_cur = mr; const float* mrow = mods + ((size_t)l * 9 + mr) * 6144;
#pragma unroll
            for (int j = 0; j < 4; ++j) { shq[j] = *(const f32x4*)(mrow + 4 * F.lane + 256 * j); sclq[j] = *(const f32x4*)(mrow + 1024 + 4 * F.lane + 256 * j) + 1.0f;
                if (l > 0) m5q[j] = *(const f32x4*)(mods + ((size_t)(l - 1) * 9 + mr) * 6144 + 5 * 1024 + 4 * F.lane + 256 * j); } }
        f32x4 v[4]; const int sov = sovn;
#pragma unroll
        for (int j = 0; j < 4; ++j) v[j] = vn[j];
        if (row + 1 < r1) { const float* src = N1_SRC(row + 1);
#pragma unroll
            for (int j = 0; j < 4; ++j) vn[j] = *(const f32x4*)(src + 4 * F.lane + 256 * j);
            if (l > 0) sovn = load_sov(F, row + 1); }
        if (l > 0) combine_row(F, v, sov, m5q);
        float ss = 0.f;
#pragma unroll
        for (int j = 0; j < 4; ++j) { if (!F.dry) *(f32x4*)(xres + (size_t)row * 1024 + 4 * F.lane + 256 * j) = v[j]; ss += (v[j][0] * v[j][0] + v[j][1] * v[j][1]) + (v[j][2] * v[j][2] + v[j][3] * v[j][3]); }
        const float rstd = 1.0f / sqrtf(wave_sum(ss) * (1.0f / 1024.0f) + EPS);
#pragma unroll
        for (int j = 0; j < 4; ++j) { const int c = 4 * F.lane + 256 * j;
            const f32x4 y = (v[j] * rstd * gq[j]) * sclq[j] + shq[j];
            u32x2 w; w.x = cvtpk(y[0], y[1]); w.y = cvtpk(y[2], y[3]); *(u32x2*)(hb + (size_t)row * 1024 + c) = w; }
    }
#undef N1_SRC
}
__device__ __forceinline__ void pf_final(Frame& F, const Args& a) {
    const int gw = F.bid * NWAVES + F.wave, NGW = F.G * NWAVES;
    const float* xres = (const float*)(F.ws + WS_XRES); const float* mods = (const float*)(F.ws + WS_MODS);
    const float* g = a.in[I_FINALG];
#define FN_ROW(r_) (((r_) / LS) * LT + ((r_) % LS))
    const int rpw = (NB * LS + NGW - 1) / NGW, r0 = gw * rpw, r1 = r0 + rpw < NB * LS ? r0 + rpw : NB * LS;
    f32x4 gq[4], m5q[4]; int b_cur = -1;
#pragma unroll
    for (int j = 0; j < 4; ++j) gq[j] = *(const f32x4*)(g + 4 * F.lane + 256 * j);
    f32x4 vn[4]; int sovn = -1;
    if (r0 < r1) { const int row = FN_ROW(r0);
#pragma unroll
        for (int j = 0; j < 4; ++j) vn[j] = *(const f32x4*)(xres + (size_t)row * 1024 + 4 * F.lane + 256 * j);
        sovn = load_sov(F, row); }
    for (int r = r0; r < r1; ++r) {
        const int b = r / LS;
        if (b != b_cur) { b_cur = b;
#pragma unroll
            for (int j = 0; j < 4; ++j) m5q[j] = *(const f32x4*)(mods + ((size_t)(DEPTH - 1) * 9 + b) * 6144 + 5 * 1024 + 4 * F.lane + 256 * j); }
        f32x4 v[4]; const int sov = sovn;
#pragma unroll
        for (int j = 0; j < 4; ++j) v[j] = vn[j];
        if (r + 1 < r1) { const int row = FN_ROW(r + 1);
#pragma unroll
            for (int j = 0; j < 4; ++j) vn[j] = *(const f32x4*)(xres + (size_t)row * 1024 + 4 * F.lane + 256 * j);
            sovn = load_sov(F, row); }
        combine_row(F, v, sov, m5q);
        float ss = 0.f;
#pragma unroll
        for (int j = 0; j < 4; ++j) ss += (v[j][0] * v[j][0] + v[j][1] * v[j][1]) + (v[j][2] * v[j][2] + v[j][3] * v[j][3]);
        const float rstd = 1.0f / sqrtf(wave_sum(ss) * (1.0f / 1024.0f) + EPS);
#pragma unroll
        for (int j = 0; j < 4; ++j) { const int c = 4 * F.lane + 256 * j; *(f32x4*)(a.out + (size_t)r * 1024 + c) = v[j] * rstd * gq[j]; }
    }
#undef FN_ROW
}
__device__ __forceinline__ void p3_rope(Frame& F) {
    float* cst = (float*)F.shm;
    float* snt = cst + 1024;
    for (int i = F.tid; i < 1024; i += 512) { const int pos = i >> 4, f = i & 15; const float inv = __builtin_amdgcn_exp2f(-(float)f * (13.287712379549449f / 16.0f));
        const float ang = (float)pos * inv, rev = ang * 0.15915494309189535f; cst[i] = cos_rev(rev); snt[i] = sin_rev(rev); }
    __syncthreads();
    bf16_t* dq = (bf16_t*)(F.ws + WS_DQ); bf16_t* dk = (bf16_t*)(F.ws + WS_DK); bf16_t* sq = (bf16_t*)(F.ws + WS_SQ); bf16_t* sk = (bf16_t*)(F.ws + WS_SK);
    const int gw = F.bid * NWAVES + F.wave, NGW = F.G * NWAVES;
    for (int row = gw; row < TROWS; row += NGW) {
        const int b = row / LT, t = row - b * LT; const bool lat = t < LS;
        for (int it = F.lane; it < 208; it += 64) {
            const int hs = it >> 2, ax = (it >> 1) & 1, fc = it & 1;
            bf16_t* base; float scl;
            if (hs < 16) { base = dq + (size_t)row * 1024 + hs * 64; scl = QSCALE; }
            else if (hs < 32) { base = dk + (size_t)row * 1024 + (hs - 16) * 64; scl = 1.f; }
            else if (hs < 48) { base = sq + (size_t)row * 1024 + (hs - 32) * 64; scl = QSCALE; }
            else { base = sk + (size_t)row * 256 + (hs - 48) * 64; scl = 1.f; }
            if (!lat && scl == 1.f) continue;
            bf16_t* p1 = base + ax * 32 + fc * 8; bf16_t* p2 = p1 + 16;
            const u32x4 a = *(const u32x4*)p1, c = *(const u32x4*)p2;
            float x1[8], x2[8];
#pragma unroll
            for (int j = 0; j < 4; ++j) { x1[2 * j] = bflo(a[j]); x1[2 * j + 1] = bfhi(a[j]); x2[2 * j] = bflo(c[j]); x2[2 * j + 1] = bfhi(c[j]); }
            float o1[8], o2[8];
            if (lat) { const int pos = ax == 0 ? (t >> 6) : (t & 63);
#pragma unroll
                for (int j = 0; j < 8; ++j) { const float cs = cst[pos * 16 + fc * 8 + j], sn = snt[pos * 16 + fc * 8 + j]; o1[j] = (x1[j] * cs - x2[j] * sn) * scl; o2[j] = (x2[j] * cs + x1[j] * sn) * scl; }
            } else {
#pragma unroll
                for (int j = 0; j < 8; ++j) { o1[j] = x1[j] * scl; o2[j] = x2[j] * scl; }
            }
            u32x4 w1, w2;
#pragma unroll
            for (int j = 0; j < 4; ++j) { w1[j] = cvtpk(o1[2 * j], o1[2 * j + 1]); w2[j] = cvtpk(o2[2 * j], o2[2 * j + 1]); }
            if (!F.dry) { *(u32x4*)p1 = w1; *(u32x4*)p2 = w2; }
        }
    }
}
struct PreTile { int b, t0, c0, Lseq, tbase; bool lat; };
__device__ __forceinline__ PreTile pre_tile(int tile) {
    constexpr int NT_L = NB * 64 * 16;
    PreTile T; T.lat = tile < NT_L;
    if (T.lat) { T.b = tile / 1024; const int r = tile % 1024; T.t0 = (r >> 4) * 64; T.c0 = (r & 15) * 64; T.Lseq = LS; T.tbase = 0; }
    else { const int q = tile - NT_L; T.b = q / 64; const int r = q % 64; T.t0 = (r >> 4) * 64; T.c0 = (r & 15) * 64; T.Lseq = LC; T.tbase = LS; }
    return T;
}
__device__ __forceinline__ void pre_load(const bf16_t* hyb, const PreTile& T, int tl, int cc, u32x4 (&x)[3][3]) {
    const int t = T.t0 + tl, c = T.c0 + cc; const size_t row = (size_t)T.b * LT + T.tbase + t;
#pragma unroll
    for (int g = 0; g < 3; ++g)
#pragma unroll
        for (int k = 0; k < 3; ++k) { const int ts = t + k - 1; x[g][k] = (u32x4){0u, 0u, 0u, 0u};
            if (ts >= 0 && ts < T.Lseq) x[g][k] = *(const u32x4*)(hyb + (row + k - 1) * 3072 + g * 1024 + c); }
}
__device__ __forceinline__ void p3_hyena_pre(Frame& F, const Args& a, int l) {
    const bf16_t* hyb = (const bf16_t*)(F.ws + WS_HY); bf16_t* x0c = (bf16_t*)(F.ws + WS_H); bf16_t* zT = (bf16_t*)(F.outb + OUT_ZT); bf16_t* zctx = (bf16_t*)(F.ws + WS_ZCTX);
    const float* cw = a.in[I_HCW] + (size_t)l * 3 * 3072; const float* cb = a.in[I_HCB] + (size_t)l * 3072;
    bf16_t* zt = (bf16_t*)(F.shm + 40960);
    constexpr int NTILES = NB * 64 * 16 + NB * 4 * 16;
    const int tl = F.tid >> 3, cc = (F.tid & 7) * 8;
    u32x4 xn[3][3];
    float wq[3][3][8], bq[3][8]; int cw_c = -1;
    if (F.bid < NTILES) { const PreTile T = pre_tile(F.bid); pre_load(hyb, T, tl, cc, xn); }
    for (int tile = F.bid; tile < NTILES; tile += F.G) {
        const PreTile T = pre_tile(tile);
        u32x4 x[3][3];
#pragma unroll
        for (int g = 0; g < 3; ++g)
#pragma unroll
            for (int k = 0; k < 3; ++k) x[g][k] = xn[g][k];
        if (tile + F.G < NTILES) { const PreTile Tn = pre_tile(tile + F.G); pre_load(hyb, Tn, tl, cc, xn); }
        const int t = T.t0 + tl, c = T.c0 + cc;
        const size_t row = (size_t)T.b * LT + T.tbase + t;
        if (c != cw_c) { cw_c = c;
#pragma unroll
            for (int g = 0; g < 3; ++g) { const int ch = g * 1024 + c;
                const f32x4 bb0 = *(const f32x4*)(cb + ch), bb1 = *(const f32x4*)(cb + ch + 4);
#pragma unroll
                for (int j = 0; j < 4; ++j) { bq[g][j] = bb0[j]; bq[g][4 + j] = bb1[j]; }
#pragma unroll
                for (int k = 0; k < 3; ++k) { const f32x4 w0 = *(const f32x4*)(cw + k * 3072 + ch), w1 = *(const f32x4*)(cw + k * 3072 + ch + 4);
#pragma unroll
                    for (int j = 0; j < 4; ++j) { wq[g][k][j] = w0[j]; wq[g][k][4 + j] = w1[j]; } } } }
        float u[3][8];
#pragma unroll
        for (int g = 0; g < 3; ++g) {
#pragma unroll
            for (int j = 0; j < 8; ++j) u[g][j] = bq[g][j];
#pragma unroll
            for (int k = 0; k < 3; ++k) { const u32x4 xv = x[g][k];
#pragma unroll
                for (int j = 0; j < 4; ++j) { u[g][2 * j] += bflo(xv[j]) * wq[g][k][2 * j]; u[g][2 * j + 1] += bfhi(xv[j]) * wq[g][k][2 * j + 1]; } }
        }
        u32x4 w;
#pragma unroll
        for (int j = 0; j < 4; ++j) w[j] = cvtpk(u[0][2 * j], u[0][2 * j + 1]);
        *(u32x4*)(x0c + row * 1024 + c) = w;
        float z[8];
#pragma unroll
        for (int j = 0; j < 8; ++j) z[j] = u[1][j] * u[2][j];
        if (!T.lat) {
#pragma unroll
            for (int j = 0; j < 4; ++j) w[j] = cvtpk(z[2 * j], z[2 * j + 1]);
            *(u32x4*)(zctx + ((size_t)T.b * LC + t) * 1024 + c) = w;
        } else {
            __syncthreads();
#pragma unroll
            for (int j = 0; j < 8; ++j) zt[(cc + j) * 72 + tl] = (bf16_t)f2bf(z[j]);
            __syncthreads();
            const int cr = F.tid >> 3, ch8 = (F.tid & 7) * 8;
            const u32x4 v = *(const u32x4*)(zt + cr * 72 + ch8);
            *(u32x4*)(zT + ((size_t)(T.c0 + cr) * NB + T.b) * LS + T.t0 + ch8) = v;
        }
    }
}
__device__ __forceinline__ void p5_hyena_post(Frame& F, const Args& a, int l) {
    const bf16_t* convT = (const bf16_t*)(F.ws + WS_CONVT); const bf16_t* zT = (const bf16_t*)(F.outb + OUT_ZT); const bf16_t* x0c = (const bf16_t*)(F.ws + WS_H); bf16_t* yhy = (bf16_t*)(F.ws + WS_YHY);
    const float* hb = a.in[I_HBIAS] + (size_t)l * 1024;
    float* tl_ = (float*)(F.shm + 49152);
    constexpr int NTILES = NB * 64 * 16;
    const int cr = F.tid >> 3, ch8 = (F.tid & 7) * 8, tl = F.tid >> 3, cc = (F.tid & 7) * 8;
#define P5_LOAD(tile_, cv_, zv_, xv_) do { const int b_ = (tile_) / 1024, r_ = (tile_) % 1024, t0_ = (r_ >> 4) * 64, c0_ = (r_ & 15) * 64; \
        const size_t off_ = ((size_t)(c0_ + cr) * NB + b_) * LS + t0_ + ch8; cv_ = *(const u32x4*)(convT + off_); zv_ = *(const u32x4*)(zT + off_); \
        xv_ = *(const u32x4*)(x0c + ((size_t)b_ * LT + t0_ + tl) * 1024 + c0_ + cc); } while (0)
    u32x4 cvn, zvn, xvn;
    if (F.bid < NTILES) P5_LOAD(F.bid, cvn, zvn, xvn);
    for (int tile = F.bid; tile < NTILES; tile += F.G) {
        const int b = tile / 1024, r = tile % 1024, t0 = (r >> 4) * 64, c0 = (r & 15) * 64;
        const u32x4 cv = cvn, zv = zvn, xv = xvn;
        if (tile + F.G < NTILES) P5_LOAD(tile + F.G, cvn, zvn, xvn);
        __syncthreads();
        { const float bias = hb[c0 + cr];
#pragma unroll
          for (int j = 0; j < 4; ++j) { tl_[cr * 65 + ch8 + 2 * j] = bflo(cv[j]) + bflo(zv[j]) * bias; tl_[cr * 65 + ch8 + 2 * j + 1] = bfhi(cv[j]) + bfhi(zv[j]) * bias; } }
        __syncthreads();
        const size_t row = (size_t)b * LT + t0 + tl;
        u32x4 w;
#pragma unroll
        for (int j = 0; j < 4; ++j) w[j] = cvtpk(bflo(xv[j]) * tl_[(cc + 2 * j) * 65 + tl], bfhi(xv[j]) * tl_[(cc + 2 * j + 1) * 65 + tl]);
        *(u32x4*)(yhy + row * 1024 + c0 + cc) = w;
    }
#undef P5_LOAD
}
__device__ __forceinline__ void p4_hyena_ctx(Frame& F, const Args& a, int l) {
    const bf16_t* zctx = (const bf16_t*)(F.ws + WS_ZCTX); const float* fctx = (const float*)(F.ws + WS_FCTX); const bf16_t* x0c = (const bf16_t*)(F.ws + WS_H); bf16_t* yhy = (bf16_t*)(F.ws + WS_YHY);
    const float* hb = a.in[I_HBIAS] + (size_t)l * 1024;
    float* g = (float*)F.shm;
    float* zs = g + 512 * 32;
    for (int it = F.bid; it < 256; it += F.G) {
        const int b = it >> 5, c0 = (it & 31) * 32, c = F.tid & 31, tg = F.tid >> 5, t0 = tg * 16;
        __syncthreads();
        for (int i = F.tid; i < 512 * 32; i += 512) { const int x = i >> 5, cc = i & 31, lag = x - 256;
            g[i] = x == 0 ? 0.f : (lag >= 0 ? fctx[(size_t)lag * 1024 + c0 + cc] : fctx[(size_t)(256 - lag) * 1024 + c0 + cc]); }
        for (int i = F.tid; i < 256 * 32; i += 512) { const int s = i >> 5, cc = i & 31; zs[i] = bf2f(zctx[((size_t)b * LC + s) * 1024 + c0 + cc]); }
        __syncthreads();
        float acc[16];
#pragma unroll
        for (int j = 0; j < 16; ++j) acc[j] = 0.f;
#pragma unroll 1
        for (int sb = 0; sb < 8; ++sb) { const int s0 = 32 * sb;
            float fw[47], zv[32];
#pragma unroll
            for (int k = 0; k < 47; ++k) fw[k] = g[(t0 - s0 + 225 + k) * 32 + c];
#pragma unroll
            for (int si = 0; si < 32; ++si) zv[si] = zs[(s0 + si) * 32 + c];
#pragma unroll
            for (int si = 0; si < 32; ++si)
#pragma unroll
                for (int j = 0; j < 16; ++j) acc[j] += fw[j - si + 31] * zv[si];
        }
        const float bias = hb[c0 + c];
#pragma unroll
        for (int j = 0; j < 16; ++j) { const size_t row = (size_t)b * LT + LS + t0 + j;
            yhy[row * 1024 + c0 + c] = (bf16_t)f2bf(bf2f(x0c[row * 1024 + c0 + c]) * (acc[j] + zs[(t0 + j) * 32 + c] * bias)); }
    }
}
__device__ __forceinline__ void p4_hyena_lat(Frame& F) {
    const bf16_t* zT = (const bf16_t*)(F.outb + OUT_ZT); const bf16_t* filtR = (const bf16_t*)(F.outb + OUT_FILT); bf16_t* convT = (bf16_t*)(F.ws + WS_CONVT);
    hy::conv_init(F.shm);
    for (int c = F.bid; c < 1024; c += F.G) hy::conv_channel(F.shm, zT + (size_t)c * NB * LS, filtR + (size_t)c * 8192, convT + (size_t)c * NB * LS);
    asm volatile("s_waitcnt lgkmcnt(0)\n\ts_barrier" ::: "memory");
}

__device__ __forceinline__ void diff_unit(Frame& F, const Args& a, int l, int b, int h, int qrow, bool isctx, float lam, float lam_init) {
    bf16_t* dq = (bf16_t*)(F.ws + WS_DQ); const bf16_t* dk = (const bf16_t*)(F.ws + WS_DK); const bf16_t* dv = (const bf16_t*)(F.ws + WS_DV);
    f32x4* stash = (f32x4*)(F.outb + OUT_STASH) + (size_t)F.bid * 16 * 512 + F.tid;
    const int lane = F.lane, r32 = lane & 31, hi = lane >> 5;
    const size_t brow = (size_t)b * LT;
    f32x16 o[4], lf;
#pragma unroll 1
    for (int m = 0; m < 2; ++m) {
        att::Pass P;
        P.Qw = dq + (brow + qrow + F.wave * 32) * 1024 + h * 128 + m * 64; P.ldq = 1024;
        P.Kb = dk + brow * 1024 + h * 128 + m * 64; P.ldk = 1024;
        P.Vb = dv + brow * 1024 + h * 128; P.ldv = 1024;
        if (isctx) { P.nA = 0; P.ks = 0; P.nC = 4; } else { P.nA = LT / 64; P.ks = 0; P.nC = 0; }
        P.band = 0; P.qpos = qrow + F.wave * 32; P.m0 = -INFINITY; P.l0 = 0.f; P.rope = isctx ? 0 : 1; P.rtab = (const LAS float*)(F.lds + ROPE_OFF);
        att::flash_pass<128>(F.shm, P, o, lf);
        att::normalize<128>(o, lf);
        if (m == 0) {
            unsigned long long spa = (unsigned long long)stash; asm volatile("" : "+v"(spa)); GAS f32x4* sp = (GAS f32x4*)spa;
#pragma unroll
            for (int d = 0; d < 4; ++d)
#pragma unroll
                for (int g = 0; g < 4; ++g) sp[(d * 4 + g) * 512] = (f32x4){o[d][4 * g], o[d][4 * g + 1], o[d][4 * g + 2], o[d][4 * g + 3]};
        }
    }
    float ss[16];
#pragma unroll
    for (int r = 0; r < 16; ++r) ss[r] = 0.f;
    { unsigned long long spa = (unsigned long long)stash; asm volatile("" : "+v"(spa)); const GAS f32x4* sp = (const GAS f32x4*)spa;
#pragma unroll
      for (int d = 0; d < 4; ++d)
#pragma unroll
        for (int g = 0; g < 4; ++g) { const f32x4 o0 = sp[(d * 4 + g) * 512];
#pragma unroll
            for (int j = 0; j < 4; ++j) { const float y = o0[j] - lam * o[d][4 * g + j]; o[d][4 * g + j] = y; ss[4 * g + j] += y * y; } } }
#pragma unroll
    for (int r = 0; r < 16; ++r) { float s = ss[r];
#pragma unroll
        for (int off = 1; off < 32; off <<= 1) s += __shfl_xor(s, off);
        ss[r] = 1.0f / sqrtf(s * (1.0f / 128.0f) + EPS) * (1.0f - lam_init); }
    const float* sg = a.in[I_SUBLN] + (size_t)l * 128;
    { int ln_ = threadIdx.x & 63; asm volatile("" : "+v"(ln_)); const int r32 = ln_ & 31, hi = ln_ >> 5, lane = ln_;
      LAS bf16_t* stg = (LAS bf16_t*)F.lds + F.wave * 4096;
#pragma unroll
      for (int d = 0; d < 4; ++d) { const float g = sg[32 * d + r32];
#pragma unroll
        for (int r = 0; r < 16; ++r) stg[att::crow(r, hi) * 128 + 32 * d + r32] = (bf16_t)f2bf(o[d][r] * ss[r] * g); }
      LDS_WAIT();
      unsigned long long yba = (unsigned long long)(dq + (brow + qrow + F.wave * 32) * 1024 + h * 128); asm volatile("" : "+v"(yba)); GAS bf16_t* yb = (GAS bf16_t*)yba;
#pragma unroll
      for (int i = 0; i < 8; ++i) { const int row = i * 4 + (lane >> 4), ch = lane & 15; const u32x4 v = *(const LAS u32x4*)(stg + row * 128 + ch * 8); if (!F.dry) *(GAS u32x4*)(yb + row * 1024 + ch * 8) = v; }
      asm volatile("s_waitcnt lgkmcnt(0)\n\ts_barrier" ::: "memory"); }
}
__device__ __forceinline__ void p4_diff(Frame& F, const Args& a, int l, bool ctx_out) {
    const float* lp = a.in[I_DLAM] + (size_t)l * 256;
    const float d01 = wave_sum(lp[F.lane] * lp[64 + F.lane]), d23 = wave_sum(lp[128 + F.lane] * lp[192 + F.lane]);
    const float lam_init = 0.8f - 0.6f * expf(-0.3f * (float)l);
    const float lam = __uint_as_float(__builtin_amdgcn_readfirstlane(__float_as_uint(expf(d01) - expf(d23) + lam_init)));
    const int nun = NB * 8 * 16 + (ctx_out ? NB * 8 : 0);
    const int vcu = (F.G % 8 == 0) ? (F.bid % 8) * (F.G / 8) + F.bid / 8 : F.bid;
    for (int u = vcu; u < nun; u += F.G) {
        if (u < NB * 8 * 16) { const int b = u >> 7, h = (u >> 4) & 7, qb = u & 15; diff_unit(F, a, l, b, h, qb * 256, false, lam, lam_init); }
        else { const int v = u - NB * 8 * 16; diff_unit(F, a, l, v >> 3, v & 7, LS, true, lam, lam_init); }
    }
}
__device__ __forceinline__ void swa_unit(Frame& F, const Args& a, int l, int b, int kvh, int qrow, bool isctx) {
    bf16_t* sq = (bf16_t*)(F.ws + WS_SQ); const bf16_t* sk = (const bf16_t*)(F.ws + WS_SK); const bf16_t* sv = (const bf16_t*)(F.ws + WS_SV);
    const int lane = F.lane, r32 = lane & 31, hi = lane >> 5; const size_t brow = (size_t)b * LT; const int qh = kvh * 4 + (F.wave & 3), rh = F.wave >> 2;
    att::Pass P;
    P.Qw = sq + (brow + qrow + rh * 32) * 1024 + qh * 64; P.ldq = 1024;
    P.Kb = sk + brow * 256 + kvh * 64; P.ldk = 256; P.Vb = sv + brow * 256 + kvh * 64; P.ldv = 256;
    if (isctx) { P.nA = 0; P.ks = 0; P.nC = 4; P.band = 0; }
    else { const int ks = qrow >= 128 ? qrow - 128 : 0, ke = qrow + 192 <= LS ? qrow + 192 : LS; P.ks = ks; P.nA = (ke - ks) >> 6; P.nC = 4; P.band = 1; }
    P.qpos = (isctx ? 0 : qrow) + rh * 32; P.m0 = a.in[I_SINK][l * 16 + qh] * LOG2E; P.l0 = 1.0f; P.rope = isctx ? 0 : 1; P.rtab = (const LAS float*)(F.lds + ROPE_OFF);
    f32x16 o[2], lf;
    att::flash_pass<64>(F.shm, P, o, lf);
    att::normalize<64>(o, lf);
    { int ln_ = threadIdx.x & 63; asm volatile("" : "+v"(ln_)); const int r32 = ln_ & 31, hi = ln_ >> 5, lane = ln_;
      LAS bf16_t* stg = (LAS bf16_t*)F.lds + F.wave * 2048;
#pragma unroll
      for (int d = 0; d < 2; ++d)
#pragma unroll
        for (int r = 0; r < 16; ++r) stg[att::crow(r, hi) * 64 + 32 * d + r32] = (bf16_t)f2bf(o[d][r]);
      LDS_WAIT();
      unsigned long long yba = (unsigned long long)(sq + (brow + qrow + rh * 32) * 1024 + qh * 64); asm volatile("" : "+v"(yba)); GAS bf16_t* yb = (GAS bf16_t*)yba;
#pragma unroll
      for (int i = 0; i < 4; ++i) { const int row = i * 8 + (lane >> 3), ch = lane & 7; const u32x4 v = *(const LAS u32x4*)(stg + row * 64 + ch * 8); if (!F.dry) *(GAS u32x4*)(yb + row * 1024 + ch * 8) = v; }
      asm volatile("s_waitcnt lgkmcnt(0)\n\ts_barrier" ::: "memory"); }
}
__device__ __forceinline__ void p4_swa(Frame& F, const Args& a, int l, bool ctx_out) {
    const int nun = NB * 4 * 64 + (ctx_out ? NB * 4 * 4 : 0);
    const int vcu0 = (F.G % 8 == 0) ? (F.bid % 8) * (F.G / 8) + F.bid / 8 : F.bid;
    const int vcu = F.G - 1 - vcu0;
    for (int u = vcu; u < nun; u += F.G) {
        if (u < NB * 4 * 64) { const int b = u >> 8, kvh = (u >> 6) & 3, qb = u & 63; swa_unit(F, a, l, b, kvh, qb * 64, false); }
        else { const int v = u - NB * 4 * 64; swa_unit(F, a, l, v >> 4, (v >> 2) & 3, LS + (v & 3) * 64, true); }
    }
}
typedef float f32x2 __attribute__((ext_vector_type(2)));
__device__ __forceinline__ float p8_reduce32(const float (&p0)[16], const float (&p1)[16], int lane) {
    float s[16], t[8], u[4], w[2];
#pragma unroll
    for (int e = 0; e < 16; ++e) { const auto r = __builtin_amdgcn_permlane32_swap(__float_as_uint(p0[e]), __float_as_uint(p1[e]), false, false); s[e] = __uint_as_float(r[0]) + __uint_as_float(r[1]); }
#pragma unroll
    for (int e = 0; e < 8; ++e) { const auto r = __builtin_amdgcn_permlane16_swap(__float_as_uint(s[e]), __float_as_uint(s[e + 8]), false, false); t[e] = __uint_as_float(r[0]) + __uint_as_float(r[1]); }
#pragma unroll
    for (int e = 0; e < 4; ++e) {
        const float X = __builtin_bit_cast(float, __builtin_amdgcn_update_dpp(__builtin_bit_cast(int, t[e]), __builtin_bit_cast(int, t[e + 4]), 0x128, 0xf, 0xc, false));
        const float Y = __builtin_bit_cast(float, __builtin_amdgcn_update_dpp(__builtin_bit_cast(int, t[e + 4]), __builtin_bit_cast(int, t[e]), 0x128, 0xf, 0x3, false));
        u[e] = X + Y; }
#pragma unroll
    for (int e = 0; e < 2; ++e) {
        const float X = __builtin_bit_cast(float, __builtin_amdgcn_update_dpp(__builtin_bit_cast(int, u[e]), __builtin_bit_cast(int, u[e + 2]), 0x114, 0xf, 0xa, false));
        const float Y = __builtin_bit_cast(float, __builtin_amdgcn_update_dpp(__builtin_bit_cast(int, u[e + 2]), __builtin_bit_cast(int, u[e]), 0x104, 0xf, 0x5, false));
        w[e] = X + Y; }
    const bool b1 = (lane & 2) != 0;
    const float x = b1 ? w[1] : w[0], y = b1 ? w[0] : w[1];
    float z = x + __builtin_bit_cast(float, __builtin_amdgcn_update_dpp(0, __builtin_bit_cast(int, y), 0x4E, 0xf, 0xf, false));
    z += __builtin_bit_cast(float, __builtin_amdgcn_update_dpp(0, __builtin_bit_cast(int, z), 0xB1, 0xf, 0xf, false));
    return z;
}
__device__ __forceinline__ float half_sum(float v) {
    v += __builtin_bit_cast(float, __builtin_amdgcn_update_dpp(0, __builtin_bit_cast(int, v), 0x128, 0xf, 0xf, false));
    v += __builtin_bit_cast(float, __builtin_amdgcn_update_dpp(0, __builtin_bit_cast(int, v), 0x124, 0xf, 0xf, false));
    v += __builtin_bit_cast(float, __builtin_amdgcn_update_dpp(0, __builtin_bit_cast(int, v), 0x122, 0xf, 0xf, false));
    v += __builtin_bit_cast(float, __builtin_amdgcn_update_dpp(0, __builtin_bit_cast(int, v), 0x121, 0xf, 0xf, false));
    const auto r = __builtin_amdgcn_permlane16_swap(__float_as_uint(v), __float_as_uint(v), false, false); return __uint_as_float(r[0]) + __uint_as_float(r[1]);
}
__device__ __forceinline__ float half_max(float v) {
    v = fmaxf(v, __builtin_bit_cast(float, __builtin_amdgcn_update_dpp(0, __builtin_bit_cast(int, v), 0x128, 0xf, 0xf, false)));
    v = fmaxf(v, __builtin_bit_cast(float, __builtin_amdgcn_update_dpp(0, __builtin_bit_cast(int, v), 0x124, 0xf, 0xf, false)));
    v = fmaxf(v, __builtin_bit_cast(float, __builtin_amdgcn_update_dpp(0, __builtin_bit_cast(int, v), 0x122, 0xf, 0xf, false)));
    v = fmaxf(v, __builtin_bit_cast(float, __builtin_amdgcn_update_dpp(0, __builtin_bit_cast(int, v), 0x121, 0xf, 0xf, false)));
    const auto r = __builtin_amdgcn_permlane16_swap(__float_as_uint(v), __float_as_uint(v), false, false); return fmaxf(__uint_as_float(r[0]), __uint_as_float(r[1]));
}
__device__ __forceinline__ void p8_norm2_router(Frame& F, const Args& a, int l) {
    float* rwT = (float*)F.shm;
    const float* rw = a.in[I_ROUTER] + (size_t)l * 1024 * 16;
    for (int i = F.tid; i < 16384; i += 512) { const int k = i >> 4, e = i & 15; rwT[e * 1024 + k] = rw[i]; }
    __syncthreads();
    const int gw = F.bid * NWAVES + F.wave, NGW = F.G * NWAVES;
    const float* xres = (const float*)(F.ws + WS_XRES); bf16_t* hb = (bf16_t*)(F.ws + WS_H); float* aff = (float*)(F.ws + WS_AFF);
    const float* mods = (const float*)(F.ws + WS_MODS); const float* g2 = a.in[I_N2G] + (size_t)l * 1024;
    const int rpw = (((TROWS + NGW - 1) / NGW) + 1) & ~1, r0 = gw * rpw, r1 = r0 + rpw < TROWS ? r0 + rpw : TROWS;
    static_assert(TROWS % 2 == 0 && LT % 2 == 0 && LS % 2 == 0, "row pairs");
    int myrow, mye;
    { float t0[16], t1[16];
#pragma unroll
      for (int e = 0; e < 16; ++e) { float te = (float)e; asm volatile("" : "+v"(te)); t0[e] = te; t1[e] = te + 100.0f; }
      const int tg = (int)(p8_reduce32(t0, t1, F.lane) * (1.0f / 64.0f) + 0.5f); myrow = tg >= 100 ? 1 : 0; mye = tg - 100 * myrow; }
    f32x4 gq[4], shq[4], sclq[4]; int mr_cur = -1;
#pragma unroll
    for (int j = 0; j < 4; ++j) gq[j] = *(const f32x4*)(g2 + 4 * F.lane + 256 * j);
    f32x4 vn0[4], vn1[4];
    if (r0 < r1) {
#pragma unroll
        for (int j = 0; j < 4; ++j) { vn0[j] = *(const f32x4*)(xres + (size_t)r0 * 1024 + 4 * F.lane + 256 * j); vn1[j] = *(const f32x4*)(xres + (size_t)(r0 + 1) * 1024 + 4 * F.lane + 256 * j); } }
    for (int row = r0; row < r1; row += 2) {
        asm volatile("" ::: "memory");
        const int b = row / LT, t = row - b * LT; const int mr = t < LS ? b : 8;
        if (mr != mr_cur) { mr_cur = mr; const float* mrow = mods + ((size_t)l * 9 + mr) * 6144;
#pragma unroll
            for (int j = 0; j < 4; ++j) { shq[j] = *(const f32x4*)(mrow + 3 * 1024 + 4 * F.lane + 256 * j); sclq[j] = *(const f32x4*)(mrow + 4 * 1024 + 4 * F.lane + 256 * j) + 1.0f; } }
        f32x4 v0[4], v1[4]; float ss0 = 0.f, ss1 = 0.f;
#pragma unroll
        for (int j = 0; j < 4; ++j) { v0[j] = vn0[j]; v1[j] = vn1[j];
            ss0 += (v0[j][0] * v0[j][0] + v0[j][1] * v0[j][1]) + (v0[j][2] * v0[j][2] + v0[j][3] * v0[j][3]);
            ss1 += (v1[j][0] * v1[j][0] + v1[j][1] * v1[j][1]) + (v1[j][2] * v1[j][2] + v1[j][3] * v1[j][3]); }
        if (row + 2 < r1) {
#pragma unroll
            for (int j = 0; j < 4; ++j) { vn0[j] = *(const f32x4*)(xres + (size_t)(row + 2) * 1024 + 4 * F.lane + 256 * j); vn1[j] = *(const f32x4*)(xres + (size_t)(row + 3) * 1024 + 4 * F.lane + 256 * j); } }
        const float rstd0 = 1.0f / sqrtf(wave_sum(ss0) * (1.0f / 1024.0f) + EPS), rstd1 = 1.0f / sqrtf(wave_sum(ss1) * (1.0f / 1024.0f) + EPS);
#pragma unroll
        for (int j = 0; j < 4; ++j) { const int c = 4 * F.lane + 256 * j;
            v0[j] = (v0[j] * rstd0 * gq[j]) * sclq[j] + shq[j]; v1[j] = (v1[j] * rstd1 * gq[j]) * sclq[j] + shq[j];
            u32x2 w; w.x = cvtpk(v0[j][0], v0[j][1]); w.y = cvtpk(v0[j][2], v0[j][3]); *(u32x2*)(hb + (size_t)row * 1024 + c) = w;
            w.x = cvtpk(v1[j][0], v1[j][1]); w.y = cvtpk(v1[j][2], v1[j][3]); *(u32x2*)(hb + (size_t)(row + 1) * 1024 + c) = w; }
        float p0[16], p1[16];
#pragma unroll
        for (int e = 0; e < 16; ++e) { f32x2 a0 = (f32x2){0.f, 0.f}, a1 = a0;
#pragma unroll
            for (int j = 0; j < 4; ++j) { const f32x4 w = *(const f32x4*)(rwT + e * 1024 + 4 * F.lane + 256 * j); const f32x2 wl = (f32x2){w[0], w[1]}, wh = (f32x2){w[2], w[3]};
                a0 += (f32x2){v0[j][0], v0[j][1]} * wl; a0 += (f32x2){v0[j][2], v0[j][3]} * wh;
                a1 += (f32x2){v1[j][0], v1[j][1]} * wl; a1 += (f32x2){v1[j][2], v1[j][3]} * wh; }
            p0[e] = a0[0] + a0[1]; p1[e] = a1[0] + a1[1]; }
        const float lg = p8_reduce32(p0, p1, F.lane);
        const float mx = half_max(lg);
        const float ex = __expf(lg - mx);
        const float den = half_sum(ex) * 0.5f;
        aff[(size_t)(row + myrow) * 16 + mye] = ex / den;
    }
}
__device__ __forceinline__ void p9_topk_gather(Frame& F) {
    unsigned* hist = (unsigned*)F.shm;
    unsigned* sh = hist + 256;
    int* rowlist = (int*)(sh + 32);
    const float* aff = (const float*)(F.ws + WS_AFF); int* slotof = (int*)(F.ws + WS_SLOTOF); float* gate = (float*)(F.ws + WS_GATE);
    const bf16_t* hb = (const bf16_t*)(F.ws + WS_H); bf16_t* xg = (bf16_t*)(F.ws + WS_XG);
    for (int item = F.bid; item < 256; item += F.G) {
        const int q = item >> 1, part = item & 1, b = q >> 4, e = q & 15;
#pragma unroll 1
        for (int cx = 0; cx < 2; ++cx) {
            const bool isctx = cx == 1;
            const int N = isctx ? LC : LS, cap = N / 8, per = isctx ? 1 : 8;
            const int rbase = b * LT + (isctx ? LS : 0);
            const bool act = isctx ? (F.tid < 256) : true;
            unsigned key[8];
#pragma unroll
            for (int j = 0; j < 8; ++j) { key[j] = 0u; if (act && j < per) key[j] = __float_as_uint(aff[(size_t)(rbase + F.tid * per + j) * 16 + e]); }
            unsigned prefix = 0u, krem = (unsigned)cap;
#pragma unroll 1
            for (int pass = 3; pass >= 0; --pass) {
                const int shft = pass * 8; const unsigned himask = pass == 3 ? 0u : (0xffffffffu << (shft + 8));
                __syncthreads();
                if (F.tid < 256) hist[F.tid] = 0u;
                __syncthreads();
#pragma unroll
                for (int j = 0; j < 8; ++j) if (act && j < per && (key[j] & himask) == prefix) atomicAdd(&hist[(key[j] >> shft) & 255u], 1u);
                __syncthreads();
                if (F.wave == 0) {
                    const unsigned h0 = hist[4 * F.lane], h1 = hist[4 * F.lane + 1], h2 = hist[4 * F.lane + 2], h3 = hist[4 * F.lane + 3];
                    const unsigned own = h0 + h1 + h2 + h3; unsigned inc = own;
#pragma unroll
                    for (int off = 1; off < 64; off <<= 1) { const unsigned o = __shfl_down(inc, off); if (F.lane + off < 64) inc += o; }
                    const unsigned S = inc - own;
                    if (S < krem && krem <= S + own) {
                        unsigned cum = S; int bin;
                        if (cum + h3 >= krem) bin = 3; else { cum += h3; if (cum + h2 >= krem) bin = 2; else { cum += h2; if (cum + h1 >= krem) bin = 1; else { cum += h1; bin = 0; } } }
                        sh[0] = prefix | ((unsigned)(4 * F.lane + bin) << shft); sh[1] = krem - cum;
                    }
                }
                __syncthreads();
                prefix = sh[0]; krem = sh[1];
            }
            unsigned cg = 0u, ce = 0u;
#pragma unroll
            for (int j = 0; j < 8; ++j) if (act && j < per) { cg += key[j] > prefix ? 1u : 0u; ce += key[j] == prefix ? 1u : 0u; }
            unsigned pk = cg | (ce << 16), inc = pk;
#pragma unroll
            for (int off = 1; off < 64; off <<= 1) { const unsigned o = __shfl_up(inc, off); if (F.lane >= off) inc += o; }
            __syncthreads();
            if (F.lane == 63) sh[16 + F.wave] = inc;
            __syncthreads();
            unsigned base = 0u;
            for (int w = 0; w < F.wave; ++w) base += sh[16 + w];
            unsigned ex = base + inc - pk; unsigned gb = ex & 0xffffu, eb = ex >> 16;
            const int sbase = isctx ? SLOT_L + (e * NB + b) * CAP_C : (e * NB + b) * CAP_L;
#pragma unroll
            for (int j = 0; j < 8; ++j) if (act && j < per) {
                const int row = rbase + F.tid * per + j; int slot = -1;
                if (key[j] > prefix) { slot = (int)(gb + (eb < krem ? eb : krem)); gb++; }
                else if (key[j] == prefix) { if (eb < krem) slot = (int)(gb + eb); eb++; }
                if (slot >= 0) { rowlist[slot] = row; if (part == 0) gate[sbase + slot] = __uint_as_float(key[j]); slot += sbase; }
                if (part == 0) slotof[(size_t)row * 16 + e] = slot;
            }
            __syncthreads();
            const int hcap = cap >> 1;
            for (int s0 = part * hcap + 4 * F.wave; s0 < (part + 1) * hcap; s0 += 4 * NWAVES) {
                u32x4 d[4][2];
#pragma unroll
                for (int i = 0; i < 4; ++i) { const u32x4* src = (const u32x4*)(hb + (size_t)rowlist[s0 + i] * 1024) + F.lane; d[i][0] = src[0]; d[i][1] = src[64]; }
#pragma unroll
                for (int i = 0; i < 4; ++i) { u32x4* dst = (u32x4*)(xg + (size_t)(sbase + s0 + i) * 1024) + F.lane; dst[0] = d[i][0]; dst[64] = d[i][1]; }
            }
        }
    }
}
constexpr int PPL = 12;
constexpr int NPHASE = 1 + DEPTH * PPL + 1;

__device__ __forceinline__ void phase_stagger(int nunits, int G, int c, int unit_ticks) {
#ifndef MK_NOSTAGGER
    const int rem = nunits % G;
    if (rem == 0 || c < rem) return;
    const int g = ((c - rem) >> 3) % 3 + 1;
    const unsigned long long t0 = __builtin_amdgcn_s_memrealtime(); const unsigned long long d = (unsigned long long)(g * unit_ticks / 4);
    while (__builtin_amdgcn_s_memrealtime() - t0 < d) __builtin_amdgcn_s_sleep(8);
#endif
}

__global__ void __launch_bounds__(NWAVES * 64, 2) mk_fwd(Args args) {
    extern __shared__ __attribute__((aligned(16))) unsigned char lds[];
    Frame F;
    F.lds = (LAS unsigned char*)lds; F.shm = (char*)lds;
    F.tid = threadIdx.x; F.lane = F.tid & 63; F.wave = __builtin_amdgcn_readfirstlane(F.tid >> 6);
    F.G = gridDim.x; F.bid = blockIdx.x; F.ws = args.ws; F.outb = (unsigned char*)args.out; F.dry = 0;
    volatile LAS unsigned* MISC = (volatile LAS unsigned*)(F.lds + MISC_OFF);
    for (int u = F.tid; u < (LDS_BYTES - LDSCTL_OFF) / 4; u += NWAVES * 64) ((LAS unsigned*)(F.lds + LDSCTL_OFF))[u] = 0u;
    __syncthreads();
    { LAS float* rt_ = (LAS float*)(F.lds + ROPE_OFF);
      for (int i = F.tid; i < 1024; i += NWAVES * 64) { const int pos = i >> 4, f = i & 15; const float inv = __builtin_amdgcn_exp2f(-(float)f * (13.287712379549449f / 16.0f));
          const float rev = (float)pos * inv * 0.15915494309189535f; rt_[i] = cos_rev(rev); rt_[1024 + i] = sin_rev(rev); } }
    __syncthreads();
    unsigned* ctl = (unsigned*)(F.ws + WS_CTL);
    const int lo = args.ph_lo, hi = args.ph_hi;
    XcdBarrier bar; bar.bar = ctl + CW_BAR; bar.x = 0; bar.st = nullptr;
    if (hi - lo > 1) bar = xcd_barrier_post(ctl + CW_BAR, MISC + 8);
#ifdef MK_ONLY
#define PHON(j) ((j) == MK_ONLY)
#else
#define PHON(j) true
#endif
#define IN(k) (lo <= (k) && (k) < hi)
#ifndef MK_DUP
#define MK_DUP 0
#endif
#define NREP(bit) (((MK_DUP >> (bit)) & 1) ? 2 : 1)
#define REP(bit) _Pragma("unroll 1") for (int rep = 0; rep < NREP(bit); ++rep)
#define REPEND(bit) do { if (rep + 1 < NREP(bit)) xcd_barrier(bar); } while (0)
#define DRY(bit) (rep + 1 < NREP(bit))
#define LOCALF Frame Fp = F; Fp.tid = threadIdx.x; asm volatile("" : "+v"(Fp.tid)); Fp.lane = Fp.tid & 63
#define SEAM(k) do { if (IN((k) + 1)) xcd_barrier(bar); } while (0)
#define STAMP(k) do { } while (0)

    if (PHON(100) && IN(0)) { STAMP(0); REP(12) { LOCALF; p0_mods_zfeat(Fp, args); REPEND(12); } SEAM(0); }

    for (int l = 0; l < DEPTH; ++l) {
        const int pb = 1 + l * PPL;
        const float* mods_l = (const float*)(F.ws + WS_MODS) + (size_t)l * 9 * 6144;
        const int lastl = l == DEPTH - 1;
        if (PHON(0) && IN(pb + 0)) { STAMP(pb + 0);
#ifndef MK_SUB0
#define MK_SUB0 7
#endif
            REP(0) { LOCALF; Fp.dry = DRY(0);
            if (MK_SUB0 & 1) { p1_weights(Fp, args, l); __syncthreads(); }
            if (MK_SUB0 & 2) { p1_filters(Fp, args, l); __syncthreads(); }
            if (MK_SUB0 & 4) { p1_norm1(Fp, args, l); }
            REPEND(0); }
            SEAM(pb + 0); }
        if (PHON(1) && IN(pb + 1)) { STAMP(pb + 1);
            pg8::SchedPlain S; S.init((const bf16_t*)(F.ws + WS_H), (const bf16_t*)(F.ws + WS_WIN), TROWS, DIN, 1024, F.G, F.bid);
            pg8::EpiProj E; E.ws = F.ws; E.rope = (const LAS float*)(F.lds + ROPE_OFF);
            REP(1) { E.dry = DRY(1); pg8::gemm_phase<pg8::EpiProj, pg8::SchedPlain>(F.lds, 1024, S, E); REPEND(1); }
            SEAM(pb + 1);
        }
        if (PHON(2) && IN(pb + 2)) { STAMP(pb + 2); REP(2) { LOCALF; Fp.dry = DRY(2); p3_hyena_pre(Fp, args, l); REPEND(2); } SEAM(pb + 2); }
        if (PHON(3) && IN(pb + 3)) { STAMP(pb + 3);
#ifndef MK_SUB
#define MK_SUB 15
#endif
            if (MK_SUB & 1) { REP(3) { LOCALF; Fp.dry = DRY(3); p4_diff(Fp, args, l, !lastl); __syncthreads(); REPEND(3); } }
            if (MK_SUB & 2) { REP(4) { LOCALF; Fp.dry = DRY(4); p4_swa(Fp, args, l, !lastl); __syncthreads(); REPEND(4); } }
            REP(5) { if (MK_SUB & 4) { LOCALF; p4_hyena_lat(Fp); __syncthreads(); }
            if ((MK_SUB & 8) && !lastl) { LOCALF; p4_hyena_ctx(Fp, args, l); } REPEND(5); }
            SEAM(pb + 3); }
        if (PHON(4) && IN(pb + 4)) { STAMP(pb + 4); REP(6) { LOCALF; p5_hyena_post(Fp, args, l); REPEND(6); } SEAM(pb + 4); }
        if (PHON(5) && IN(pb + 5)) { STAMP(pb + 5);
            pg8::SchedBranch S; S.latonly = lastl; S.T.init(lastl ? NB * 16 : TROWS / 256, 4); S.G = F.G; S.c = F.bid; S.ws = (const char*)F.ws;
            S.B = (const char*)(F.ws + WS_WBR); S.tstep = (size_t)256 * 1024 * 2; S.bstep = (size_t)1024 * 1024 * 2;
            pg8::EpiBranch E; E.ws = F.ws; static_assert(WS_MERGED == OFF_DK && WS_GT == OFF_GT, "branch epilogue offsets");
            REP(7) { pg8::gemm_phase<pg8::EpiBranch, pg8::SchedBranch>(F.lds, 1024, S, E); REPEND(7); }
            SEAM(pb + 5);
        }
        if (PHON(6) && IN(pb + 6)) { STAMP(pb + 6);
            pg8::SchedPlain S; S.init((const bf16_t*)(F.ws + WS_MERGED), (const bf16_t*)(F.ws + WS_WOUT), TROWS, 1024, 1024, F.G, F.bid, lastl);
            pg8::EpiResid E; E.xres = (float*)(F.ws + WS_XRES); E.mod = mods_l;
            REP(8) { E.dry = DRY(8); pg8::gemm_phase<pg8::EpiResid, pg8::SchedPlain>(F.lds, 1024, S, E); REPEND(8); }
            SEAM(pb + 6);
        }
        if (PHON(7) && IN(pb + 7)) { STAMP(pb + 7); REP(9) { LOCALF; p8_norm2_router(Fp, args, l); REPEND(9); } SEAM(pb + 7); }
        if (PHON(8) && IN(pb + 8)) { STAMP(pb + 8); REP(14) { LOCALF; p9_topk_gather(Fp); REPEND(14); } SEAM(pb + 8); }
        if (PHON(9) && IN(pb + 9)) { STAMP(pb + 9); }
        if (PHON(10) && IN(pb + 10)) { STAMP(pb + 10);
            pg8::SchedMoe S; S.T.init(lastl ? SLOT_L / 256 : SLOTS / 256, 8); S.G = F.G; S.c = F.bid; S.A = (const char*)(F.ws + WS_XG); S.B = (const char*)(F.ws + WS_W13); S.tstep = (size_t)256 * 1024 * 2; S.estep = (size_t)2048 * 1024 * 2;
            pg8::EpiSwiglu E; E.hid = (bf16_t*)(F.ws + WS_HID);
            REP(10) { pg8::gemm_phase<pg8::EpiSwiglu, pg8::SchedMoe>(F.lds, 1024, S, E); REPEND(10); }
            SEAM(pb + 10);
        }
        if (PHON(11) && IN(pb + 11)) { STAMP(pb + 11);
            pg8::SchedMoe S; S.T.init(lastl ? SLOT_L / 256 : SLOTS / 256, 4); S.G = F.G; S.c = F.bid; S.A = (const char*)(F.ws + WS_HID); S.B = (const char*)(F.ws + WS_W2); S.tstep = (size_t)256 * 1024 * 2; S.estep = (size_t)1024 * 1024 * 2;
            pg8::EpiRowScale E; E.out = (bf16_t*)(F.ws + WS_XG); E.gate = (const float*)(F.ws + WS_GATE);
            REP(11) { pg8::gemm_phase<pg8::EpiRowScale, pg8::SchedMoe>(F.lds, 1024, S, E); REPEND(11); }
            SEAM(pb + 11);
        }
    }
    if (PHON(101) && IN(NPHASE - 1)) { STAMP(NPHASE - 1); REP(13) { LOCALF; pf_final(Fp, args); REPEND(13); }
    }
#undef IN
#undef SEAM
}

extern "C" void kernel_launch(void* const* d_in, const int* in_sizes, int n_in, void* d_out, int out_size, void* d_ws, size_t ws_size, hipStream_t stream) {
    static int grid = 0;
    if (grid == 0) {
        if (n_in != 28 || out_size != NB * LS * D || ws_size < WS_TOTAL) { fprintf(stderr, "kernel_launch: unexpected shapes (n_in %d out %d ws %zu need %zu)\n", n_in, out_size, ws_size, (size_t)WS_TOTAL); grid = -1; return; }
        int dev = 0, cus = 0, per_cu = 0;
        if (hipGetDevice(&dev) != hipSuccess || hipDeviceGetAttribute(&cus, hipDeviceAttributeMultiprocessorCount, dev) != hipSuccess) { grid = -1; return; }
        if (hipFuncSetAttribute((const void*)mk_fwd, hipFuncAttributeMaxDynamicSharedMemorySize, LDS_BYTES) != hipSuccess) { fprintf(stderr, "kernel_launch: hipFuncSetAttribute failed\n"); grid = -1; return; }
        if (hipOccupancyMaxActiveBlocksPerMultiprocessor(&per_cu, (const void*)mk_fwd, NWAVES * 64, LDS_BYTES) != hipSuccess || per_cu < 1) { fprintf(stderr, "kernel_launch: occupancy query says %d\n", per_cu); }
        (void)hipGetLastError();
        grid = cus;
    }
    if (grid < 0) return;
    if (hipMemsetAsync((char*)d_ws + WS_CTL, 0, CTL_ZERO_BYTES, stream) != hipSuccess) return;
    Args a{};
    for (int i = 0; i < 28; ++i) a.in[i] = (const float*)d_in[i];
    a.out = (float*)d_out; a.ws = (unsigned char*)d_ws;
#if MK_N_LAUNCHES == 1
    a.ph_lo = 0; a.ph_hi = NPHASE;
    hipLaunchKernelGGL(mk_fwd, dim3(grid), dim3(NWAVES * 64), LDS_BYTES, stream, a);
#else
    for (int p = 0; p < NPHASE; ++p) { a.ph_lo = p; a.ph_hi = p + 1; hipLaunchKernelGGL(mk_fwd, dim3(grid), dim3(NWAVES * 64), LDS_BYTES, stream, a); }
#endif
}
```

```cpp
#include <hip/hip_runtime.h>
#include <cstdio>
#include <cstdint>
#include <type_traits>

#ifndef MK_N_LAUNCHES
#define MK_N_LAUNCHES 1
#endif

#define LAS __attribute__((address_space(3)))
#define GAS __attribute__((address_space(1)))
typedef unsigned short bf16_t;
typedef short bf16x8 __attribute__((ext_vector_type(8)));
typedef short s16x4 __attribute__((ext_vector_type(4)));
typedef float f32x2 __attribute__((ext_vector_type(2)));
typedef float f32x4 __attribute__((ext_vector_type(4)));
typedef float f32x16 __attribute__((ext_vector_type(16)));
typedef unsigned u32x2 __attribute__((ext_vector_type(2)));
typedef unsigned u32x4 __attribute__((ext_vector_type(4)));
typedef GAS unsigned gu32;
#define RLX_AGENT __ATOMIC_RELAXED, __HIP_MEMORY_SCOPE_AGENT
#define LDS_WAIT() asm volatile("s_waitcnt lgkmcnt(0)" ::: "memory")
#define VM_WAIT() asm volatile("s_waitcnt vmcnt(0)" ::: "memory")

constexpr int NB = 8, LS = 4096, LC = 256, LT = LS + LC;
constexpr int TROWS = NB * LT;
constexpr int D = 1024, DIN = 10752, DEPTH = 4, NEXP = 16;
constexpr int CAP_L = 512, CAP_C = 32;
constexpr int SLOT_L = NEXP * NB * CAP_L, SLOT_C = NEXP * NB * CAP_C, SLOTS = SLOT_L + SLOT_C;
constexpr float EPS = 1e-6f;
constexpr float LOG2E = 1.4426950408889634f;
constexpr float QSCALE = 0.125f * LOG2E;

__device__ __forceinline__ unsigned f2bf(float f) { unsigned u = __builtin_bit_cast(unsigned, f); return (u + 0x7fffu + ((u >> 16) & 1u)) >> 16; }
__device__ __forceinline__ unsigned pk2(float lo, float hi) { return f2bf(lo) | (f2bf(hi) << 16); }
__device__ __forceinline__ float bf2f(unsigned v) { return __builtin_bit_cast(float, v << 16); }
__device__ __forceinline__ float bflo(unsigned w) { return __builtin_bit_cast(float, w << 16); }
__device__ __forceinline__ float bfhi(unsigned w) { return __builtin_bit_cast(float, w & 0xffff0000u); }
typedef __bf16 bf16x2_t __attribute__((ext_vector_type(2)));
__device__ __forceinline__ unsigned cvtpk(float lo, float hi) { f32x2 v = {lo, hi}; bf16x2_t b = __builtin_convertvector(v, bf16x2_t); return __builtin_bit_cast(unsigned, b); }
__device__ __forceinline__ u32x2 ldxr(const bf16_t* p) { return *(const u32x2*)p; }
__device__ __forceinline__ f32x4 cvx4(const u32x2 w) { return (f32x4){bflo(w.x), bfhi(w.x), bflo(w.y), bfhi(w.y)}; }
__device__ __forceinline__ void stx4(bf16_t* p, const f32x4& v) { u32x2 w; w.x = cvtpk(v[0], v[1]); w.y = cvtpk(v[2], v[3]); *(u32x2*)p = w; }
__device__ __forceinline__ float wave_sum(float v) {
    v += __builtin_bit_cast(float, __builtin_amdgcn_update_dpp(0, __builtin_bit_cast(int, v), 0x128, 0xf, 0xf, false));
    v += __builtin_bit_cast(float, __builtin_amdgcn_update_dpp(0, __builtin_bit_cast(int, v), 0x124, 0xf, 0xf, false));
    v += __builtin_bit_cast(float, __builtin_amdgcn_update_dpp(0, __builtin_bit_cast(int, v), 0x122, 0xf, 0xf, false));
    v += __builtin_bit_cast(float, __builtin_amdgcn_update_dpp(0, __builtin_bit_cast(int, v), 0x121, 0xf, 0xf, false));
    { const auto r = __builtin_amdgcn_permlane16_swap(__float_as_uint(v), __float_as_uint(v), false, false); v = __uint_as_float(r[0]) + __uint_as_float(r[1]); }
    { const auto r = __builtin_amdgcn_permlane32_swap(__float_as_uint(v), __float_as_uint(v), false, false); v = __uint_as_float(r[0]) + __uint_as_float(r[1]); }
    return v;
}
__device__ __forceinline__ float sin_rev(float rev) { return __builtin_amdgcn_sinf(__builtin_amdgcn_fractf(rev)); }
__device__ __forceinline__ float cos_rev(float rev) { return __builtin_amdgcn_cosf(__builtin_amdgcn_fractf(rev)); }
__device__ __forceinline__ float sin_rad(float x) { return sin_rev(x * 0.15915494309189535f); }
__device__ __forceinline__ float fast_exp(float x) { return __builtin_amdgcn_exp2f(x * LOG2E); }
__device__ __forceinline__ float sigmoidf_(float x) { return __builtin_amdgcn_rcpf(1.0f + fast_exp(-x)); }

constexpr size_t SZ1K = (size_t)TROWS * 1024 * 2;
constexpr size_t OFF_PROJ = (size_t)353 << 20;
constexpr size_t OFF_DQ = OFF_PROJ, OFF_DK = OFF_DQ + SZ1K, OFF_DV = OFF_DK + SZ1K, OFF_HY = OFF_DV + SZ1K, OFF_SQ = OFF_HY + 3 * SZ1K, OFF_SK = OFF_SQ + SZ1K, OFF_SV = OFF_SK + SZ1K / 4, OFF_GT = OFF_SV + SZ1K / 4;
constexpr size_t OFF_YHY = OFF_HY + ((size_t)64 << 20);

namespace pg8 {
constexpr int BM = 256, BK = 64, HALF = 128, HTB = HALF * BK * 2, STAGE_BYTES = 8 * HTB, NXCD = 8, WGM = 8;
__host__ __device__ __forceinline__ int lds_byte(int r, int c) { const int st = (r >> 4) * 2 + (c >> 5), rr = r & 15, cc = c & 31, ob = rr * 64 + cc * 2; return st * 1024 + (ob ^ (((ob >> 9) & 1) << 5)); }
__host__ __device__ __forceinline__ void stage_rc(int b, int& R, int& C) { const int st = b / 1024, sb = b % 1024, swz = sb ^ (((sb >> 9) & 1) << 5); R = (st >> 1) * 16 + swz / 64; C = (st & 1) * 32 + (swz % 64) / 2; }
__host__ __device__ __forceinline__ int perm32(int rho) { const int n = rho >> 4, i = rho & 15; return 8 * (i >> 2) + 4 * n + (i & 3); }

struct Unit { int pm, pn, aux; const char* A; const char* B; };

struct TileOrder {
    int nM, nN, nwg;
    __device__ __forceinline__ void init(int nM_, int nN_) { nM = nM_; nN = nN_; nwg = nM * nN; }
    __device__ __forceinline__ void map(int L, int& pm, int& pn) const {
        int wgid = L; { const int q = nwg / NXCD, r = nwg % NXCD, xcd = wgid % NXCD, off = wgid / NXCD; wgid = (xcd < r ? xcd * (q + 1) : r * (q + 1) + (xcd - r) * q) + off; }
        const int nig = WGM * nN, gid = wgid / nig, fm = gid * WGM, gsz = (nM - fm) < WGM ? (nM - fm) : WGM;
        pm = fm + ((wgid % nig) % gsz); pn = (wgid % nig) / gsz;
    }
};

template <class E_, class = void> struct EpiFull { static constexpr bool value = false; };
template <class E_> struct EpiFull<E_, decltype((void)E_::FULL)> { static constexpr bool value = E_::FULL; };
template <class Epi, class Sched>
__device__ __forceinline__ void gemm_phase(LAS unsigned char* lds, const int K, const Sched& S, const Epi& E) {
    int tid_ = threadIdx.x; asm volatile("" : "+v"(tid_));
    const int tid = tid_, wid = __builtin_amdgcn_readfirstlane(tid >> 6), lane = tid & 63, wr = wid >> 2, wc = wid & 3, fr = lane & 15, fq = lane >> 4;
    const int nt = K / BK;
    unsigned voffA[2], voffB[2];
    constexpr bool FULL = EpiFull<Epi>::value;
#pragma unroll
    for (int i = 0; i < 2; ++i) { int R, C; stage_rc(tid * 16 + i * 8192, R, C); const int Rb = Epi::PERM ? ((FULL ? (R >> 5) * 64 : (R & ~31)) + perm32(R & 31)) : R;
        voffA[i] = (unsigned)(R * K + C) * 2u; voffB[i] = (unsigned)(Rb * K + C) * 2u; }
    const size_t kstep = (size_t)(BK * 2);
    const size_t hstep = (size_t)HALF * K * 2;
    const size_t hstepB = FULL ? (size_t)32 * K * 2 : hstep;
    const unsigned ldsw = (unsigned)wid * 1024u;
    const int aoff = lds_byte(wr * 64 + fr, fq * 8), boff = lds_byte(wc * 32 + fr, fq * 8);
#define PG8_SA(b, h) (((b) * 2 + (h)) * HTB)
#define PG8_SB(b, h) ((4 + (b) * 2 + (h)) * HTB)
#define PG8_STAGE(bufoff, gbase, voff) do { _Pragma("unroll") for (int _i = 0; _i < 2; ++_i) \
        __builtin_amdgcn_global_load_lds((const unsigned*)((const char*)(gbase) + (voff)[_i]), (LAS unsigned*)(lds + (bufoff) + ldsw + _i * 8192), 16, 0, 0); } while (0)
#define PG8_LDA(dst, b, h) do { _Pragma("unroll") for (int m = 0; m < 4; ++m) _Pragma("unroll") for (int k = 0; k < 2; ++k) dst[m][k] = *(const LAS bf16x8*)(lds + PG8_SA(b, h) + aoff + m * 2048 + k * 1024); } while (0)
#define PG8_LDB(dst, b, h) do { _Pragma("unroll") for (int n = 0; n < 2; ++n) _Pragma("unroll") for (int k = 0; k < 2; ++k) dst[n][k] = *(const LAS bf16x8*)(lds + PG8_SB(b, h) + boff + n * 2048 + k * 1024); } while (0)
#define PG8_MMA(ai, bj, At, Bt) do { __builtin_amdgcn_s_setprio(1); _Pragma("unroll") for (int m = 0; m < 4; ++m) _Pragma("unroll") for (int n = 0; n < 2; ++n) _Pragma("unroll") for (int k = 0; k < 2; ++k) \
        acc[ai][bj][m][n] = __builtin_amdgcn_mfma_f32_16x16x32_bf16(Bt[n][k], At[m][k], acc[ai][bj][m][n], 0, 0, 0); __builtin_amdgcn_s_setprio(0); } while (0)
#define PG8_WAIT_V(n) asm volatile("s_waitcnt vmcnt(" #n ")" ::: "memory")
#define PG8_WAIT_L(n) asm volatile("s_waitcnt lgkmcnt(" #n ")" ::: "memory")
#define PG8_BAR __builtin_amdgcn_s_barrier()
#define PG8_SCHED __builtin_amdgcn_sched_barrier(0)
    Unit cur, nxt; int ui = 0;
    if (!S.next(0, cur)) return;
    f32x4 acc[2][2][4][2];
#pragma unroll
    for (int a = 0; a < 2; ++a)
#pragma unroll
        for (int b = 0; b < 2; ++b)
#pragma unroll
            for (int m = 0; m < 4; ++m)
#pragma unroll
                for (int n = 0; n < 2; ++n) acc[a][b][m][n] = (f32x4){0.f, 0.f, 0.f, 0.f};
    bf16x8 At[4][2], B0[2][2], B1[2][2];
    const char* cA = cur.A; const char* cB = cur.B;
    PG8_STAGE(PG8_SB(0, 0), cB, voffB); PG8_STAGE(PG8_SB(0, 1), cB + hstepB, voffB); PG8_STAGE(PG8_SA(0, 0), cA, voffA); PG8_STAGE(PG8_SA(0, 1), cA + hstep, voffA);
    if (wr == 1) PG8_BAR;
    PG8_WAIT_V(2); PG8_BAR;
    PG8_STAGE(PG8_SB(1, 0), cB + kstep, voffB); PG8_STAGE(PG8_SA(1, 0), cA + kstep, voffA); PG8_STAGE(PG8_SB(1, 1), cB + hstepB + kstep, voffB);
    PG8_WAIT_V(6); PG8_BAR;
    for (;;) {
        const bool has_next = S.next(ui + 1, nxt);
        const char* nA = has_next ? nxt.A : cA; const char* nB = has_next ? nxt.B : cB;
        for (int t = 0; t < nt; t += 2) {
            const bool last = (t == nt - 2);
            const char* a1 = cA + (size_t)(t + 1) * kstep;
            const char* a2 = last ? nA : cA + (size_t)(t + 2) * kstep; const char* b2 = last ? nB : cB + (size_t)(t + 2) * kstep;
            const char* a3 = a2 + kstep; const char* b3 = b2 + kstep;
            PG8_LDB(B0, 0, 0); PG8_LDB(B1, 0, 1); PG8_SCHED; PG8_LDA(At, 0, 0); PG8_STAGE(PG8_SA(1, 1), a1 + hstep, voffA);
            PG8_WAIT_V(8); PG8_WAIT_L(0); PG8_BAR; PG8_MMA(0, 0, At, B0); PG8_MMA(0, 1, At, B1); PG8_BAR; PG8_SCHED;
            PG8_LDA(At, 0, 1); PG8_STAGE(PG8_SB(0, 0), b2, voffB); PG8_STAGE(PG8_SB(0, 1), b2 + hstepB, voffB); PG8_STAGE(PG8_SA(0, 0), a2, voffA);
            PG8_WAIT_V(8); PG8_WAIT_L(0); PG8_BAR; PG8_MMA(1, 0, At, B0); PG8_MMA(1, 1, At, B1); PG8_BAR; PG8_SCHED;
            PG8_LDB(B0, 1, 0); PG8_LDB(B1, 1, 1); PG8_SCHED; PG8_LDA(At, 1, 0); PG8_STAGE(PG8_SA(0, 1), a2 + hstep, voffA);
            PG8_WAIT_V(8); PG8_WAIT_L(0); PG8_BAR; PG8_MMA(0, 0, At, B0); PG8_MMA(0, 1, At, B1); PG8_BAR; PG8_SCHED;
            PG8_LDA(At, 1, 1); PG8_STAGE(PG8_SB(1, 0), b3, voffB); PG8_STAGE(PG8_SB(1, 1), b3 + hstepB, voffB); PG8_STAGE(PG8_SA(1, 0), a3, voffA);
            PG8_WAIT_V(8); PG8_WAIT_L(0); PG8_BAR; PG8_MMA(1, 0, At, B0); PG8_MMA(1, 1, At, B1); PG8_BAR; PG8_SCHED;
        }
#ifndef PG8_NOALIGN
        if (wr == 0) PG8_BAR;
#else
        if (wr == 0 && !has_next) PG8_BAR;
#endif
        E(acc, cur, wr, wc, fr, fq);
        if (!has_next) break;
        if (!E.keep(cur)) {
#pragma unroll
            for (int a = 0; a < 2; ++a)
#pragma unroll
                for (int b = 0; b < 2; ++b)
#pragma unroll
                    for (int m = 0; m < 4; ++m)
#pragma unroll
                        for (int n = 0; n < 2; ++n) acc[a][b][m][n] = (f32x4){0.f, 0.f, 0.f, 0.f};
        }
        cur = nxt; cA = nA; cB = nB; ++ui;
#ifndef PG8_NOALIGN
        if (wr == 1) PG8_BAR;
#endif
    }
    PG8_WAIT_V(0);
    PG8_BAR;
#undef PG8_SA
#undef PG8_SB
#undef PG8_STAGE
#undef PG8_LDA
#undef PG8_LDB
#undef PG8_MMA
#undef PG8_WAIT_V
#undef PG8_WAIT_L
#undef PG8_BAR
#undef PG8_SCHED
}
}
namespace pg8 {

struct SchedPlain {
    TileOrder T; int G, c; const char* A; const char* B; size_t tstep; int latonly;
    __device__ __forceinline__ void init(const bf16_t* A_, const bf16_t* B_, int M, int N, int K, int G_, int c_, int latonly_ = 0) { latonly = latonly_; T.init(latonly_ ? NB * 16 : M / BM, N / BM); G = G_; c = c_; A = (const char*)A_; B = (const char*)B_; tstep = (size_t)BM * K * 2; }
    __device__ __forceinline__ bool next(int i, Unit& u) const {
        const long L = (long)i * G + c; if (L >= T.nwg) return false;
        T.map((int)L, u.pm, u.pn); if (latonly) u.pm = (u.pm >> 4) * 17 + (u.pm & 15); u.aux = 0; u.A = A + (size_t)u.pm * tstep; u.B = B + (size_t)u.pn * tstep; return true;
    }
};

struct EpiProj {
    static constexpr bool PERM = true;
    static constexpr bool FULL = true;
    unsigned char* ws;
    const LAS float* rope;
    int dry = 0;
    __device__ __forceinline__ bool keep(const Unit&) const { return false; }
    static __device__ __forceinline__ void trade(const u32x4& w0, const u32x4& w1, u32x4& X, u32x4& Y) {
#pragma unroll
        for (int j = 0; j < 4; ++j) {
            X[j] = (unsigned)__builtin_amdgcn_update_dpp((int)w0[j], (int)w1[j], 0x128, 0xf, 0xc, false);
            Y[j] = (unsigned)__builtin_amdgcn_update_dpp((int)w1[j], (int)w0[j], 0x128, 0xf, 0x3, false); }
    }
    __device__ __forceinline__ void operator()(f32x4 (&acc)[2][2][4][2], const Unit& u, int wr, int wc, int fr, int fq) const {
        if (dry) return;
        const int pn = u.pn; int t0, ldc; size_t boff; bool roped = false; float scl = 1.0f;
        if (pn < 4) { boff = OFF_DQ; t0 = 0; ldc = 1024; }                           else if (pn < 8) { boff = OFF_DK; t0 = 4; ldc = 1024; roped = true; } else if (pn < 12) { boff = OFF_DV; t0 = 8; ldc = 1024; }
        else if (pn < 24) { boff = OFF_HY; t0 = 12; ldc = 3072; } else if (pn < 28) { boff = OFF_SQ; t0 = 24; ldc = 1024; } else if (pn < 29) { boff = OFF_SK; t0 = 28; ldc = 256; roped = true; }
        else if (pn < 30) { boff = OFF_SV; t0 = 29; ldc = 256; } else { boff = OFF_GT; t0 = 30; ldc = 3072; }
        bf16_t* base = (bf16_t*)(ws + boff);
        const int row0 = u.pm * BM + wr * 64 + (fr & 7), col0 = (pn - t0) * BM + wc * 64 + 32 * (fr >> 3) + 8 * fq;
        const int tb = (u.pm % 17) * BM;
        const bool lat = tb < LS;
        if (roped) {
            const int half = fq >> 1, f0 = 8 * (fq & 1);
#pragma unroll
            for (int ai = 0; ai < 2; ++ai)
#pragma unroll
                for (int m = 0; m < 4; ++m) {
                    const int t = tb + wr * 64 + fr + ai * HALF + m * 16;
                    u32x4 wv[2];
#pragma unroll
                    for (int bj = 0; bj < 2; ++bj) { const int pos = bj == 0 ? (t >> 6) : (t & 63);
                        f32x4 c0 = (f32x4){1.f, 1.f, 1.f, 1.f}, c1 = c0, s0 = (f32x4){0.f, 0.f, 0.f, 0.f}, s1 = s0;
                        if (lat) { const LAS float* cp = rope + pos * 16 + f0; c0 = *(const LAS f32x4*)cp; c1 = *(const LAS f32x4*)(cp + 4); s0 = *(const LAS f32x4*)(cp + 1024); s1 = *(const LAS f32x4*)(cp + 1028); }
                        if (half == 0) { s0 = -s0; s1 = -s1; }
                        const f32x4 v0 = acc[ai][bj][m][0], v1 = acc[ai][bj][m][1];
                        f32x4 q0, q1;
#pragma unroll
                        for (int j = 0; j < 4; ++j) {
                            const auto r0 = __builtin_amdgcn_permlane32_swap(__float_as_uint(v0[j]), __float_as_uint(v0[j]), false, false);
                            const auto r1 = __builtin_amdgcn_permlane32_swap(__float_as_uint(v1[j]), __float_as_uint(v1[j]), false, false);
                            q0[j] = __uint_as_float(half == 0 ? r0[1] : r0[0]); q1[j] = __uint_as_float(half == 0 ? r1[1] : r1[0]); }
                        const f32x4 o0 = (v0 * c0 + q0 * s0) * scl, o1 = (v1 * c1 + q1 * s1) * scl;
                        wv[bj].x = cvtpk(o0[0], o0[1]); wv[bj].y = cvtpk(o0[2], o0[3]); wv[bj].z = cvtpk(o1[0], o1[1]); wv[bj].w = cvtpk(o1[2], o1[3]); }
                    u32x4 X, Y; trade(wv[0], wv[1], X, Y);
                    bf16_t* rowp = base + (size_t)(row0 + ai * HALF + m * 16) * ldc + col0;
                    *(u32x4*)rowp = X; *(u32x4*)(rowp + (size_t)8 * ldc) = Y;
                }
            return;
        }
#pragma unroll
        for (int ai = 0; ai < 2; ++ai)
#pragma unroll
            for (int m = 0; m < 4; ++m) { bf16_t* rowp = base + (size_t)(row0 + ai * HALF + m * 16) * ldc + col0;
                u32x4 wv[2];
#pragma unroll
                for (int bj = 0; bj < 2; ++bj) { const f32x4 v0 = acc[ai][bj][m][0], v1 = acc[ai][bj][m][1];
                    wv[bj].x = cvtpk(v0[0], v0[1]); wv[bj].y = cvtpk(v0[2], v0[3]); wv[bj].z = cvtpk(v1[0], v1[1]); wv[bj].w = cvtpk(v1[2], v1[3]); }
                u32x4 X, Y; trade(wv[0], wv[1], X, Y);
                *(u32x4*)rowp = X; *(u32x4*)(rowp + (size_t)8 * ldc) = Y; }
    }
};

struct SchedBranch {
    TileOrder T; int G, c; const char* ws; const char* B; size_t tstep, bstep; int latonly;
    __device__ __forceinline__ bool next(int i, Unit& u) const {
        const int ti = i / 3, br = i - ti * 3; const long L = (long)ti * G + c; if (L >= T.nwg) return false;
        T.map((int)L, u.pm, u.pn); if (latonly) u.pm = (u.pm >> 4) * 17 + (u.pm & 15); u.aux = br; size_t ao = br == 0 ? OFF_DQ : (br == 1 ? OFF_YHY : OFF_SQ); asm volatile("" : "+s"(ao));     u.A = ws + ao + (size_t)u.pm * tstep; u.B = B + (size_t)br * bstep + (size_t)u.pn * tstep; return true;
    }
};
struct EpiBranch {
    static constexpr bool PERM = true;
    unsigned char* ws;
    __device__ __forceinline__ bool keep(const Unit& u) const { return u.aux < 2; }
    __device__ __forceinline__ void operator()(f32x4 (&acc)[2][2][4][2], const Unit& u, int wr, int wc, int fr, int fq) const {
        const int br = u.aux;
        const bf16_t* gt = (const bf16_t*)(ws + OFF_GT); bf16_t* out = (bf16_t*)(ws + OFF_DK);
        const int row0 = u.pm * BM + wr * 64 + fr, col0 = u.pn * BM + wc * 32 + 8 * fq;
#pragma unroll
        for (int ai = 0; ai < 2; ++ai) {
            u32x4 GA[4][2], GB[4][2];
#pragma unroll
            for (int m = 0; m < 4; ++m)
#pragma unroll
                for (int bj = 0; bj < 2; ++bj) { const bf16_t* gp = gt + (size_t)(row0 + ai * HALF + m * 16) * 3072 + br * 1024 + col0 + bj * HALF;
                    GA[m][bj] = *(const u32x4*)gp; GB[m][bj] = br < 2 ? *(const u32x4*)(gp + 1024) : (u32x4){0u, 0u, 0u, 0u}; }
#pragma unroll
            for (int m = 0; m < 4; ++m) { const size_t row = (size_t)(row0 + ai * HALF + m * 16);
#pragma unroll
                for (int bj = 0; bj < 2; ++bj) {
                    const u32x4 ga = GA[m][bj], gb = GB[m][bj];
                    float s[8];
                    if (br < 2) {
#pragma unroll
                        for (int j = 0; j < 4; ++j) {
                            const float a0 = bflo(ga[j]), a1 = bfhi(ga[j]), b0 = bflo(gb[j]), b1 = bfhi(gb[j]);
                            s[2 * j]     = (1.0f + fast_exp(fminf(-b0, 80.f))) * __builtin_amdgcn_rcpf(1.0f + fast_exp(fminf(-a0, 80.f)));
                            s[2 * j + 1] = (1.0f + fast_exp(fminf(-b1, 80.f))) * __builtin_amdgcn_rcpf(1.0f + fast_exp(fminf(-a1, 80.f)));
                        }
                    } else {
#pragma unroll
                        for (int j = 0; j < 4; ++j) { s[2 * j] = __builtin_amdgcn_rcpf(1.0f + fast_exp(fminf(-bflo(ga[j]), 80.f))); s[2 * j + 1] = __builtin_amdgcn_rcpf(1.0f + fast_exp(fminf(-bfhi(ga[j]), 80.f))); }
                    }
                    f32x4 v0 = acc[ai][bj][m][0], v1 = acc[ai][bj][m][1];
                    v0[0] *= s[0]; v0[1] *= s[1]; v0[2] *= s[2]; v0[3] *= s[3]; v1[0] *= s[4]; v1[1] *= s[5]; v1[2] *= s[6]; v1[3] *= s[7];
                    if (br < 2) { acc[ai][bj][m][0] = v0; acc[ai][bj][m][1] = v1; }
                    else { u32x4 w; w.x = cvtpk(v0[0], v0[1]); w.y = cvtpk(v0[2], v0[3]); w.z = cvtpk(v1[0], v1[1]); w.w = cvtpk(v1[2], v1[3]);
                        *(u32x4*)(out + row * 1024 + col0 + bj * HALF) = w; }
                } }
            asm volatile("" ::: "memory"); }
    }
};

struct EpiResid {
    static constexpr bool PERM = true;
    bf16_t* xres; const float* mod; int dry;
    __device__ __forceinline__ bool keep(const Unit&) const { return false; }
    __device__ __forceinline__ void operator()(f32x4 (&acc)[2][2][4][2], const Unit& u, int wr, int wc, int fr, int fq) const {
        const int b = u.pm / 17, isctx = (u.pm - b * 17) == 16; const float* mrow = mod + (size_t)(isctx ? 8 : b) * 6144 + 2 * 1024;
        const int row0 = u.pm * BM + wr * 64 + fr, col0 = u.pn * BM + wc * 32 + 8 * fq;
        f32x4 mv[2][2];
#pragma unroll
        for (int bj = 0; bj < 2; ++bj)
#pragma unroll
            for (int n = 0; n < 2; ++n) mv[bj][n] = *(const f32x4*)(mrow + col0 + bj * HALF + n * 4);
#pragma unroll
        for (int ai = 0; ai < 2; ++ai)
#pragma unroll
            for (int m = 0; m < 4; ++m) { bf16_t* rowp = xres + (size_t)(row0 + ai * HALF + m * 16) * 1024 + col0;
#pragma unroll
                for (int bj = 0; bj < 2; ++bj) { u32x4* p = (u32x4*)(rowp + bj * HALF); const u32x4 x = *p;
                    const f32x4 o0 = (f32x4){bflo(x.x), bfhi(x.x), bflo(x.y), bfhi(x.y)} + mv[bj][0] * acc[ai][bj][m][0], o1 = (f32x4){bflo(x.z), bfhi(x.z), bflo(x.w), bfhi(x.w)} + mv[bj][1] * acc[ai][bj][m][1];
                    u32x4 w; w.x = cvtpk(o0[0], o0[1]); w.y = cvtpk(o0[2], o0[3]); w.z = cvtpk(o1[0], o1[1]); w.w = cvtpk(o1[2], o1[3]);
                    if (!dry) *p = w; }
                if (m == 3) asm volatile("" ::: "memory"); }
    }
};

struct SchedMoe {
    TileOrder T; int G, c; const char* A; const char* B; size_t tstep, estep;
    __device__ __forceinline__ bool next(int i, Unit& u) const {
        const long L = (long)i * G + c; if (L >= T.nwg) return false;
        T.map((int)L, u.pm, u.pn); const int e = u.pm < 256 ? (u.pm >> 4) : (u.pm - 256); u.aux = e;
        u.A = A + (size_t)u.pm * tstep; u.B = B + (size_t)e * estep + (size_t)u.pn * tstep; return true;
    }
};
struct EpiSwiglu {
    static constexpr bool PERM = true;
    bf16_t* hid;
    __device__ __forceinline__ bool keep(const Unit&) const { return false; }
    __device__ __forceinline__ void operator()(f32x4 (&acc)[2][2][4][2], const Unit& u, int wr, int wc, int fr, int fq) const {
        const int row0 = u.pm * BM + wr * 64 + fr, col0 = u.pn * HALF + wc * 32 + 8 * fq;
#pragma unroll
        for (int ai = 0; ai < 2; ++ai)
#pragma unroll
            for (int m = 0; m < 4; ++m) { bf16_t* rowp = hid + (size_t)(row0 + ai * HALF + m * 16) * 1024 + col0;
                float h[8];
#pragma unroll
                for (int n = 0; n < 2; ++n)
#pragma unroll
                    for (int j = 0; j < 4; ++j) { const float a = acc[ai][0][m][n][j], b = acc[ai][1][m][n][j]; h[4 * n + j] = a * __builtin_amdgcn_rcpf(1.0f + fast_exp(-a)) * b; }
                u32x4 w; w.x = cvtpk(h[0], h[1]); w.y = cvtpk(h[2], h[3]); w.z = cvtpk(h[4], h[5]); w.w = cvtpk(h[6], h[7]);
                *(u32x4*)rowp = w; }
    }
};
struct EpiRowScale {
    static constexpr bool PERM = true;
    bf16_t* out; const float* gate;
    __device__ __forceinline__ bool keep(const Unit&) const { return false; }
    __device__ __forceinline__ void operator()(f32x4 (&acc)[2][2][4][2], const Unit& u, int wr, int wc, int fr, int fq) const {
        const int row0 = u.pm * BM + wr * 64 + fr, col0 = u.pn * BM + wc * 32 + 8 * fq;
#pragma unroll
        for (int ai = 0; ai < 2; ++ai)
#pragma unroll
            for (int m = 0; m < 4; ++m) { const int row = row0 + ai * HALF + m * 16; const float g = gate[row]; bf16_t* rowp = out + (size_t)row * 1024 + col0;
#pragma unroll
                for (int bj = 0; bj < 2; ++bj) { const f32x4 v0 = acc[ai][bj][m][0] * g, v1 = acc[ai][bj][m][1] * g;
                    u32x4 w; w.x = cvtpk(v0[0], v0[1]); w.y = cvtpk(v0[2], v0[3]); w.z = cvtpk(v1[0], v1[1]); w.w = cvtpk(v1[2], v1[3]);
                    *(u32x4*)(rowp + bj * HALF) = w; } }
    }
};
}
namespace att {
__device__ __forceinline__ int crow(int r, int hi) { return (r & 3) + 8 * (r >> 2) + 4 * hi; }
__device__ __forceinline__ void glds16(const void* gsrc, unsigned lds_dst) { unsigned keep;
    asm volatile("s_mov_b32 %0, m0\n\ts_mov_b32 m0, %2\n\ts_nop 0\n\tglobal_load_lds_dwordx4 %1, off\n\ts_mov_b32 m0, %0" : "=&s"(keep) : "v"(gsrc), "s"(lds_dst) : "memory"); }
#define ATT_WAIT_BAR() asm volatile("s_waitcnt vmcnt(0) lgkmcnt(0)\n\ts_barrier" ::: "memory")

constexpr int KSLOT = 8192;
constexpr int NSLOT = 4;
template <int DV> struct Lay { static constexpr int VSLOT = DV * 128, K0 = 0, V0 = NSLOT * KSLOT, WS = V0 + NSLOT * VSLOT, BYTES = WS + 8 * 256; };

struct Pass {
    const bf16_t* Qw; int ldq;
    const bf16_t* Kb; int ldk;
    const bf16_t* Vb; int ldv;
    int nA, ks, nC;
    int band;
    int qpos;
    float m0, l0;
    int rope; const LAS float* rtab;
};

__device__ __forceinline__ float max3f(float a, float b, float c) { float r; asm("v_max3_f32 %0, %1, %2, %3" : "=v"(r) : "v"(a), "v"(b), "v"(c)); return r; }
constexpr float ATT_THR = 8.0f;

template <int DV>
__device__ __forceinline__ void flash_pass(char* shm, const Pass& P, f32x16 (&o)[DV / 32], f32x16& osum) {
    typedef Lay<DV> L;
    int tid_ = threadIdx.x; asm volatile("" : "+v"(tid_));
    const int tid = tid_, lane = tid & 63, r32 = lane & 31, hi = lane >> 5; const int wid = __builtin_amdgcn_readfirstlane(tid >> 6);
    const unsigned lds0 = (unsigned)(uintptr_t)shm;
    float* wsf = (float*)(shm + L::WS) + wid * 64;
    const int NT = P.nA + P.nC;
    bf16x8 qr[4];
#pragma unroll
    for (int d0 = 0; d0 < 4; ++d0) qr[d0] = *reinterpret_cast<const bf16x8*>(P.Qw + (size_t)r32 * P.ldq + d0 * 16 + hi * 8);
    { const int tq = P.qpos + r32;
#pragma unroll
      for (int ax = 0; ax < 2; ++ax) {
          f32x4 c0 = (f32x4){1.f, 1.f, 1.f, 1.f}, c1 = c0, s0 = (f32x4){0.f, 0.f, 0.f, 0.f}, s1 = s0;
          if (P.rope) { const LAS float* cp = P.rtab + (ax == 0 ? (tq >> 6) : (tq & 63)) * 16 + 8 * hi; c0 = *(const LAS f32x4*)cp; c1 = *(const LAS f32x4*)(cp + 4); s0 = *(const LAS f32x4*)(cp + 1024); s1 = *(const LAS f32x4*)(cp + 1028); }
          const u32x4 a = __builtin_bit_cast(u32x4, qr[2 * ax]), b = __builtin_bit_cast(u32x4, qr[2 * ax + 1]); u32x4 oa, ob;
#pragma unroll
          for (int j = 0; j < 4; ++j) { const float cl = j < 2 ? c0[2 * j] : c1[2 * j - 4], ch = j < 2 ? c0[2 * j + 1] : c1[2 * j - 3], sl_ = j < 2 ? s0[2 * j] : s1[2 * j - 4], sh_ = j < 2 ? s0[2 * j + 1] : s1[2 * j - 3];
              const float x1l = bflo(a[j]), x1h = bfhi(a[j]), x2l = bflo(b[j]), x2h = bfhi(b[j]);
              oa[j] = cvtpk((x1l * cl - x2l * sl_) * QSCALE, (x1h * ch - x2h * sh_) * QSCALE); ob[j] = cvtpk((x2l * cl + x1l * sl_) * QSCALE, (x2h * ch + x1h * sh_) * QSCALE); }
          qr[2 * ax] = __builtin_bit_cast(bf16x8, oa); qr[2 * ax + 1] = __builtin_bit_cast(bf16x8, ob); } }
#pragma unroll
    for (int d = 0; d < DV / 32; ++d) o[d] = f32x16{};
    float lsum = (hi == 0) ? P.l0 : 0.f;
    const bf16_t* ksrc = P.Kb + (size_t)lane * P.ldk + wid * 8;
    const bf16_t* vsrc = P.Vb + (size_t)(16 * (wid & 3) + (lane >> 2)) * P.ldv + (wid >> 2) * 32 + (lane & 3) * 8;
#define ATT_KEYROW(t) ((t) < P.nA ? P.ks + 64 * (t) : LS + 64 * ((t) - P.nA))
#define ATT_DMA_K(t, slot) do { const int kr_ = ATT_KEYROW(t); \
        glds16(ksrc + (size_t)kr_ * P.ldk, (unsigned)__builtin_amdgcn_readfirstlane(lds0 + L::K0 + (slot) * KSLOT + wid * 1024)); } while (0)
#define ATT_DMA_V(t, slot, s2_) do { const int kr_ = ATT_KEYROW(t); \
        glds16(vsrc + (size_t)kr_ * P.ldv + (s2_) * 64, (unsigned)__builtin_amdgcn_readfirstlane(lds0 + L::V0 + (slot) * L::VSLOT + (s2_) * 8192 + wid * 1024)); } while (0)
#define ATT_DMA(t, slot) do { ATT_DMA_K(t, slot); _Pragma("unroll") for (int s2__ = 0; s2__ < DV / 64; ++s2__) ATT_DMA_V(t, slot, s2__); } while (0)
#define ATT_QK(p0_, p1_, slot, cinit) do { const char* kb_ = shm + L::K0 + (slot) * KSLOT + hi * 1024 + r32 * 16; bf16x8 kf_[4]; \
        _Pragma("unroll") for (int d0 = 0; d0 < 2; ++d0) { kf_[2 * d0] = *reinterpret_cast<const bf16x8*>(kb_ + d0 * 2048); kf_[2 * d0 + 1] = *reinterpret_cast<const bf16x8*>(kb_ + d0 * 2048 + 512); } \
        __builtin_amdgcn_sched_barrier(0);        \
        p0_ = __builtin_amdgcn_mfma_f32_32x32x16_bf16(kf_[0], qr[0], cinit, 0, 0, 0); p1_ = __builtin_amdgcn_mfma_f32_32x32x16_bf16(kf_[1], qr[0], cinit, 0, 0, 0); \
        p0_ = __builtin_amdgcn_mfma_f32_32x32x16_bf16(kf_[2], qr[1], p0_, 0, 0, 0); p1_ = __builtin_amdgcn_mfma_f32_32x32x16_bf16(kf_[3], qr[1], p1_, 0, 0, 0); \
        __builtin_amdgcn_sched_barrier(0); \
        _Pragma("unroll") for (int d0 = 2; d0 < 4; ++d0) { kf_[2 * d0 - 4] = *reinterpret_cast<const bf16x8*>(kb_ + d0 * 2048); kf_[2 * d0 - 3] = *reinterpret_cast<const bf16x8*>(kb_ + d0 * 2048 + 512); } \
        __builtin_amdgcn_sched_barrier(0); \
        p0_ = __builtin_amdgcn_mfma_f32_32x32x16_bf16(kf_[0], qr[2], p0_, 0, 0, 0); p1_ = __builtin_amdgcn_mfma_f32_32x32x16_bf16(kf_[1], qr[2], p1_, 0, 0, 0); \
        p0_ = __builtin_amdgcn_mfma_f32_32x32x16_bf16(kf_[2], qr[3], p0_, 0, 0, 0); p1_ = __builtin_amdgcn_mfma_f32_32x32x16_bf16(kf_[3], qr[3], p1_, 0, 0, 0); } while (0)
#define ATT_ROWMAX(rm_, p0_, p1_) do { float a_ = max3f(p0_[0], p0_[1], p1_[0]), b_ = max3f(p0_[2], p0_[3], p1_[1]); a_ = max3f(a_, p1_[2], p1_[3]); \
        _Pragma("unroll") for (int r = 4; r < 16; r += 4) { a_ = max3f(a_, p0_[r], p0_[r + 1]); b_ = max3f(b_, p0_[r + 2], p0_[r + 3]); a_ = max3f(a_, p1_[r], p1_[r + 1]); b_ = max3f(b_, p1_[r + 2], p1_[r + 3]); } \
        rm_ = fmaxf(a_, b_); auto rr_ = __builtin_amdgcn_permlane32_swap(__float_as_uint(rm_), __float_as_uint(rm_), false, false); rm_ = fmaxf(__uint_as_float(rr_[0]), __uint_as_float(rr_[1])); } while (0)
    ATT_DMA(0, 0);
#define ATT_WAITV(ktiles) do { if ((ktiles) == 0) asm volatile("s_waitcnt vmcnt(0)" ::: "memory"); \
        else if ((ktiles) == 1) { if (DV == 128) asm volatile("s_waitcnt vmcnt(3)" ::: "memory"); else asm volatile("s_waitcnt vmcnt(2)" ::: "memory"); } \
        else { if (DV == 128) asm volatile("s_waitcnt vmcnt(6)" ::: "memory"); else asm volatile("s_waitcnt vmcnt(4)" ::: "memory"); } } while (0)
    if (NT > 1) ATT_DMA(1, 1);
    if (NT > 2) ATT_DMA(2, 2);
    { const int younger = NT > 2 ? 2 : (NT > 1 ? 1 : 0); ATT_WAITV(younger); }
    asm volatile("s_waitcnt lgkmcnt(0)\n\ts_barrier" ::: "memory");
    f32x16 p0, p1, n0, n1, negm;
    { const f32x16 zero = f32x16{}; ATT_QK(p0, p1, 0, zero); }
    asm volatile("s_nop 15\n\ts_nop 7" : "+v"(p0), "+v"(p1));
#define ATT_NEEDMASK(tt) (P.band && (tt) < P.nA && !(P.ks + 64 * (tt) >= P.qpos - 97 && P.ks + 64 * (tt) <= P.qpos + 65))
#define ATT_MASK(v0_, v1_, tt) do { const int q_ = P.qpos + r32, kb0_ = P.ks + 64 * (tt) + 4 * hi; \
        _Pragma("unroll") for (int r = 0; r < 16; ++r) { const int kv_ = kb0_ + (r & 3) + 8 * (r >> 2); int dd_ = kv_ - q_; dd_ = dd_ < 0 ? -dd_ : dd_; int d1_ = kv_ + 32 - q_; d1_ = d1_ < 0 ? -d1_ : d1_; \
            if (dd_ > 128) v0_[r] = -INFINITY; if (d1_ > 128) v1_[r] = -INFINITY; } } while (0)
    if (ATT_NEEDMASK(0)) ATT_MASK(p0, p1, 0);
    float m; { float rm0; ATT_ROWMAX(rm0, p0, p1); m = fmaxf(P.m0, rm0); }
    lsum *= __builtin_amdgcn_exp2f(P.m0 - m);
#pragma unroll
    for (int r = 0; r < 16; ++r) { p0[r] -= m; p1[r] -= m; negm[r] = -m; }
    n0 = p0; n1 = p1;
    int sl = 0;
    for (int t = 0; t < NT; ++t) {
        { const int younger = t + 2 < NT ? 1 : 0; ATT_WAITV(younger); }
        asm volatile("s_waitcnt lgkmcnt(0)\n\ts_barrier" ::: "memory");
        const int sl1 = (sl + 1) & (NSLOT - 1), sl2 = (sl + 3) & (NSLOT - 1);
        if (t + 1 < NT) { ATT_QK(n0, n1, sl1, negm); }
        __builtin_amdgcn_sched_barrier(0);
        const bool pre = t + 3 < NT;
        if (pre) ATT_DMA_K(t + 3, sl2);
        { float sacc = 0.f;
#pragma unroll
          for (int r = 0; r < 16; ++r) { p0[r] = __builtin_amdgcn_exp2f(p0[r]); p1[r] = __builtin_amdgcn_exp2f(p1[r]); sacc += p0[r] + p1[r]; }
          lsum += sacc; }
        u32x4 pw0, pw1, pw2, pw3;
        pw0 = (u32x4){cvtpk(p0[0], p0[1]), cvtpk(p0[2], p0[3]), cvtpk(p0[4], p0[5]), cvtpk(p0[6], p0[7])};
        pw1 = (u32x4){cvtpk(p0[8], p0[9]), cvtpk(p0[10], p0[11]), cvtpk(p0[12], p0[13]), cvtpk(p0[14], p0[15])};
        pw2 = (u32x4){cvtpk(p1[0], p1[1]), cvtpk(p1[2], p1[3]), cvtpk(p1[4], p1[5]), cvtpk(p1[6], p1[7])};
        pw3 = (u32x4){cvtpk(p1[8], p1[9]), cvtpk(p1[10], p1[11]), cvtpk(p1[12], p1[13]), cvtpk(p1[14], p1[15])};
        const int vb = (int)(lds0 + L::V0 + sl * L::VSLOT) + ((lane >> 4) & 1) * 32 + (lane & 3) * 8 + (4 * hi + ((lane & 15) >> 2)) * 64;
        s16x4 loA[4], hhA[4], loB[4], hhB[4];
        asm volatile("s_waitcnt lgkmcnt(0)" ::: "memory");
#define ATT_VRD(lo_, hh_, d0) do { _Pragma("unroll") for (int ks = 0; ks < 4; ++ks) { \
            asm volatile("ds_read_b64_tr_b16 %0,%1 offset:%c2" : "=&v"(lo_[ks]) : "v"(vb), "i"(((d0) >> 1) * 8192 + ((d0) & 1) * 4096 + ks * 1024) : "memory"); \
            asm volatile("ds_read_b64_tr_b16 %0,%1 offset:%c2" : "=&v"(hh_[ks]) : "v"(vb), "i"(((d0) >> 1) * 8192 + ((d0) & 1) * 4096 + ks * 1024 + 512) : "memory"); } } while (0)
#define ATT_PK(lo_, hh_, k) (bf16x8){lo_[k][0], lo_[k][1], lo_[k][2], lo_[k][3], hh_[k][0], hh_[k][1], hh_[k][2], hh_[k][3]}
        float ra_ = 0.f, rb_ = 0.f, rm = 0.f;
#define ATT_RMSTEP(s_) do { \
            if ((s_) == 0) { if (t + 1 < NT && ATT_NEEDMASK(t + 1)) ATT_MASK(n0, n1, t + 1); ra_ = max3f(n0[0], n0[1], n1[0]); rb_ = max3f(n0[2], n0[3], n1[1]); } \
            else if ((s_) == 1) { ra_ = max3f(ra_, n1[2], n1[3]); } \
            else if ((s_) == 2 || (s_) == 4 || (s_) == 6) { ra_ = max3f(ra_, n0[(2 * (s_)) & 15], n0[(2 * (s_) + 1) & 15]); rb_ = max3f(rb_, n0[(2 * (s_) + 2) & 15], n0[(2 * (s_) + 3) & 15]); } \
            else if ((s_) == 3 || (s_) == 5 || (s_) == 7) { ra_ = max3f(ra_, n1[(2 * (s_) - 2) & 15], n1[(2 * (s_) - 1) & 15]); rb_ = max3f(rb_, n1[(2 * (s_)) & 15], n1[(2 * (s_) + 1) & 15]); } \
            else if ((s_) == 8) { rm = fmaxf(ra_, rb_); auto rr_ = __builtin_amdgcn_permlane32_swap(__float_as_uint(rm), __float_as_uint(rm), false, false); rm = fmaxf(__uint_as_float(rr_[0]), __uint_as_float(rr_[1])); } } while (0)
#define ATT_SLOT(i_) do { if (DV == 128) { ATT_RMSTEP(i_); } else { ATT_RMSTEP(2 * (i_)); ATT_RMSTEP(2 * (i_) + 1); } __builtin_amdgcn_sched_barrier(0); } while (0)
#define ATT_PV(lo_, hh_, d0) do { \
            o[d0] = __builtin_amdgcn_mfma_f32_32x32x16_bf16(__builtin_bit_cast(bf16x8, pw0), ATT_PK(lo_, hh_, 0), o[d0], 0, 0, 0); ATT_SLOT(4 * (d0)); \
            o[d0] = __builtin_amdgcn_mfma_f32_32x32x16_bf16(__builtin_bit_cast(bf16x8, pw1), ATT_PK(lo_, hh_, 1), o[d0], 0, 0, 0); ATT_SLOT(4 * (d0) + 1); \
            o[d0] = __builtin_amdgcn_mfma_f32_32x32x16_bf16(__builtin_bit_cast(bf16x8, pw2), ATT_PK(lo_, hh_, 2), o[d0], 0, 0, 0); ATT_SLOT(4 * (d0) + 2); \
            o[d0] = __builtin_amdgcn_mfma_f32_32x32x16_bf16(__builtin_bit_cast(bf16x8, pw3), ATT_PK(lo_, hh_, 3), o[d0], 0, 0, 0); ATT_SLOT(4 * (d0) + 3); } while (0)
        ATT_VRD(loA, hhA, 0);
#pragma unroll
        for (int d0 = 0; d0 < DV / 32; d0 += 2) {
            ATT_VRD(loB, hhB, d0 + 1);
            asm volatile("s_waitcnt lgkmcnt(8)" ::: "memory"); __builtin_amdgcn_sched_barrier(0);
            ATT_PV(loA, hhA, d0);
            __builtin_amdgcn_sched_barrier(0);
            if (pre) ATT_DMA_V(t + 3, sl2, d0 >> 1);
            if (d0 + 2 < DV / 32) { ATT_VRD(loA, hhA, d0 + 2); asm volatile("s_waitcnt lgkmcnt(8)" ::: "memory"); }
            else asm volatile("s_waitcnt lgkmcnt(0)" ::: "memory");
            __builtin_amdgcn_sched_barrier(0);
            ATT_PV(loB, hhB, d0 + 1);
            __builtin_amdgcn_sched_barrier(0);
        }
#undef ATT_VRD
#undef ATT_PK
#undef ATT_PV
#undef ATT_SLOT
#undef ATT_RMSTEP
        if (t + 1 < NT && __any(rm > ATT_THR)) {
            const float dl = fmaxf(rm, 0.f), f = __builtin_amdgcn_exp2f(-dl);
            m += dl; lsum *= f; if (hi == 0) wsf[r32] = f;
#pragma unroll
            for (int r = 0; r < 16; ++r) { n0[r] -= dl; n1[r] -= dl; negm[r] = -m; }
            LDS_WAIT();
#pragma unroll
            for (int r = 0; r < 16; ++r) { const float fr_ = wsf[crow(r, hi)];
#pragma unroll
                for (int d = 0; d < DV / 32; ++d) o[d][r] *= fr_; }
        }
        p0 = n0; p1 = n1; sl = sl1;
    }
    asm volatile("s_waitcnt lgkmcnt(0)\n\ts_barrier" ::: "memory");
    { auto rr = __builtin_amdgcn_permlane32_swap(__float_as_uint(lsum), __float_as_uint(lsum), false, false); const float l = __uint_as_float(rr[0]) + __uint_as_float(rr[1]);
      if (hi == 0) wsf[r32] = l; LDS_WAIT();
#pragma unroll
      for (int r = 0; r < 16; ++r) osum[r] = wsf[crow(r, hi)];
      LDS_WAIT(); }
#undef ATT_KEYROW
#undef ATT_WAITV
#undef ATT_DMA
#undef ATT_QK
#undef ATT_ROWMAX
#undef ATT_NEEDMASK
#undef ATT_MASK
}

template <int DV>
__device__ __forceinline__ void normalize(f32x16 (&o)[DV / 32], const f32x16& osum) {
#pragma unroll
    for (int r = 0; r < 16; ++r) { const float rl = 1.0f / osum[r];
#pragma unroll
        for (int d = 0; d < DV / 32; ++d) o[d][r] *= rl; }
}
}
namespace hy {
constexpr int UPAD = 20 * 64;
constexpr int UROW = UPAD + 4096 * 2 + UPAD + 16;
constexpr int LDS_U = 0, LDS_R = 8 * UROW, LDS_R1 = LDS_R + 16384 + 64, LDS_BYTES = LDS_R1 + 16384;
static_assert(LDS_BYTES <= 131072 && UROW % 16 == 0, "hyena LDS");

__device__ __forceinline__ void conv_init(char* shm) {
    constexpr int Q = UPAD / 16;
    unsigned z_ = 0u; asm volatile("" : "+v"(z_));
    for (int i = threadIdx.x; i < 8 * 2 * Q; i += 512) { const int b = i / (2 * Q), r = i % (2 * Q), side = r / Q, q = r % Q;
        *(u32x4*)(shm + LDS_U + b * UROW + (side ? UPAD + 8192 : 0) + q * 16) = (u32x4){z_, z_, z_, z_}; }
}
__device__ __forceinline__ void conv_channel(char* shm, const bf16_t* zc, const bf16_t* Rc, bf16_t* outc) {
    int tid_ = threadIdx.x; asm volatile("" : "+v"(tid_));
    const int tid = tid_, lane = tid & 63, n = lane & 31, kg = lane >> 5; const int w = __builtin_amdgcn_readfirstlane(tid >> 6);
    asm volatile("s_waitcnt lgkmcnt(0)\n\ts_barrier" ::: "memory");
#pragma unroll
    for (int j = 0; j < 8; ++j) { const int id = tid + 512 * j, b = id >> 9, off = (id & 511) * 16; *(u32x4*)(shm + LDS_U + b * UROW + UPAD + off) = *(const u32x4*)((const char*)zc + (size_t)b * 8192 + off); }
#pragma unroll
    for (int j = 0; j < 2; ++j) { const int ci = tid + 512 * j, off = ci * 16; const u32x4 a = *(const u32x4*)((const char*)Rc + off);
        const unsigned e8 = ci < 1023 ? (unsigned)Rc[8 * ci + 8] : 0u;
        *(u32x4*)(shm + LDS_R + off) = a;
        u32x4 sft; sft.x = (a.x >> 16) | (a.y << 16); sft.y = (a.y >> 16) | (a.z << 16); sft.z = (a.z >> 16) | (a.w << 16); sft.w = (a.w >> 16) | (e8 << 16);
        *(u32x4*)(shm + LDS_R1 + off) = sft; }
    asm volatile("s_waitcnt vmcnt(0) lgkmcnt(0)\n\ts_barrier" ::: "memory");
    f32x16 acc[4];
#pragma unroll
    for (int k = 0; k < 4; ++k) acc[k] = f32x16{};
    const int bcol = n >> 2, il = n & 3;
    const LAS char* Abase = (const LAS char*)shm + ((n & 1) ? (LDS_R1 - 2) : LDS_R) + (4096 - n + 8 * kg) * 2;
    const LAS char* Ubase = (const LAS char*)shm + LDS_U + bcol * UROW + UPAD + kg * 16 + 64 * (16 * w + il);
    const int dlo = 16 * w - 127, dhi = 16 * w + 15;
#define HY_LDA(dst, d, sc) do { const volatile LAS unsigned* ap_ = (const volatile LAS unsigned*)(Abase + (16 * (sc) - 32 * (d)) * 2); u32x4 aw_; aw_.x = ap_[0]; aw_.y = ap_[1]; aw_.z = ap_[2]; aw_.w = ap_[3]; dst = __builtin_bit_cast(bf16x8, aw_); } while (0)
#define HY_LDB(dst, m, sc) dst = *(const LAS bf16x8*)(Ubase + 64 * (m) + 32 * (sc))
#pragma unroll 1
    for (int rho = 0; rho < 4; ++rho) {
        int d = dlo + rho;
        bf16x8 A0, A1, X0[5], X1[5];
        HY_LDA(A0, d, 0); HY_LDA(A1, d, 1);
#pragma unroll
        for (int k = 0; k < 4; ++k) { HY_LDB(X0[k], 4 * k - d, 0); HY_LDB(X1[k], 4 * k - d, 1); }
#define HY_STEP(s) { if (d > dhi) break; \
            bf16x8 nA0, nA1;                   \
            HY_LDA(nA0, d + 4, 0); HY_LDA(nA1, d + 4, 1); HY_LDB(X0[(4 - (s) + 5) % 5], -(d + 4), 0); HY_LDB(X1[(4 - (s) + 5) % 5], -(d + 4), 1); \
            _Pragma("unroll") for (int k = 0; k < 4; ++k) { acc[k] = __builtin_amdgcn_mfma_f32_32x32x16_bf16(A0, X0[(k - (s) + 5) % 5], acc[k], 0, 0, 0); acc[k] = __builtin_amdgcn_mfma_f32_32x32x16_bf16(A1, X1[(k - (s) + 5) % 5], acc[k], 0, 0, 0); } \
            A0 = nA0; A1 = nA1; d += 4; }
        for (;;) { HY_STEP(0) HY_STEP(1) HY_STEP(2) HY_STEP(3) HY_STEP(4) }
#undef HY_STEP
    }
#undef HY_LDA
#undef HY_LDB
#pragma unroll
    for (int k = 0; k < 4; ++k) { const int i = 16 * w + 4 * k + il; bf16_t* op = outc + (size_t)bcol * 4096 + 32 * i + 4 * kg;
#pragma unroll
        for (int g = 0; g < 4; ++g) { u32x2 v; v.x = cvtpk(acc[k][4 * g], acc[k][4 * g + 1]); v.y = cvtpk(acc[k][4 * g + 2], acc[k][4 * g + 3]); *(u32x2*)(op + 8 * g) = v; } }
}
}
constexpr int NWAVES = 8;
constexpr size_t MiB = 1u << 20;
constexpr size_t WS_CTL = 0, CTL_ZERO_BYTES = 1 * MiB;
constexpr size_t WS_MODS = 1 * MiB;
constexpr size_t WS_FCTX = 2 * MiB;
constexpr size_t WS_ZFEAT = 4 * MiB;
constexpr size_t WS_AFF = 9 * MiB;
constexpr size_t WS_SLOTOF = 12 * MiB;
constexpr size_t WS_GATE = 16 * MiB;
constexpr size_t WS_ZCTX = 17 * MiB;
constexpr size_t WS_XRES = 24 * MiB;
constexpr size_t WS_H = WS_XRES + 136 * MiB;
constexpr size_t WS_W = WS_H + 68 * MiB;
constexpr size_t WS_WIN = WS_W, WS_WBR = WS_WIN + 21 * MiB, WS_WOUT = WS_WBR + 6 * MiB, WS_W13 = WS_WOUT + 2 * MiB, WS_W2 = WS_W13 + 64 * MiB;
constexpr size_t WS_PROJ = WS_W2 + 32 * MiB;
static_assert(WS_PROJ == OFF_PROJ, "projection base");
constexpr size_t WS_DQ = OFF_DQ, WS_DK = OFF_DK, WS_DV = OFF_DV, WS_HY = OFF_HY, WS_SQ = OFF_SQ, WS_SK = OFF_SK, WS_SV = OFF_SV, WS_GT = OFF_GT;
constexpr size_t WS_END = WS_GT + 3 * SZ1K;
constexpr size_t WS_HRAW = WS_END;
constexpr size_t WS_TOTAL = WS_HRAW + 32 * MiB;
constexpr size_t WS_CONVT = WS_HY;
constexpr size_t WS_YHY = OFF_YHY;
constexpr size_t WS_MERGED = WS_DK;
constexpr size_t WS_XG = WS_HY;
constexpr size_t WS_HID = WS_GT;
static_assert(WS_YHY + SZ1K <= WS_SQ && WS_XG + (size_t)SLOTS * 2048 <= WS_SQ && WS_HID + (size_t)SLOTS * 2048 <= WS_END, "overlays");
constexpr size_t OUT_ZT = 0;
constexpr size_t OUT_FILT = 64 * MiB;
constexpr size_t OUT_STASH = 80 * MiB;
static_assert(OUT_STASH + 32 * MiB <= (size_t)NB * LS * D * 4, "d_out scratch");

constexpr int CW_TMO = 0, CW_CODE = 1, CW_CHK = 64, CW_BAR = 4096;

constexpr int RING_BYTES = 131072, LDSCTL_OFF = RING_BYTES, MISC_OFF = LDSCTL_OFF + 320, ROPE_OFF = LDSCTL_OFF + 1024  , LDS_BYTES = 147456;
static_assert(ROPE_OFF + 8192 <= LDS_BYTES, "LDS map");

#define XB_TMO      128
#define XB_XCNT(j)  (256  + 64 * (j))
#define XB_XSUB(j)  (1280 + 64 * (j))
#define XB_XGEN(j)  (2304 + 64 * (j))
#define XB_TOP      3328
#define XB_TOPGEN   3392
#define XCD_BAR_WORDS 3456
#define XB_SPIN_CAP (1u << 22)
__device__ __forceinline__ unsigned xb_ld(unsigned* p)              { return __hip_atomic_load(p, __ATOMIC_RELAXED, __HIP_MEMORY_SCOPE_AGENT); }
__device__ __forceinline__ unsigned xb_add(unsigned* p, unsigned v) { return __hip_atomic_fetch_add(p, v, __ATOMIC_RELAXED, __HIP_MEMORY_SCOPE_AGENT); }
__device__ __forceinline__ unsigned xb_xcc_id() { return (unsigned)__builtin_amdgcn_s_getreg((3 << 11) | 20) & 0xFu; }
#define XB_SPIN(cond, bar) do { unsigned _sp = 0; while (cond) { __builtin_amdgcn_s_sleep(1); \
    if ((++_sp & 255u) == 0u) { if (xb_ld(&(bar)[XB_TMO])) break; if (_sp > XB_SPIN_CAP) { atomicAdd(&(bar)[XB_TMO], 1u); break; } } } } while (0)
struct XcdBarrier { unsigned* bar; unsigned x; volatile LAS unsigned* st; };
__device__ __forceinline__ XcdBarrier xcd_barrier_post(unsigned* bar, volatile LAS unsigned* st) {
    XcdBarrier b; b.bar = bar; b.x = xb_xcc_id(); b.st = st;
    if (threadIdx.x == 0) (void)xb_add(&bar[XB_XCNT(b.x)], 1u);
    return b;
}
__device__ __forceinline__ void xcd_barrier_complete(unsigned* bar, unsigned x, unsigned& nloc, unsigned& nx) {
    const unsigned G = gridDim.x * gridDim.y * gridDim.z;
    unsigned sum, cnt, mine, sp = 0u;
    for (;;) {
        sum = 0u; cnt = 0u; mine = 0u;
#pragma unroll
        for (unsigned j = 0; j < 16; ++j) { const unsigned c = xb_ld(&bar[XB_XCNT(j)]); sum += c; cnt += (c > 0u) ? 1u : 0u; mine = (j == x) ? c : mine; }
        if (sum == G) break;
        __builtin_amdgcn_s_sleep(1);
        if ((++sp & 255u) == 0u) { if (xb_ld(&bar[XB_TMO])) break; if (sp > XB_SPIN_CAP) { atomicAdd(&bar[XB_TMO], 1u); break; } }
    }
    nloc = mine > 0u ? mine : 1u; nx = cnt > 0u ? cnt : 1u;
}
__device__ __forceinline__ void xcd_barrier(const XcdBarrier& b) {
    asm volatile("s_waitcnt vmcnt(0)" ::: "memory");
    __syncthreads();
    if (threadIdx.x == 0) {
        unsigned* bar = b.bar;
        __builtin_amdgcn_s_waitcnt(0);
        unsigned nloc = b.st[0], nx = b.st[1];
        if (nloc == 0u) { xcd_barrier_complete(bar, b.x, nloc, nx); b.st[0] = nloc; b.st[1] = nx; }
#ifdef XB_EARLY_WB
        __builtin_amdgcn_fence(__ATOMIC_RELEASE, "agent");
        asm volatile("s_waitcnt vmcnt(0)" ::: "memory");
#endif
        const unsigned old = xb_add(&bar[XB_XSUB(b.x)], 1u);
        const unsigned gen = old / nloc;
        if (old + 1u == (gen + 1u) * nloc) {
            __builtin_amdgcn_fence(__ATOMIC_RELEASE, "agent");
            asm volatile("s_waitcnt vmcnt(0)" ::: "memory");
            const unsigned og = xb_add(&bar[XB_TOP], 1u);
            const unsigned tg = og / nx;
            if (og + 1u == (tg + 1u) * nx) xb_add(&bar[XB_TOPGEN], 1u);
            else XB_SPIN(xb_ld(&bar[XB_TOPGEN]) == tg, bar);
            __builtin_amdgcn_fence(__ATOMIC_ACQUIRE, "agent");
            xb_add(&bar[XB_XGEN(b.x)], 1u);
            asm volatile("s_waitcnt vmcnt(0)" ::: "memory");
        } else {
            XB_SPIN(xb_ld(&bar[XB_XGEN(b.x)]) == gen, bar);
            __builtin_amdgcn_fence(__ATOMIC_ACQUIRE, "agent");
            asm volatile("s_waitcnt vmcnt(0)" ::: "memory");
        }
    }
    __syncthreads();
}

struct Args {
    const float* in[28]; float* out; unsigned char* ws; int ph_lo, ph_hi;
};
struct Frame {
    LAS unsigned char* lds; char* shm;
    int tid, lane, wave, G, bid;
    int dry;
    unsigned char* ws; unsigned char* outb;
};
enum { I_X = 0, I_C, I_CTX, I_CCTX, I_WMOD, I_BMOD, I_N1G, I_N2G, I_WIN, I_DLAM, I_SUBLN, I_HCW, I_HCB, I_FW1, I_FB1, I_FW2, I_FB2, I_FW3, I_FREQ, I_HBIAS, I_SINK, I_WBR, I_WOUT, I_ROUTER, I_W1, I_W3, I_W2, I_FINALG };
__device__ __forceinline__ void p0_mods_zfeat(Frame& F, const Args& a) {
    float* sc = (float*)F.shm;
    float* part = (float*)(F.shm + 9 * 1024 * 4);
    for (int i = F.tid; i < 9 * 1024; i += 512) { const int r = i >> 10, k = i & 1023; const float v = r < 8 ? a.in[I_C][r * 1024 + k] : a.in[I_CCTX][k]; sc[i] = v * sigmoidf_(v); }
    __syncthreads();
    float* mods = (float*)(F.ws + WS_MODS);
    for (int ch = F.bid; ch < 192; ch += F.G) {
        const int l = ch / 48, c0 = (ch % 48) * 128, col = F.tid & 127, kq = F.tid >> 7;
        const float* w = a.in[I_WMOD] + ((size_t)l * 1024 + kq * 256) * 6144 + c0 + col;
        float acc[9];
#pragma unroll
        for (int r = 0; r < 9; ++r) acc[r] = 0.f;
        for (int k = 0; k < 256; ++k) { const float wv = w[(size_t)k * 6144];
#pragma unroll
            for (int r = 0; r < 9; ++r) acc[r] += sc[r * 1024 + kq * 256 + k] * wv; }
#pragma unroll
        for (int r = 0; r < 9; ++r) part[(kq * 9 + r) * 128 + col] = acc[r];
        __syncthreads();
        for (int i = F.tid; i < 9 * 128; i += 512) { const int r = i >> 7, cc = i & 127;
            const float s = part[(0 * 9 + r) * 128 + cc] + part[(1 * 9 + r) * 128 + cc] + part[(2 * 9 + r) * 128 + cc] + part[(3 * 9 + r) * 128 + cc];
            mods[((size_t)l * 9 + r) * 6144 + c0 + cc] = s + a.in[I_BMOD][l * 6144 + c0 + cc]; }
        __syncthreads();
    }
    float* zf = (float*)(F.ws + WS_ZFEAT);
    const int gw = F.bid * NWAVES + F.wave, NGW = F.G * NWAVES;
    for (int it = gw; it < DEPTH * LT; it += NGW) {
        const int l = it / LT, row = it - l * LT; const int Lf = row < LS ? LS : LC, ii = row < LS ? row : row - LS;
        const float tt = (float)ii / (float)(Lf - 1);
        const float wrev = (float)ii / (float)Lf;
        const int j = F.lane & 15; const float fj = 1e-4f + (float)j * ((15.0f - 1e-4f) / 15.0f);
        const float cs = cos_rev(fj * wrev), sn = -sin_rev(fj * wrev);
        const float* w1 = a.in[I_FW1] + (size_t)l * 33 * 64; const float* w2 = a.in[I_FW2] + (size_t)l * 64 * 64;
        const float fq = a.in[I_FREQ][l * 64 + F.lane];
        float s = tt * w1[F.lane] + a.in[I_FB1][l * 64 + F.lane];
#pragma unroll
        for (int k = 0; k < 16; ++k) { s += __shfl(cs, k) * w1[(1 + k) * 64 + F.lane]; s += __shfl(sn, k) * w1[(17 + k) * 64 + F.lane]; }
        const float z1 = sin_rad(fq * s);
        float s2 = a.in[I_FB2][l * 64 + F.lane];
#pragma unroll 8
        for (int k = 0; k < 64; ++k) s2 += __shfl(z1, k) * w2[k * 64 + F.lane];
        zf[((size_t)l * 64 + F.lane) * LT + row] = sin_rad(fq * s2);
    }
}

__device__ __forceinline__ void transpose_item(const float* W, int K, int N, bf16_t* WT, int k0, int n0, int drow, LAS float* scr, int lane) {
#pragma unroll 8
    for (int i = 0; i < 32; ++i) { const int kk = 2 * i + (lane >> 5); scr[kk * 33 + (lane & 31)] = W[(size_t)(k0 + kk) * N + n0 + (lane & 31)]; }
    LDS_WAIT(); asm volatile("" ::: "memory");
    const int c = lane & 7;
#pragma unroll
    for (int j = 0; j < 4; ++j) { const int n = (lane >> 3) + 8 * j; const LAS float* s = scr + (8 * c) * 33 + n;
        u32x4 o; o.x = pk2(s[0 * 33], s[1 * 33]); o.y = pk2(s[2 * 33], s[3 * 33]); o.z = pk2(s[4 * 33], s[5 * 33]); o.w = pk2(s[6 * 33], s[7 * 33]);
        *(GAS u32x4*)(WT + (size_t)(drow + n) * K + k0 + 8 * c) = o; }
    LDS_WAIT(); asm volatile("" ::: "memory");
}
__device__ __forceinline__ void p1_weights(Frame& F, const Args& a, int l) {
    LAS float* scr = (LAS float*)(F.lds + F.wave * 8448);
    const int gw = F.bid * NWAVES + F.wave, NGW = F.G * NWAVES;
    constexpr int I_IN = 16 * 336, I_SQ = 16 * 32;
    constexpr int NITEMS = I_IN + 4 * I_SQ + 48 * I_SQ;
    bf16_t* WinT = (bf16_t*)(F.ws + WS_WIN); bf16_t* WbrT = (bf16_t*)(F.ws + WS_WBR); bf16_t* WoutT = (bf16_t*)(F.ws + WS_WOUT);
    bf16_t* W13T = (bf16_t*)(F.ws + WS_W13); bf16_t* W2T = (bf16_t*)(F.ws + WS_W2);
    for (int it = gw; it < NITEMS; it += NGW) {
        int r = it;
        if (r < I_IN) { const int kb = r / 336, nb = r % 336; transpose_item(a.in[I_WIN] + (size_t)l * 1024 * DIN, 1024, DIN, WinT, 64 * kb, 32 * nb, 32 * nb, scr, F.lane); continue; }
        r -= I_IN;
        const int mi = r / I_SQ, q = r % I_SQ, kb = q / 32, nb = q % 32, n0 = 32 * nb;
        if (mi < 3) { transpose_item(a.in[I_WBR] + ((size_t)l * 3 + mi) * 1048576, 1024, 1024, WbrT + (size_t)mi * 1048576, 64 * kb, n0, n0, scr, F.lane); continue; }
        if (mi == 3) { transpose_item(a.in[I_WOUT] + (size_t)l * 1048576, 1024, 1024, WoutT, 64 * kb, n0, n0, scr, F.lane); continue; }
        const int e = (mi - 4) / 3, which = (mi - 4) % 3; const size_t eo = ((size_t)l * 16 + e) * 1048576;
        if (which == 0) transpose_item(a.in[I_W1] + eo, 1024, 1024, W13T + (size_t)e * 2097152, 64 * kb, n0, (n0 >> 7) * 256 + (n0 & 127), scr, F.lane);
        else if (which == 1) transpose_item(a.in[I_W3] + eo, 1024, 1024, W13T + (size_t)e * 2097152, 64 * kb, n0, (n0 >> 7) * 256 + 128 + (n0 & 127), scr, F.lane);
        else transpose_item(a.in[I_W2] + eo, 1024, 1024, W2T + (size_t)e * 1048576, 64 * kb, n0, n0, scr, F.lane);
    }
}

__device__ __forceinline__ void p1_filters(Frame& F, const Args& a, int l) {
    float* w3s = (float*)(F.shm + 72 * 1024);
    float* red = w3s + 512;
    float* nrm = red + 32;
    const float* zf = (const float*)(F.ws + WS_ZFEAT) + (size_t)l * LT * 64;
    bf16_t* filtR = (bf16_t*)(F.outb + OUT_FILT); float* fctx = (float*)(F.ws + WS_FCTX);
    const float da = -15.350567286626973f, db = -3.0701134573253946f;
    for (int cg = F.bid; cg < 256; cg += F.G) {
        const int c0 = 4 * cg;
        __syncthreads();
        { const int k = F.tid >> 3, q = F.tid & 7; w3s[F.tid] = a.in[I_FW3][((size_t)l * 64 + k) * 2048 + (q >> 2) * 1024 + c0 + (q & 3)]; }
        __syncthreads();
        float delta[4];
#pragma unroll
        for (int cc = 0; cc < 4; ++cc) delta[cc] = fabsf(da + (float)(c0 + cc) * ((db - da) / 1023.0f));
        float asum[4] = {0.f, 0.f, 0.f, 0.f};
        f32x4* slab = (f32x4*)(F.ws + WS_HRAW) + ((size_t)F.bid * 4096 + 8 * F.tid) * 2;
        { float h[8][8];
#pragma unroll
          for (int j = 0; j < 8; ++j)
#pragma unroll
            for (int q = 0; q < 8; ++q) h[j][q] = 0.f;
          const float* zc = zf + 8 * F.tid;
          f32x4 zq[4][2];
#pragma unroll
          for (int kk = 0; kk < 4; ++kk) { zq[kk][0] = *(const f32x4*)(zc + (size_t)kk * LT); zq[kk][1] = *(const f32x4*)(zc + (size_t)kk * LT + 4); }
#pragma unroll 1
          for (int g = 0; g < 16; ++g) {
              f32x4 zn[4][2]; const int gn = g + 1 < 16 ? g + 1 : g;
              const float* zg = zc + (size_t)gn * 4 * LT;
#pragma unroll
              for (int kk = 0; kk < 4; ++kk) { zn[kk][0] = *(const f32x4*)(zg + (size_t)kk * LT); zn[kk][1] = *(const f32x4*)(zg + (size_t)kk * LT + 4); }
              __builtin_amdgcn_sched_barrier(0);
#pragma unroll
              for (int kk = 0; kk < 4; ++kk) { const int k = g * 4 + kk; const f32x4 za = zq[kk][0], zb = zq[kk][1];
                  const f32x4 wa = *(const f32x4*)(w3s + k * 8), wb = *(const f32x4*)(w3s + k * 8 + 4);
#pragma unroll
                  for (int j = 0; j < 8; ++j) { const float z = j < 4 ? za[j] : zb[j - 4];
#pragma unroll
                      for (int q = 0; q < 4; ++q) { h[j][q] += z * wa[q]; h[j][4 + q] += z * wb[q]; } } }
              __builtin_amdgcn_sched_barrier(0);
#pragma unroll
              for (int kk = 0; kk < 4; ++kk) { zq[kk][0] = zn[kk][0]; zq[kk][1] = zn[kk][1]; }
          }
#pragma unroll
          for (int j = 0; j < 8; ++j) { const int i = 8 * F.tid + j; const float tt = (float)i / 4095.0f; f32x4 hf, hbk;
#pragma unroll
              for (int cc = 0; cc < 4; ++cc) { const float dec = fast_exp(-tt * delta[cc]); hf[cc] = h[j][cc] * dec; hbk[cc] = h[j][4 + cc] * dec; asum[cc] += fabsf(hf[cc]) + fabsf(hbk[cc]); }
              slab[2 * j] = hf; slab[2 * j + 1] = hbk; } }
#pragma unroll
        for (int cc = 0; cc < 4; ++cc) { const float s = wave_sum(asum[cc]); if (F.lane == 0) red[F.wave * 4 + cc] = s; }
        __syncthreads();
        if (F.tid < 4) { float s = 0.f; for (int w = 0; w < 8; ++w) s += red[w * 4 + F.tid]; nrm[F.tid] = 1.0f / (s + EPS); }
        __syncthreads();
        { bf16_t* img = (bf16_t*)F.shm;
          if (F.tid < 4) img[F.tid * 8192] = 0;
#pragma unroll 1
          for (int j = 0; j < 8; ++j) { const int i = 8 * F.tid + j; const f32x4 hf = slab[2 * j], hbk = slab[2 * j + 1];
#pragma unroll
              for (int cc = 0; cc < 4; ++cc) { const float inv = nrm[cc];
                  img[cc * 8192 + 4096 - i] = (bf16_t)f2bf(hf[cc] * inv);
                  if (i > 0) img[cc * 8192 + 4096 + i] = (bf16_t)f2bf(hbk[cc] * inv); } }
          __syncthreads();
          for (int q = F.tid; q < 4096; q += 512) *(u32x4*)(filtR + (size_t)c0 * 8192 + q * 8) = *(const u32x4*)(img + q * 8);
        }
        __syncthreads();

        float hc[8]; float cs4[4] = {0.f, 0.f, 0.f, 0.f};
        if (F.tid < 256) {
            const float* zr = zf + LS + F.tid;
#pragma unroll
            for (int q = 0; q < 8; ++q) hc[q] = 0.f;
#pragma unroll 1
            for (int k0 = 0; k0 < 64; k0 += 16) { float zz[16];
#pragma unroll
                for (int k = 0; k < 16; ++k) zz[k] = zr[(size_t)(k0 + k) * LT];
#pragma unroll
                for (int k = 0; k < 16; ++k) { const float z = zz[k];
#pragma unroll
                    for (int q = 0; q < 8; ++q) hc[q] += z * w3s[(k0 + k) * 8 + q]; } }
            const float tt = (float)F.tid / 255.0f;
#pragma unroll
            for (int cc = 0; cc < 4; ++cc) { const float dec = fast_exp(-tt * delta[cc]); hc[cc] *= dec; hc[4 + cc] *= dec; cs4[cc] = fabsf(hc[cc]) + fabsf(hc[4 + cc]); }
        }
#pragma unroll
        for (int cc = 0; cc < 4; ++cc) { const float s = wave_sum(cs4[cc]); if (F.lane == 0) red[F.wave * 4 + cc] = s; }
        __syncthreads();
        if (F.tid < 4) { float s = 0.f; for (int w = 0; w < 8; ++w) s += red[w * 4 + F.tid]; nrm[F.tid] = 1.0f / (s + EPS); }
        __syncthreads();
        if (F.tid < 256) {
#pragma unroll
            for (int q = 0; q < 8; ++q) fctx[((size_t)(q >> 2) * 256 + F.tid) * 1024 + c0 + (q & 3)] = hc[q] * nrm[q & 3];
        }
    }
}

__device__ __forceinline__ int load_sov(Frame& F, int row) { return F.lane < 16 ? ((const int*)(F.ws + WS_SLOTOF))[(size_t)row * 16 + F.lane] : -1; }
__device__ __forceinline__ void combine_row(Frame& F, f32x4 (&v)[4], const int sov, const f32x4 (&m5q)[4]) {
    const bf16_t* ys = (const bf16_t*)(F.ws + WS_XG) + 4 * F.lane;
    unsigned mask = (unsigned)(__ballot(sov >= 0) & 0xffffull);
    f32x4 s[4];
#pragma unroll
    for (int j = 0; j < 4; ++j) s[j] = (f32x4){0.f, 0.f, 0.f, 0.f};
    while (mask) {
        const int e0 = __builtin_ctz(mask); mask &= mask - 1; const bool two = mask != 0u; int e1 = e0; if (two) { e1 = __builtin_ctz(mask); mask &= mask - 1; }
        const int s0 = __builtin_amdgcn_readlane(sov, e0), s1 = __builtin_amdgcn_readlane(sov, e1); const float w1 = two ? 1.f : 0.f;
        const bf16_t* y0 = ys + (size_t)s0 * 1024; const bf16_t* y1 = ys + (size_t)s1 * 1024;
        u32x2 a[4], b[4];
#pragma unroll
        for (int j = 0; j < 4; ++j) { a[j] = *(const u32x2*)(y0 + 256 * j); b[j] = *(const u32x2*)(y1 + 256 * j); }
#pragma unroll
        for (int j = 0; j < 4; ++j) { s[j][0] += bflo(a[j].x) + w1 * bflo(b[j].x); s[j][1] += bfhi(a[j].x) + w1 * bfhi(b[j].x); s[j][2] += bflo(a[j].y) + w1 * bflo(b[j].y); s[j][3] += bfhi(a[j].y) + w1 * bfhi(b[j].y); }
    }
#pragma unroll
    for (int j = 0; j < 4; ++j) v[j] += m5q[j] * s[j];
}
__device__ __forceinline__ void p1_norm1(Frame& F, const Args& a, int l) {
    const int gw = F.bid * NWAVES + F.wave, NGW = F.G * NWAVES;
    bf16_t* xres = (bf16_t*)(F.ws + WS_XRES); bf16_t* hb = (bf16_t*)(F.ws + WS_H);
    const float* mods = (const float*)(F.ws + WS_MODS);
    const float* g1 = a.in[I_N1G] + (size_t)l * 1024;
#define N1_SRC0(row_) (((row_) % LT) < LS ? a.in[I_X] + ((size_t)((row_) / LT) * LS + ((row_) % LT)) * 1024 : a.in[I_CTX] + ((size_t)((row_) / LT) * LC + (((row_) % LT) - LS)) * 1024)
#define N1_LOAD(dst_, row_) do { if (l == 0) { const float* src_ = N1_SRC0(row_); _Pragma("unroll") for (int j = 0; j < 4; ++j) dst_[j] = *(const f32x4*)(src_ + 4 * F.lane + 256 * j); } \
        else { _Pragma("unroll") for (int j = 0; j < 4; ++j) rn[j] = ldxr(xres + (size_t)(row_) * 1024 + 4 * F.lane + 256 * j); } } while (0)
    const int rpw = (TROWS + NGW - 1) / NGW, r0 = gw * rpw, r1 = r0 + rpw < TROWS ? r0 + rpw : TROWS;
    f32x4 gq[4], shq[4], sclq[4], m5q[4]; int mr_cur = -1;
#pragma unroll
    for (int j = 0; j < 4; ++j) { gq[j] = *(const f32x4*)(g1 + 4 * F.lane + 256 * j); m5q[j] = (f32x4){0.f, 0.f, 0.f, 0.f}; }
    f32x4 vn[4]; u32x2 rn[4]; int sovn = -1;
#pragma unroll
    for (int j = 0; j < 4; ++j) { vn[j] = (f32x4){0.f, 0.f, 0.f, 0.f}; rn[j] = (u32x2){0u, 0u}; }
    if (r0 < r1) { N1_LOAD(vn, r0);
        if (l > 0) sovn = load_sov(F, r0); }
    for (int row = r0; row < r1; ++row) {
        const int b = row / LT, t = row - b * LT; const int mr = t < LS ? b : 8;
        if (mr != mr_cur) { mr_cur = mr; const float* mrow = mods + ((size_t)l * 9 + mr) * 6144;
#pragma unroll
            for (int j = 0; j < 4; ++j) { shq[j] = *(const f32x4*)(mrow + 4 * F.lane + 256 * j); sclq[j] = *(const f32x4*)(mrow + 1024 + 4 * F.lane + 256 * j) + 1.0f;
                if (l > 0) m5q[j] = *(const f32x4*)(mods + ((size_t)(l - 1) * 9 + mr) * 6144 + 5 * 1024 + 4 * F.lane + 256 * j); } }
        f32x4 v[4]; const int sov = sovn;
#pragma unroll
        for (int j = 0; j < 4; ++j) v[j] = l == 0 ? vn[j] : cvx4(rn[j]);
        if (row + 1 < r1) { N1_LOAD(vn, row + 1);
            if (l > 0) sovn = load_sov(F, row + 1); }
        if (l > 0) combine_row(F, v, sov, m5q);
        float ss = 0.f;
#pragma unroll
        for (int j = 0; j < 4; ++j) { if (!F.dry) stx4(xres + (size_t)row * 1024 + 4 * F.lane + 256 * j, v[j]); ss += (v[j][0] * v[j][0] + v[j][1] * v[j][1]) + (v[j][2] * v[j][2] + v[j][3] * v[j][3]); }
        const float rstd = 1.0f / sqrtf(wave_sum(ss) * (1.0f / 1024.0f) + EPS);
#pragma unroll
        for (int j = 0; j < 4; ++j) { const int c = 4 * F.lane + 256 * j;
            const f32x4 y = (v[j] * rstd * gq[j]) * sclq[j] + shq[j];
            u32x2 w; w.x = cvtpk(y[0], y[1]); w.y = cvtpk(y[2], y[3]); *(u32x2*)(hb + (size_t)row * 1024 + c) = w; }
    }
#undef N1_SRC0
#undef N1_LOAD
}
__device__ __forceinline__ void pf_final(Frame& F, const Args& a) {
    const int gw = F.bid * NWAVES + F.wave, NGW = F.G * NWAVES;
    const bf16_t* xres = (const bf16_t*)(F.ws + WS_XRES); const float* mods = (const float*)(F.ws + WS_MODS);
    const float* g = a.in[I_FINALG];
#define FN_ROW(r_) (((r_) / LS) * LT + ((r_) % LS))
    const int rpw = (NB * LS + NGW - 1) / NGW, r0 = gw * rpw, r1 = r0 + rpw < NB * LS ? r0 + rpw : NB * LS;
    f32x4 gq[4], m5q[4]; int b_cur = -1;
#pragma unroll
    for (int j = 0; j < 4; ++j) gq[j] = *(const f32x4*)(g + 4 * F.lane + 256 * j);
    u32x2 vn[4]; int sovn = -1;
    if (r0 < r1) { const int row = FN_ROW(r0);
#pragma unroll
        for (int j = 0; j < 4; ++j) vn[j] = ldxr(xres + (size_t)row * 1024 + 4 * F.lane + 256 * j);
        sovn = load_sov(F, row); }
    for (int r = r0; r < r1; ++r) {
        const int b = r / LS;
        if (b != b_cur) { b_cur = b;
#pragma unroll
            for (int j = 0; j < 4; ++j) m5q[j] = *(const f32x4*)(mods + ((size_t)(DEPTH - 1) * 9 + b) * 6144 + 5 * 1024 + 4 * F.lane + 256 * j); }
        f32x4 v[4]; const int sov = sovn;
#pragma unroll
        for (int j = 0; j < 4; ++j) v[j] = cvx4(vn[j]);
        if (r + 1 < r1) { const int row = FN_ROW(r + 1);
#pragma unroll
            for (int j = 0; j < 4; ++j) vn[j] = ldxr(xres + (size_t)row * 1024 + 4 * F.lane + 256 * j);
            sovn = load_sov(F, row); }
        combine_row(F, v, sov, m5q);
        float ss = 0.f;
#pragma unroll
        for (int j = 0; j < 4; ++j) ss += (v[j][0] * v[j][0] + v[j][1] * v[j][1]) + (v[j][2] * v[j][2] + v[j][3] * v[j][3]);
        const float rstd = 1.0f / sqrtf(wave_sum(ss) * (1.0f / 1024.0f) + EPS);
#pragma unroll
        for (int j = 0; j < 4; ++j) { const int c = 4 * F.lane + 256 * j; *(f32x4*)(a.out + (size_t)r * 1024 + c) = v[j] * rstd * gq[j]; }
    }
#undef FN_ROW
}
__device__ __forceinline__ void p3_rope(Frame& F) {
    float* cst = (float*)F.shm;
    float* snt = cst + 1024;
    for (int i = F.tid; i < 1024; i += 512) { const int pos = i >> 4, f = i & 15; const float inv = __builtin_amdgcn_exp2f(-(float)f * (13.287712379549449f / 16.0f));
        const float ang = (float)pos * inv, rev = ang * 0.15915494309189535f; cst[i] = cos_rev(rev); snt[i] = sin_rev(rev); }
    __syncthreads();
    bf16_t* dq = (bf16_t*)(F.ws + WS_DQ); bf16_t* dk = (bf16_t*)(F.ws + WS_DK); bf16_t* sq = (bf16_t*)(F.ws + WS_SQ); bf16_t* sk = (bf16_t*)(F.ws + WS_SK);
    const int gw = F.bid * NWAVES + F.wave, NGW = F.G * NWAVES;
    for (int row = gw; row < TROWS; row += NGW) {
        const int b = row / LT, t = row - b * LT; const bool lat = t < LS;
        for (int it = F.lane; it < 208; it += 64) {
            const int hs = it >> 2, ax = (it >> 1) & 1, fc = it & 1;
            bf16_t* base; float scl;
            if (hs < 16) { base = dq + (size_t)row * 1024 + hs * 64; scl = QSCALE; }
            else if (hs < 32) { base = dk + (size_t)row * 1024 + (hs - 16) * 64; scl = 1.f; }
            else if (hs < 48) { base = sq + (size_t)row * 1024 + (hs - 32) * 64; scl = QSCALE; }
            else { base = sk + (size_t)row * 256 + (hs - 48) * 64; scl = 1.f; }
            if (!lat && scl == 1.f) continue;
            bf16_t* p1 = base + ax * 32 + fc * 8; bf16_t* p2 = p1 + 16;
            const u32x4 a = *(const u32x4*)p1, c = *(const u32x4*)p2;
            float x1[8], x2[8];
#pragma unroll
            for (int j = 0; j < 4; ++j) { x1[2 * j] = bflo(a[j]); x1[2 * j + 1] = bfhi(a[j]); x2[2 * j] = bflo(c[j]); x2[2 * j + 1] = bfhi(c[j]); }
            float o1[8], o2[8];
            if (lat) { const int pos = ax == 0 ? (t >> 6) : (t & 63);
#pragma unroll
                for (int j = 0; j < 8; ++j) { const float cs = cst[pos * 16 + fc * 8 + j], sn = snt[pos * 16 + fc * 8 + j]; o1[j] = (x1[j] * cs - x2[j] * sn) * scl; o2[j] = (x2[j] * cs + x1[j] * sn) * scl; }
            } else {
#pragma unroll
                for (int j = 0; j < 8; ++j) { o1[j] = x1[j] * scl; o2[j] = x2[j] * scl; }
            }
            u32x4 w1, w2;
#pragma unroll
            for (int j = 0; j < 4; ++j) { w1[j] = cvtpk(o1[2 * j], o1[2 * j + 1]); w2[j] = cvtpk(o2[2 * j], o2[2 * j + 1]); }
            if (!F.dry) { *(u32x4*)p1 = w1; *(u32x4*)p2 = w2; }
        }
    }
}
struct PreTile { int b, t0, c0, Lseq, tbase; bool lat; };
__device__ __forceinline__ PreTile pre_tile(int tile) {
    constexpr int NT_L = NB * 64 * 16;
    PreTile T; T.lat = tile < NT_L;
    if (T.lat) { T.b = tile / 1024; const int r = tile % 1024; T.t0 = (r >> 4) * 64; T.c0 = (r & 15) * 64; T.Lseq = LS; T.tbase = 0; }
    else { const int q = tile - NT_L; T.b = q / 64; const int r = q % 64; T.t0 = (r >> 4) * 64; T.c0 = (r & 15) * 64; T.Lseq = LC; T.tbase = LS; }
    return T;
}
__device__ __forceinline__ void pre_load(const bf16_t* hyb, const PreTile& T, int tl, int cc, u32x4 (&x)[3][3]) {
    const int t = T.t0 + tl, c = T.c0 + cc; const size_t row = (size_t)T.b * LT + T.tbase + t;
#pragma unroll
    for (int g = 0; g < 3; ++g)
#pragma unroll
        for (int k = 0; k < 3; ++k) { const int ts = t + k - 1; x[g][k] = (u32x4){0u, 0u, 0u, 0u};
            if (ts >= 0 && ts < T.Lseq) x[g][k] = *(const u32x4*)(hyb + (row + k - 1) * 3072 + g * 1024 + c); }
}
__device__ __forceinline__ void p3_hyena_pre(Frame& F, const Args& a, int l) {
    const bf16_t* hyb = (const bf16_t*)(F.ws + WS_HY); bf16_t* x0c = (bf16_t*)(F.ws + WS_H); bf16_t* zT = (bf16_t*)(F.outb + OUT_ZT); bf16_t* zctx = (bf16_t*)(F.ws + WS_ZCTX);
    const float* cw = a.in[I_HCW] + (size_t)l * 3 * 3072; const float* cb = a.in[I_HCB] + (size_t)l * 3072;
    bf16_t* zt = (bf16_t*)(F.shm + 40960);
    constexpr int NTILES = NB * 64 * 16 + NB * 4 * 16;
    const int tl = F.tid >> 3, cc = (F.tid & 7) * 8;
    u32x4 xn[3][3];
    float wq[3][3][8], bq[3][8]; int cw_c = -1;
    if (F.bid < NTILES) { const PreTile T = pre_tile(F.bid); pre_load(hyb, T, tl, cc, xn); }
    for (int tile = F.bid; tile < NTILES; tile += F.G) {
        const PreTile T = pre_tile(tile);
        u32x4 x[3][3];
#pragma unroll
        for (int g = 0; g < 3; ++g)
#pragma unroll
            for (int k = 0; k < 3; ++k) x[g][k] = xn[g][k];
        if (tile + F.G < NTILES) { const PreTile Tn = pre_tile(tile + F.G); pre_load(hyb, Tn, tl, cc, xn); }
        const int t = T.t0 + tl, c = T.c0 + cc;
        const size_t row = (size_t)T.b * LT + T.tbase + t;
        if (c != cw_c) { cw_c = c;
#pragma unroll
            for (int g = 0; g < 3; ++g) { const int ch = g * 1024 + c;
                const f32x4 bb0 = *(const f32x4*)(cb + ch), bb1 = *(const f32x4*)(cb + ch + 4);
#pragma unroll
                for (int j = 0; j < 4; ++j) { bq[g][j] = bb0[j]; bq[g][4 + j] = bb1[j]; }
#pragma unroll
                for (int k = 0; k < 3; ++k) { const f32x4 w0 = *(const f32x4*)(cw + k * 3072 + ch), w1 = *(const f32x4*)(cw + k * 3072 + ch + 4);
#pragma unroll
                    for (int j = 0; j < 4; ++j) { wq[g][k][j] = w0[j]; wq[g][k][4 + j] = w1[j]; } } } }
        float u[3][8];
#pragma unroll
        for (int g = 0; g < 3; ++g) {
#pragma unroll
            for (int j = 0; j < 8; ++j) u[g][j] = bq[g][j];
#pragma unroll
            for (int k = 0; k < 3; ++k) { const u32x4 xv = x[g][k];
#pragma unroll
                for (int j = 0; j < 4; ++j) { u[g][2 * j] += bflo(xv[j]) * wq[g][k][2 * j]; u[g][2 * j + 1] += bfhi(xv[j]) * wq[g][k][2 * j + 1]; } }
        }
        u32x4 w;
#pragma unroll
        for (int j = 0; j < 4; ++j) w[j] = cvtpk(u[0][2 * j], u[0][2 * j + 1]);
        *(u32x4*)(x0c + row * 1024 + c) = w;
        float z[8];
#pragma unroll
        for (int j = 0; j < 8; ++j) z[j] = u[1][j] * u[2][j];
        if (!T.lat) {
#pragma unroll
            for (int j = 0; j < 4; ++j) w[j] = cvtpk(z[2 * j], z[2 * j + 1]);
            *(u32x4*)(zctx + ((size_t)T.b * LC + t) * 1024 + c) = w;
        } else {
            __syncthreads();
#pragma unroll
            for (int j = 0; j < 8; ++j) zt[(cc + j) * 72 + tl] = (bf16_t)f2bf(z[j]);
            __syncthreads();
            const int cr = F.tid >> 3, ch8 = (F.tid & 7) * 8;
            const u32x4 v = *(const u32x4*)(zt + cr * 72 + ch8);
            *(u32x4*)(zT + ((size_t)(T.c0 + cr) * NB + T.b) * LS + T.t0 + ch8) = v;
        }
    }
}
__device__ __forceinline__ void p5_hyena_post(Frame& F, const Args& a, int l) {
    const bf16_t* convT = (const bf16_t*)(F.ws + WS_CONVT); const bf16_t* zT = (const bf16_t*)(F.outb + OUT_ZT); const bf16_t* x0c = (const bf16_t*)(F.ws + WS_H); bf16_t* yhy = (bf16_t*)(F.ws + WS_YHY);
    const float* hb = a.in[I_HBIAS] + (size_t)l * 1024;
    float* tl_ = (float*)(F.shm + 49152);
    constexpr int NTILES = NB * 64 * 16;
    const int cr = F.tid >> 3, ch8 = (F.tid & 7) * 8, tl = F.tid >> 3, cc = (F.tid & 7) * 8;
#define P5_LOAD(tile_, cv_, zv_, xv_) do { const int b_ = (tile_) / 1024, r_ = (tile_) % 1024, t0_ = (r_ >> 4) * 64, c0_ = (r_ & 15) * 64; \
        const size_t off_ = ((size_t)(c0_ + cr) * NB + b_) * LS + t0_ + ch8; cv_ = *(const u32x4*)(convT + off_); zv_ = *(const u32x4*)(zT + off_); \
        xv_ = *(const u32x4*)(x0c + ((size_t)b_ * LT + t0_ + tl) * 1024 + c0_ + cc); } while (0)
    u32x4 cvn, zvn, xvn;
    if (F.bid < NTILES) P5_LOAD(F.bid, cvn, zvn, xvn);
    for (int tile = F.bid; tile < NTILES; tile += F.G) {
        const int b = tile / 1024, r = tile % 1024, t0 = (r >> 4) * 64, c0 = (r & 15) * 64;
        const u32x4 cv = cvn, zv = zvn, xv = xvn;
        if (tile + F.G < NTILES) P5_LOAD(tile + F.G, cvn, zvn, xvn);
        __syncthreads();
        { const float bias = hb[c0 + cr];
#pragma unroll
          for (int j = 0; j < 4; ++j) { tl_[cr * 65 + ch8 + 2 * j] = bflo(cv[j]) + bflo(zv[j]) * bias; tl_[cr * 65 + ch8 + 2 * j + 1] = bfhi(cv[j]) + bfhi(zv[j]) * bias; } }
        __syncthreads();
        const size_t row = (size_t)b * LT + t0 + tl;
        u32x4 w;
#pragma unroll
        for (int j = 0; j < 4; ++j) w[j] = cvtpk(bflo(xv[j]) * tl_[(cc + 2 * j) * 65 + tl], bfhi(xv[j]) * tl_[(cc + 2 * j + 1) * 65 + tl]);
        *(u32x4*)(yhy + row * 1024 + c0 + cc) = w;
    }
#undef P5_LOAD
}
__device__ __forceinline__ void p4_hyena_ctx(Frame& F, const Args& a, int l) {
    const bf16_t* zctx = (const bf16_t*)(F.ws + WS_ZCTX); const float* fctx = (const float*)(F.ws + WS_FCTX); const bf16_t* x0c = (const bf16_t*)(F.ws + WS_H); bf16_t* yhy = (bf16_t*)(F.ws + WS_YHY);
    const float* hb = a.in[I_HBIAS] + (size_t)l * 1024;
    float* g = (float*)F.shm;
    float* zs = g + 512 * 32;
    for (int it = F.bid; it < 256; it += F.G) {
        const int b = it >> 5, c0 = (it & 31) * 32, c = F.tid & 31, tg = F.tid >> 5, t0 = tg * 16;
        __syncthreads();
        for (int i = F.tid; i < 512 * 32; i += 512) { const int x = i >> 5, cc = i & 31, lag = x - 256;
            g[i] = x == 0 ? 0.f : (lag >= 0 ? fctx[(size_t)lag * 1024 + c0 + cc] : fctx[(size_t)(256 - lag) * 1024 + c0 + cc]); }
        for (int i = F.tid; i < 256 * 32; i += 512) { const int s = i >> 5, cc = i & 31; zs[i] = bf2f(zctx[((size_t)b * LC + s) * 1024 + c0 + cc]); }
        __syncthreads();
        float acc[16];
#pragma unroll
        for (int j = 0; j < 16; ++j) acc[j] = 0.f;
#pragma unroll 1
        for (int sb = 0; sb < 8; ++sb) { const int s0 = 32 * sb;
            float fw[47], zv[32];
#pragma unroll
            for (int k = 0; k < 47; ++k) fw[k] = g[(t0 - s0 + 225 + k) * 32 + c];
#pragma unroll
            for (int si = 0; si < 32; ++si) zv[si] = zs[(s0 + si) * 32 + c];
#pragma unroll
            for (int si = 0; si < 32; ++si)
#pragma unroll
                for (int j = 0; j < 16; ++j) acc[j] += fw[j - si + 31] * zv[si];
        }
        const float bias = hb[c0 + c];
#pragma unroll
        for (int j = 0; j < 16; ++j) { const size_t row = (size_t)b * LT + LS + t0 + j;
            yhy[row * 1024 + c0 + c] = (bf16_t)f2bf(bf2f(x0c[row * 1024 + c0 + c]) * (acc[j] + zs[(t0 + j) * 32 + c] * bias)); }
    }
}
__device__ __forceinline__ void p4_hyena_lat(Frame& F) {
    const bf16_t* zT = (const bf16_t*)(F.outb + OUT_ZT); const bf16_t* filtR = (const bf16_t*)(F.outb + OUT_FILT); bf16_t* convT = (bf16_t*)(F.ws + WS_CONVT);
    hy::conv_init(F.shm);
    for (int c = F.bid; c < 1024; c += F.G) hy::conv_channel(F.shm, zT + (size_t)c * NB * LS, filtR + (size_t)c * 8192, convT + (size_t)c * NB * LS);
    asm volatile("s_waitcnt lgkmcnt(0)\n\ts_barrier" ::: "memory");
}

__device__ __forceinline__ void diff_unit(Frame& F, const Args& a, int l, int b, int h, int qrow, bool isctx, float lam, float lam_init) {
    bf16_t* dq = (bf16_t*)(F.ws + WS_DQ); const bf16_t* dk = (const bf16_t*)(F.ws + WS_DK); const bf16_t* dv = (const bf16_t*)(F.ws + WS_DV);
    f32x4* stash = (f32x4*)(F.outb + OUT_STASH) + (size_t)F.bid * 16 * 512 + F.tid;
    const int lane = F.lane, r32 = lane & 31, hi = lane >> 5;
    const size_t brow = (size_t)b * LT;
    f32x16 o[4], lf;
#pragma unroll 1
    for (int m = 0; m < 2; ++m) {
        att::Pass P;
        P.Qw = dq + (brow + qrow + F.wave * 32) * 1024 + h * 128 + m * 64; P.ldq = 1024;
        P.Kb = dk + brow * 1024 + h * 128 + m * 64; P.ldk = 1024;
        P.Vb = dv + brow * 1024 + h * 128; P.ldv = 1024;
        if (isctx) { P.nA = 0; P.ks = 0; P.nC = 4; } else { P.nA = LT / 64; P.ks = 0; P.nC = 0; }
        P.band = 0; P.qpos = qrow + F.wave * 32; P.m0 = -INFINITY; P.l0 = 0.f; P.rope = isctx ? 0 : 1; P.rtab = (const LAS float*)(F.lds + ROPE_OFF);
        att::flash_pass<128>(F.shm, P, o, lf);
        att::normalize<128>(o, lf);
        if (m == 0) {
            unsigned long long spa = (unsigned long long)stash; asm volatile("" : "+v"(spa)); GAS f32x4* sp = (GAS f32x4*)spa;
#pragma unroll
            for (int d = 0; d < 4; ++d)
#pragma unroll
                for (int g = 0; g < 4; ++g) sp[(d * 4 + g) * 512] = (f32x4){o[d][4 * g], o[d][4 * g + 1], o[d][4 * g + 2], o[d][4 * g + 3]};
        }
    }
    float ss[16];
#pragma unroll
    for (int r = 0; r < 16; ++r) ss[r] = 0.f;
    { unsigned long long spa = (unsigned long long)stash; asm volatile("" : "+v"(spa)); const GAS f32x4* sp = (const GAS f32x4*)spa;
#pragma unroll
      for (int d = 0; d < 4; ++d)
#pragma unroll
        for (int g = 0; g < 4; ++g) { const f32x4 o0 = sp[(d * 4 + g) * 512];
#pragma unroll
            for (int j = 0; j < 4; ++j) { const float y = o0[j] - lam * o[d][4 * g + j]; o[d][4 * g + j] = y; ss[4 * g + j] += y * y; } } }
#pragma unroll
    for (int r = 0; r < 16; ++r) { float s = ss[r];
#pragma unroll
        for (int off = 1; off < 32; off <<= 1) s += __shfl_xor(s, off);
        ss[r] = 1.0f / sqrtf(s * (1.0f / 128.0f) + EPS) * (1.0f - lam_init); }
    const float* sg = a.in[I_SUBLN] + (size_t)l * 128;
    { int ln_ = threadIdx.x & 63; asm volatile("" : "+v"(ln_)); const int r32 = ln_ & 31, hi = ln_ >> 5, lane = ln_;
      LAS bf16_t* stg = (LAS bf16_t*)F.lds + F.wave * 4096;
#pragma unroll
      for (int d = 0; d < 4; ++d) { const float g = sg[32 * d + r32];
#pragma unroll
        for (int r = 0; r < 16; ++r) stg[att::crow(r, hi) * 128 + 32 * d + r32] = (bf16_t)f2bf(o[d][r] * ss[r] * g); }
      LDS_WAIT();
      unsigned long long yba = (unsigned long long)(dq + (brow + qrow + F.wave * 32) * 1024 + h * 128); asm volatile("" : "+v"(yba)); GAS bf16_t* yb = (GAS bf16_t*)yba;
#pragma unroll
      for (int i = 0; i < 8; ++i) { const int row = i * 4 + (lane >> 4), ch = lane & 15; const u32x4 v = *(const LAS u32x4*)(stg + row * 128 + ch * 8); if (!F.dry) *(GAS u32x4*)(yb + row * 1024 + ch * 8) = v; }
      asm volatile("s_waitcnt lgkmcnt(0)\n\ts_barrier" ::: "memory"); }
}
__device__ __forceinline__ void p4_diff(Frame& F, const Args& a, int l, bool ctx_out) {
    const float* lp = a.in[I_DLAM] + (size_t)l * 256;
    const float d01 = wave_sum(lp[F.lane] * lp[64 + F.lane]), d23 = wave_sum(lp[128 + F.lane] * lp[192 + F.lane]);
    const float lam_init = 0.8f - 0.6f * expf(-0.3f * (float)l);
    const float lam = __uint_as_float(__builtin_amdgcn_readfirstlane(__float_as_uint(expf(d01) - expf(d23) + lam_init)));
    const int nun = NB * 8 * 16 + (ctx_out ? NB * 8 : 0);
    const int vcu = (F.G % 8 == 0) ? (F.bid % 8) * (F.G / 8) + F.bid / 8 : F.bid;
    for (int u = vcu; u < nun; u += F.G) {
        if (u < NB * 8 * 16) { const int b = u >> 7, h = (u >> 4) & 7, qb = u & 15; diff_unit(F, a, l, b, h, qb * 256, false, lam, lam_init); }
        else { const int v = u - NB * 8 * 16; diff_unit(F, a, l, v >> 3, v & 7, LS, true, lam, lam_init); }
    }
}
__device__ __forceinline__ void swa_unit(Frame& F, const Args& a, int l, int b, int kvh, int qrow, bool isctx) {
    bf16_t* sq = (bf16_t*)(F.ws + WS_SQ); const bf16_t* sk = (const bf16_t*)(F.ws + WS_SK); const bf16_t* sv = (const bf16_t*)(F.ws + WS_SV);
    const int lane = F.lane, r32 = lane & 31, hi = lane >> 5; const size_t brow = (size_t)b * LT; const int qh = kvh * 4 + (F.wave & 3), rh = F.wave >> 2;
    att::Pass P;
    P.Qw = sq + (brow + qrow + rh * 32) * 1024 + qh * 64; P.ldq = 1024;
    P.Kb = sk + brow * 256 + kvh * 64; P.ldk = 256; P.Vb = sv + brow * 256 + kvh * 64; P.ldv = 256;
    if (isctx) { P.nA = 0; P.ks = 0; P.nC = 4; P.band = 0; }
    else { const int ks = qrow >= 128 ? qrow - 128 : 0, ke = qrow + 192 <= LS ? qrow + 192 : LS; P.ks = ks; P.nA = (ke - ks) >> 6; P.nC = 4; P.band = 1; }
    P.qpos = (isctx ? 0 : qrow) + rh * 32; P.m0 = a.in[I_SINK][l * 16 + qh] * LOG2E; P.l0 = 1.0f; P.rope = isctx ? 0 : 1; P.rtab = (const LAS float*)(F.lds + ROPE_OFF);
    f32x16 o[2], lf;
    att::flash_pass<64>(F.shm, P, o, lf);
    att::normalize<64>(o, lf);
    { int ln_ = threadIdx.x & 63; asm volatile("" : "+v"(ln_)); const int r32 = ln_ & 31, hi = ln_ >> 5, lane = ln_;
      LAS bf16_t* stg = (LAS bf16_t*)F.lds + F.wave * 2048;
#pragma unroll
      for (int d = 0; d < 2; ++d)
#pragma unroll
        for (int r = 0; r < 16; ++r) stg[att::crow(r, hi) * 64 + 32 * d + r32] = (bf16_t)f2bf(o[d][r]);
      LDS_WAIT();
      unsigned long long yba = (unsigned long long)(sq + (brow + qrow + rh * 32) * 1024 + qh * 64); asm volatile("" : "+v"(yba)); GAS bf16_t* yb = (GAS bf16_t*)yba;
#pragma unroll
      for (int i = 0; i < 4; ++i) { const int row = i * 8 + (lane >> 3), ch = lane & 7; const u32x4 v = *(const LAS u32x4*)(stg + row * 64 + ch * 8); if (!F.dry) *(GAS u32x4*)(yb + row * 1024 + ch * 8) = v; }
      asm volatile("s_waitcnt lgkmcnt(0)\n\ts_barrier" ::: "memory"); }
}
__device__ __forceinline__ void p4_swa(Frame& F, const Args& a, int l, bool ctx_out) {
    const int nun = NB * 4 * 64 + (ctx_out ? NB * 4 * 4 : 0);
    const int vcu0 = (F.G % 8 == 0) ? (F.bid % 8) * (F.G / 8) + F.bid / 8 : F.bid;
    const int vcu = F.G - 1 - vcu0;
    for (int u = vcu; u < nun; u += F.G) {
        if (u < NB * 4 * 64) { const int b = u >> 8, kvh = (u >> 6) & 3, qb = u & 63; swa_unit(F, a, l, b, kvh, qb * 64, false); }
        else { const int v = u - NB * 4 * 64; swa_unit(F, a, l, v >> 4, (v >> 2) & 3, LS + (v & 3) * 64, true); }
    }
}
typedef float f32x2 __attribute__((ext_vector_type(2)));
__device__ __forceinline__ float p8_reduce32(const float (&p0)[16], const float (&p1)[16], int lane) {
    float s[16], t[8], u[4], w[2];
#pragma unroll
    for (int e = 0; e < 16; ++e) { const auto r = __builtin_amdgcn_permlane32_swap(__float_as_uint(p0[e]), __float_as_uint(p1[e]), false, false); s[e] = __uint_as_float(r[0]) + __uint_as_float(r[1]); }
#pragma unroll
    for (int e = 0; e < 8; ++e) { const auto r = __builtin_amdgcn_permlane16_swap(__float_as_uint(s[e]), __float_as_uint(s[e + 8]), false, false); t[e] = __uint_as_float(r[0]) + __uint_as_float(r[1]); }
#pragma unroll
    for (int e = 0; e < 4; ++e) {
        const float X = __builtin_bit_cast(float, __builtin_amdgcn_update_dpp(__builtin_bit_cast(int, t[e]), __builtin_bit_cast(int, t[e + 4]), 0x128, 0xf, 0xc, false));
        const float Y = __builtin_bit_cast(float, __builtin_amdgcn_update_dpp(__builtin_bit_cast(int, t[e + 4]), __builtin_bit_cast(int, t[e]), 0x128, 0xf, 0x3, false));
        u[e] = X + Y; }
#pragma unroll
    for (int e = 0; e < 2; ++e) {
        const float X = __builtin_bit_cast(float, __builtin_amdgcn_update_dpp(__builtin_bit_cast(int, u[e]), __builtin_bit_cast(int, u[e + 2]), 0x114, 0xf, 0xa, false));
        const float Y = __builtin_bit_cast(float, __builtin_amdgcn_update_dpp(__builtin_bit_cast(int, u[e + 2]), __builtin_bit_cast(int, u[e]), 0x104, 0xf, 0x5, false));
        w[e] = X + Y; }
    const bool b1 = (lane & 2) != 0;
    const float x = b1 ? w[1] : w[0], y = b1 ? w[0] : w[1];
    float z = x + __builtin_bit_cast(float, __builtin_amdgcn_update_dpp(0, __builtin_bit_cast(int, y), 0x4E, 0xf, 0xf, false));
    z += __builtin_bit_cast(float, __builtin_amdgcn_update_dpp(0, __builtin_bit_cast(int, z), 0xB1, 0xf, 0xf, false));
    return z;
}
__device__ __forceinline__ float half_sum(float v) {
    v += __builtin_bit_cast(float, __builtin_amdgcn_update_dpp(0, __builtin_bit_cast(int, v), 0x128, 0xf, 0xf, false));
    v += __builtin_bit_cast(float, __builtin_amdgcn_update_dpp(0, __builtin_bit_cast(int, v), 0x124, 0xf, 0xf, false));
    v += __builtin_bit_cast(float, __builtin_amdgcn_update_dpp(0, __builtin_bit_cast(int, v), 0x122, 0xf, 0xf, false));
    v += __builtin_bit_cast(float, __builtin_amdgcn_update_dpp(0, __builtin_bit_cast(int, v), 0x121, 0xf, 0xf, false));
    const auto r = __builtin_amdgcn_permlane16_swap(__float_as_uint(v), __float_as_uint(v), false, false); return __uint_as_float(r[0]) + __uint_as_float(r[1]);
}
__device__ __forceinline__ float half_max(float v) {
    v = fmaxf(v, __builtin_bit_cast(float, __builtin_amdgcn_update_dpp(0, __builtin_bit_cast(int, v), 0x128, 0xf, 0xf, false)));
    v = fmaxf(v, __builtin_bit_cast(float, __builtin_amdgcn_update_dpp(0, __builtin_bit_cast(int, v), 0x124, 0xf, 0xf, false)));
    v = fmaxf(v, __builtin_bit_cast(float, __builtin_amdgcn_update_dpp(0, __builtin_bit_cast(int, v), 0x122, 0xf, 0xf, false)));
    v = fmaxf(v, __builtin_bit_cast(float, __builtin_amdgcn_update_dpp(0, __builtin_bit_cast(int, v), 0x121, 0xf, 0xf, false)));
    const auto r = __builtin_amdgcn_permlane16_swap(__float_as_uint(v), __float_as_uint(v), false, false); return fmaxf(__uint_as_float(r[0]), __uint_as_float(r[1]));
}
__device__ __forceinline__ void p8_norm2_router(Frame& F, const Args& a, int l) {
    float* rwT = (float*)F.shm;
    const float* rw = a.in[I_ROUTER] + (size_t)l * 1024 * 16;
    for (int i = F.tid; i < 16384; i += 512) { const int k = i >> 4, e = i & 15; rwT[e * 1024 + k] = rw[i]; }
    __syncthreads();
    const int gw = F.bid * NWAVES + F.wave, NGW = F.G * NWAVES;
    const bf16_t* xres = (const bf16_t*)(F.ws + WS_XRES); bf16_t* hb = (bf16_t*)(F.ws + WS_H); float* aff = (float*)(F.ws + WS_AFF);
    const float* mods = (const float*)(F.ws + WS_MODS); const float* g2 = a.in[I_N2G] + (size_t)l * 1024;
    const int rpw = (((TROWS + NGW - 1) / NGW) + 1) & ~1, r0 = gw * rpw, r1 = r0 + rpw < TROWS ? r0 + rpw : TROWS;
    static_assert(TROWS % 2 == 0 && LT % 2 == 0 && LS % 2 == 0, "row pairs");
    int myrow, mye;
    { float t0[16], t1[16];
#pragma unroll
      for (int e = 0; e < 16; ++e) { float te = (float)e; asm volatile("" : "+v"(te)); t0[e] = te; t1[e] = te + 100.0f; }
      const int tg = (int)(p8_reduce32(t0, t1, F.lane) * (1.0f / 64.0f) + 0.5f); myrow = tg >= 100 ? 1 : 0; mye = tg - 100 * myrow; }
    f32x4 gq[4], shq[4], sclq[4]; int mr_cur = -1;
#pragma unroll
    for (int j = 0; j < 4; ++j) gq[j] = *(const f32x4*)(g2 + 4 * F.lane + 256 * j);
    u32x2 vn0[4], vn1[4];
    if (r0 < r1) {
#pragma unroll
        for (int j = 0; j < 4; ++j) { vn0[j] = ldxr(xres + (size_t)r0 * 1024 + 4 * F.lane + 256 * j); vn1[j] = ldxr(xres + (size_t)(r0 + 1) * 1024 + 4 * F.lane + 256 * j); } }
    for (int row = r0; row < r1; row += 2) {
        asm volatile("" ::: "memory");
        const int b = row / LT, t = row - b * LT; const int mr = t < LS ? b : 8;
        if (mr != mr_cur) { mr_cur = mr; const float* mrow = mods + ((size_t)l * 9 + mr) * 6144;
#pragma unroll
            for (int j = 0; j < 4; ++j) { shq[j] = *(const f32x4*)(mrow + 3 * 1024 + 4 * F.lane + 256 * j); sclq[j] = *(const f32x4*)(mrow + 4 * 1024 + 4 * F.lane + 256 * j) + 1.0f; } }
        f32x4 v0[4], v1[4]; float ss0 = 0.f, ss1 = 0.f;
#pragma unroll
        for (int j = 0; j < 4; ++j) { v0[j] = cvx4(vn0[j]); v1[j] = cvx4(vn1[j]);
            ss0 += (v0[j][0] * v0[j][0] + v0[j][1] * v0[j][1]) + (v0[j][2] * v0[j][2] + v0[j][3] * v0[j][3]);
            ss1 += (v1[j][0] * v1[j][0] + v1[j][1] * v1[j][1]) + (v1[j][2] * v1[j][2] + v1[j][3] * v1[j][3]); }
        if (row + 2 < r1) {
#pragma unroll
            for (int j = 0; j < 4; ++j) { vn0[j] = ldxr(xres + (size_t)(row + 2) * 1024 + 4 * F.lane + 256 * j); vn1[j] = ldxr(xres + (size_t)(row + 3) * 1024 + 4 * F.lane + 256 * j); } }
        const float rstd0 = 1.0f / sqrtf(wave_sum(ss0) * (1.0f / 1024.0f) + EPS), rstd1 = 1.0f / sqrtf(wave_sum(ss1) * (1.0f / 1024.0f) + EPS);
#pragma unroll
        for (int j = 0; j < 4; ++j) { const int c = 4 * F.lane + 256 * j;
            v0[j] = (v0[j] * rstd0 * gq[j]) * sclq[j] + shq[j]; v1[j] = (v1[j] * rstd1 * gq[j]) * sclq[j] + shq[j];
            u32x2 w; w.x = cvtpk(v0[j][0], v0[j][1]); w.y = cvtpk(v0[j][2], v0[j][3]); *(u32x2*)(hb + (size_t)row * 1024 + c) = w;
            w.x = cvtpk(v1[j][0], v1[j][1]); w.y = cvtpk(v1[j][2], v1[j][3]); *(u32x2*)(hb + (size_t)(row + 1) * 1024 + c) = w; }
        float p0[16], p1[16];
#pragma unroll
        for (int e = 0; e < 16; ++e) { f32x2 a0 = (f32x2){0.f, 0.f}, a1 = a0;
#pragma unroll
            for (int j = 0; j < 4; ++j) { const f32x4 w = *(const f32x4*)(rwT + e * 1024 + 4 * F.lane + 256 * j); const f32x2 wl = (f32x2){w[0], w[1]}, wh = (f32x2){w[2], w[3]};
                a0 += (f32x2){v0[j][0], v0[j][1]} * wl; a0 += (f32x2){v0[j][2], v0[j][3]} * wh;
                a1 += (f32x2){v1[j][0], v1[j][1]} * wl; a1 += (f32x2){v1[j][2], v1[j][3]} * wh; }
            p0[e] = a0[0] + a0[1]; p1[e] = a1[0] + a1[1]; }
        const float lg = p8_reduce32(p0, p1, F.lane);
        const float mx = half_max(lg);
        const float ex = __expf(lg - mx);
        const float den = half_sum(ex) * 0.5f;
        aff[(size_t)(row + myrow) * 16 + mye] = ex / den;
    }
}
__device__ __forceinline__ void p9_topk_gather(Frame& F) {
    unsigned* hist = (unsigned*)F.shm;
    unsigned* sh = hist + 256;
    int* rowlist = (int*)(sh + 32);
    const float* aff = (const float*)(F.ws + WS_AFF); int* slotof = (int*)(F.ws + WS_SLOTOF); float* gate = (float*)(F.ws + WS_GATE);
    const bf16_t* hb = (const bf16_t*)(F.ws + WS_H); bf16_t* xg = (bf16_t*)(F.ws + WS_XG);
    for (int item = F.bid; item < 256; item += F.G) {
        const int q = item >> 1, part = item & 1, b = q >> 4, e = q & 15;
#pragma unroll 1
        for (int cx = 0; cx < 2; ++cx) {
            const bool isctx = cx == 1;
            const int N = isctx ? LC : LS, cap = N / 8, per = isctx ? 1 : 8;
            const int rbase = b * LT + (isctx ? LS : 0);
            const bool act = isctx ? (F.tid < 256) : true;
            unsigned key[8];
#pragma unroll
            for (int j = 0; j < 8; ++j) { key[j] = 0u; if (act && j < per) key[j] = __float_as_uint(aff[(size_t)(rbase + F.tid * per + j) * 16 + e]); }
            unsigned prefix = 0u, krem = (unsigned)cap;
#pragma unroll 1
            for (int pass = 3; pass >= 0; --pass) {
                const int shft = pass * 8; const unsigned himask = pass == 3 ? 0u : (0xffffffffu << (shft + 8));
                __syncthreads();
                if (F.tid < 256) hist[F.tid] = 0u;
                __syncthreads();
#pragma unroll
                for (int j = 0; j < 8; ++j) if (act && j < per && (key[j] & himask) == prefix) atomicAdd(&hist[(key[j] >> shft) & 255u], 1u);
                __syncthreads();
                if (F.wave == 0) {
                    const unsigned h0 = hist[4 * F.lane], h1 = hist[4 * F.lane + 1], h2 = hist[4 * F.lane + 2], h3 = hist[4 * F.lane + 3];
                    const unsigned own = h0 + h1 + h2 + h3; unsigned inc = own;
#pragma unroll
                    for (int off = 1; off < 64; off <<= 1) { const unsigned o = __shfl_down(inc, off); if (F.lane + off < 64) inc += o; }
                    const unsigned S = inc - own;
                    if (S < krem && krem <= S + own) {
                        unsigned cum = S; int bin;
                        if (cum + h3 >= krem) bin = 3; else { cum += h3; if (cum + h2 >= krem) bin = 2; else { cum += h2; if (cum + h1 >= krem) bin = 1; else { cum += h1; bin = 0; } } }
                        sh[0] = prefix | ((unsigned)(4 * F.lane + bin) << shft); sh[1] = krem - cum;
                    }
                }
                __syncthreads();
                prefix = sh[0]; krem = sh[1];
            }
            unsigned cg = 0u, ce = 0u;
#pragma unroll
            for (int j = 0; j < 8; ++j) if (act && j < per) { cg += key[j] > prefix ? 1u : 0u; ce += key[j] == prefix ? 1u : 0u; }
            unsigned pk = cg | (ce << 16), inc = pk;
#pragma unroll
            for (int off = 1; off < 64; off <<= 1) { const unsigned o = __shfl_up(inc, off); if (F.lane >= off) inc += o; }
            __syncthreads();
            if (F.lane == 63) sh[16 + F.wave] = inc;
            __syncthreads();
            unsigned base = 0u;
            for (int w = 0; w < F.wave; ++w) base += sh[16 + w];
            unsigned ex = base + inc - pk; unsigned gb = ex & 0xffffu, eb = ex >> 16;
            const int sbase = isctx ? SLOT_L + (e * NB + b) * CAP_C : (e * NB + b) * CAP_L;
#pragma unroll
            for (int j = 0; j < 8; ++j) if (act && j < per) {
                const int row = rbase + F.tid * per + j; int slot = -1;
                if (key[j] > prefix) { slot = (int)(gb + (eb < krem ? eb : krem)); gb++; }
                else if (key[j] == prefix) { if (eb < krem) slot = (int)(gb + eb); eb++; }
                if (slot >= 0) { rowlist[slot] = row; if (part == 0) gate[sbase + slot] = __uint_as_float(key[j]); slot += sbase; }
                if (part == 0) slotof[(size_t)row * 16 + e] = slot;
            }
            __syncthreads();
            const int hcap = cap >> 1;
            for (int s0 = part * hcap + 4 * F.wave; s0 < (part + 1) * hcap; s0 += 4 * NWAVES) {
                u32x4 d[4][2];
#pragma unroll
                for (int i = 0; i < 4; ++i) { const u32x4* src = (const u32x4*)(hb + (size_t)rowlist[s0 + i] * 1024) + F.lane; d[i][0] = src[0]; d[i][1] = src[64]; }
#pragma unroll
                for (int i = 0; i < 4; ++i) { u32x4* dst = (u32x4*)(xg + (size_t)(sbase + s0 + i) * 1024) + F.lane; dst[0] = d[i][0]; dst[64] = d[i][1]; }
            }
        }
    }
}
constexpr int PPL = 12;
constexpr int NPHASE = 1 + DEPTH * PPL + 1;

__device__ __forceinline__ void phase_stagger(int nunits, int G, int c, int unit_ticks) {
#ifndef MK_NOSTAGGER
    const int rem = nunits % G;
    if (rem == 0 || c < rem) return;
    const int g = ((c - rem) >> 3) % 3 + 1;
    const unsigned long long t0 = __builtin_amdgcn_s_memrealtime(); const unsigned long long d = (unsigned long long)(g * unit_ticks / 4);
    while (__builtin_amdgcn_s_memrealtime() - t0 < d) __builtin_amdgcn_s_sleep(8);
#endif
}

__global__ void __launch_bounds__(NWAVES * 64, 2) mk_fwd(Args args) {
    extern __shared__ __attribute__((aligned(16))) unsigned char lds[];
    Frame F;
    F.lds = (LAS unsigned char*)lds; F.shm = (char*)lds;
    F.tid = threadIdx.x; F.lane = F.tid & 63; F.wave = __builtin_amdgcn_readfirstlane(F.tid >> 6);
    F.G = gridDim.x; F.bid = blockIdx.x; F.ws = args.ws; F.outb = (unsigned char*)args.out; F.dry = 0;
    volatile LAS unsigned* MISC = (volatile LAS unsigned*)(F.lds + MISC_OFF);
    for (int u = F.tid; u < (LDS_BYTES - LDSCTL_OFF) / 4; u += NWAVES * 64) ((LAS unsigned*)(F.lds + LDSCTL_OFF))[u] = 0u;
    __syncthreads();
    { LAS float* rt_ = (LAS float*)(F.lds + ROPE_OFF);
      for (int i = F.tid; i < 1024; i += NWAVES * 64) { const int pos = i >> 4, f = i & 15; const float inv = __builtin_amdgcn_exp2f(-(float)f * (13.287712379549449f / 16.0f));
          const float rev = (float)pos * inv * 0.15915494309189535f; rt_[i] = cos_rev(rev); rt_[1024 + i] = sin_rev(rev); } }
    __syncthreads();
    unsigned* ctl = (unsigned*)(F.ws + WS_CTL);
    const int lo = args.ph_lo, hi = args.ph_hi;
    XcdBarrier bar; bar.bar = ctl + CW_BAR; bar.x = 0; bar.st = nullptr;
    if (hi - lo > 1) bar = xcd_barrier_post(ctl + CW_BAR, MISC + 8);
#ifdef MK_ONLY
#define PHON(j) ((j) == MK_ONLY)
#else
#define PHON(j) true
#endif
#define IN(k) (lo <= (k) && (k) < hi)
#ifndef MK_DUP
#define MK_DUP 0
#endif
#define NREP(bit) (((MK_DUP >> (bit)) & 1) ? 2 : 1)
#define REP(bit) _Pragma("unroll 1") for (int rep = 0; rep < NREP(bit); ++rep)
#define REPEND(bit) do { if (rep + 1 < NREP(bit)) xcd_barrier(bar); } while (0)
#define DRY(bit) (rep + 1 < NREP(bit))
#define LOCALF Frame Fp = F; Fp.tid = threadIdx.x; asm volatile("" : "+v"(Fp.tid)); Fp.lane = Fp.tid & 63
#define SEAM(k) do { if (IN((k) + 1)) xcd_barrier(bar); } while (0)
#define STAMP(k) do { } while (0)

    if (PHON(100) && IN(0)) { STAMP(0); REP(12) { LOCALF; p0_mods_zfeat(Fp, args); REPEND(12); } SEAM(0); }

    for (int l = 0; l < DEPTH; ++l) {
        const int pb = 1 + l * PPL;
        const float* mods_l = (const float*)(F.ws + WS_MODS) + (size_t)l * 9 * 6144;
        const int lastl = l == DEPTH - 1;
        if (PHON(0) && IN(pb + 0)) { STAMP(pb + 0);
#ifndef MK_SUB0
#define MK_SUB0 7
#endif
            REP(0) { LOCALF; Fp.dry = DRY(0);
#ifndef MK_DRYSUB0
#define MK_DRYSUB0 7
#endif
            const int sub0 = Fp.dry ? MK_DRYSUB0 : MK_SUB0;
            if (sub0 & 1) { p1_weights(Fp, args, l); __syncthreads(); }
            if (sub0 & 2) { p1_filters(Fp, args, l); __syncthreads(); }
            if (sub0 & 4) { p1_norm1(Fp, args, l); }
            REPEND(0); }
            SEAM(pb + 0); }
        if (PHON(1) && IN(pb + 1)) { STAMP(pb + 1);
            pg8::SchedPlain S; S.init((const bf16_t*)(F.ws + WS_H), (const bf16_t*)(F.ws + WS_WIN), TROWS, DIN, 1024, F.G, F.bid);
            pg8::EpiProj E; E.ws = F.ws; E.rope = (const LAS float*)(F.lds + ROPE_OFF);
            REP(1) { E.dry = DRY(1); pg8::gemm_phase<pg8::EpiProj, pg8::SchedPlain>(F.lds, 1024, S, E); REPEND(1); }
            SEAM(pb + 1);
        }
        if (PHON(2) && IN(pb + 2)) { STAMP(pb + 2); REP(2) { LOCALF; Fp.dry = DRY(2); p3_hyena_pre(Fp, args, l); REPEND(2); } SEAM(pb + 2); }
        if (PHON(3) && IN(pb + 3)) { STAMP(pb + 3);
#ifndef MK_SUB
#define MK_SUB 15
#endif
            if (MK_SUB & 1) { REP(3) { LOCALF; Fp.dry = DRY(3); p4_diff(Fp, args, l, !lastl); __syncthreads(); REPEND(3); } }
            if (MK_SUB & 2) { REP(4) { LOCALF; Fp.dry = DRY(4); p4_swa(Fp, args, l, !lastl); __syncthreads(); REPEND(4); } }
            REP(5) { if (MK_SUB & 4) { LOCALF; p4_hyena_lat(Fp); __syncthreads(); }
            if ((MK_SUB & 8) && !lastl) { LOCALF; p4_hyena_ctx(Fp, args, l); } REPEND(5); }
            SEAM(pb + 3); }
        if (PHON(4) && IN(pb + 4)) { STAMP(pb + 4); REP(6) { LOCALF; p5_hyena_post(Fp, args, l); REPEND(6); } SEAM(pb + 4); }
        if (PHON(5) && IN(pb + 5)) { STAMP(pb + 5);
            pg8::SchedBranch S; S.latonly = lastl; S.T.init(lastl ? NB * 16 : TROWS / 256, 4); S.G = F.G; S.c = F.bid; S.ws = (const char*)F.ws;
            S.B = (const char*)(F.ws + WS_WBR); S.tstep = (size_t)256 * 1024 * 2; S.bstep = (size_t)1024 * 1024 * 2;
            pg8::EpiBranch E; E.ws = F.ws; static_assert(WS_MERGED == OFF_DK && WS_GT == OFF_GT, "branch epilogue offsets");
            REP(7) { pg8::gemm_phase<pg8::EpiBranch, pg8::SchedBranch>(F.lds, 1024, S, E); REPEND(7); }
            SEAM(pb + 5);
        }
        if (PHON(6) && IN(pb + 6)) { STAMP(pb + 6);
            pg8::SchedPlain S; S.init((const bf16_t*)(F.ws + WS_MERGED), (const bf16_t*)(F.ws + WS_WOUT), TROWS, 1024, 1024, F.G, F.bid, lastl);
            pg8::EpiResid E; E.xres = (bf16_t*)(F.ws + WS_XRES); E.mod = mods_l;
            REP(8) { E.dry = DRY(8); pg8::gemm_phase<pg8::EpiResid, pg8::SchedPlain>(F.lds, 1024, S, E); REPEND(8); }
            SEAM(pb + 6);
        }
        if (PHON(7) && IN(pb + 7)) { STAMP(pb + 7); REP(9) { LOCALF; p8_norm2_router(Fp, args, l); REPEND(9); } SEAM(pb + 7); }
        if (PHON(8) && IN(pb + 8)) { STAMP(pb + 8); REP(14) { LOCALF; p9_topk_gather(Fp); REPEND(14); } SEAM(pb + 8); }
        if (PHON(9) && IN(pb + 9)) { STAMP(pb + 9); }
        if (PHON(10) && IN(pb + 10)) { STAMP(pb + 10);
            pg8::SchedMoe S; S.T.init(lastl ? SLOT_L / 256 : SLOTS / 256, 8); S.G = F.G; S.c = F.bid; S.A = (const char*)(F.ws + WS_XG); S.B = (const char*)(F.ws + WS_W13); S.tstep = (size_t)256 * 1024 * 2; S.estep = (size_t)2048 * 1024 * 2;
            pg8::EpiSwiglu E; E.hid = (bf16_t*)(F.ws + WS_HID);
            REP(10) { pg8::gemm_phase<pg8::EpiSwiglu, pg8::SchedMoe>(F.lds, 1024, S, E); REPEND(10); }
            SEAM(pb + 10);
        }
        if (PHON(11) && IN(pb + 11)) { STAMP(pb + 11);
            pg8::SchedMoe S; S.T.init(lastl ? SLOT_L / 256 : SLOTS / 256, 4); S.G = F.G; S.c = F.bid; S.A = (const char*)(F.ws + WS_HID); S.B = (const char*)(F.ws + WS_W2); S.tstep = (size_t)256 * 1024 * 2; S.estep = (size_t)1024 * 1024 * 2;
            pg8::EpiRowScale E; E.out = (bf16_t*)(F.ws + WS_XG); E.gate = (const float*)(F.ws + WS_GATE);
            REP(11) { pg8::gemm_phase<pg8::EpiRowScale, pg8::SchedMoe>(F.lds, 1024, S, E); REPEND(11); }
            SEAM(pb + 11);
        }
    }
    if (PHON(101) && IN(NPHASE - 1)) { STAMP(NPHASE - 1); REP(13) { LOCALF; pf_final(Fp, args); REPEND(13); }
    }
#undef IN
#undef SEAM
}

extern "C" void kernel_launch(void* const* d_in, const int* in_sizes, int n_in, void* d_out, int out_size, void* d_ws, size_t ws_size, hipStream_t stream) {
    static int grid = 0;
    if (grid == 0) {
        if (n_in != 28 || out_size != NB * LS * D || ws_size < WS_TOTAL) { fprintf(stderr, "kernel_launch: unexpected shapes (n_in %d out %d ws %zu need %zu)\n", n_in, out_size, ws_size, (size_t)WS_TOTAL); grid = -1; return; }
        int dev = 0, cus = 0, per_cu = 0;
        if (hipGetDevice(&dev) != hipSuccess || hipDeviceGetAttribute(&cus, hipDeviceAttributeMultiprocessorCount, dev) != hipSuccess) { grid = -1; return; }
        if (hipFuncSetAttribute((const void*)mk_fwd, hipFuncAttributeMaxDynamicSharedMemorySize, LDS_BYTES) != hipSuccess) { fprintf(stderr, "kernel_launch: hipFuncSetAttribute failed\n"); grid = -1; return; }
        if (hipOccupancyMaxActiveBlocksPerMultiprocessor(&per_cu, (const void*)mk_fwd, NWAVES * 64, LDS_BYTES) != hipSuccess || per_cu < 1) { fprintf(stderr, "kernel_launch: occupancy query says %d\n", per_cu); }
        (void)hipGetLastError();
        grid = cus;
    }
    if (grid < 0) return;
    if (hipMemsetAsync((char*)d_ws + WS_CTL, 0, CTL_ZERO_BYTES, stream) != hipSuccess) return;
    Args a{};
    for (int i = 0; i < 28; ++i) a.in[i] = (const float*)d_in[i];
    a.out = (float*)d_out; a.ws = (unsigned char*)d_ws;
#if MK_N_LAUNCHES == 1
    a.ph_lo = 0; a.ph_hi = NPHASE;
    hipLaunchKernelGGL(mk_fwd, dim3(grid), dim3(NWAVES * 64), LDS_BYTES, stream, a);
#else
    for (int p = 0; p < NPHASE; ++p) { a.ph_lo = p; a.ph_hi = p + 1; hipLaunchKernelGGL(mk_fwd, dim3(grid), dim3(NWAVES * 64), LDS_BYTES, stream, a); }
#endif
}
```

```cpp
#include <hip/hip_runtime.h>
#include <cstdio>
#include <cstdint>
#include <type_traits>

#ifndef MK_N_LAUNCHES
#define MK_N_LAUNCHES 1
#endif

#define LAS __attribute__((address_space(3)))
#define GAS __attribute__((address_space(1)))
typedef unsigned short bf16_t;
typedef short bf16x8 __attribute__((ext_vector_type(8)));
typedef short s16x4 __attribute__((ext_vector_type(4)));
typedef float f32x2 __attribute__((ext_vector_type(2)));
typedef float f32x4 __attribute__((ext_vector_type(4)));
typedef float f32x16 __attribute__((ext_vector_type(16)));
typedef unsigned u32x2 __attribute__((ext_vector_type(2)));
typedef unsigned u32x4 __attribute__((ext_vector_type(4)));
typedef GAS unsigned gu32;
#define RLX_AGENT __ATOMIC_RELAXED, __HIP_MEMORY_SCOPE_AGENT
#define LDS_WAIT() asm volatile("s_waitcnt lgkmcnt(0)" ::: "memory")
#define VM_WAIT() asm volatile("s_waitcnt vmcnt(0)" ::: "memory")

constexpr int NB = 8, LS = 4096, LC = 256, LT = LS + LC;
constexpr int TROWS = NB * LT;
constexpr int D = 1024, DIN = 10752, DEPTH = 4, NEXP = 16;
constexpr int CAP_L = 512, CAP_C = 32;
constexpr int SLOT_L = NEXP * NB * CAP_L, SLOT_C = NEXP * NB * CAP_C, SLOTS = SLOT_L + SLOT_C;
constexpr float EPS = 1e-6f;
constexpr float LOG2E = 1.4426950408889634f;
constexpr float QSCALE = 0.125f * LOG2E;

__device__ __forceinline__ unsigned f2bf(float f) { unsigned u = __builtin_bit_cast(unsigned, f); return (u + 0x7fffu + ((u >> 16) & 1u)) >> 16; }
__device__ __forceinline__ unsigned pk2(float lo, float hi) { return f2bf(lo) | (f2bf(hi) << 16); }
__device__ __forceinline__ float bf2f(unsigned v) { return __builtin_bit_cast(float, v << 16); }
__device__ __forceinline__ float bflo(unsigned w) { return __builtin_bit_cast(float, w << 16); }
__device__ __forceinline__ float bfhi(unsigned w) { return __builtin_bit_cast(float, w & 0xffff0000u); }
typedef __bf16 bf16x2_t __attribute__((ext_vector_type(2)));
__device__ __forceinline__ unsigned cvtpk(float lo, float hi) { f32x2 v = {lo, hi}; bf16x2_t b = __builtin_convertvector(v, bf16x2_t); return __builtin_bit_cast(unsigned, b); }
__device__ __forceinline__ u32x2 ldxr(const bf16_t* p) { return __builtin_nontemporal_load((const u32x2*)p); }
__device__ __forceinline__ f32x4 cvx4(const u32x2 w) { return (f32x4){bflo(w.x), bfhi(w.x), bflo(w.y), bfhi(w.y)}; }
__device__ __forceinline__ void stx4(bf16_t* p, const f32x4& v) { u32x2 w; w.x = cvtpk(v[0], v[1]); w.y = cvtpk(v[2], v[3]); *(u32x2*)p = w; }
__device__ __forceinline__ float wave_sum(float v) {
    v += __builtin_bit_cast(float, __builtin_amdgcn_update_dpp(0, __builtin_bit_cast(int, v), 0x128, 0xf, 0xf, false));
    v += __builtin_bit_cast(float, __builtin_amdgcn_update_dpp(0, __builtin_bit_cast(int, v), 0x124, 0xf, 0xf, false));
    v += __builtin_bit_cast(float, __builtin_amdgcn_update_dpp(0, __builtin_bit_cast(int, v), 0x122, 0xf, 0xf, false));
    v += __builtin_bit_cast(float, __builtin_amdgcn_update_dpp(0, __builtin_bit_cast(int, v), 0x121, 0xf, 0xf, false));
    { const auto r = __builtin_amdgcn_permlane16_swap(__float_as_uint(v), __float_as_uint(v), false, false); v = __uint_as_float(r[0]) + __uint_as_float(r[1]); }
    { const auto r = __builtin_amdgcn_permlane32_swap(__float_as_uint(v), __float_as_uint(v), false, false); v = __uint_as_float(r[0]) + __uint_as_float(r[1]); }
    return v;
}
__device__ __forceinline__ float half_sum(float v) {
    v += __builtin_bit_cast(float, __builtin_amdgcn_update_dpp(0, __builtin_bit_cast(int, v), 0x128, 0xf, 0xf, false));
    v += __builtin_bit_cast(float, __builtin_amdgcn_update_dpp(0, __builtin_bit_cast(int, v), 0x124, 0xf, 0xf, false));
    v += __builtin_bit_cast(float, __builtin_amdgcn_update_dpp(0, __builtin_bit_cast(int, v), 0x122, 0xf, 0xf, false));
    v += __builtin_bit_cast(float, __builtin_amdgcn_update_dpp(0, __builtin_bit_cast(int, v), 0x121, 0xf, 0xf, false));
    const auto r = __builtin_amdgcn_permlane16_swap(__float_as_uint(v), __float_as_uint(v), false, false); return __uint_as_float(r[0]) + __uint_as_float(r[1]);
}
__device__ __forceinline__ float half_max(float v) {
    v = fmaxf(v, __builtin_bit_cast(float, __builtin_amdgcn_update_dpp(0, __builtin_bit_cast(int, v), 0x128, 0xf, 0xf, false)));
    v = fmaxf(v, __builtin_bit_cast(float, __builtin_amdgcn_update_dpp(0, __builtin_bit_cast(int, v), 0x124, 0xf, 0xf, false)));
    v = fmaxf(v, __builtin_bit_cast(float, __builtin_amdgcn_update_dpp(0, __builtin_bit_cast(int, v), 0x122, 0xf, 0xf, false)));
    v = fmaxf(v, __builtin_bit_cast(float, __builtin_amdgcn_update_dpp(0, __builtin_bit_cast(int, v), 0x121, 0xf, 0xf, false)));
    const auto r = __builtin_amdgcn_permlane16_swap(__float_as_uint(v), __float_as_uint(v), false, false); return fmaxf(__uint_as_float(r[0]), __uint_as_float(r[1]));
}
__device__ __forceinline__ float sin_rev(float rev) { return __builtin_amdgcn_sinf(__builtin_amdgcn_fractf(rev)); }
__device__ __forceinline__ float cos_rev(float rev) { return __builtin_amdgcn_cosf(__builtin_amdgcn_fractf(rev)); }
__device__ __forceinline__ float sin_rad(float x) { return sin_rev(x * 0.15915494309189535f); }
__device__ __forceinline__ float fast_exp(float x) { return __builtin_amdgcn_exp2f(x * LOG2E); }
__device__ __forceinline__ float sigmoidf_(float x) { return __builtin_amdgcn_rcpf(1.0f + fast_exp(-x)); }

constexpr size_t SZ1K = (size_t)TROWS * 1024 * 2;
constexpr size_t OFF_PROJ = (size_t)353 << 20;
constexpr size_t OFF_DQ = OFF_PROJ, OFF_DK = OFF_DQ + SZ1K, OFF_DV = OFF_DK + SZ1K, OFF_HY = OFF_DV + SZ1K, OFF_SQ = OFF_HY + 3 * SZ1K, OFF_SK = OFF_SQ + SZ1K, OFF_SV = OFF_SK + SZ1K / 4, OFF_GT = OFF_SV + SZ1K / 4;
constexpr size_t OFF_YHY = OFF_HY + ((size_t)64 << 20);

namespace pg8 {
constexpr int BM = 256, BK = 64, HALF = 128, HTB = HALF * BK * 2, STAGE_BYTES = 8 * HTB, NXCD = 8, WGM = 8;
__host__ __device__ __forceinline__ int lds_byte(int r, int c) { const int st = (r >> 4) * 2 + (c >> 5), rr = r & 15, cc = c & 31, ob = rr * 64 + cc * 2; return st * 1024 + (ob ^ (((ob >> 9) & 1) << 5)); }
__host__ __device__ __forceinline__ void stage_rc(int b, int& R, int& C) { const int st = b / 1024, sb = b % 1024, swz = sb ^ (((sb >> 9) & 1) << 5); R = (st >> 1) * 16 + swz / 64; C = (st & 1) * 32 + (swz % 64) / 2; }
__host__ __device__ __forceinline__ int perm32(int rho) { const int n = rho >> 4, i = rho & 15; return 8 * (i >> 2) + 4 * n + (i & 3); }

struct Unit { int pm, pn, aux; const char* A; const char* B; };

struct TileOrder {
    int nM, nN, nwg;
    __device__ __forceinline__ void init(int nM_, int nN_) { nM = nM_; nN = nN_; nwg = nM * nN; }
    __device__ __forceinline__ void map(int L, int& pm, int& pn) const {
        int wgid = L; { const int q = nwg / NXCD, r = nwg % NXCD, xcd = wgid % NXCD, off = wgid / NXCD; wgid = (xcd < r ? xcd * (q + 1) : r * (q + 1) + (xcd - r) * q) + off; }
        const int nig = WGM * nN, gid = wgid / nig, fm = gid * WGM, gsz = (nM - fm) < WGM ? (nM - fm) : WGM;
        pm = fm + ((wgid % nig) % gsz); pn = (wgid % nig) / gsz;
    }
};

template <class E_, class = void> struct EpiFull { static constexpr bool value = false; };
template <class E_> struct EpiFull<E_, decltype((void)E_::FULL)> { static constexpr bool value = E_::FULL; };
template <class S_, class = void> struct SchedGather { static constexpr bool value = false; };
template <class S_> struct SchedGather<S_, decltype((void)S_::GATHER)> { static constexpr bool value = S_::GATHER; };
template <class Epi, class Sched>
__device__ __forceinline__ void gemm_phase(LAS unsigned char* lds, const int K, const Sched& S, const Epi& E) {
    int tid_ = threadIdx.x; asm volatile("" : "+v"(tid_));
    const int tid = tid_, wid = __builtin_amdgcn_readfirstlane(tid >> 6), lane = tid & 63, wr = wid >> 2, wc = wid & 3, fr = lane & 15, fq = lane >> 4;
    const int nt = K / BK;
    unsigned voffA[2], voffB[2]; int gR[2]; unsigned gC[2];
    constexpr bool GATHER = SchedGather<Sched>::value;
    unsigned gA0[2], gA1[2], nG0[2], nG1[2]; int nR0[2], nR1[2];
    constexpr bool FULL = EpiFull<Epi>::value;
#pragma unroll
    for (int i = 0; i < 2; ++i) { int R, C; stage_rc(tid * 16 + i * 8192, R, C); const int Rb = Epi::PERM ? ((FULL ? (R >> 5) * 64 : (R & ~31)) + perm32(R & 31)) : R;
        voffA[i] = (unsigned)(R * K + C) * 2u; voffB[i] = (unsigned)(Rb * K + C) * 2u; gR[i] = R; gC[i] = (unsigned)C * 2u; }
    const size_t kstep = (size_t)(BK * 2);
    const size_t hstep = (size_t)HALF * K * 2;
    const size_t hstepB = FULL ? (size_t)32 * K * 2 : hstep;
    const unsigned ldsw = (unsigned)wid * 1024u;
    const int aoff = lds_byte(wr * 64 + fr, fq * 8), boff = lds_byte(wc * 32 + fr, fq * 8);
#define PG8_SA(b, h) (((b) * 2 + (h)) * HTB)
#define PG8_SB(b, h) ((4 + (b) * 2 + (h)) * HTB)
#define PG8_STAGE(bufoff, gbase, voff) do { _Pragma("unroll") for (int _i = 0; _i < 2; ++_i) \
        __builtin_amdgcn_global_load_lds((const unsigned*)((const char*)(gbase) + (voff)[_i]), (LAS unsigned*)(lds + (bufoff) + ldsw + _i * 8192), 16, 0, 0); } while (0)
#define PG8_STAGE_A(bufoff, gbase, h) do { if (GATHER) { if (h) PG8_STAGE(bufoff, gbase, gA1); else PG8_STAGE(bufoff, gbase, gA0); } else { PG8_STAGE(bufoff, (gbase) + ((h) ? hstep : 0), voffA); } } while (0)
#define PG8_LDA(dst, b, h) do { _Pragma("unroll") for (int m = 0; m < 4; ++m) _Pragma("unroll") for (int k = 0; k < 2; ++k) dst[m][k] = *(const LAS bf16x8*)(lds + PG8_SA(b, h) + aoff + m * 2048 + k * 1024); } while (0)
#define PG8_LDB(dst, b, h) do { _Pragma("unroll") for (int n = 0; n < 2; ++n) _Pragma("unroll") for (int k = 0; k < 2; ++k) dst[n][k] = *(const LAS bf16x8*)(lds + PG8_SB(b, h) + boff + n * 2048 + k * 1024); } while (0)
#define PG8_MMA(ai, bj, At, Bt) do { __builtin_amdgcn_s_setprio(1); _Pragma("unroll") for (int m = 0; m < 4; ++m) _Pragma("unroll") for (int n = 0; n < 2; ++n) _Pragma("unroll") for (int k = 0; k < 2; ++k) \
        acc[ai][bj][m][n] = __builtin_amdgcn_mfma_f32_16x16x32_bf16(Bt[n][k], At[m][k], acc[ai][bj][m][n], 0, 0, 0); __builtin_amdgcn_s_setprio(0); } while (0)
#define PG8_WAIT_V(n) asm volatile("s_waitcnt vmcnt(" #n ")" ::: "memory")
#define PG8_WAIT_L(n) asm volatile("s_waitcnt lgkmcnt(" #n ")" ::: "memory")
#define PG8_BAR __builtin_amdgcn_s_barrier()
#define PG8_SCHED __builtin_amdgcn_sched_barrier(0)
    Unit cur, nxt; int ui = 0;
    if (!S.next(0, cur)) return;
    f32x4 acc[2][2][4][2];
#pragma unroll
    for (int a = 0; a < 2; ++a)
#pragma unroll
        for (int b = 0; b < 2; ++b)
#pragma unroll
            for (int m = 0; m < 4; ++m)
#pragma unroll
                for (int n = 0; n < 2; ++n) acc[a][b][m][n] = (f32x4){0.f, 0.f, 0.f, 0.f};
    bf16x8 At[4][2], B0[2][2], B1[2][2];
    const char* cA = cur.A; const char* cB = cur.B;
#pragma unroll
    for (int i = 0; i < 2; ++i) { gA0[i] = gA1[i] = nG0[i] = nG1[i] = 0u; nR0[i] = nR1[i] = 0; }
    if constexpr (GATHER) {
#pragma unroll
        for (int i = 0; i < 2; ++i) { const int* rp = S.rows + cur.pm * BM + gR[i]; gA0[i] = (unsigned)rp[0] * (unsigned)(K * 2) + gC[i]; gA1[i] = (unsigned)rp[HALF] * (unsigned)(K * 2) + gC[i]; }
    }
    PG8_STAGE(PG8_SB(0, 0), cB, voffB); PG8_STAGE(PG8_SB(0, 1), cB + hstepB, voffB); PG8_STAGE_A(PG8_SA(0, 0), cA, 0); PG8_STAGE_A(PG8_SA(0, 1), cA, 1);
    if (wr == 1) PG8_BAR;
    PG8_WAIT_V(2); PG8_BAR;
    PG8_STAGE(PG8_SB(1, 0), cB + kstep, voffB); PG8_STAGE_A(PG8_SA(1, 0), cA + kstep, 0); PG8_STAGE(PG8_SB(1, 1), cB + hstepB + kstep, voffB);
    PG8_WAIT_V(6); PG8_BAR;
    for (;;) {
        const bool has_next = S.next(ui + 1, nxt);
        const char* nA = has_next ? nxt.A : cA; const char* nB = has_next ? nxt.B : cB;
        if constexpr (GATHER) {
#pragma unroll
            for (int i = 0; i < 2; ++i) { const int* rp = S.rows + (has_next ? nxt.pm : cur.pm) * BM + gR[i]; nR0[i] = rp[0]; nR1[i] = rp[HALF]; }
        }
        for (int t = 0; t < nt; t += 2) {
            const bool last = (t == nt - 2);
            const char* a1 = cA + (size_t)(t + 1) * kstep;
            const char* a2 = last ? nA : cA + (size_t)(t + 2) * kstep; const char* b2 = last ? nB : cB + (size_t)(t + 2) * kstep;
            const char* a3 = a2 + kstep; const char* b3 = b2 + kstep;
            PG8_LDB(B0, 0, 0); PG8_LDB(B1, 0, 1); PG8_SCHED; PG8_LDA(At, 0, 0); PG8_STAGE_A(PG8_SA(1, 1), a1, 1);
            if (GATHER && last) {
#pragma unroll
                for (int i = 0; i < 2; ++i) { gA0[i] = nG0[i]; gA1[i] = nG1[i]; } }
            PG8_WAIT_V(8); PG8_WAIT_L(0); PG8_BAR; PG8_MMA(0, 0, At, B0); PG8_MMA(0, 1, At, B1); PG8_BAR; PG8_SCHED;
            PG8_LDA(At, 0, 1); PG8_STAGE(PG8_SB(0, 0), b2, voffB); PG8_STAGE(PG8_SB(0, 1), b2 + hstepB, voffB); PG8_STAGE_A(PG8_SA(0, 0), a2, 0);
            PG8_WAIT_V(8); PG8_WAIT_L(0);
            if constexpr (GATHER) {
#pragma unroll
                for (int i = 0; i < 2; ++i) { int r0_ = nR0[i], r1_ = nR1[i]; asm volatile("" : "+v"(r0_), "+v"(r1_));
                    nG0[i] = (unsigned)r0_ * (unsigned)(K * 2) + gC[i]; nG1[i] = (unsigned)r1_ * (unsigned)(K * 2) + gC[i]; } }
            PG8_BAR; PG8_MMA(1, 0, At, B0); PG8_MMA(1, 1, At, B1); PG8_BAR; PG8_SCHED;
            PG8_LDB(B0, 1, 0); PG8_LDB(B1, 1, 1); PG8_SCHED; PG8_LDA(At, 1, 0); PG8_STAGE_A(PG8_SA(0, 1), a2, 1);
            PG8_WAIT_V(8); PG8_WAIT_L(0); PG8_BAR; PG8_MMA(0, 0, At, B0); PG8_MMA(0, 1, At, B1); PG8_BAR; PG8_SCHED;
            PG8_LDA(At, 1, 1); PG8_STAGE(PG8_SB(1, 0), b3, voffB); PG8_STAGE(PG8_SB(1, 1), b3 + hstepB, voffB); PG8_STAGE_A(PG8_SA(1, 0), a3, 0);
            PG8_WAIT_V(8); PG8_WAIT_L(0); PG8_BAR; PG8_MMA(1, 0, At, B0); PG8_MMA(1, 1, At, B1); PG8_BAR; PG8_SCHED;
        }
#ifndef PG8_NOALIGN
        if (wr == 0) PG8_BAR;
#else
        if (wr == 0 && !has_next) PG8_BAR;
#endif
        E(acc, cur, wr, wc, fr, fq);
        if (!has_next) break;
        if (!E.keep(cur)) {
#pragma unroll
            for (int a = 0; a < 2; ++a)
#pragma unroll
                for (int b = 0; b < 2; ++b)
#pragma unroll
                    for (int m = 0; m < 4; ++m)
#pragma unroll
                        for (int n = 0; n < 2; ++n) acc[a][b][m][n] = (f32x4){0.f, 0.f, 0.f, 0.f};
        }
        cur = nxt; cA = nA; cB = nB; ++ui;
#ifndef PG8_NOALIGN
        if (wr == 1) PG8_BAR;
#endif
    }
    PG8_WAIT_V(0);
    PG8_BAR;
#undef PG8_SA
#undef PG8_SB
#undef PG8_STAGE
#undef PG8_LDA
#undef PG8_STAGE_A
#undef PG8_LDB
#undef PG8_MMA
#undef PG8_WAIT_V
#undef PG8_WAIT_L
#undef PG8_BAR
#undef PG8_SCHED
}
}
namespace pg8 {

struct SchedPlain {
    TileOrder T; int G, c; const char* A; const char* B; size_t tstep; int latonly;
    int extra;
    __device__ __forceinline__ void init(const bf16_t* A_, const bf16_t* B_, int M, int N, int K, int G_, int c_, int latonly_ = 0) { latonly = latonly_; T.init(latonly_ ? NB * 16 : M / BM, N / BM); G = G_; c = c_; A = (const char*)A_; B = (const char*)B_; tstep = (size_t)BM * K * 2; extra = latonly_ == 2 ? NB * 10 : 0; }
    __device__ __forceinline__ bool next(int i, Unit& u) const {
        const long L = (long)i * G + c; if (L >= T.nwg + extra) return false;
        if (L < T.nwg) { T.map((int)L, u.pm, u.pn); if (latonly) u.pm = (u.pm >> 4) * 17 + (u.pm & 15); }
        else { const int idx = (int)L - T.nwg, j = idx % 10; u.pm = 17 * (idx / 10) + 16; u.pn = j < 8 ? 4 + j : 20 + j; }
        u.aux = 0; u.A = A + (size_t)u.pm * tstep; u.B = B + (size_t)u.pn * tstep; return true;
    }
};

struct EpiProj {
    static constexpr bool PERM = true;
    static constexpr bool FULL = true;
    unsigned char* ws;
    const LAS float* rope;
    int dry = 0;
    __device__ __forceinline__ bool keep(const Unit&) const { return false; }
    static __device__ __forceinline__ void trade(const u32x4& w0, const u32x4& w1, u32x4& X, u32x4& Y) {
#pragma unroll
        for (int j = 0; j < 4; ++j) {
            X[j] = (unsigned)__builtin_amdgcn_update_dpp((int)w0[j], (int)w1[j], 0x128, 0xf, 0xc, false);
            Y[j] = (unsigned)__builtin_amdgcn_update_dpp((int)w1[j], (int)w0[j], 0x128, 0xf, 0x3, false); }
    }
    __device__ __forceinline__ void operator()(f32x4 (&acc)[2][2][4][2], const Unit& u, int wr, int wc, int fr, int fq) const {
        if (dry) return;
        const int pn = u.pn; int t0, ldc; size_t boff; bool roped = false; float scl = 1.0f;
        if (pn < 4) { boff = OFF_DQ; t0 = 0; ldc = 1024; }                           else if (pn < 8) { boff = OFF_DK; t0 = 4; ldc = 1024; roped = true; } else if (pn < 12) { boff = OFF_DV; t0 = 8; ldc = 1024; }
        else if (pn < 24) { boff = OFF_HY; t0 = 12; ldc = 3072; } else if (pn < 28) { boff = OFF_SQ; t0 = 24; ldc = 1024; } else if (pn < 29) { boff = OFF_SK; t0 = 28; ldc = 256; roped = true; }
        else if (pn < 30) { boff = OFF_SV; t0 = 29; ldc = 256; } else { boff = OFF_GT; t0 = 30; ldc = 3072; }
        bf16_t* base = (bf16_t*)(ws + boff);
        const int row0 = u.pm * BM + wr * 64 + (fr & 7), col0 = (pn - t0) * BM + wc * 64 + 32 * (fr >> 3) + 8 * fq;
        const int tb = (u.pm % 17) * BM;
        const bool lat = tb < LS;
        if (roped) {
            const int half = fq >> 1, f0 = 8 * (fq & 1);
#pragma unroll
            for (int ai = 0; ai < 2; ++ai)
#pragma unroll
                for (int m = 0; m < 4; ++m) {
                    const int t = tb + wr * 64 + fr + ai * HALF + m * 16;
                    u32x4 wv[2];
#pragma unroll
                    for (int bj = 0; bj < 2; ++bj) { const int pos = bj == 0 ? (t >> 6) : (t & 63);
                        f32x4 c0 = (f32x4){1.f, 1.f, 1.f, 1.f}, c1 = c0, s0 = (f32x4){0.f, 0.f, 0.f, 0.f}, s1 = s0;
                        if (lat) { const LAS float* cp = rope + pos * 16 + f0; c0 = *(const LAS f32x4*)cp; c1 = *(const LAS f32x4*)(cp + 4); s0 = *(const LAS f32x4*)(cp + 1024); s1 = *(const LAS f32x4*)(cp + 1028); }
                        if (half == 0) { s0 = -s0; s1 = -s1; }
                        const f32x4 v0 = acc[ai][bj][m][0], v1 = acc[ai][bj][m][1];
                        f32x4 q0, q1;
#pragma unroll
                        for (int j = 0; j < 4; ++j) {
                            const auto r0 = __builtin_amdgcn_permlane32_swap(__float_as_uint(v0[j]), __float_as_uint(v0[j]), false, false);
                            const auto r1 = __builtin_amdgcn_permlane32_swap(__float_as_uint(v1[j]), __float_as_uint(v1[j]), false, false);
                            q0[j] = __uint_as_float(half == 0 ? r0[1] : r0[0]); q1[j] = __uint_as_float(half == 0 ? r1[1] : r1[0]); }
                        const f32x4 o0 = (v0 * c0 + q0 * s0) * scl, o1 = (v1 * c1 + q1 * s1) * scl;
                        wv[bj].x = cvtpk(o0[0], o0[1]); wv[bj].y = cvtpk(o0[2], o0[3]); wv[bj].z = cvtpk(o1[0], o1[1]); wv[bj].w = cvtpk(o1[2], o1[3]); }
                    u32x4 X, Y; trade(wv[0], wv[1], X, Y);
                    bf16_t* rowp = base + (size_t)(row0 + ai * HALF + m * 16) * ldc + col0;
                    *(u32x4*)rowp = X; *(u32x4*)(rowp + (size_t)8 * ldc) = Y;
                }
            return;
        }
#pragma unroll
        for (int ai = 0; ai < 2; ++ai)
#pragma unroll
            for (int m = 0; m < 4; ++m) { bf16_t* rowp = base + (size_t)(row0 + ai * HALF + m * 16) * ldc + col0;
                u32x4 wv[2];
#pragma unroll
                for (int bj = 0; bj < 2; ++bj) { const f32x4 v0 = acc[ai][bj][m][0], v1 = acc[ai][bj][m][1];
                    wv[bj].x = cvtpk(v0[0], v0[1]); wv[bj].y = cvtpk(v0[2], v0[3]); wv[bj].z = cvtpk(v1[0], v1[1]); wv[bj].w = cvtpk(v1[2], v1[3]); }
                u32x4 X, Y; trade(wv[0], wv[1], X, Y);
                *(u32x4*)rowp = X; *(u32x4*)(rowp + (size_t)8 * ldc) = Y; }
    }
};

struct SchedBranch {
    TileOrder T; int G, c; const char* ws; const char* B; size_t tstep, bstep; int latonly;
    __device__ __forceinline__ bool next(int i, Unit& u) const {
        const int ti = i / 3, br = i - ti * 3; const long L = (long)ti * G + c; if (L >= T.nwg) return false;
        T.map((int)L, u.pm, u.pn); if (latonly == 1) u.pm = (u.pm >> 4) * 17 + (u.pm & 15); else if (latonly == 2) u.pm = u.pm * 17 + 16;     u.aux = br; size_t ao = br == 0 ? OFF_DQ : (br == 1 ? OFF_YHY : OFF_SQ); asm volatile("" : "+s"(ao));     u.A = ws + ao + (size_t)u.pm * tstep; u.B = B + (size_t)br * bstep + (size_t)u.pn * tstep; return true;
    }
};
struct EpiBranch {
    static constexpr bool PERM = true;
    unsigned char* ws;
    __device__ __forceinline__ bool keep(const Unit& u) const { return u.aux < 2; }
    __device__ __forceinline__ void operator()(f32x4 (&acc)[2][2][4][2], const Unit& u, int wr, int wc, int fr, int fq) const {
        const int br = u.aux;
        const bf16_t* gt = (const bf16_t*)(ws + OFF_GT); bf16_t* out = (bf16_t*)(ws + OFF_DK);
        const int row0 = u.pm * BM + wr * 64 + fr, col0 = u.pn * BM + wc * 32 + 8 * fq;
#pragma unroll
        for (int ai = 0; ai < 2; ++ai) {
            u32x4 GA[4][2], GB[4][2];
#pragma unroll
            for (int m = 0; m < 4; ++m)
#pragma unroll
                for (int bj = 0; bj < 2; ++bj) { const bf16_t* gp = gt + (size_t)(row0 + ai * HALF + m * 16) * 3072 + br * 1024 + col0 + bj * HALF;
                    GA[m][bj] = *(const u32x4*)gp; GB[m][bj] = br < 2 ? *(const u32x4*)(gp + 1024) : (u32x4){0u, 0u, 0u, 0u}; }
#pragma unroll
            for (int m = 0; m < 4; ++m) { const size_t row = (size_t)(row0 + ai * HALF + m * 16);
#pragma unroll
                for (int bj = 0; bj < 2; ++bj) {
                    const u32x4 ga = GA[m][bj], gb = GB[m][bj];
                    float s[8];
                    if (br < 2) {
#pragma unroll
                        for (int j = 0; j < 4; ++j) {
                            const float a0 = bflo(ga[j]), a1 = bfhi(ga[j]), b0 = bflo(gb[j]), b1 = bfhi(gb[j]);
                            s[2 * j]     = (1.0f + fast_exp(fminf(-b0, 80.f))) * __builtin_amdgcn_rcpf(1.0f + fast_exp(fminf(-a0, 80.f)));
                            s[2 * j + 1] = (1.0f + fast_exp(fminf(-b1, 80.f))) * __builtin_amdgcn_rcpf(1.0f + fast_exp(fminf(-a1, 80.f)));
                        }
                    } else {
#pragma unroll
                        for (int j = 0; j < 4; ++j) { s[2 * j] = __builtin_amdgcn_rcpf(1.0f + fast_exp(fminf(-bflo(ga[j]), 80.f))); s[2 * j + 1] = __builtin_amdgcn_rcpf(1.0f + fast_exp(fminf(-bfhi(ga[j]), 80.f))); }
                    }
                    f32x4 v0 = acc[ai][bj][m][0], v1 = acc[ai][bj][m][1];
                    v0[0] *= s[0]; v0[1] *= s[1]; v0[2] *= s[2]; v0[3] *= s[3]; v1[0] *= s[4]; v1[1] *= s[5]; v1[2] *= s[6]; v1[3] *= s[7];
                    if (br < 2) { acc[ai][bj][m][0] = v0; acc[ai][bj][m][1] = v1; }
                    else { u32x4 w; w.x = cvtpk(v0[0], v0[1]); w.y = cvtpk(v0[2], v0[3]); w.z = cvtpk(v1[0], v1[1]); w.w = cvtpk(v1[2], v1[3]);
                        *(u32x4*)(out + row * 1024 + col0 + bj * HALF) = w; }
                } }
            asm volatile("" ::: "memory"); }
    }
};

struct EpiResid {
    static constexpr bool PERM = true;
    bf16_t* xres; const float* mod; int dry;
    __device__ __forceinline__ bool keep(const Unit&) const { return false; }
    __device__ __forceinline__ void operator()(f32x4 (&acc)[2][2][4][2], const Unit& u, int wr, int wc, int fr, int fq) const {
        const int b = u.pm / 17, isctx = (u.pm - b * 17) == 16; const float* mrow = mod + (size_t)(isctx ? 8 : b) * 6144 + 2 * 1024;
        const int row0 = u.pm * BM + wr * 64 + fr, col0 = u.pn * BM + wc * 32 + 8 * fq;
        f32x4 mv[2][2];
#pragma unroll
        for (int bj = 0; bj < 2; ++bj)
#pragma unroll
            for (int n = 0; n < 2; ++n) mv[bj][n] = *(const f32x4*)(mrow + col0 + bj * HALF + n * 4);
#pragma unroll
        for (int ai = 0; ai < 2; ++ai)
#pragma unroll
            for (int m = 0; m < 4; ++m) { bf16_t* rowp = xres + (size_t)(row0 + ai * HALF + m * 16) * 1024 + col0;
#pragma unroll
                for (int bj = 0; bj < 2; ++bj) { u32x4* p = (u32x4*)(rowp + bj * HALF); const u32x4 x = __builtin_nontemporal_load((const u32x4*)p);
                    const f32x4 o0 = (f32x4){bflo(x.x), bfhi(x.x), bflo(x.y), bfhi(x.y)} + mv[bj][0] * acc[ai][bj][m][0], o1 = (f32x4){bflo(x.z), bfhi(x.z), bflo(x.w), bfhi(x.w)} + mv[bj][1] * acc[ai][bj][m][1];
                    u32x4 w; w.x = cvtpk(o0[0], o0[1]); w.y = cvtpk(o0[2], o0[3]); w.z = cvtpk(o1[0], o1[1]); w.w = cvtpk(o1[2], o1[3]);
                    if (!dry) *p = w; }
                if (m == 3) asm volatile("" ::: "memory"); }
    }
};

struct SchedMoe {
    TileOrder T; int G, c; const char* A; const char* B; size_t tstep, estep;
    __device__ __forceinline__ bool next(int i, Unit& u) const {
        const long L = (long)i * G + c; if (L >= T.nwg) return false;
        T.map((int)L, u.pm, u.pn); const int e = u.pm < 256 ? (u.pm >> 4) : (u.pm - 256); u.aux = e;
        u.A = A + (size_t)u.pm * tstep; u.B = B + (size_t)e * estep + (size_t)u.pn * tstep; return true;
    }
};
struct SchedMoeG {
    static constexpr bool GATHER = true;
    TileOrder T; int G, c; const char* A; const char* B; const char* Bhi; size_t tstep, estep; const int* rows;
    __device__ __forceinline__ bool next(int i, Unit& u) const {
        const long L = (long)i * G + c; if (L >= T.nwg) return false;
        T.map((int)L, u.pm, u.pn); const int e = u.pm < 256 ? (u.pm >> 4) : (u.pm - 256); u.aux = e;
        u.A = A; u.B = (e < 8 ? B : Bhi) + (size_t)e * estep + (size_t)u.pn * tstep; return true;
    }
};
struct EpiSwiglu {
    static constexpr bool PERM = true;
    bf16_t* hid;
    __device__ __forceinline__ bool keep(const Unit&) const { return false; }
    __device__ __forceinline__ void operator()(f32x4 (&acc)[2][2][4][2], const Unit& u, int wr, int wc, int fr, int fq) const {
        const int row0 = u.pm * BM + wr * 64 + fr, col0 = u.pn * HALF + wc * 32 + 8 * fq;
#pragma unroll
        for (int ai = 0; ai < 2; ++ai)
#pragma unroll
            for (int m = 0; m < 4; ++m) { bf16_t* rowp = hid + (size_t)(row0 + ai * HALF + m * 16) * 1024 + col0;
                float h[8];
#pragma unroll
                for (int n = 0; n < 2; ++n)
#pragma unroll
                    for (int j = 0; j < 4; ++j) { const float a = acc[ai][0][m][n][j], b = acc[ai][1][m][n][j]; h[4 * n + j] = a * __builtin_amdgcn_rcpf(1.0f + fast_exp(-a)) * b; }
                u32x4 w; w.x = cvtpk(h[0], h[1]); w.y = cvtpk(h[2], h[3]); w.z = cvtpk(h[4], h[5]); w.w = cvtpk(h[6], h[7]);
                *(u32x4*)rowp = w; }
    }
};
struct EpiRowScale {
    static constexpr bool PERM = true;
    bf16_t* out; const float* gate;
    __device__ __forceinline__ bool keep(const Unit&) const { return false; }
    __device__ __forceinline__ void operator()(f32x4 (&acc)[2][2][4][2], const Unit& u, int wr, int wc, int fr, int fq) const {
        const int row0 = u.pm * BM + wr * 64 + fr, col0 = u.pn * BM + wc * 32 + 8 * fq;
#pragma unroll
        for (int ai = 0; ai < 2; ++ai)
#pragma unroll
            for (int m = 0; m < 4; ++m) { const int row = row0 + ai * HALF + m * 16; const float g = gate[row]; bf16_t* rowp = out + (size_t)row * 1024 + col0;
#pragma unroll
                for (int bj = 0; bj < 2; ++bj) { const f32x4 v0 = acc[ai][bj][m][0] * g, v1 = acc[ai][bj][m][1] * g;
                    u32x4 w; w.x = cvtpk(v0[0], v0[1]); w.y = cvtpk(v0[2], v0[3]); w.z = cvtpk(v1[0], v1[1]); w.w = cvtpk(v1[2], v1[3]);
                    *(u32x4*)(rowp + bj * HALF) = w; } }
    }
};
}
namespace att {
__device__ __forceinline__ int crow(int r, int hi) { return (r & 3) + 8 * (r >> 2) + 4 * hi; }
__device__ __forceinline__ void glds16(const void* gsrc, unsigned lds_dst) { unsigned keep;
    asm volatile("s_mov_b32 %0, m0\n\ts_mov_b32 m0, %2\n\ts_nop 0\n\tglobal_load_lds_dwordx4 %1, off\n\ts_mov_b32 m0, %0" : "=&s"(keep) : "v"(gsrc), "s"(lds_dst) : "memory"); }
#define ATT_WAIT_BAR() asm volatile("s_waitcnt vmcnt(0) lgkmcnt(0)\n\ts_barrier" ::: "memory")

constexpr int KSLOT = 8192;
constexpr int NSLOT = 4;
template <int DV> struct Lay { static constexpr int VSLOT = DV * 128, K0 = 0, V0 = NSLOT * KSLOT, WS = V0 + NSLOT * VSLOT, BYTES = WS + 8 * 256; };

struct Pass {
    const bf16_t* Qw; int ldq;
    const bf16_t* Kb; int ldk;
    const bf16_t* Vb; int ldv;
    int nA, ks, nC;
    int band;
    int qpos;
    float m0, l0;
    int rope; const LAS float* rtab;
};

__device__ __forceinline__ float max3f(float a, float b, float c) { float r; asm("v_max3_f32 %0, %1, %2, %3" : "=v"(r) : "v"(a), "v"(b), "v"(c)); return r; }
constexpr float ATT_THR = 8.0f;

template <int DV>
__device__ __forceinline__ void flash_pass(char* shm, const Pass& P, f32x16 (&o)[DV / 32], f32x16& osum) {
    typedef Lay<DV> L;
    int tid_ = threadIdx.x; asm volatile("" : "+v"(tid_));
    const int tid = tid_, lane = tid & 63, r32 = lane & 31, hi = lane >> 5; const int wid = __builtin_amdgcn_readfirstlane(tid >> 6);
    const unsigned lds0 = (unsigned)(uintptr_t)shm;
    float* wsf = (float*)(shm + L::WS) + wid * 64;
    const int NT = P.nA + P.nC;
    bf16x8 qr[4];
#pragma unroll
    for (int d0 = 0; d0 < 4; ++d0) qr[d0] = *reinterpret_cast<const bf16x8*>(P.Qw + (size_t)r32 * P.ldq + d0 * 16 + hi * 8);
    { const int tq = P.qpos + r32;
#pragma unroll
      for (int ax = 0; ax < 2; ++ax) {
          f32x4 c0 = (f32x4){1.f, 1.f, 1.f, 1.f}, c1 = c0, s0 = (f32x4){0.f, 0.f, 0.f, 0.f}, s1 = s0;
          if (P.rope) { const LAS float* cp = P.rtab + (ax == 0 ? (tq >> 6) : (tq & 63)) * 16 + 8 * hi; c0 = *(const LAS f32x4*)cp; c1 = *(const LAS f32x4*)(cp + 4); s0 = *(const LAS f32x4*)(cp + 1024); s1 = *(const LAS f32x4*)(cp + 1028); }
          const u32x4 a = __builtin_bit_cast(u32x4, qr[2 * ax]), b = __builtin_bit_cast(u32x4, qr[2 * ax + 1]); u32x4 oa, ob;
#pragma unroll
          for (int j = 0; j < 4; ++j) { const float cl = j < 2 ? c0[2 * j] : c1[2 * j - 4], ch = j < 2 ? c0[2 * j + 1] : c1[2 * j - 3], sl_ = j < 2 ? s0[2 * j] : s1[2 * j - 4], sh_ = j < 2 ? s0[2 * j + 1] : s1[2 * j - 3];
              const float x1l = bflo(a[j]), x1h = bfhi(a[j]), x2l = bflo(b[j]), x2h = bfhi(b[j]);
              oa[j] = cvtpk((x1l * cl - x2l * sl_) * QSCALE, (x1h * ch - x2h * sh_) * QSCALE); ob[j] = cvtpk((x2l * cl + x1l * sl_) * QSCALE, (x2h * ch + x1h * sh_) * QSCALE); }
          qr[2 * ax] = __builtin_bit_cast(bf16x8, oa); qr[2 * ax + 1] = __builtin_bit_cast(bf16x8, ob); } }
#pragma unroll
    for (int d = 0; d < DV / 32; ++d) o[d] = f32x16{};
    float lsum = (hi == 0) ? P.l0 : 0.f;
    const bf16_t* ksrc = P.Kb + (size_t)lane * P.ldk + wid * 8;
    const bf16_t* vsrc = P.Vb + (size_t)(16 * (wid & 3) + (lane >> 2)) * P.ldv + (wid >> 2) * 32 + (lane & 3) * 8;
#define ATT_KEYROW(t) ((t) < P.nA ? P.ks + 64 * (t) : LS + 64 * ((t) - P.nA))
#define ATT_DMA_K(t, slot) do { const int kr_ = ATT_KEYROW(t); \
        glds16(ksrc + (size_t)kr_ * P.ldk, (unsigned)__builtin_amdgcn_readfirstlane(lds0 + L::K0 + (slot) * KSLOT + wid * 1024)); } while (0)
#define ATT_DMA_V(t, slot, s2_) do { const int kr_ = ATT_KEYROW(t); \
        glds16(vsrc + (size_t)kr_ * P.ldv + (s2_) * 64, (unsigned)__builtin_amdgcn_readfirstlane(lds0 + L::V0 + (slot) * L::VSLOT + (s2_) * 8192 + wid * 1024)); } while (0)
#define ATT_DMA(t, slot) do { ATT_DMA_K(t, slot); _Pragma("unroll") for (int s2__ = 0; s2__ < DV / 64; ++s2__) ATT_DMA_V(t, slot, s2__); } while (0)
#define ATT_QK(p0_, p1_, slot, cinit) do { const char* kb_ = shm + L::K0 + (slot) * KSLOT + hi * 1024 + r32 * 16; bf16x8 kf_[4]; \
        _Pragma("unroll") for (int d0 = 0; d0 < 2; ++d0) { kf_[2 * d0] = *reinterpret_cast<const bf16x8*>(kb_ + d0 * 2048); kf_[2 * d0 + 1] = *reinterpret_cast<const bf16x8*>(kb_ + d0 * 2048 + 512); } \
        __builtin_amdgcn_sched_barrier(0);        \
        p0_ = __builtin_amdgcn_mfma_f32_32x32x16_bf16(kf_[0], qr[0], cinit, 0, 0, 0); p1_ = __builtin_amdgcn_mfma_f32_32x32x16_bf16(kf_[1], qr[0], cinit, 0, 0, 0); \
        p0_ = __builtin_amdgcn_mfma_f32_32x32x16_bf16(kf_[2], qr[1], p0_, 0, 0, 0); p1_ = __builtin_amdgcn_mfma_f32_32x32x16_bf16(kf_[3], qr[1], p1_, 0, 0, 0); \
        __builtin_amdgcn_sched_barrier(0); \
        _Pragma("unroll") for (int d0 = 2; d0 < 4; ++d0) { kf_[2 * d0 - 4] = *reinterpret_cast<const bf16x8*>(kb_ + d0 * 2048); kf_[2 * d0 - 3] = *reinterpret_cast<const bf16x8*>(kb_ + d0 * 2048 + 512); } \
        __builtin_amdgcn_sched_barrier(0); \
        p0_ = __builtin_amdgcn_mfma_f32_32x32x16_bf16(kf_[0], qr[2], p0_, 0, 0, 0); p1_ = __builtin_amdgcn_mfma_f32_32x32x16_bf16(kf_[1], qr[2], p1_, 0, 0, 0); \
        p0_ = __builtin_amdgcn_mfma_f32_32x32x16_bf16(kf_[2], qr[3], p0_, 0, 0, 0); p1_ = __builtin_amdgcn_mfma_f32_32x32x16_bf16(kf_[3], qr[3], p1_, 0, 0, 0); } while (0)
#define ATT_ROWMAX(rm_, p0_, p1_) do { float a_ = max3f(p0_[0], p0_[1], p1_[0]), b_ = max3f(p0_[2], p0_[3], p1_[1]); a_ = max3f(a_, p1_[2], p1_[3]); \
        _Pragma("unroll") for (int r = 4; r < 16; r += 4) { a_ = max3f(a_, p0_[r], p0_[r + 1]); b_ = max3f(b_, p0_[r + 2], p0_[r + 3]); a_ = max3f(a_, p1_[r], p1_[r + 1]); b_ = max3f(b_, p1_[r + 2], p1_[r + 3]); } \
        rm_ = fmaxf(a_, b_); auto rr_ = __builtin_amdgcn_permlane32_swap(__float_as_uint(rm_), __float_as_uint(rm_), false, false); rm_ = fmaxf(__uint_as_float(rr_[0]), __uint_as_float(rr_[1])); } while (0)
    ATT_DMA(0, 0);
#define ATT_WAITV(ktiles) do { if ((ktiles) == 0) asm volatile("s_waitcnt vmcnt(0)" ::: "memory"); \
        else if ((ktiles) == 1) { if (DV == 128) asm volatile("s_waitcnt vmcnt(3)" ::: "memory"); else asm volatile("s_waitcnt vmcnt(2)" ::: "memory"); } \
        else { if (DV == 128) asm volatile("s_waitcnt vmcnt(6)" ::: "memory"); else asm volatile("s_waitcnt vmcnt(4)" ::: "memory"); } } while (0)
    if (NT > 1) ATT_DMA(1, 1);
    if (NT > 2) ATT_DMA(2, 2);
    { const int younger = NT > 2 ? 2 : (NT > 1 ? 1 : 0); ATT_WAITV(younger); }
    asm volatile("s_waitcnt lgkmcnt(0)\n\ts_barrier" ::: "memory");
    f32x16 p0, p1, n0, n1, negm;
    { const f32x16 zero = f32x16{}; ATT_QK(p0, p1, 0, zero); }
    asm volatile("s_nop 15\n\ts_nop 7" : "+v"(p0), "+v"(p1));
#define ATT_NEEDMASK(tt) (P.band && (tt) < P.nA && !(P.ks + 64 * (tt) >= P.qpos - 97 && P.ks + 64 * (tt) <= P.qpos + 65))
#define ATT_MASK(v0_, v1_, tt) do { const int q_ = P.qpos + r32, kb0_ = P.ks + 64 * (tt) + 4 * hi; \
        _Pragma("unroll") for (int r = 0; r < 16; ++r) { const int kv_ = kb0_ + (r & 3) + 8 * (r >> 2); int dd_ = kv_ - q_; dd_ = dd_ < 0 ? -dd_ : dd_; int d1_ = kv_ + 32 - q_; d1_ = d1_ < 0 ? -d1_ : d1_; \
            if (dd_ > 128) v0_[r] = -INFINITY; if (d1_ > 128) v1_[r] = -INFINITY; } } while (0)
    if (ATT_NEEDMASK(0)) ATT_MASK(p0, p1, 0);
    float m; { float rm0; ATT_ROWMAX(rm0, p0, p1); m = fmaxf(P.m0, rm0); }
    lsum *= __builtin_amdgcn_exp2f(P.m0 - m);
#pragma unroll
    for (int r = 0; r < 16; ++r) { p0[r] -= m; p1[r] -= m; negm[r] = -m; }
    n0 = p0; n1 = p1;
    int sl = 0;
    for (int t = 0; t < NT; ++t) {
        { const int younger = t + 2 < NT ? 1 : 0; ATT_WAITV(younger); }
        asm volatile("s_waitcnt lgkmcnt(0)\n\ts_barrier" ::: "memory");
        const int sl1 = (sl + 1) & (NSLOT - 1), sl2 = (sl + 3) & (NSLOT - 1);
        if (t + 1 < NT) { ATT_QK(n0, n1, sl1, negm); }
        __builtin_amdgcn_sched_barrier(0);
        const bool pre = t + 3 < NT;
        if (pre) ATT_DMA_K(t + 3, sl2);
        { float sacc = 0.f;
#pragma unroll
          for (int r = 0; r < 16; ++r) { p0[r] = __builtin_amdgcn_exp2f(p0[r]); p1[r] = __builtin_amdgcn_exp2f(p1[r]); sacc += p0[r] + p1[r]; }
          lsum += sacc; }
        u32x4 pw0, pw1, pw2, pw3;
        pw0 = (u32x4){cvtpk(p0[0], p0[1]), cvtpk(p0[2], p0[3]), cvtpk(p0[4], p0[5]), cvtpk(p0[6], p0[7])};
        pw1 = (u32x4){cvtpk(p0[8], p0[9]), cvtpk(p0[10], p0[11]), cvtpk(p0[12], p0[13]), cvtpk(p0[14], p0[15])};
        pw2 = (u32x4){cvtpk(p1[0], p1[1]), cvtpk(p1[2], p1[3]), cvtpk(p1[4], p1[5]), cvtpk(p1[6], p1[7])};
        pw3 = (u32x4){cvtpk(p1[8], p1[9]), cvtpk(p1[10], p1[11]), cvtpk(p1[12], p1[13]), cvtpk(p1[14], p1[15])};
        const int vb = (int)(lds0 + L::V0 + sl * L::VSLOT) + ((lane >> 4) & 1) * 32 + (lane & 3) * 8 + (4 * hi + ((lane & 15) >> 2)) * 64;
        s16x4 loA[4], hhA[4], loB[4], hhB[4];
        asm volatile("s_waitcnt lgkmcnt(0)" ::: "memory");
#define ATT_VRD(lo_, hh_, d0) do { _Pragma("unroll") for (int ks = 0; ks < 4; ++ks) { \
            asm volatile("ds_read_b64_tr_b16 %0,%1 offset:%c2" : "=&v"(lo_[ks]) : "v"(vb), "i"(((d0) >> 1) * 8192 + ((d0) & 1) * 4096 + ks * 1024) : "memory"); \
            asm volatile("ds_read_b64_tr_b16 %0,%1 offset:%c2" : "=&v"(hh_[ks]) : "v"(vb), "i"(((d0) >> 1) * 8192 + ((d0) & 1) * 4096 + ks * 1024 + 512) : "memory"); } } while (0)
#define ATT_PK(lo_, hh_, k) (bf16x8){lo_[k][0], lo_[k][1], lo_[k][2], lo_[k][3], hh_[k][0], hh_[k][1], hh_[k][2], hh_[k][3]}
        float ra_ = 0.f, rb_ = 0.f, rm = 0.f;
#define ATT_RMSTEP(s_) do { \
            if ((s_) == 0) { if (t + 1 < NT && ATT_NEEDMASK(t + 1)) ATT_MASK(n0, n1, t + 1); ra_ = max3f(n0[0], n0[1], n1[0]); rb_ = max3f(n0[2], n0[3], n1[1]); } \
            else if ((s_) == 1) { ra_ = max3f(ra_, n1[2], n1[3]); } \
            else if ((s_) == 2 || (s_) == 4 || (s_) == 6) { ra_ = max3f(ra_, n0[(2 * (s_)) & 15], n0[(2 * (s_) + 1) & 15]); rb_ = max3f(rb_, n0[(2 * (s_) + 2) & 15], n0[(2 * (s_) + 3) & 15]); } \
            else if ((s_) == 3 || (s_) == 5 || (s_) == 7) { ra_ = max3f(ra_, n1[(2 * (s_) - 2) & 15], n1[(2 * (s_) - 1) & 15]); rb_ = max3f(rb_, n1[(2 * (s_)) & 15], n1[(2 * (s_) + 1) & 15]); } \
            else if ((s_) == 8) { rm = fmaxf(ra_, rb_); auto rr_ = __builtin_amdgcn_permlane32_swap(__float_as_uint(rm), __float_as_uint(rm), false, false); rm = fmaxf(__uint_as_float(rr_[0]), __uint_as_float(rr_[1])); } } while (0)
#define ATT_SLOT(i_) do { if (DV == 128) { ATT_RMSTEP(i_); } else { ATT_RMSTEP(2 * (i_)); ATT_RMSTEP(2 * (i_) + 1); } __builtin_amdgcn_sched_barrier(0); } while (0)
#define ATT_PV(lo_, hh_, d0) do { \
            o[d0] = __builtin_amdgcn_mfma_f32_32x32x16_bf16(__builtin_bit_cast(bf16x8, pw0), ATT_PK(lo_, hh_, 0), o[d0], 0, 0, 0); ATT_SLOT(4 * (d0)); \
            o[d0] = __builtin_amdgcn_mfma_f32_32x32x16_bf16(__builtin_bit_cast(bf16x8, pw1), ATT_PK(lo_, hh_, 1), o[d0], 0, 0, 0); ATT_SLOT(4 * (d0) + 1); \
            o[d0] = __builtin_amdgcn_mfma_f32_32x32x16_bf16(__builtin_bit_cast(bf16x8, pw2), ATT_PK(lo_, hh_, 2), o[d0], 0, 0, 0); ATT_SLOT(4 * (d0) + 2); \
            o[d0] = __builtin_amdgcn_mfma_f32_32x32x16_bf16(__builtin_bit_cast(bf16x8, pw3), ATT_PK(lo_, hh_, 3), o[d0], 0, 0, 0); ATT_SLOT(4 * (d0) + 3); } while (0)
        ATT_VRD(loA, hhA, 0);
#pragma unroll
        for (int d0 = 0; d0 < DV / 32; d0 += 2) {
            ATT_VRD(loB, hhB, d0 + 1);
            asm volatile("s_waitcnt lgkmcnt(8)" ::: "memory"); __builtin_amdgcn_sched_barrier(0);
            ATT_PV(loA, hhA, d0);
            __builtin_amdgcn_sched_barrier(0);
            if (pre) ATT_DMA_V(t + 3, sl2, d0 >> 1);
            if (d0 + 2 < DV / 32) { ATT_VRD(loA, hhA, d0 + 2); asm volatile("s_waitcnt lgkmcnt(8)" ::: "memory"); }
            else asm volatile("s_waitcnt lgkmcnt(0)" ::: "memory");
            __builtin_amdgcn_sched_barrier(0);
            ATT_PV(loB, hhB, d0 + 1);
            __builtin_amdgcn_sched_barrier(0);
        }
#undef ATT_VRD
#undef ATT_PK
#undef ATT_PV
#undef ATT_SLOT
#undef ATT_RMSTEP
        if (t + 1 < NT && __any(rm > ATT_THR)) {
            const float dl = fmaxf(rm, 0.f), f = __builtin_amdgcn_exp2f(-dl);
            m += dl; lsum *= f; if (hi == 0) wsf[r32] = f;
#pragma unroll
            for (int r = 0; r < 16; ++r) { n0[r] -= dl; n1[r] -= dl; negm[r] = -m; }
            LDS_WAIT();
#pragma unroll
            for (int r = 0; r < 16; ++r) { const float fr_ = wsf[crow(r, hi)];
#pragma unroll
                for (int d = 0; d < DV / 32; ++d) o[d][r] *= fr_; }
        }
        p0 = n0; p1 = n1; sl = sl1;
    }
    asm volatile("s_waitcnt lgkmcnt(0)\n\ts_barrier" ::: "memory");
    { auto rr = __builtin_amdgcn_permlane32_swap(__float_as_uint(lsum), __float_as_uint(lsum), false, false); const float l = __uint_as_float(rr[0]) + __uint_as_float(rr[1]);
      if (hi == 0) wsf[r32] = l; LDS_WAIT();
#pragma unroll
      for (int r = 0; r < 16; ++r) osum[r] = wsf[crow(r, hi)];
      LDS_WAIT(); }
#undef ATT_KEYROW
#undef ATT_WAITV
#undef ATT_DMA
#undef ATT_QK
#undef ATT_ROWMAX
#undef ATT_NEEDMASK
#undef ATT_MASK
}

template <int DV>
__device__ __forceinline__ void normalize(f32x16 (&o)[DV / 32], const f32x16& osum) {
#pragma unroll
    for (int r = 0; r < 16; ++r) { const float rl = 1.0f / osum[r];
#pragma unroll
        for (int d = 0; d < DV / 32; ++d) o[d][r] *= rl; }
}
}
namespace hy {
constexpr int UPAD = 20 * 64;
constexpr int UROW = UPAD + 4096 * 2 + UPAD + 16;
constexpr int LDS_U = 0, LDS_R = 8 * UROW, LDS_R1 = LDS_R + 16384 + 64, LDS_BYTES = LDS_R1 + 16384;
static_assert(LDS_BYTES <= 131072 && UROW % 16 == 0, "hyena LDS");

__device__ __forceinline__ void conv_init(char* shm) {
    constexpr int Q = UPAD / 16;
    unsigned z_ = 0u; asm volatile("" : "+v"(z_));
    for (int i = threadIdx.x; i < 8 * 2 * Q; i += 512) { const int b = i / (2 * Q), r = i % (2 * Q), side = r / Q, q = r % Q;
        *(u32x4*)(shm + LDS_U + b * UROW + (side ? UPAD + 8192 : 0) + q * 16) = (u32x4){z_, z_, z_, z_}; }
}
__device__ __forceinline__ void conv_channel(char* shm, const bf16_t* zc, const bf16_t* Rc, bf16_t* outc, const float bias) {
    int tid_ = threadIdx.x; asm volatile("" : "+v"(tid_));
    const int tid = tid_, lane = tid & 63, n = lane & 31, kg = lane >> 5; const int w = __builtin_amdgcn_readfirstlane(tid >> 6);
    asm volatile("s_waitcnt lgkmcnt(0)\n\ts_barrier" ::: "memory");
#pragma unroll
    for (int j = 0; j < 8; ++j) { const int id = tid + 512 * j, b = id >> 9, off = (id & 511) * 16; *(u32x4*)(shm + LDS_U + b * UROW + UPAD + off) = __builtin_nontemporal_load((const u32x4*)((const char*)zc + (size_t)b * 8192 + off)); }
#pragma unroll
    for (int j = 0; j < 2; ++j) { const int ci = tid + 512 * j, off = ci * 16; const u32x4 a = __builtin_nontemporal_load((const u32x4*)((const char*)Rc + off));
        const unsigned e8 = ci < 1023 ? (unsigned)Rc[8 * ci + 8] : 0u;
        *(u32x4*)(shm + LDS_R + off) = a;
        u32x4 sft; sft.x = (a.x >> 16) | (a.y << 16); sft.y = (a.y >> 16) | (a.z << 16); sft.z = (a.z >> 16) | (a.w << 16); sft.w = (a.w >> 16) | (e8 << 16);
        *(u32x4*)(shm + LDS_R1 + off) = sft; }
    asm volatile("s_waitcnt vmcnt(0) lgkmcnt(0)\n\ts_barrier" ::: "memory");
    f32x16 acc[4];
#pragma unroll
    for (int k = 0; k < 4; ++k) acc[k] = f32x16{};
    const int bcol = n >> 2, il = n & 3;
    const LAS char* Abase = (const LAS char*)shm + ((n & 1) ? (LDS_R1 - 2) : LDS_R) + (4096 - n + 8 * kg) * 2;
    const LAS char* Ubase = (const LAS char*)shm + LDS_U + bcol * UROW + UPAD + kg * 16 + 64 * (16 * w + il);
    const int dlo = 16 * w - 127, dhi = 16 * w + 15;
#define HY_LDA(dst, d, sc) do { const volatile LAS unsigned* ap_ = (const volatile LAS unsigned*)(Abase + (16 * (sc) - 32 * (d)) * 2); u32x4 aw_; aw_.x = ap_[0]; aw_.y = ap_[1]; aw_.z = ap_[2]; aw_.w = ap_[3]; dst = __builtin_bit_cast(bf16x8, aw_); } while (0)
#define HY_LDB(dst, m, sc) dst = *(const LAS bf16x8*)(Ubase + 64 * (m) + 32 * (sc))
#pragma unroll 1
    for (int rho = 0; rho < 4; ++rho) {
        int d = dlo + rho;
        bf16x8 A0, A1, X0[5], X1[5];
        HY_LDA(A0, d, 0); HY_LDA(A1, d, 1);
#pragma unroll
        for (int k = 0; k < 4; ++k) { HY_LDB(X0[k], 4 * k - d, 0); HY_LDB(X1[k], 4 * k - d, 1); }
#define HY_STEP(s) { if (d > dhi) break; \
            bf16x8 nA0, nA1;                   \
            HY_LDA(nA0, d + 4, 0); HY_LDA(nA1, d + 4, 1); HY_LDB(X0[(4 - (s) + 5) % 5], -(d + 4), 0); HY_LDB(X1[(4 - (s) + 5) % 5], -(d + 4), 1); \
            _Pragma("unroll") for (int k = 0; k < 4; ++k) { if (!(d >= dlo + 4 * k && d <= dhi - 12 + 4 * k)) continue;     \
                acc[k] = __builtin_amdgcn_mfma_f32_32x32x16_bf16(A0, X0[(k - (s) + 5) % 5], acc[k], 0, 0, 0); acc[k] = __builtin_amdgcn_mfma_f32_32x32x16_bf16(A1, X1[(k - (s) + 5) % 5], acc[k], 0, 0, 0); } \
            A0 = nA0; A1 = nA1; d += 4; }
        for (;;) { HY_STEP(0) HY_STEP(1) HY_STEP(2) HY_STEP(3) HY_STEP(4) }
#undef HY_STEP
    }
#undef HY_LDA
#undef HY_LDB
#pragma unroll
    for (int k = 0; k < 4; ++k) { const int i = 16 * w + 4 * k + il; bf16_t* op = outc + (size_t)bcol * 4096 + 32 * i + 4 * kg;
        const LAS char* zp = (const LAS char*)shm + LDS_U + bcol * UROW + UPAD + (32 * i + 4 * kg) * 2;
#pragma unroll
        for (int g = 0; g < 4; ++g) { const u32x2 zz = *(const LAS u32x2*)(zp + 16 * g);
            u32x2 v; v.x = cvtpk(acc[k][4 * g] + bflo(zz.x) * bias, acc[k][4 * g + 1] + bfhi(zz.x) * bias); v.y = cvtpk(acc[k][4 * g + 2] + bflo(zz.y) * bias, acc[k][4 * g + 3] + bfhi(zz.y) * bias); *(u32x2*)(op + 8 * g) = v; } }
}
}
constexpr int NWAVES = 8;
constexpr size_t MiB = 1u << 20;
constexpr size_t WS_CTL = 0, CTL_ZERO_BYTES = 1 * MiB;
constexpr size_t WS_MODS = 1 * MiB;
constexpr size_t WS_FCTX = 2 * MiB;
constexpr size_t WS_ZFEAT = 4 * MiB;
constexpr size_t WS_AFF = 9 * MiB;
constexpr size_t WS_SLOTOF = 12 * MiB;
constexpr size_t WS_GATE = 16 * MiB;
constexpr size_t WS_ROWS = 16 * MiB + 512 * 1024;
constexpr size_t WS_ZCTX = 17 * MiB;
constexpr size_t WS_XRES = 24 * MiB;
constexpr size_t WS_H = WS_XRES + 136 * MiB;
constexpr size_t WS_W = WS_H + 68 * MiB;
constexpr size_t WS_WIN = WS_W, WS_WBR = WS_WIN + 21 * MiB, WS_WOUT = WS_WBR + 6 * MiB, WS_W13 = WS_WOUT + 2 * MiB, WS_W2 = WS_W13 + 64 * MiB;
constexpr size_t WS_PROJ = WS_W2 + 32 * MiB;
static_assert(WS_PROJ == OFF_PROJ, "projection base");
constexpr size_t WS_DQ = OFF_DQ, WS_DK = OFF_DK, WS_DV = OFF_DV, WS_HY = OFF_HY, WS_SQ = OFF_SQ, WS_SK = OFF_SK, WS_SV = OFF_SV, WS_GT = OFF_GT;
constexpr size_t WS_END = WS_GT + 3 * SZ1K;
constexpr size_t WS_HRAW = WS_END;
constexpr size_t WS_TOTAL = WS_HRAW + 32 * MiB;
constexpr size_t WS_W13B = WS_TOTAL, WS_W2B = WS_W13B + 32 * MiB, WS_TOTAL_DB = WS_W2B + 32 * MiB;
constexpr size_t WS_CONVT = WS_HY;
constexpr size_t WS_YHY = OFF_YHY;
constexpr size_t WS_MERGED = WS_DK;
constexpr size_t WS_XG = WS_HY;
constexpr size_t WS_HID = WS_GT;
static_assert(WS_YHY + SZ1K <= WS_SQ && WS_XG + (size_t)SLOTS * 2048 <= WS_SQ && WS_HID + (size_t)SLOTS * 2048 <= WS_END, "overlays");
constexpr size_t OUT_ZT = 0;
constexpr size_t OUT_FILT = 64 * MiB;
constexpr size_t OUT_STASH = 80 * MiB;
static_assert(OUT_STASH + 32 * MiB <= (size_t)NB * LS * D * 4, "d_out scratch");

constexpr int CW_TMO = 0, CW_CODE = 1, CW_CHK = 64, CW_BAR = 4096;

constexpr int RING_BYTES = 131072, LDSCTL_OFF = RING_BYTES, MISC_OFF = LDSCTL_OFF + 320, ROPE_OFF = LDSCTL_OFF + 1024  , LDS_BYTES = 147456;
static_assert(ROPE_OFF + 8192 <= LDS_BYTES, "LDS map");

#define XB_TMO      128
#define XB_XCNT(j)  (256  + 64 * (j))
#define XB_XSUB(j)  (1280 + 64 * (j))
#define XB_XGEN(j)  (2304 + 64 * (j))
#define XB_TOP      3328
#define XB_TOPGEN   3392
#define XCD_BAR_WORDS 3456
#define XB_SPIN_CAP (1u << 22)
__device__ __forceinline__ unsigned xb_ld(unsigned* p)              { return __hip_atomic_load(p, __ATOMIC_RELAXED, __HIP_MEMORY_SCOPE_AGENT); }
__device__ __forceinline__ unsigned xb_add(unsigned* p, unsigned v) { return __hip_atomic_fetch_add(p, v, __ATOMIC_RELAXED, __HIP_MEMORY_SCOPE_AGENT); }
__device__ __forceinline__ unsigned xb_xcc_id() { return (unsigned)__builtin_amdgcn_s_getreg((3 << 11) | 20) & 0xFu; }
#define XB_SPIN(cond, bar) do { unsigned _sp = 0; while (cond) { __builtin_amdgcn_s_sleep(1); \
    if ((++_sp & 255u) == 0u) { if (xb_ld(&(bar)[XB_TMO])) break; if (_sp > XB_SPIN_CAP) { atomicAdd(&(bar)[XB_TMO], 1u); break; } } } } while (0)
struct XcdBarrier { unsigned* bar; unsigned x; volatile LAS unsigned* st; };
__device__ __forceinline__ XcdBarrier xcd_barrier_post(unsigned* bar, volatile LAS unsigned* st) {
    XcdBarrier b; b.bar = bar; b.x = xb_xcc_id(); b.st = st;
    if (threadIdx.x == 0) (void)xb_add(&bar[XB_XCNT(b.x)], 1u);
    return b;
}
__device__ __forceinline__ void xcd_barrier_complete(unsigned* bar, unsigned x, unsigned& nloc, unsigned& nx) {
    const unsigned G = gridDim.x * gridDim.y * gridDim.z;
    unsigned sum, cnt, mine, sp = 0u;
    for (;;) {
        sum = 0u; cnt = 0u; mine = 0u;
#pragma unroll
        for (unsigned j = 0; j < 16; ++j) { const unsigned c = xb_ld(&bar[XB_XCNT(j)]); sum += c; cnt += (c > 0u) ? 1u : 0u; mine = (j == x) ? c : mine; }
        if (sum == G) break;
        __builtin_amdgcn_s_sleep(1);
        if ((++sp & 255u) == 0u) { if (xb_ld(&bar[XB_TMO])) break; if (sp > XB_SPIN_CAP) { atomicAdd(&bar[XB_TMO], 1u); break; } }
    }
    nloc = mine > 0u ? mine : 1u; nx = cnt > 0u ? cnt : 1u;
}
__device__ __forceinline__ void xcd_barrier(const XcdBarrier& b) {
    asm volatile("s_waitcnt vmcnt(0)" ::: "memory");
    __syncthreads();
    if (threadIdx.x == 0) {
        unsigned* bar = b.bar;
        __builtin_amdgcn_s_waitcnt(0);
        unsigned nloc = b.st[0], nx = b.st[1];
        if (nloc == 0u) { xcd_barrier_complete(bar, b.x, nloc, nx); b.st[0] = nloc; b.st[1] = nx; }
#ifdef XB_EARLY_WB
        __builtin_amdgcn_fence(__ATOMIC_RELEASE, "agent");
        asm volatile("s_waitcnt vmcnt(0)" ::: "memory");
#endif
        const unsigned old = xb_add(&bar[XB_XSUB(b.x)], 1u);
        const unsigned gen = old / nloc;
        if (old + 1u == (gen + 1u) * nloc) {
            __builtin_amdgcn_fence(__ATOMIC_RELEASE, "agent");
            asm volatile("s_waitcnt vmcnt(0)" ::: "memory");
            const unsigned og = xb_add(&bar[XB_TOP], 1u);
            const unsigned tg = og / nx;
            if (og + 1u == (tg + 1u) * nx) xb_add(&bar[XB_TOPGEN], 1u);
            else XB_SPIN(xb_ld(&bar[XB_TOPGEN]) == tg, bar);
            __builtin_amdgcn_fence(__ATOMIC_ACQUIRE, "agent");
            xb_add(&bar[XB_XGEN(b.x)], 1u);
            asm volatile("s_waitcnt vmcnt(0)" ::: "memory");
        } else {
            XB_SPIN(xb_ld(&bar[XB_XGEN(b.x)]) == gen, bar);
            __builtin_amdgcn_fence(__ATOMIC_ACQUIRE, "agent");
            asm volatile("s_waitcnt vmcnt(0)" ::: "memory");
        }
    }
    __syncthreads();
}

struct Args {
    const float* in[28]; float* out; unsigned char* ws; int ph_lo, ph_hi; int wdb, pad_;
};
struct Frame {
    LAS unsigned char* lds; char* shm;
    int tid, lane, wave, G, bid;
    int dry;
    unsigned char* ws; unsigned char* outb;
};
enum { I_X = 0, I_C, I_CTX, I_CCTX, I_WMOD, I_BMOD, I_N1G, I_N2G, I_WIN, I_DLAM, I_SUBLN, I_HCW, I_HCB, I_FW1, I_FB1, I_FW2, I_FB2, I_FW3, I_FREQ, I_HBIAS, I_SINK, I_WBR, I_WOUT, I_ROUTER, I_W1, I_W3, I_W2, I_FINALG };
__device__ __forceinline__ void p0_mods_zfeat(Frame& F, const Args& a) {
    float* sc = (float*)F.shm;
    float* part = (float*)(F.shm + 9 * 1024 * 4);
    for (int i = F.tid; i < 9 * 1024; i += 512) { const int r = i >> 10, k = i & 1023; const float v = r < 8 ? a.in[I_C][r * 1024 + k] : a.in[I_CCTX][k]; sc[i] = v * sigmoidf_(v); }
    __syncthreads();
    float* mods = (float*)(F.ws + WS_MODS);
    for (int ch = F.bid; ch < 192; ch += F.G) {
        const int l = ch / 48, c0 = (ch % 48) * 128, col = F.tid & 127, kq = F.tid >> 7;
        const float* w = a.in[I_WMOD] + ((size_t)l * 1024 + kq * 256) * 6144 + c0 + col;
        float acc[9];
#pragma unroll
        for (int r = 0; r < 9; ++r) acc[r] = 0.f;
#pragma unroll 1
        for (int k0 = 0; k0 < 256; k0 += 16) { float wv[16];
#pragma unroll
            for (int k = 0; k < 16; ++k) wv[k] = __builtin_nontemporal_load(w + (size_t)(k0 + k) * 6144);
#pragma unroll
            for (int k = 0; k < 16; ++k)
#pragma unroll
                for (int r = 0; r < 9; ++r) acc[r] += sc[r * 1024 + kq * 256 + k0 + k] * wv[k]; }
#pragma unroll
        for (int r = 0; r < 9; ++r) part[(kq * 9 + r) * 128 + col] = acc[r];
        __syncthreads();
        for (int i = F.tid; i < 9 * 128; i += 512) { const int r = i >> 7, cc = i & 127;
            const float s = part[(0 * 9 + r) * 128 + cc] + part[(1 * 9 + r) * 128 + cc] + part[(2 * 9 + r) * 128 + cc] + part[(3 * 9 + r) * 128 + cc];
            mods[((size_t)l * 9 + r) * 6144 + c0 + cc] = s + a.in[I_BMOD][l * 6144 + c0 + cc]; }
        __syncthreads();
    }
    bf16_t* zf = (bf16_t*)(F.ws + WS_ZFEAT);
    const int gw = F.bid * NWAVES + F.wave, NGW = F.G * NWAVES;
    const int rpw = (DEPTH * LT + NGW - 1) / NGW, i0 = gw * rpw, i1 = i0 + rpw < DEPTH * LT ? i0 + rpw : DEPTH * LT;
    float w1c[33], w2c[64], b1c = 0.f, b2c = 0.f, fq = 0.f; int l_cur = -1;
    for (int it = i0; it < i1; ++it) {
        const int l = it / LT, row = it - l * LT; const int Lf = row < LS ? LS : LC, ii = row < LS ? row : row - LS;
        if (l != l_cur) { l_cur = l; const float* w1 = a.in[I_FW1] + (size_t)l * 33 * 64; const float* w2 = a.in[I_FW2] + (size_t)l * 64 * 64;
#pragma unroll
            for (int k = 0; k < 33; ++k) w1c[k] = w1[k * 64 + F.lane];
#pragma unroll
            for (int k = 0; k < 64; ++k) w2c[k] = w2[k * 64 + F.lane];
            b1c = a.in[I_FB1][l * 64 + F.lane]; b2c = a.in[I_FB2][l * 64 + F.lane]; fq = a.in[I_FREQ][l * 64 + F.lane]; }
        const float tt = (float)ii / (float)(Lf - 1);
        const float wrev = (float)ii / (float)Lf;
        const int j = F.lane & 15; const float fj = 1e-4f + (float)j * ((15.0f - 1e-4f) / 15.0f);
        const float cs = cos_rev(fj * wrev), sn = -sin_rev(fj * wrev);
        float s = tt * w1c[0] + b1c;
#pragma unroll
        for (int k = 0; k < 16; ++k) { s += __shfl(cs, k) * w1c[1 + k]; s += __shfl(sn, k) * w1c[17 + k]; }
        const float z1 = sin_rad(fq * s);
        float s2 = b2c;
#pragma unroll
        for (int k = 0; k < 64; ++k) s2 += __shfl(z1, k) * w2c[k];
        zf[((size_t)l * 64 + F.lane) * LT + row] = (bf16_t)f2bf(sin_rad(fq * s2));
    }
}

__device__ __forceinline__ void transpose_item(const float* W, int K, int N, bf16_t* WT, int k0, int n0, int drow, LAS float* scr, int lane) {
    f32x4 ld[8];
#pragma unroll
    for (int i = 0; i < 8; ++i) { const int kk = 8 * i + (lane >> 3); ld[i] = __builtin_nontemporal_load((const f32x4*)(W + (size_t)(k0 + kk) * N + n0 + 4 * (lane & 7))); }
#pragma unroll
    for (int i = 0; i < 8; ++i) { const int kk = 8 * i + (lane >> 3); LAS float* d = scr + kk * 33 + 4 * (lane & 7); d[0] = ld[i][0]; d[1] = ld[i][1]; d[2] = ld[i][2]; d[3] = ld[i][3]; }
    LDS_WAIT(); asm volatile("" ::: "memory");
    const int c = lane & 7;
#pragma unroll
    for (int j = 0; j < 4; ++j) { const int n = (lane >> 3) + 8 * j; const LAS float* s = scr + (8 * c) * 33 + n;
        u32x4 o; o.x = pk2(s[0 * 33], s[1 * 33]); o.y = pk2(s[2 * 33], s[3 * 33]); o.z = pk2(s[4 * 33], s[5 * 33]); o.w = pk2(s[6 * 33], s[7 * 33]);
        *(GAS u32x4*)(WT + (size_t)(drow + n) * K + k0 + 8 * c) = o; }
    LDS_WAIT(); asm volatile("" ::: "memory");
}
constexpr int W_IN_ITEMS = 16 * 336, W_SQ_ITEMS = 16 * 32, W_NITEMS = W_IN_ITEMS + 4 * W_SQ_ITEMS + 48 * W_SQ_ITEMS;
constexpr int WA_END = W_IN_ITEMS + 3 * W_SQ_ITEMS;
constexpr int WB_END = WA_END + W_SQ_ITEMS + 16 * W_SQ_ITEMS;
__device__ __forceinline__ void p1_weights(Frame& F, const Args& a, int l, int it0 = 0, int it1 = W_NITEMS, int par = 0) {
    LAS float* scr = (LAS float*)(F.lds + F.wave * 8448);
    const int gw = F.bid * NWAVES + F.wave, NGW = F.G * NWAVES;
    constexpr int I_IN = W_IN_ITEMS, I_SQ = W_SQ_ITEMS;
    bf16_t* WinT = (bf16_t*)(F.ws + WS_WIN); bf16_t* WbrT = (bf16_t*)(F.ws + WS_WBR); bf16_t* WoutT = (bf16_t*)(F.ws + WS_WOUT);
    bf16_t* W13T = (bf16_t*)(F.ws + WS_W13); bf16_t* W2T = (bf16_t*)(F.ws + (par ? WS_W2B : WS_W2));
    bf16_t* W13H = par ? (bf16_t*)(F.ws + WS_W13B) - (size_t)8 * 2097152 : W13T;
    for (int it = it0 + gw; it < it1; it += NGW) {
        int r = it;
        if (r < I_IN) { const int kb = r / 336, nb = r % 336; transpose_item(a.in[I_WIN] + (size_t)l * 1024 * DIN, 1024, DIN, WinT, 64 * kb, 32 * nb, 32 * nb, scr, F.lane); continue; }
        r -= I_IN;
        const int mi = r / I_SQ, q = r % I_SQ, kb = q / 32, nb = q % 32, n0 = 32 * nb;
        if (mi < 3) { transpose_item(a.in[I_WBR] + ((size_t)l * 3 + mi) * 1048576, 1024, 1024, WbrT + (size_t)mi * 1048576, 64 * kb, n0, n0, scr, F.lane); continue; }
        if (mi == 3) { transpose_item(a.in[I_WOUT] + (size_t)l * 1048576, 1024, 1024, WoutT, 64 * kb, n0, n0, scr, F.lane); continue; }
        if (mi < 4 + 32) { const int e = (mi - 4) >> 1, which = (mi - 4) & 1; const size_t eo = ((size_t)l * 16 + e) * 1048576;
            transpose_item(a.in[which ? I_W3 : I_W1] + eo, 1024, 1024, (e < 8 ? W13T : W13H) + (size_t)e * 2097152, 64 * kb, n0, (n0 >> 7) * 256 + which * 128 + (n0 & 127), scr, F.lane); continue; }
        { const int e = mi - 36; const size_t eo = ((size_t)l * 16 + e) * 1048576;
          transpose_item(a.in[I_W2] + eo, 1024, 1024, W2T + (size_t)e * 1048576, 64 * kb, n0, n0, scr, F.lane); }
    }
}

__device__ __forceinline__ void p1_filters(Frame& F, const Args& a, int l, int cg0 = 0, int cg1 = 256) {
    float* w3s = (float*)(F.shm + 72 * 1024);
    float* red = w3s + 512;
    float* nrm = red + 32;
    const bf16_t* zf = (const bf16_t*)(F.ws + WS_ZFEAT) + (size_t)l * LT * 64;
    bf16_t* filtR = (bf16_t*)(F.outb + OUT_FILT); float* fctx = (float*)(F.ws + WS_FCTX);
    const float da = -15.350567286626973f, db = -3.0701134573253946f;
    for (int cg = cg0 + F.bid; cg < cg1; cg += F.G) {
        int c0_ = __builtin_amdgcn_readfirstlane(4 * cg); asm volatile("" : "+s"(c0_)); const int c0 = c0_;
        __syncthreads();
        { const int k = F.tid >> 3, q = F.tid & 7; w3s[F.tid] = a.in[I_FW3][((size_t)l * 64 + k) * 2048 + (q >> 2) * 1024 + c0 + (q & 3)]; }
        __syncthreads();
        float delta[4];
#pragma unroll
        for (int cc = 0; cc < 4; ++cc) delta[cc] = fabsf(da + (float)(c0 + cc) * ((db - da) / 1023.0f));
        float asum[4] = {0.f, 0.f, 0.f, 0.f};
        f32x4* slab = (f32x4*)(F.ws + WS_HRAW) + ((size_t)F.bid * 4096 + 8 * F.tid) * 2;
        { float h[8][8];
#pragma unroll
          for (int j = 0; j < 8; ++j)
#pragma unroll
            for (int q = 0; q < 8; ++q) h[j][q] = 0.f;
          const bf16_t* zc = zf + 8 * F.tid;
          u32x4 zq[4];
#pragma unroll
          for (int kk = 0; kk < 4; ++kk) zq[kk] = *(const u32x4*)(zc + (size_t)kk * LT);
#pragma unroll 1
          for (int g = 0; g < 16; ++g) {
              u32x4 zn[4]; const int gn = g + 1 < 16 ? g + 1 : g;
              const bf16_t* zg = zc + (size_t)gn * 4 * LT;
#pragma unroll
              for (int kk = 0; kk < 4; ++kk) zn[kk] = *(const u32x4*)(zg + (size_t)kk * LT);
              __builtin_amdgcn_sched_barrier(0);
#pragma unroll
              for (int kk = 0; kk < 4; ++kk) { const int k = g * 4 + kk; const u32x4 zw = zq[kk];
                  const f32x4 za = (f32x4){bflo(zw.x), bfhi(zw.x), bflo(zw.y), bfhi(zw.y)}, zb = (f32x4){bflo(zw.z), bfhi(zw.z), bflo(zw.w), bfhi(zw.w)};
                  const f32x4 wa = *(const f32x4*)(w3s + k * 8), wb = *(const f32x4*)(w3s + k * 8 + 4);
#pragma unroll
                  for (int j = 0; j < 8; ++j) { const float z = j < 4 ? za[j] : zb[j - 4];
#pragma unroll
                      for (int q = 0; q < 4; ++q) { h[j][q] += z * wa[q]; h[j][4 + q] += z * wb[q]; } } }
              __builtin_amdgcn_sched_barrier(0);
#pragma unroll
              for (int kk = 0; kk < 4; ++kk) zq[kk] = zn[kk];
          }
#pragma unroll
          for (int j = 0; j < 8; ++j) { const int i = 8 * F.tid + j; const float tt = (float)i / 4095.0f; f32x4 hf, hbk;
#pragma unroll
              for (int cc = 0; cc < 4; ++cc) { const float dec = fast_exp(-tt * delta[cc]); hf[cc] = h[j][cc] * dec; hbk[cc] = h[j][4 + cc] * dec; asum[cc] += fabsf(hf[cc]) + fabsf(hbk[cc]); }
              slab[2 * j] = hf; slab[2 * j + 1] = hbk; } }
#pragma unroll
        for (int cc = 0; cc < 4; ++cc) { const float s = wave_sum(asum[cc]); if (F.lane == 0) red[F.wave * 4 + cc] = s; }
        __syncthreads();
        if (F.tid < 4) { float s = 0.f; for (int w = 0; w < 8; ++w) s += red[w * 4 + F.tid]; nrm[F.tid] = 1.0f / (s + EPS); }
        __syncthreads();
        { bf16_t* img = (bf16_t*)F.shm;
          if (F.tid < 4) img[F.tid * 8192] = 0;
#pragma unroll 1
          for (int j = 0; j < 8; ++j) { const int i = 8 * F.tid + j; const f32x4 hf = slab[2 * j], hbk = slab[2 * j + 1];
#pragma unroll
              for (int cc = 0; cc < 4; ++cc) { const float inv = nrm[cc];
                  img[cc * 8192 + 4096 - i] = (bf16_t)f2bf(hf[cc] * inv);
                  if (i > 0) img[cc * 8192 + 4096 + i] = (bf16_t)f2bf(hbk[cc] * inv); } }
          __syncthreads();
          for (int q = F.tid; q < 4096; q += 512) *(u32x4*)(filtR + (size_t)c0 * 8192 + q * 8) = *(const u32x4*)(img + q * 8);
        }
        __syncthreads();

        float hc[8]; float cs4[4] = {0.f, 0.f, 0.f, 0.f};
        if (F.tid < 256) {
            const bf16_t* zr = zf + LS + F.tid;
#pragma unroll
            for (int q = 0; q < 8; ++q) hc[q] = 0.f;
#pragma unroll 1
            for (int k0 = 0; k0 < 64; k0 += 16) { float zz[16];
#pragma unroll
                for (int k = 0; k < 16; ++k) zz[k] = bf2f(zr[(size_t)(k0 + k) * LT]);
#pragma unroll
                for (int k = 0; k < 16; ++k) { const float z = zz[k];
#pragma unroll
                    for (int q = 0; q < 8; ++q) hc[q] += z * w3s[(k0 + k) * 8 + q]; } }
            const float tt = (float)F.tid / 255.0f;
#pragma unroll
            for (int cc = 0; cc < 4; ++cc) { const float dec = fast_exp(-tt * delta[cc]); hc[cc] *= dec; hc[4 + cc] *= dec; cs4[cc] = fabsf(hc[cc]) + fabsf(hc[4 + cc]); }
        }
#pragma unroll
        for (int cc = 0; cc < 4; ++cc) { const float s = wave_sum(cs4[cc]); if (F.lane == 0) red[F.wave * 4 + cc] = s; }
        __syncthreads();
        if (F.tid < 4) { float s = 0.f; for (int w = 0; w < 8; ++w) s += red[w * 4 + F.tid]; nrm[F.tid] = 1.0f / (s + EPS); }
        __syncthreads();
        if (F.tid < 256) {
#pragma unroll
            for (int q = 0; q < 8; ++q) fctx[((size_t)(q >> 2) * 256 + F.tid) * 1024 + c0 + (q & 3)] = hc[q] * nrm[q & 3];
        }
    }
}

__device__ __forceinline__ int load_sov(Frame& F, int row) { return F.lane < 16 ? ((const int*)(F.ws + WS_SLOTOF))[(size_t)row * 16 + F.lane] : -1; }
__device__ __forceinline__ void combine_row(Frame& F, f32x4 (&v)[4], const int sov, const f32x4 (&m5q)[4]) {
    const bf16_t* ys = (const bf16_t*)(F.ws + WS_XG) + 4 * F.lane;
    unsigned mask = (unsigned)(__ballot(sov >= 0) & 0xffffull);
    f32x4 s[4];
#pragma unroll
    for (int j = 0; j < 4; ++j) s[j] = (f32x4){0.f, 0.f, 0.f, 0.f};
    while (mask) {
        const int e0 = __builtin_ctz(mask); mask &= mask - 1; const bool two = mask != 0u; int e1 = e0; if (two) { e1 = __builtin_ctz(mask); mask &= mask - 1; }
        const int s0 = __builtin_amdgcn_readlane(sov, e0), s1 = __builtin_amdgcn_readlane(sov, e1); const float w1 = two ? 1.f : 0.f;
        const bf16_t* y0 = ys + (size_t)s0 * 1024; const bf16_t* y1 = ys + (size_t)s1 * 1024;
        u32x2 a[4], b[4];
#pragma unroll
        for (int j = 0; j < 4; ++j) { a[j] = __builtin_nontemporal_load((const u32x2*)(y0 + 256 * j)); b[j] = __builtin_nontemporal_load((const u32x2*)(y1 + 256 * j)); }
#pragma unroll
        for (int j = 0; j < 4; ++j) { s[j][0] += bflo(a[j].x) + w1 * bflo(b[j].x); s[j][1] += bfhi(a[j].x) + w1 * bfhi(b[j].x); s[j][2] += bflo(a[j].y) + w1 * bflo(b[j].y); s[j][3] += bfhi(a[j].y) + w1 * bfhi(b[j].y); }
    }
#pragma unroll
    for (int j = 0; j < 4; ++j) v[j] += m5q[j] * s[j];
}
__device__ __forceinline__ void p1_norm1(Frame& F, const Args& a, int l) {
    const int gw = F.bid * NWAVES + F.wave, NGW = F.G * NWAVES;
    bf16_t* xres = (bf16_t*)(F.ws + WS_XRES); bf16_t* hb = (bf16_t*)(F.ws + WS_H);
    const float* mods = (const float*)(F.ws + WS_MODS);
    const float* g1 = a.in[I_N1G] + (size_t)l * 1024;
#define N1_SRC0(row_) (((row_) % LT) < LS ? a.in[I_X] + ((size_t)((row_) / LT) * LS + ((row_) % LT)) * 1024 : a.in[I_CTX] + ((size_t)((row_) / LT) * LC + (((row_) % LT) - LS)) * 1024)
#define N1_LOAD(dst_, row_) do { if (l == 0) { const float* src_ = N1_SRC0(row_); _Pragma("unroll") for (int j = 0; j < 4; ++j) dst_[j] = __builtin_nontemporal_load((const f32x4*)(src_ + 4 * F.lane + 256 * j)); } \
        else { _Pragma("unroll") for (int j = 0; j < 4; ++j) rn[j] = ldxr(xres + (size_t)(row_) * 1024 + 4 * F.lane + 256 * j); } } while (0)
    const int rpw = (TROWS + NGW - 1) / NGW, r0 = gw * rpw, r1 = r0 + rpw < TROWS ? r0 + rpw : TROWS;
    f32x4 gq[4], shq[4], sclq[4], m5q[4]; int mr_cur = -1;
#pragma unroll
    for (int j = 0; j < 4; ++j) { gq[j] = *(const f32x4*)(g1 + 4 * F.lane + 256 * j); m5q[j] = (f32x4){0.f, 0.f, 0.f, 0.f}; }
    f32x4 vn[4]; u32x2 rn[4]; int sovn = -1;
#pragma unroll
    for (int j = 0; j < 4; ++j) { vn[j] = (f32x4){0.f, 0.f, 0.f, 0.f}; rn[j] = (u32x2){0u, 0u}; }
    if (r0 < r1) { N1_LOAD(vn, r0);
        if (l > 0) sovn = load_sov(F, r0); }
    for (int row = r0; row < r1; ++row) {
        const int b = row / LT, t = row - b * LT; const int mr = t < LS ? b : 8;
        if (mr != mr_cur) { mr_cur = mr; const float* mrow = mods + ((size_t)l * 9 + mr) * 6144;
#pragma unroll
            for (int j = 0; j < 4; ++j) { shq[j] = *(const f32x4*)(mrow + 4 * F.lane + 256 * j); sclq[j] = *(const f32x4*)(mrow + 1024 + 4 * F.lane + 256 * j) + 1.0f;
                if (l > 0) m5q[j] = *(const f32x4*)(mods + ((size_t)(l - 1) * 9 + mr) * 6144 + 5 * 1024 + 4 * F.lane + 256 * j); } }
        f32x4 v[4]; const int sov = sovn;
#pragma unroll
        for (int j = 0; j < 4; ++j) v[j] = l == 0 ? vn[j] : cvx4(rn[j]);
        if (row + 1 < r1) { N1_LOAD(vn, row + 1);
            if (l > 0) sovn = load_sov(F, row + 1); }
        if (l > 0) combine_row(F, v, sov, m5q);
        float ss = 0.f;
#pragma unroll
        for (int j = 0; j < 4; ++j) { if (!F.dry) stx4(xres + (size_t)row * 1024 + 4 * F.lane + 256 * j, v[j]); ss += (v[j][0] * v[j][0] + v[j][1] * v[j][1]) + (v[j][2] * v[j][2] + v[j][3] * v[j][3]); }
        const float rstd = 1.0f / sqrtf(wave_sum(ss) * (1.0f / 1024.0f) + EPS);
#pragma unroll
        for (int j = 0; j < 4; ++j) { const int c = 4 * F.lane + 256 * j;
            const f32x4 y = (v[j] * rstd * gq[j]) * sclq[j] + shq[j];
            u32x2 w; w.x = cvtpk(y[0], y[1]); w.y = cvtpk(y[2], y[3]); *(u32x2*)(hb + (size_t)row * 1024 + c) = w; }
    }
#undef N1_SRC0
#undef N1_LOAD
}
__device__ __forceinline__ void pf_final(Frame& F, const Args& a) {
    const int gw = F.bid * NWAVES + F.wave, NGW = F.G * NWAVES;
    const bf16_t* xres = (const bf16_t*)(F.ws + WS_XRES); const float* mods = (const float*)(F.ws + WS_MODS);
    const float* g = a.in[I_FINALG];
#define FN_ROW(r_) (((r_) / LS) * LT + ((r_) % LS))
    const int rpw = (NB * LS + NGW - 1) / NGW, r0 = gw * rpw, r1 = r0 + rpw < NB * LS ? r0 + rpw : NB * LS;
    f32x4 gq[4], m5q[4]; int b_cur = -1;
#pragma unroll
    for (int j = 0; j < 4; ++j) gq[j] = *(const f32x4*)(g + 4 * F.lane + 256 * j);
    u32x2 vn[4]; int sovn = -1;
    if (r0 < r1) { const int row = FN_ROW(r0);
#pragma unroll
        for (int j = 0; j < 4; ++j) vn[j] = ldxr(xres + (size_t)row * 1024 + 4 * F.lane + 256 * j);
        sovn = load_sov(F, row); }
    for (int r = r0; r < r1; ++r) {
        const int b = r / LS;
        if (b != b_cur) { b_cur = b;
#pragma unroll
            for (int j = 0; j < 4; ++j) m5q[j] = *(const f32x4*)(mods + ((size_t)(DEPTH - 1) * 9 + b) * 6144 + 5 * 1024 + 4 * F.lane + 256 * j); }
        f32x4 v[4]; const int sov = sovn;
#pragma unroll
        for (int j = 0; j < 4; ++j) v[j] = cvx4(vn[j]);
        if (r + 1 < r1) { const int row = FN_ROW(r + 1);
#pragma unroll
            for (int j = 0; j < 4; ++j) vn[j] = ldxr(xres + (size_t)row * 1024 + 4 * F.lane + 256 * j);
            sovn = load_sov(F, row); }
        combine_row(F, v, sov, m5q);
        float ss = 0.f;
#pragma unroll
        for (int j = 0; j < 4; ++j) ss += (v[j][0] * v[j][0] + v[j][1] * v[j][1]) + (v[j][2] * v[j][2] + v[j][3] * v[j][3]);
        const float rstd = 1.0f / sqrtf(wave_sum(ss) * (1.0f / 1024.0f) + EPS);
#pragma unroll
        for (int j = 0; j < 4; ++j) { const int c = 4 * F.lane + 256 * j; *(f32x4*)(a.out + (size_t)r * 1024 + c) = v[j] * rstd * gq[j]; }
    }
#undef FN_ROW
}
__device__ __forceinline__ void p3_rope(Frame& F) {
    float* cst = (float*)F.shm;
    float* snt = cst + 1024;
    for (int i = F.tid; i < 1024; i += 512) { const int pos = i >> 4, f = i & 15; const float inv = __builtin_amdgcn_exp2f(-(float)f * (13.287712379549449f / 16.0f));
        const float ang = (float)pos * inv, rev = ang * 0.15915494309189535f; cst[i] = cos_rev(rev); snt[i] = sin_rev(rev); }
    __syncthreads();
    bf16_t* dq = (bf16_t*)(F.ws + WS_DQ); bf16_t* dk = (bf16_t*)(F.ws + WS_DK); bf16_t* sq = (bf16_t*)(F.ws + WS_SQ); bf16_t* sk = (bf16_t*)(F.ws + WS_SK);
    const int gw = F.bid * NWAVES + F.wave, NGW = F.G * NWAVES;
    for (int row = gw; row < TROWS; row += NGW) {
        const int b = row / LT, t = row - b * LT; const bool lat = t < LS;
        for (int it = F.lane; it < 208; it += 64) {
            const int hs = it >> 2, ax = (it >> 1) & 1, fc = it & 1;
            bf16_t* base; float scl;
            if (hs < 16) { base = dq + (size_t)row * 1024 + hs * 64; scl = QSCALE; }
            else if (hs < 32) { base = dk + (size_t)row * 1024 + (hs - 16) * 64; scl = 1.f; }
            else if (hs < 48) { base = sq + (size_t)row * 1024 + (hs - 32) * 64; scl = QSCALE; }
            else { base = sk + (size_t)row * 256 + (hs - 48) * 64; scl = 1.f; }
            if (!lat && scl == 1.f) continue;
            bf16_t* p1 = base + ax * 32 + fc * 8; bf16_t* p2 = p1 + 16;
            const u32x4 a = *(const u32x4*)p1, c = *(const u32x4*)p2;
            float x1[8], x2[8];
#pragma unroll
            for (int j = 0; j < 4; ++j) { x1[2 * j] = bflo(a[j]); x1[2 * j + 1] = bfhi(a[j]); x2[2 * j] = bflo(c[j]); x2[2 * j + 1] = bfhi(c[j]); }
            float o1[8], o2[8];
            if (lat) { const int pos = ax == 0 ? (t >> 6) : (t & 63);
#pragma unroll
                for (int j = 0; j < 8; ++j) { const float cs = cst[pos * 16 + fc * 8 + j], sn = snt[pos * 16 + fc * 8 + j]; o1[j] = (x1[j] * cs - x2[j] * sn) * scl; o2[j] = (x2[j] * cs + x1[j] * sn) * scl; }
            } else {
#pragma unroll
                for (int j = 0; j < 8; ++j) { o1[j] = x1[j] * scl; o2[j] = x2[j] * scl; }
            }
            u32x4 w1, w2;
#pragma unroll
            for (int j = 0; j < 4; ++j) { w1[j] = cvtpk(o1[2 * j], o1[2 * j + 1]); w2[j] = cvtpk(o2[2 * j], o2[2 * j + 1]); }
            if (!F.dry) { *(u32x4*)p1 = w1; *(u32x4*)p2 = w2; }
        }
    }
}
struct PreTile { int b, t0, c0, Lseq, tbase; bool lat; };
__device__ __forceinline__ PreTile pre_tile(int tile) {
    constexpr int NT_L = NB * 64 * 16;
    PreTile T; T.lat = tile < NT_L;
    if (T.lat) { T.b = tile / 1024; const int r = tile % 1024; T.t0 = (r >> 4) * 64; T.c0 = (r & 15) * 64; T.Lseq = LS; T.tbase = 0; }
    else { const int q = tile - NT_L; T.b = q / 64; const int r = q % 64; T.t0 = (r >> 4) * 64; T.c0 = (r & 15) * 64; T.Lseq = LC; T.tbase = LS; }
    return T;
}
__device__ __forceinline__ void pre_load(const bf16_t* hyb, const PreTile& T, int tl, int cc, u32x4 (&x)[3][3]) {
    const int t = T.t0 + tl, c = T.c0 + cc; const size_t row = (size_t)T.b * LT + T.tbase + t;
#pragma unroll
    for (int g = 0; g < 3; ++g)
#pragma unroll
        for (int k = 0; k < 3; ++k) { const int ts = t + k - 1; x[g][k] = (u32x4){0u, 0u, 0u, 0u};
            if (ts >= 0 && ts < T.Lseq) x[g][k] = *(const u32x4*)(hyb + (row + k - 1) * 3072 + g * 1024 + c); }
}
__device__ __forceinline__ void p3_hyena_pre(Frame& F, const Args& a, int l) {
    const bf16_t* hyb = (const bf16_t*)(F.ws + WS_HY); bf16_t* x0c = (bf16_t*)(F.ws + WS_H); bf16_t* zT = (bf16_t*)(F.outb + OUT_ZT); bf16_t* zctx = (bf16_t*)(F.ws + WS_ZCTX);
    const float* cw = a.in[I_HCW] + (size_t)l * 3 * 3072; const float* cb = a.in[I_HCB] + (size_t)l * 3072;
    bf16_t* zt = (bf16_t*)(F.shm + 40960);
    constexpr int NTILES = NB * 64 * 16 + NB * 4 * 16;
    const int tl = F.tid >> 3, cc = (F.tid & 7) * 8;
    u32x4 xn[3][3];
    float wq[3][3][8], bq[3][8]; int cw_c = -1;
    if (F.bid < NTILES) { const PreTile T = pre_tile(F.bid); pre_load(hyb, T, tl, cc, xn); }
    for (int tile = F.bid; tile < NTILES; tile += F.G) {
        const PreTile T = pre_tile(tile);
        u32x4 x[3][3];
#pragma unroll
        for (int g = 0; g < 3; ++g)
#pragma unroll
            for (int k = 0; k < 3; ++k) x[g][k] = xn[g][k];
        if (tile + F.G < NTILES) { const PreTile Tn = pre_tile(tile + F.G); pre_load(hyb, Tn, tl, cc, xn); }
        const int t = T.t0 + tl, c = T.c0 + cc;
        const size_t row = (size_t)T.b * LT + T.tbase + t;
        if (c != cw_c) { cw_c = c;
#pragma unroll
            for (int g = 0; g < 3; ++g) { const int ch = g * 1024 + c;
                const f32x4 bb0 = *(const f32x4*)(cb + ch), bb1 = *(const f32x4*)(cb + ch + 4);
#pragma unroll
                for (int j = 0; j < 4; ++j) { bq[g][j] = bb0[j]; bq[g][4 + j] = bb1[j]; }
#pragma unroll
                for (int k = 0; k < 3; ++k) { const f32x4 w0 = *(const f32x4*)(cw + k * 3072 + ch), w1 = *(const f32x4*)(cw + k * 3072 + ch + 4);
#pragma unroll
                    for (int j = 0; j < 4; ++j) { wq[g][k][j] = w0[j]; wq[g][k][4 + j] = w1[j]; } } } }
        float u[3][8];
#pragma unroll
        for (int g = 0; g < 3; ++g) {
#pragma unroll
            for (int j = 0; j < 8; ++j) u[g][j] = bq[g][j];
#pragma unroll
            for (int k = 0; k < 3; ++k) { const u32x4 xv = x[g][k];
#pragma unroll
                for (int j = 0; j < 4; ++j) { u[g][2 * j] += bflo(xv[j]) * wq[g][k][2 * j]; u[g][2 * j + 1] += bfhi(xv[j]) * wq[g][k][2 * j + 1]; } }
        }
        u32x4 w;
#pragma unroll
        for (int j = 0; j < 4; ++j) w[j] = cvtpk(u[0][2 * j], u[0][2 * j + 1]);
        *(u32x4*)(x0c + row * 1024 + c) = w;
        float z[8];
#pragma unroll
        for (int j = 0; j < 8; ++j) z[j] = u[1][j] * u[2][j];
        if (!T.lat) {
#pragma unroll
            for (int j = 0; j < 4; ++j) w[j] = cvtpk(z[2 * j], z[2 * j + 1]);
            *(u32x4*)(zctx + ((size_t)T.b * LC + t) * 1024 + c) = w;
        } else {
            __syncthreads();
#pragma unroll
            for (int j = 0; j < 8; ++j) zt[(cc + j) * 72 + (tl ^ cc)] = (bf16_t)f2bf(z[j]);
            __syncthreads();
            const int cr = F.tid >> 3, ch8 = (F.tid & 7) * 8;
            const u32x4 v = *(const u32x4*)(zt + cr * 72 + (ch8 ^ (cr & 56)));
            *(u32x4*)(zT + ((size_t)(T.c0 + cr) * NB + T.b) * LS + T.t0 + ch8) = v;
        }
    }
}
__device__ __forceinline__ void p5_hyena_post(Frame& F, const Args& a, int l) {
    const bf16_t* convT = (const bf16_t*)(F.ws + WS_CONVT); const bf16_t* x0c = (const bf16_t*)(F.ws + WS_H); bf16_t* yhy = (bf16_t*)(F.ws + WS_YHY);
    float* tl_ = (float*)(F.shm + 49152);
    constexpr int NTILES = NB * 64 * 16;
    const int cr = F.tid >> 3, ch8 = (F.tid & 7) * 8, tl = F.tid >> 3, cc = (F.tid & 7) * 8;
#define P5_LOAD(tile_, cv_, xv_) do { const int b_ = (tile_) / 1024, r_ = (tile_) % 1024, t0_ = (r_ >> 4) * 64, c0_ = (r_ & 15) * 64; \
        const size_t off_ = ((size_t)(c0_ + cr) * NB + b_) * LS + t0_ + ch8; cv_ = *(const u32x4*)(convT + off_); \
        xv_ = *(const u32x4*)(x0c + ((size_t)b_ * LT + t0_ + tl) * 1024 + c0_ + cc); } while (0)
    u32x4 cvn, xvn;
    if (F.bid < NTILES) P5_LOAD(F.bid, cvn, xvn);
    for (int tile = F.bid; tile < NTILES; tile += F.G) {
        const int b = tile / 1024, r = tile % 1024, t0 = (r >> 4) * 64, c0 = (r & 15) * 64;
        const u32x4 cv = cvn, xv = xvn;
        if (tile + F.G < NTILES) P5_LOAD(tile + F.G, cvn, xvn);
        __syncthreads();
        {
#pragma unroll
          for (int j = 0; j < 4; ++j) { tl_[cr * 65 + ch8 + 2 * j] = bflo(cv[j]); tl_[cr * 65 + ch8 + 2 * j + 1] = bfhi(cv[j]); } }
        __syncthreads();
        const size_t row = (size_t)b * LT + t0 + tl;
        u32x4 w;
#pragma unroll
        for (int j = 0; j < 4; ++j) w[j] = cvtpk(bflo(xv[j]) * tl_[(cc + 2 * j) * 65 + tl], bfhi(xv[j]) * tl_[(cc + 2 * j + 1) * 65 + tl]);
        *(u32x4*)(yhy + row * 1024 + c0 + cc) = w;
    }
#undef P5_LOAD
}
__device__ __forceinline__ void p4_hyena_ctx(Frame& F, const Args& a, int l) {
    const bf16_t* zctx = (const bf16_t*)(F.ws + WS_ZCTX); const float* fctx = (const float*)(F.ws + WS_FCTX); const bf16_t* x0c = (const bf16_t*)(F.ws + WS_H); bf16_t* yhy = (bf16_t*)(F.ws + WS_YHY);
    const float* hb = a.in[I_HBIAS] + (size_t)l * 1024;
    float* g = (float*)F.shm;
    float* zs = g + 512 * 32;
    for (int it = F.bid; it < 256; it += F.G) {
        const int b = it >> 5, c0 = (it & 31) * 32, c = F.tid & 31, tg = F.tid >> 5, t0 = tg * 16;
        __syncthreads();
        {
          f32x4 gv[8]; u32x4 zv8[2];
#pragma unroll
          for (int k = 0; k < 8; ++k) { const int i4 = F.tid + 512 * k, x = i4 >> 3, c4 = (i4 & 7) * 4, lag = x - 256;
              gv[k] = *(const f32x4*)(fctx + (size_t)(lag >= 0 ? lag : 256 - lag) * 1024 + c0 + c4); if (x == 0) gv[k] = (f32x4){0.f, 0.f, 0.f, 0.f}; }
#pragma unroll
          for (int k = 0; k < 2; ++k) { const int i8 = F.tid + 512 * k, s = i8 >> 2, c8 = (i8 & 3) * 8; zv8[k] = *(const u32x4*)(zctx + ((size_t)b * LC + s) * 1024 + c0 + c8); }
#pragma unroll
          for (int k = 0; k < 8; ++k) { const int i4 = F.tid + 512 * k; *(f32x4*)(g + 4 * i4) = gv[k]; }
#pragma unroll
          for (int k = 0; k < 2; ++k) { const int i8 = F.tid + 512 * k; float* d = zs + 8 * i8;
              *(f32x4*)d = (f32x4){bflo(zv8[k].x), bfhi(zv8[k].x), bflo(zv8[k].y), bfhi(zv8[k].y)}; *(f32x4*)(d + 4) = (f32x4){bflo(zv8[k].z), bfhi(zv8[k].z), bflo(zv8[k].w), bfhi(zv8[k].w)}; } }
        __syncthreads();
        float acc[16];
#pragma unroll
        for (int j = 0; j < 16; ++j) acc[j] = 0.f;
#pragma unroll 1
        for (int sb = 0; sb < 8; ++sb) { const int s0 = 32 * sb;
            float fw[47], zv[32];
#pragma unroll
            for (int k = 0; k < 47; ++k) fw[k] = g[(t0 - s0 + 225 + k) * 32 + c];
#pragma unroll
            for (int si = 0; si < 32; ++si) zv[si] = zs[(s0 + si) * 32 + c];
#pragma unroll
            for (int si = 0; si < 32; ++si)
#pragma unroll
                for (int j = 0; j < 16; ++j) acc[j] += fw[j - si + 31] * zv[si];
        }
        const float bias = hb[c0 + c];
#pragma unroll
        for (int j = 0; j < 16; ++j) { const size_t row = (size_t)b * LT + LS + t0 + j;
            yhy[row * 1024 + c0 + c] = (bf16_t)f2bf(bf2f(x0c[row * 1024 + c0 + c]) * (acc[j] + zs[(t0 + j) * 32 + c] * bias)); }
    }
}
__device__ __forceinline__ void p4_hyena_lat(Frame& F, const Args& a, int l) {
    const bf16_t* zT = (const bf16_t*)(F.outb + OUT_ZT); const bf16_t* filtR = (const bf16_t*)(F.outb + OUT_FILT); bf16_t* convT = (bf16_t*)(F.ws + WS_CONVT);
    hy::conv_init(F.shm);
    const float* hb = a.in[I_HBIAS] + (size_t)l * 1024;
    for (int c = F.bid; c < 1024; c += F.G) hy::conv_channel(F.shm, zT + (size_t)c * NB * LS, filtR + (size_t)c * 8192, convT + (size_t)c * NB * LS, hb[c]);
    asm volatile("s_waitcnt lgkmcnt(0)\n\ts_barrier" ::: "memory");
}

__device__ __forceinline__ void diff_unit(Frame& F, const Args& a, int l, int b, int h, int qrow, bool isctx, float lam, float lam_init) {
    bf16_t* dq = (bf16_t*)(F.ws + WS_DQ); const bf16_t* dk = (const bf16_t*)(F.ws + WS_DK); const bf16_t* dv = (const bf16_t*)(F.ws + WS_DV);
    f32x4* stash = (f32x4*)(F.outb + OUT_STASH) + (size_t)F.bid * 16 * 512 + F.tid;
    const int lane = F.lane, r32 = lane & 31, hi = lane >> 5;
    const size_t brow = (size_t)b * LT;
    f32x16 o[4], lf;
#pragma unroll 1
    for (int m = 0; m < 2; ++m) {
        att::Pass P;
        P.Qw = dq + (brow + qrow + F.wave * 32) * 1024 + h * 128 + m * 64; P.ldq = 1024;
        P.Kb = dk + brow * 1024 + h * 128 + m * 64; P.ldk = 1024;
        P.Vb = dv + brow * 1024 + h * 128; P.ldv = 1024;
        if (isctx) { P.nA = 0; P.ks = 0; P.nC = 4; } else { P.nA = LT / 64; P.ks = 0; P.nC = 0; }
        P.band = 0; P.qpos = qrow + F.wave * 32; P.m0 = -INFINITY; P.l0 = 0.f; P.rope = isctx ? 0 : 1; P.rtab = (const LAS float*)(F.lds + ROPE_OFF);
        att::flash_pass<128>(F.shm, P, o, lf);
        att::normalize<128>(o, lf);
        if (m == 0) {
            unsigned long long spa = (unsigned long long)stash; asm volatile("" : "+v"(spa)); GAS f32x4* sp = (GAS f32x4*)spa;
#pragma unroll
            for (int d = 0; d < 4; ++d)
#pragma unroll
                for (int g = 0; g < 4; ++g) sp[(d * 4 + g) * 512] = (f32x4){o[d][4 * g], o[d][4 * g + 1], o[d][4 * g + 2], o[d][4 * g + 3]};
        }
    }
    float ss[16];
#pragma unroll
    for (int r = 0; r < 16; ++r) ss[r] = 0.f;
    { unsigned long long spa = (unsigned long long)stash; asm volatile("" : "+v"(spa)); const GAS f32x4* sp = (const GAS f32x4*)spa;
#pragma unroll
      for (int d = 0; d < 4; ++d)
#pragma unroll
        for (int g = 0; g < 4; ++g) { const f32x4 o0 = sp[(d * 4 + g) * 512];
#pragma unroll
            for (int j = 0; j < 4; ++j) { const float y = o0[j] - lam * o[d][4 * g + j]; o[d][4 * g + j] = y; ss[4 * g + j] += y * y; } } }
#pragma unroll
    for (int r = 0; r < 16; ++r) { const float s = half_sum(ss[r]);
        ss[r] = 1.0f / sqrtf(s * (1.0f / 128.0f) + EPS) * (1.0f - lam_init); }
    const float* sg = a.in[I_SUBLN] + (size_t)l * 128;
    { int ln_ = threadIdx.x & 63; asm volatile("" : "+v"(ln_)); const int r32 = ln_ & 31, hi = ln_ >> 5, lane = ln_;
      LAS bf16_t* stg = (LAS bf16_t*)F.lds + F.wave * 4096;
#pragma unroll
      for (int d = 0; d < 4; ++d) { const float g = sg[32 * d + r32];
#pragma unroll
        for (int r = 0; r < 16; ++r) stg[att::crow(r, hi) * 128 + 32 * d + r32] = (bf16_t)f2bf(o[d][r] * ss[r] * g); }
      LDS_WAIT();
      unsigned long long yba = (unsigned long long)(dq + (brow + qrow + F.wave * 32) * 1024 + h * 128); asm volatile("" : "+v"(yba)); GAS bf16_t* yb = (GAS bf16_t*)yba;
#pragma unroll
      for (int i = 0; i < 8; ++i) { const int row = i * 4 + (lane >> 4), ch = lane & 15; const u32x4 v = *(const LAS u32x4*)(stg + row * 128 + ch * 8); if (!F.dry) *(GAS u32x4*)(yb + row * 1024 + ch * 8) = v; }
      asm volatile("s_waitcnt lgkmcnt(0)\n\ts_barrier" ::: "memory"); }
}
__device__ __forceinline__ void p4_diff(Frame& F, const Args& a, int l, bool ctx_out) {
    const float* lp = a.in[I_DLAM] + (size_t)l * 256;
    const float d01 = wave_sum(lp[F.lane] * lp[64 + F.lane]), d23 = wave_sum(lp[128 + F.lane] * lp[192 + F.lane]);
    const float lam_init = 0.8f - 0.6f * expf(-0.3f * (float)l);
    const float lam = __uint_as_float(__builtin_amdgcn_readfirstlane(__float_as_uint(expf(d01) - expf(d23) + lam_init)));
    const int nun = NB * 8 * 16 + (ctx_out ? NB * 8 : 0);
    const int vcu = (F.G % 8 == 0) ? (F.bid % 8) * (F.G / 8) + F.bid / 8 : F.bid;
    for (int u = vcu; u < nun; u += F.G) {
        if (u < NB * 8 * 16) { const int b = u >> 7, h = (u >> 4) & 7, qb = u & 15; diff_unit(F, a, l, b, h, qb * 256, false, lam, lam_init); }
        else { const int v = u - NB * 8 * 16; diff_unit(F, a, l, v >> 3, v & 7, LS, true, lam, lam_init); }
    }
}
__device__ __forceinline__ void swa_unit(Frame& F, const Args& a, int l, int b, int kvh, int qrow, bool isctx) {
    bf16_t* sq = (bf16_t*)(F.ws + WS_SQ); const bf16_t* sk = (const bf16_t*)(F.ws + WS_SK); const bf16_t* sv = (const bf16_t*)(F.ws + WS_SV);
    const int lane = F.lane, r32 = lane & 31, hi = lane >> 5; const size_t brow = (size_t)b * LT; const int qh = kvh * 4 + (F.wave & 3), rh = F.wave >> 2;
    att::Pass P;
    P.Qw = sq + (brow + qrow + rh * 32) * 1024 + qh * 64; P.ldq = 1024;
    P.Kb = sk + brow * 256 + kvh * 64; P.ldk = 256; P.Vb = sv + brow * 256 + kvh * 64; P.ldv = 256;
    if (isctx) { P.nA = 0; P.ks = 0; P.nC = 4; P.band = 0; }
    else { const int ks = qrow >= 128 ? qrow - 128 : 0, ke = qrow + 192 <= LS ? qrow + 192 : LS; P.ks = ks; P.nA = (ke - ks) >> 6; P.nC = 4; P.band = 1; }
    P.qpos = (isctx ? 0 : qrow) + rh * 32; P.m0 = a.in[I_SINK][l * 16 + qh] * LOG2E; P.l0 = 1.0f; P.rope = isctx ? 0 : 1; P.rtab = (const LAS float*)(F.lds + ROPE_OFF);
    f32x16 o[2], lf;
    att::flash_pass<64>(F.shm, P, o, lf);
    att::normalize<64>(o, lf);
    { int ln_ = threadIdx.x & 63; asm volatile("" : "+v"(ln_)); const int r32 = ln_ & 31, hi = ln_ >> 5, lane = ln_;
      LAS bf16_t* stg = (LAS bf16_t*)F.lds + F.wave * 2048;
#pragma unroll
      for (int d = 0; d < 2; ++d)
#pragma unroll
        for (int r = 0; r < 16; ++r) stg[att::crow(r, hi) * 64 + 32 * d + r32] = (bf16_t)f2bf(o[d][r]);
      LDS_WAIT();
      unsigned long long yba = (unsigned long long)(sq + (brow + qrow + rh * 32) * 1024 + qh * 64); asm volatile("" : "+v"(yba)); GAS bf16_t* yb = (GAS bf16_t*)yba;
#pragma unroll
      for (int i = 0; i < 4; ++i) { const int row = i * 8 + (lane >> 3), ch = lane & 7; const u32x4 v = *(const LAS u32x4*)(stg + row * 64 + ch * 8); if (!F.dry) *(GAS u32x4*)(yb + row * 1024 + ch * 8) = v; }
      asm volatile("s_waitcnt lgkmcnt(0)\n\ts_barrier" ::: "memory"); }
}
__device__ __forceinline__ void p4_swa(Frame& F, const Args& a, int l, bool ctx_out) {
    const int nun = NB * 4 * 64 + (ctx_out ? NB * 4 * 4 : 0);
    const int vcu0 = (F.G % 8 == 0) ? (F.bid % 8) * (F.G / 8) + F.bid / 8 : F.bid;
    const int vcu = F.G - 1 - vcu0;
    for (int u = vcu; u < nun; u += F.G) {
        if (u < NB * 4 * 64) { const int b = u >> 8, kvh = (u >> 6) & 3, qb = u & 63; swa_unit(F, a, l, b, kvh, qb * 64, false); }
        else { const int v = u - NB * 4 * 64; swa_unit(F, a, l, v >> 4, (v >> 2) & 3, LS + (v & 3) * 64, true); }
    }
}
typedef float f32x2 __attribute__((ext_vector_type(2)));
__device__ __forceinline__ float p8_reduce32(const float (&p0)[16], const float (&p1)[16], int lane) {
    float s[16], t[8], u[4], w[2];
#pragma unroll
    for (int e = 0; e < 16; ++e) { const auto r = __builtin_amdgcn_permlane32_swap(__float_as_uint(p0[e]), __float_as_uint(p1[e]), false, false); s[e] = __uint_as_float(r[0]) + __uint_as_float(r[1]); }
#pragma unroll
    for (int e = 0; e < 8; ++e) { const auto r = __builtin_amdgcn_permlane16_swap(__float_as_uint(s[e]), __float_as_uint(s[e + 8]), false, false); t[e] = __uint_as_float(r[0]) + __uint_as_float(r[1]); }
#pragma unroll
    for (int e = 0; e < 4; ++e) {
        const float X = __builtin_bit_cast(float, __builtin_amdgcn_update_dpp(__builtin_bit_cast(int, t[e]), __builtin_bit_cast(int, t[e + 4]), 0x128, 0xf, 0xc, false));
        const float Y = __builtin_bit_cast(float, __builtin_amdgcn_update_dpp(__builtin_bit_cast(int, t[e + 4]), __builtin_bit_cast(int, t[e]), 0x128, 0xf, 0x3, false));
        u[e] = X + Y; }
#pragma unroll
    for (int e = 0; e < 2; ++e) {
        const float X = __builtin_bit_cast(float, __builtin_amdgcn_update_dpp(__builtin_bit_cast(int, u[e]), __builtin_bit_cast(int, u[e + 2]), 0x114, 0xf, 0xa, false));
        const float Y = __builtin_bit_cast(float, __builtin_amdgcn_update_dpp(__builtin_bit_cast(int, u[e + 2]), __builtin_bit_cast(int, u[e]), 0x104, 0xf, 0x5, false));
        w[e] = X + Y; }
    const bool b1 = (lane & 2) != 0;
    const float x = b1 ? w[1] : w[0], y = b1 ? w[0] : w[1];
    float z = x + __builtin_bit_cast(float, __builtin_amdgcn_update_dpp(0, __builtin_bit_cast(int, y), 0x4E, 0xf, 0xf, false));
    z += __builtin_bit_cast(float, __builtin_amdgcn_update_dpp(0, __builtin_bit_cast(int, z), 0xB1, 0xf, 0xf, false));
    return z;
}
__device__ __forceinline__ void p8_norm2_router(Frame& F, const Args& a, int l) {
    float* rwT = (float*)F.shm;
    const float* rw = a.in[I_ROUTER] + (size_t)l * 1024 * 16;
    for (int i = F.tid; i < 16384; i += 512) { const int k = i >> 4, e = i & 15; rwT[e * 1028 + k] = rw[i]; }
    __syncthreads();
    const int gw = F.bid * NWAVES + F.wave, NGW = F.G * NWAVES;
    const bf16_t* xres = (const bf16_t*)(F.ws + WS_XRES); bf16_t* hb = (bf16_t*)(F.ws + WS_H); float* aff = (float*)(F.ws + WS_AFF);
    const float* mods = (const float*)(F.ws + WS_MODS); const float* g2 = a.in[I_N2G] + (size_t)l * 1024;
    const int rpw = (((TROWS + NGW - 1) / NGW) + 1) & ~1, r0 = gw * rpw, r1 = r0 + rpw < TROWS ? r0 + rpw : TROWS;
    static_assert(TROWS % 2 == 0 && LT % 2 == 0 && LS % 2 == 0, "row pairs");
    int myrow, mye;
    { float t0[16], t1[16];
#pragma unroll
      for (int e = 0; e < 16; ++e) { float te = (float)e; asm volatile("" : "+v"(te)); t0[e] = te; t1[e] = te + 100.0f; }
      const int tg = (int)(p8_reduce32(t0, t1, F.lane) * (1.0f / 64.0f) + 0.5f); myrow = tg >= 100 ? 1 : 0; mye = tg - 100 * myrow; }
    f32x4 gq[4], shq[4], sclq[4]; int mr_cur = -1;
#pragma unroll
    for (int j = 0; j < 4; ++j) gq[j] = *(const f32x4*)(g2 + 4 * F.lane + 256 * j);
    u32x2 vn0[4], vn1[4];
    if (r0 < r1) {
#pragma unroll
        for (int j = 0; j < 4; ++j) { vn0[j] = ldxr(xres + (size_t)r0 * 1024 + 4 * F.lane + 256 * j); vn1[j] = ldxr(xres + (size_t)(r0 + 1) * 1024 + 4 * F.lane + 256 * j); } }
    for (int row = r0; row < r1; row += 2) {
        asm volatile("" ::: "memory");
        const int b = row / LT, t = row - b * LT; const int mr = t < LS ? b : 8;
        if (mr != mr_cur) { mr_cur = mr; const float* mrow = mods + ((size_t)l * 9 + mr) * 6144;
#pragma unroll
            for (int j = 0; j < 4; ++j) { shq[j] = *(const f32x4*)(mrow + 3 * 1024 + 4 * F.lane + 256 * j); sclq[j] = *(const f32x4*)(mrow + 4 * 1024 + 4 * F.lane + 256 * j) + 1.0f; } }
        f32x4 v0[4], v1[4]; float ss0 = 0.f, ss1 = 0.f;
#pragma unroll
        for (int j = 0; j < 4; ++j) { v0[j] = cvx4(vn0[j]); v1[j] = cvx4(vn1[j]);
            ss0 += (v0[j][0] * v0[j][0] + v0[j][1] * v0[j][1]) + (v0[j][2] * v0[j][2] + v0[j][3] * v0[j][3]);
            ss1 += (v1[j][0] * v1[j][0] + v1[j][1] * v1[j][1]) + (v1[j][2] * v1[j][2] + v1[j][3] * v1[j][3]); }
        if (row + 2 < r1) {
#pragma unroll
            for (int j = 0; j < 4; ++j) { vn0[j] = ldxr(xres + (size_t)(row + 2) * 1024 + 4 * F.lane + 256 * j); vn1[j] = ldxr(xres + (size_t)(row + 3) * 1024 + 4 * F.lane + 256 * j); } }
        const float rstd0 = 1.0f / sqrtf(wave_sum(ss0) * (1.0f / 1024.0f) + EPS), rstd1 = 1.0f / sqrtf(wave_sum(ss1) * (1.0f / 1024.0f) + EPS);
#pragma unroll
        for (int j = 0; j < 4; ++j) { const int c = 4 * F.lane + 256 * j;
            v0[j] = (v0[j] * rstd0 * gq[j]) * sclq[j] + shq[j]; v1[j] = (v1[j] * rstd1 * gq[j]) * sclq[j] + shq[j];
            u32x2 w; w.x = cvtpk(v0[j][0], v0[j][1]); w.y = cvtpk(v0[j][2], v0[j][3]); *(u32x2*)(hb + (size_t)row * 1024 + c) = w;
            w.x = cvtpk(v1[j][0], v1[j][1]); w.y = cvtpk(v1[j][2], v1[j][3]); *(u32x2*)(hb + (size_t)(row + 1) * 1024 + c) = w; }
        float p0[16], p1[16];
#pragma unroll
        for (int e = 0; e < 16; ++e) { f32x2 a0 = (f32x2){0.f, 0.f}, a1 = a0;
#pragma unroll
            for (int j = 0; j < 4; ++j) { const f32x4 w = *(const f32x4*)(rwT + e * 1028 + 4 * F.lane + 256 * j); const f32x2 wl = (f32x2){w[0], w[1]}, wh = (f32x2){w[2], w[3]};
                a0 += (f32x2){v0[j][0], v0[j][1]} * wl; a0 += (f32x2){v0[j][2], v0[j][3]} * wh;
                a1 += (f32x2){v1[j][0], v1[j][1]} * wl; a1 += (f32x2){v1[j][2], v1[j][3]} * wh; }
            p0[e] = a0[0] + a0[1]; p1[e] = a1[0] + a1[1]; }
        const float lg = p8_reduce32(p0, p1, F.lane);
        const float mx = half_max(lg);
        const float ex = __expf(lg - mx);
        const float den = half_sum(ex) * 0.5f;
        aff[(size_t)(row + myrow) * 16 + mye] = ex / den;
    }
}
__device__ __forceinline__ void p9_topk_gather(Frame& F) {
    unsigned* hist = (unsigned*)F.shm;
    unsigned* sh = hist + 256;
    int* rowlist = (int*)(sh + 32);
    const float* aff = (const float*)(F.ws + WS_AFF); int* slotof = (int*)(F.ws + WS_SLOTOF); float* gate = (float*)(F.ws + WS_GATE);
    int* rowsg = (int*)(F.ws + WS_ROWS);
    for (int item = F.bid; item < 128; item += F.G) {
        const int q = item, part = 0, b = q >> 4, e = q & 15;
#pragma unroll 1
        for (int cx = 0; cx < 2; ++cx) {
            const bool isctx = cx == 1;
            const int N = isctx ? LC : LS, cap = N / 8, per = isctx ? 1 : 8;
            const int rbase = b * LT + (isctx ? LS : 0);
            const bool act = isctx ? (F.tid < 256) : true;
            unsigned key[8];
#pragma unroll
            for (int j = 0; j < 8; ++j) { key[j] = 0u; if (act && j < per) key[j] = __float_as_uint(aff[(size_t)(rbase + F.tid * per + j) * 16 + e]); }
            unsigned prefix = 0u, krem = (unsigned)cap;
#pragma unroll 1
            for (int pass = 3; pass >= 0; --pass) {
                const int shft = pass * 8; const unsigned himask = pass == 3 ? 0u : (0xffffffffu << (shft + 8));
                __syncthreads();
                if (F.tid < 256) hist[F.tid] = 0u;
                __syncthreads();
#pragma unroll
                for (int j = 0; j < 8; ++j) if (act && j < per && (key[j] & himask) == prefix) atomicAdd(&hist[(key[j] >> shft) & 255u], 1u);
                __syncthreads();
                if (F.wave == 0) {
                    const unsigned h0 = hist[4 * F.lane], h1 = hist[4 * F.lane + 1], h2 = hist[4 * F.lane + 2], h3 = hist[4 * F.lane + 3];
                    const unsigned own = h0 + h1 + h2 + h3; unsigned inc = own;
#pragma unroll
                    for (int off = 1; off < 64; off <<= 1) { const unsigned o = __shfl_down(inc, off); if (F.lane + off < 64) inc += o; }
                    const unsigned S = inc - own;
                    if (S < krem && krem <= S + own) {
                        unsigned cum = S; int bin;
                        if (cum + h3 >= krem) bin = 3; else { cum += h3; if (cum + h2 >= krem) bin = 2; else { cum += h2; if (cum + h1 >= krem) bin = 1; else { cum += h1; bin = 0; } } }
                        sh[0] = prefix | ((unsigned)(4 * F.lane + bin) << shft); sh[1] = krem - cum;
                    }
                }
                __syncthreads();
                prefix = sh[0]; krem = sh[1];
            }
            unsigned cg = 0u, ce = 0u;
#pragma unroll
            for (int j = 0; j < 8; ++j) if (act && j < per) { cg += key[j] > prefix ? 1u : 0u; ce += key[j] == prefix ? 1u : 0u; }
            unsigned pk = cg | (ce << 16), inc = pk;
#pragma unroll
            for (int off = 1; off < 64; off <<= 1) { const unsigned o = __shfl_up(inc, off); if (F.lane >= off) inc += o; }
            __syncthreads();
            if (F.lane == 63) sh[16 + F.wave] = inc;
            __syncthreads();
            unsigned base = 0u;
            for (int w = 0; w < F.wave; ++w) base += sh[16 + w];
            unsigned ex = base + inc - pk; unsigned gb = ex & 0xffffu, eb = ex >> 16;
            const int sbase = isctx ? SLOT_L + (e * NB + b) * CAP_C : (e * NB + b) * CAP_L;
#pragma unroll
            for (int j = 0; j < 8; ++j) if (act && j < per) {
                const int row = rbase + F.tid * per + j; int slot = -1;
                if (key[j] > prefix) { slot = (int)(gb + (eb < krem ? eb : krem)); gb++; }
                else if (key[j] == prefix) { if (eb < krem) slot = (int)(gb + eb); eb++; }
                if (slot >= 0) { rowlist[slot] = row; if (part == 0) gate[sbase + slot] = __uint_as_float(key[j]); slot += sbase; }
                if (part == 0) slotof[(size_t)row * 16 + e] = slot;
            }
            __syncthreads();
            if (part == 0) { for (int s0 = 4 * F.tid; s0 < cap; s0 += 4 * 512) *(u32x4*)(rowsg + sbase + s0) = *(const u32x4*)(rowlist + s0); }
        }
    }
}
constexpr int PPL = 12;
constexpr int NPHASE = 1 + DEPTH * PPL + 1;

__device__ __forceinline__ void phase_stagger(int nunits, int G, int c, int unit_ticks) {
#ifndef MK_NOSTAGGER
    const int rem = nunits % G;
    if (rem == 0 || c < rem) return;
    const int g = ((c - rem) >> 3) % 3 + 1;
    const unsigned long long t0 = __builtin_amdgcn_s_memrealtime(); const unsigned long long d = (unsigned long long)(g * unit_ticks / 4);
    while (__builtin_amdgcn_s_memrealtime() - t0 < d) __builtin_amdgcn_s_sleep(8);
#endif
}

__global__ void __launch_bounds__(NWAVES * 64, 2) mk_fwd(Args args) {
    extern __shared__ __attribute__((aligned(16))) unsigned char lds[];
    Frame F;
    F.lds = (LAS unsigned char*)lds; F.shm = (char*)lds;
    F.tid = threadIdx.x; F.lane = F.tid & 63; F.wave = __builtin_amdgcn_readfirstlane(F.tid >> 6);
    F.G = gridDim.x; F.bid = blockIdx.x; F.ws = args.ws; F.outb = (unsigned char*)args.out; F.dry = 0;
    volatile LAS unsigned* MISC = (volatile LAS unsigned*)(F.lds + MISC_OFF);
    for (int u = F.tid; u < (LDS_BYTES - LDSCTL_OFF) / 4; u += NWAVES * 64) ((LAS unsigned*)(F.lds + LDSCTL_OFF))[u] = 0u;
    __syncthreads();
    { LAS float* rt_ = (LAS float*)(F.lds + ROPE_OFF);
      for (int i = F.tid; i < 1024; i += NWAVES * 64) { const int pos = i >> 4, f = i & 15; const float inv = __builtin_amdgcn_exp2f(-(float)f * (13.287712379549449f / 16.0f));
          const float rev = (float)pos * inv * 0.15915494309189535f; rt_[i] = cos_rev(rev); rt_[1024 + i] = sin_rev(rev); } }
    __syncthreads();
    unsigned* ctl = (unsigned*)(F.ws + WS_CTL);
    const int lo = args.ph_lo, hi = args.ph_hi;
    XcdBarrier bar; bar.bar = ctl + CW_BAR; bar.x = 0; bar.st = nullptr;
    if (hi - lo > 1) bar = xcd_barrier_post(ctl + CW_BAR, MISC + 8);
#ifdef MK_ONLY
#define PHON(j) ((j) == MK_ONLY)
#else
#define PHON(j) true
#endif
#define IN(k) (lo <= (k) && (k) < hi)
#ifndef MK_DUP
#define MK_DUP 0
#endif
#define NREP(bit) (((MK_DUP >> (bit)) & 1) ? 2 : 1)
#define REP(bit) _Pragma("unroll 1") for (int rep = 0; rep < NREP(bit); ++rep)
#define REPEND(bit) do { if (rep + 1 < NREP(bit)) xcd_barrier(bar); } while (0)
#define DRY(bit) (rep + 1 < NREP(bit))
#define LOCALF Frame Fp = F; Fp.tid = threadIdx.x; asm volatile("" : "+v"(Fp.tid)); Fp.lane = Fp.tid & 63
#define SEAM(k) do { if (IN((k) + 1)) xcd_barrier(bar); } while (0)
#define STAMP(k) do { } while (0)

    if (PHON(100) && IN(0)) { STAMP(0); REP(12) { LOCALF; p0_mods_zfeat(Fp, args); REPEND(12); } SEAM(0); }

    for (int l = 0; l < DEPTH; ++l) {
        const int pb = 1 + l * PPL;
        const float* mods_l = (const float*)(F.ws + WS_MODS) + (size_t)l * 9 * 6144;
        const int lastl = l == DEPTH - 1;
        const int wpar = (args.wdb && (l & 1)) ? 1 : 0;
        const bool W_AHEAD = F.G >= 256 && lo == 0 && hi == NPHASE;
        const bool FILT_AHEAD = F.G >= 256 && lo == 0 && hi == NPHASE;
        if (PHON(0) && IN(pb + 0)) { STAMP(pb + 0);
#ifndef MK_SUB0
#define MK_SUB0 7
#endif
            REP(0) { LOCALF; Fp.dry = DRY(0);
#ifndef MK_DRYSUB0
#define MK_DRYSUB0 7
#endif
            const int sub0 = Fp.dry ? MK_DRYSUB0 : MK_SUB0;
            if (sub0 & 1) { p1_weights(Fp, args, l, (l > 0 && W_AHEAD) ? (args.wdb ? W_NITEMS : WB_END) : 0, W_NITEMS, wpar); __syncthreads(); }
            if ((sub0 & 2) && !(l > 0 && FILT_AHEAD)) { p1_filters(Fp, args, l); __syncthreads(); }
            if (sub0 & 4) { p1_norm1(Fp, args, l); }
            REPEND(0); }
            SEAM(pb + 0); }
        if (PHON(1) && IN(pb + 1)) { STAMP(pb + 1);
            pg8::SchedPlain S; S.init((const bf16_t*)(F.ws + WS_H), (const bf16_t*)(F.ws + WS_WIN), TROWS, DIN, 1024, F.G, F.bid, lastl ? 2 : 0);
            pg8::EpiProj E; E.ws = F.ws; E.rope = (const LAS float*)(F.lds + ROPE_OFF);
            REP(1) { E.dry = DRY(1); pg8::gemm_phase<pg8::EpiProj, pg8::SchedPlain>(F.lds, 1024, S, E); REPEND(1); }
            if (!lastl && W_AHEAD && args.wdb && F.bid >= 80) { LOCALF; Fp.bid -= 80; Fp.G = 176; __syncthreads(); p1_weights(Fp, args, l + 1, WB_END, WB_END + 11264, wpar ^ 1); }
            SEAM(pb + 1);
        }
        if (PHON(2) && IN(pb + 2)) { STAMP(pb + 2); REP(2) { LOCALF; Fp.dry = DRY(2); p3_hyena_pre(Fp, args, l); REPEND(2); } SEAM(pb + 2); }
        if (PHON(3) && IN(pb + 3)) { STAMP(pb + 3);
#ifndef MK_SUB
#define MK_SUB 15
#endif
            if (MK_SUB & 1) { REP(3) { LOCALF; Fp.dry = DRY(3); p4_diff(Fp, args, l, !lastl); __syncthreads(); REPEND(3); } }
            if (MK_SUB & 2) { REP(4) { LOCALF; Fp.dry = DRY(4); p4_swa(Fp, args, l, !lastl); __syncthreads(); REPEND(4); } }
#ifndef MK_DRYSUB
#define MK_DRYSUB 15
#endif
            REP(5) { const int subs = DRY(5) ? MK_DRYSUB : MK_SUB;
            if (subs & 4) { LOCALF; p4_hyena_lat(Fp, args, l); __syncthreads(); }
            if ((subs & 8) && !lastl) { LOCALF; p4_hyena_ctx(Fp, args, l); } REPEND(5); }
            SEAM(pb + 3); }
        {
            const bool piggy = !lastl && F.G >= 128 && IN(pb + 4) && IN(pb + 5);
#pragma unroll 1
            for (int sub = 0; sub < 2; ++sub) {
                if (!(PHON(4 + sub) && IN(pb + 4 + sub))) continue;
                STAMP(pb + 4 + sub);
                const bool gemm_here = sub == 1 || (piggy && F.bid < 32);
                if (sub == 0 && !gemm_here) { LOCALF; if (piggy) { Fp.bid -= 32; Fp.G -= 32; } p5_hyena_post(Fp, args, l);
                    if (piggy && FILT_AHEAD) { __syncthreads(); p1_filters(Fp, args, l + 1, 0, 224); } }
                if (gemm_here) {
                    pg8::SchedBranch S; S.ws = (const char*)F.ws; S.B = (const char*)(F.ws + WS_WBR); S.tstep = (size_t)256 * 1024 * 2; S.bstep = (size_t)1024 * 1024 * 2;
                    if (sub == 0) { S.latonly = 2; S.T.init(NB, 4); S.G = 32; S.c = F.bid; }
                    else { const int lo_ = (lastl || piggy) ? 1 : 0; S.latonly = lo_; S.T.init(lo_ ? NB * 16 : TROWS / 256, 4); S.G = F.G; S.c = F.bid; }
                    pg8::EpiBranch E; E.ws = F.ws; static_assert(WS_MERGED == OFF_DK && WS_GT == OFF_GT, "branch epilogue offsets");
                    pg8::gemm_phase<pg8::EpiBranch, pg8::SchedBranch>(F.lds, 1024, S, E);
                }
                SEAM(pb + 4 + sub);
            }
        }
        if (PHON(6) && IN(pb + 6)) { STAMP(pb + 6);
            pg8::SchedPlain S; S.init((const bf16_t*)(F.ws + WS_MERGED), (const bf16_t*)(F.ws + WS_WOUT), TROWS, 1024, 1024, F.G, F.bid, lastl);
            pg8::EpiResid E; E.xres = (bf16_t*)(F.ws + WS_XRES); E.mod = mods_l;
            REP(8) { E.dry = DRY(8); pg8::gemm_phase<pg8::EpiResid, pg8::SchedPlain>(F.lds, 1024, S, E); REPEND(8); }
            if (!lastl && FILT_AHEAD && F.bid >= 224) { LOCALF; Fp.bid -= 224; Fp.G = 32; __syncthreads(); p1_filters(Fp, args, l + 1, 224, 256); }
            else if (!lastl && W_AHEAD && F.bid >= 32) { LOCALF; Fp.bid -= 32; Fp.G = 192; __syncthreads(); p1_weights(Fp, args, l + 1, 0, WA_END); }
            SEAM(pb + 6);
        }
        if (PHON(7) && IN(pb + 7)) { STAMP(pb + 7); REP(9) { LOCALF; p8_norm2_router(Fp, args, l); REPEND(9); } SEAM(pb + 7); }
        if (PHON(8) && IN(pb + 8)) { STAMP(pb + 8); REP(14) { LOCALF; p9_topk_gather(Fp); REPEND(14); } SEAM(pb + 8); }
        if (PHON(9) && IN(pb + 9)) { STAMP(pb + 9); }
        if (PHON(10) && IN(pb + 10)) { STAMP(pb + 10);
            pg8::SchedMoeG S; S.T.init(lastl ? SLOT_L / 256 : SLOTS / 256, 8); S.G = F.G; S.c = F.bid; S.A = (const char*)(F.ws + WS_H); S.rows = (const int*)(F.ws + WS_ROWS); S.B = (const char*)(F.ws + WS_W13); S.tstep = (size_t)256 * 1024 * 2; S.estep = (size_t)2048 * 1024 * 2; S.Bhi = wpar ? (const char*)(F.ws + WS_W13B) - (size_t)8 * S.estep : S.B;
            pg8::EpiSwiglu E; E.hid = (bf16_t*)(F.ws + WS_HID);
            REP(10) { pg8::gemm_phase<pg8::EpiSwiglu, pg8::SchedMoeG>(F.lds, 1024, S, E); REPEND(10); }
            if (!lastl && W_AHEAD && args.wdb && F.bid >= 128) { LOCALF; Fp.bid -= 128; Fp.G = 128; __syncthreads(); p1_weights(Fp, args, l + 1, WB_END + 11264, W_NITEMS, wpar ^ 1); }
            SEAM(pb + 10);
        }
        if (PHON(11) && IN(pb + 11)) { STAMP(pb + 11);
            pg8::SchedMoe S; S.T.init(lastl ? SLOT_L / 256 : SLOTS / 256, 4); S.G = F.G; S.c = F.bid; S.A = (const char*)(F.ws + WS_HID); S.B = (const char*)(F.ws + (wpar ? WS_W2B : WS_W2)); S.tstep = (size_t)256 * 1024 * 2; S.estep = (size_t)1024 * 1024 * 2;
            pg8::EpiRowScale E; E.out = (bf16_t*)(F.ws + WS_XG); E.gate = (const float*)(F.ws + WS_GATE);
            REP(11) { pg8::gemm_phase<pg8::EpiRowScale, pg8::SchedMoe>(F.lds, 1024, S, E); REPEND(11); }
            if (!lastl && W_AHEAD && F.bid >= 64) { LOCALF; Fp.bid -= 64; Fp.G = 192; __syncthreads(); p1_weights(Fp, args, l + 1, WA_END, WB_END); }
            SEAM(pb + 11);
        }
    }
    if (PHON(101) && IN(NPHASE - 1)) { STAMP(NPHASE - 1); REP(13) { LOCALF; pf_final(Fp, args); REPEND(13); }
    }
#undef IN
#undef SEAM
}

extern "C" void kernel_launch(void* const* d_in, const int* in_sizes, int n_in, void* d_out, int out_size, void* d_ws, size_t ws_size, hipStream_t stream) {
    static int grid = 0;
    if (grid == 0) {
        if (n_in != 28 || out_size != NB * LS * D || ws_size < WS_TOTAL) { fprintf(stderr, "kernel_launch: unexpected shapes (n_in %d out %d ws %zu need %zu)\n", n_in, out_size, ws_size, (size_t)WS_TOTAL); grid = -1; return; }
        int dev = 0, cus = 0, per_cu = 0;
        if (hipGetDevice(&dev) != hipSuccess || hipDeviceGetAttribute(&cus, hipDeviceAttributeMultiprocessorCount, dev) != hipSuccess) { grid = -1; return; }
        if (hipFuncSetAttribute((const void*)mk_fwd, hipFuncAttributeMaxDynamicSharedMemorySize, LDS_BYTES) != hipSuccess) { fprintf(stderr, "kernel_launch: hipFuncSetAttribute failed\n"); grid = -1; return; }
        if (hipOccupancyMaxActiveBlocksPerMultiprocessor(&per_cu, (const void*)mk_fwd, NWAVES * 64, LDS_BYTES) != hipSuccess || per_cu < 1) { fprintf(stderr, "kernel_launch: occupancy query says %d\n", per_cu); }
        (void)hipGetLastError();
        grid = cus;
    }
    if (grid < 0) return;
    if (hipMemsetAsync((char*)d_ws + WS_CTL, 0, CTL_ZERO_BYTES, stream) != hipSuccess) return;
    Args a{};
    for (int i = 0; i < 28; ++i) a.in[i] = (const float*)d_in[i];
    a.out = (float*)d_out; a.ws = (unsigned char*)d_ws; a.wdb = ws_size >= WS_TOTAL_DB ? 1 : 0;
#if MK_N_LAUNCHES == 1
    a.ph_lo = 0; a.ph_hi = NPHASE;
    hipLaunchKernelGGL(mk_fwd, dim3(grid), dim3(NWAVES * 64), LDS_BYTES, stream, a);
#else
    for (int p = 0; p < NPHASE; ++p) { a.ph_lo = p; a.ph_hi = p + 1; hipLaunchKernelGGL(mk_fwd, dim3(grid), dim3(NWAVES * 64), LDS_BYTES, stream, a); }
#endif
}
```
